# Optimizing an MI355X kernel written in HIP

```python
import jax
import jax.numpy as jnp
from jax import lax
import numpy as np

D_MODEL = 2048
BATCH = 8
SEQ = 2048
DEPTH = 4

HEAD_DIM = 128
N_HEADS = D_MODEL // HEAD_DIM
A_HEADS = N_HEADS // 4
B_HEADS = N_HEADS // 4
C_HEADS = N_HEADS - A_HEADS - B_HEADS
IDX_HEADS = 16
IDX_DIM = 64
DSA_TOPK_MAX = 256
DILATED_PATTERNS = ((128, 1), (512, 4), (2048, 16))
C_KV_GROUPS = 2
C_GROUP_SIZE = C_HEADS // C_KV_GROUPS
CMP_BLOCK = 32
CMP_STRIDE = 16
CMP_HIDDEN = 256
SEL_BLOCK = 64
SEL_COUNT = 16
WIN_SIZE = 512
BAND_BLOCK = 128
Q_BLOCK = 128
SEL_Q_CHUNK = 32
D_FF = ((8 * D_MODEL + 2) // 3 + 255) // 256 * 256
ROPE_THETA = 10000.0
RMS_EPS = 1e-6
ATTN_SCALE = HEAD_DIM ** -0.5

IN_WIDTHS = (
    A_HEADS * HEAD_DIM, HEAD_DIM, HEAD_DIM,
    IDX_HEADS * IDX_DIM, IDX_DIM, IDX_HEADS,
    B_HEADS * HEAD_DIM, B_HEADS * HEAD_DIM, B_HEADS * HEAD_DIM,
    C_HEADS * HEAD_DIM,
    C_KV_GROUPS * HEAD_DIM, C_KV_GROUPS * HEAD_DIM,
    C_KV_GROUPS * HEAD_DIM, C_KV_GROUPS * HEAD_DIM,
    C_KV_GROUPS * HEAD_DIM, C_KV_GROUPS * HEAD_DIM,
    3 * C_HEADS,
)
IN_WIDTH = sum(IN_WIDTHS)

kernel_name = "hybrid_dsa_dilated_nsa_block"


def rms_norm(x, g):
    xf = x.astype(jnp.float32)
    y = xf * lax.rsqrt(jnp.mean(xf * xf, axis=-1, keepdims=True) + RMS_EPS)
    return (y * g.astype(jnp.float32)).astype(x.dtype)


def rope_tables(seq_len, dim):
    inv = 1.0 / (ROPE_THETA ** (jnp.arange(0, dim, 2, dtype=jnp.float32) / dim))
    ang = jnp.arange(seq_len, dtype=jnp.float32)[:, None] * inv[None, :]
    return jnp.cos(ang), jnp.sin(ang)


def apply_rope(x, cos, sin):
    xf = x.astype(jnp.float32)
    x1, x2 = jnp.split(xf, 2, axis=-1)
    return jnp.concatenate([x1 * cos - x2 * sin, x2 * cos + x1 * sin], axis=-1).astype(x.dtype)


def banded_attention(q, k, v, max_dist, blk):
    n, r, length, dh = q.shape
    nb = length // blk
    n_prev = -(-max_dist // blk)
    pad = ((0, 0), (n_prev * blk, 0), (0, 0))
    kb = jnp.pad(k, pad).reshape(n, nb + n_prev, blk, dh)
    vb = jnp.pad(v, pad).reshape(n, nb + n_prev, blk, dh)
    kw = jnp.concatenate([kb[:, i:i + nb] for i in range(n_prev + 1)], axis=2)
    vw = jnp.concatenate([vb[:, i:i + nb] for i in range(n_prev + 1)], axis=2)
    width = (n_prev + 1) * blk
    qb = q.reshape(n, r, nb, blk, dh)
    s = jnp.einsum('nrbqd,nbkd->nrbqk', qb, kw).astype(jnp.float32) * dh ** -0.5
    dist = n_prev * blk + jnp.arange(blk)[:, None] - jnp.arange(width)[None, :]
    kglob = (jnp.arange(nb)[:, None] - n_prev) * blk + jnp.arange(width)[None, :]
    mask = ((dist >= 0) & (dist <= max_dist))[None] & (kglob >= 0)[:, None, :]
    s = jnp.where(mask, s, -jnp.inf)
    mx = jnp.max(s, axis=-1, keepdims=True)
    e = jnp.exp(s - mx)
    den = jnp.sum(e, axis=-1, keepdims=True)
    o = jnp.einsum('nrbqk,nbkd->nrbqd', e, vw.astype(jnp.float32)) / den
    lse = (mx + jnp.log(den))[..., 0]
    return o.reshape(n, r, length, dh), lse.reshape(n, r, length)


def dilated_attention(q, k, v, window, dilation):
    b, h, s, dh = q.shape
    unit = dilation * BAND_BLOCK
    s_pad = -(-s // unit) * unit
    m = s_pad // dilation

    def split(t):
        t = jnp.pad(t, ((0, 0), (0, 0), (0, s_pad - s), (0, 0)))
        return t.reshape(b, h, m, dilation, dh).transpose(0, 1, 3, 2, 4).reshape(b * h * dilation, m, dh)

    o, lse = banded_attention(split(q)[:, None], split(k), split(v), window // dilation, BAND_BLOCK)
    o = o.reshape(b, h, dilation, m, dh).transpose(0, 1, 3, 2, 4).reshape(b, h, s_pad, dh)[:, :, :s]
    lse = lse.reshape(b, h, dilation, m).transpose(0, 1, 3, 2).reshape(b, h, s_pad)[:, :, :s]
    return o, lse


def dilated_mixture(q, k, v):
    outs, lses = [], []
    for window, dilation in DILATED_PATTERNS:
        o, lse = dilated_attention(q, k, v, window, dilation)
        outs.append(o)
        lses.append(lse)
    wts = jax.nn.softmax(jnp.stack(lses, axis=0), axis=0)
    return jnp.sum(wts[..., None] * jnp.stack(outs, axis=0), axis=0)


def dsa_attention(q, k, v, iq, ik, iw):
    b, ha, s, dh = q.shape
    topk = min(DSA_TOPK_MAX, s // 4)
    n_blocks = s // Q_BLOCK
    kpos = jnp.arange(s)
    bi = jnp.arange(b)[:, None, None]
    iwf = iw.astype(jnp.float32) * IDX_HEADS ** -0.5

    def block(i):
        start = i * Q_BLOCK
        qb = lax.dynamic_slice_in_dim(q, start, Q_BLOCK, axis=2)
        iqb = lax.dynamic_slice_in_dim(iq, start, Q_BLOCK, axis=2)
        iwb = lax.dynamic_slice_in_dim(iwf, start, Q_BLOCK, axis=1)
        qpos = start + jnp.arange(Q_BLOCK)
        logits = jnp.einsum('bhqd,bsd->bhqs', iqb, ik).astype(jnp.float32) * IDX_DIM ** -0.5
        score = jnp.einsum('bhqs,bqh->bqs', jax.nn.relu(logits), iwb)
        score = jnp.where((kpos[None, :] <= qpos[:, None])[None], score, -jnp.inf)
        _, idx = lax.top_k(score, topk)
        kg = k[bi, idx]
        vg = v[bi, idx]
        valid = idx <= qpos[None, :, None]
        sc = jnp.einsum('bhqd,bqkd->bhqk', qb, kg).astype(jnp.float32) * ATTN_SCALE
        p = jax.nn.softmax(jnp.where(valid[:, None], sc, -jnp.inf), axis=-1)
        return jnp.einsum('bhqk,bqkd->bhqd', p, vg.astype(jnp.float32))

    o = lax.map(block, jnp.arange(n_blocks))
    return o.transpose(1, 2, 0, 3, 4).reshape(b, ha, s, dh)


def compress_blocks(x, pe, w1, w2):
    b, g, s, dh = x.shape
    ratio = CMP_BLOCK // CMP_STRIDE
    chunks = x.reshape(b, g, s // CMP_STRIDE, CMP_STRIDE, dh)
    n_cmp = s // CMP_STRIDE - ratio + 1
    blocks = jnp.concatenate([chunks[:, :, j:j + n_cmp] for j in range(ratio)], axis=3)
    flat = (blocks + pe).reshape(b, g, n_cmp, CMP_BLOCK * dh)
    return jax.nn.gelu(flat @ w1) @ w2


def selected_block_attention(q, k, v, sel):
    b, g, r, s, dh = q.shape
    n_sel = sel.shape[-1]
    n_chunk = s // SEL_Q_CHUNK
    kb = k.reshape(b, g, s // SEL_BLOCK, SEL_BLOCK, dh)
    vb = v.reshape(b, g, s // SEL_BLOCK, SEL_BLOCK, dh)
    qc = q.reshape(b, g, r, n_chunk, SEL_Q_CHUNK, dh).transpose(3, 0, 1, 2, 4, 5)
    selc = sel.reshape(b, g, n_chunk, SEL_Q_CHUNK, n_sel).transpose(2, 0, 1, 3, 4)
    bi = jnp.arange(b)[:, None, None, None]
    gi = jnp.arange(g)[None, :, None, None]
    offs = jnp.arange(SEL_BLOCK)

    def chunk(args):
        qx, sx, ci = args
        kg = kb[bi, gi, sx].reshape(b, g, SEL_Q_CHUNK, n_sel * SEL_BLOCK, dh)
        vg = vb[bi, gi, sx].reshape(b, g, SEL_Q_CHUNK, n_sel * SEL_BLOCK, dh)
        kpos = (sx[..., None] * SEL_BLOCK + offs).reshape(b, g, SEL_Q_CHUNK, n_sel * SEL_BLOCK)
        qpos = ci * SEL_Q_CHUNK + jnp.arange(SEL_Q_CHUNK)
        valid = kpos <= qpos[None, None, :, None]
        sc = jnp.einsum('bgrqd,bgqkd->bgrqk', qx, kg).astype(jnp.float32) * ATTN_SCALE
        p = jax.nn.softmax(jnp.where(valid[:, :, None], sc, -jnp.inf), axis=-1)
        return jnp.einsum('bgrqk,bgqkd->bgrqd', p, vg.astype(jnp.float32))

    o = lax.map(chunk, (qc, selc, jnp.arange(n_chunk)))
    return o.transpose(1, 2, 3, 0, 4, 5).reshape(b, g, r, s, dh)


def nsa_attention(q, k_cmp, v_cmp, k_slc, v_slc, k_win, v_win, gate_logits, cos, sin,
                  pe_k, w1_k, w2_k, pe_v, w1_v, w2_v):
    b, hc, s, dh = q.shape
    g, r = C_KV_GROUPS, C_GROUP_SIZE
    qg = q.reshape(b, g, r, s, dh)
    t = jnp.arange(s)

    kc = compress_blocks(k_cmp, pe_k, w1_k, w2_k)
    vc = compress_blocks(v_cmp, pe_v, w1_v, w2_v)
    n_cmp = kc.shape[2]
    sc = jnp.einsum('bgrsd,bgcd->bgrsc', qg, kc).astype(jnp.float32) * ATTN_SCALE
    cmp_end = jnp.arange(n_cmp) * CMP_STRIDE + CMP_BLOCK - 1
    cmask = cmp_end[None, :] <= t[:, None]
    sc = jnp.where(cmask, sc, -jnp.inf)
    mx = jnp.max(sc, axis=-1, keepdims=True)
    mx = jnp.where(jnp.isfinite(mx), mx, 0.0)
    e = jnp.where(cmask, jnp.exp(sc - mx), 0.0)
    den = jnp.sum(e, axis=-1, keepdims=True)
    p_cmp = e / jnp.where(den > 0, den, 1.0)
    o_cmp = jnp.einsum('bgrsc,bgcd->bgrsd', p_cmp, vc.astype(jnp.float32))

    n_slc = s // SEL_BLOCK
    c_start = np.arange(n_cmp) * CMP_STRIDE
    n_start = np.arange(n_slc) * SEL_BLOCK
    intersect = ((c_start[:, None] < n_start[None, :] + SEL_BLOCK)
                 & (c_start[:, None] + CMP_BLOCK > n_start[None, :])).astype(np.float32)
    imp = jnp.einsum('bgrsc,cn->bgsn', p_cmp, jnp.asarray(intersect))
    blk = jnp.arange(n_slc)[None, :]
    cur = (t // SEL_BLOCK)[:, None]
    admissible = blk <= cur
    forced = (blk == 0) | (blk == cur) | (blk == cur - 1)
    imp = jnp.where(admissible, jnp.where(forced, jnp.inf, imp), -jnp.inf)
    _, sel = lax.top_k(imp, min(SEL_COUNT, n_slc))
    qr = apply_rope(qg, cos, sin)
    o_slc = selected_block_attention(qr, apply_rope(k_slc, cos, sin), v_slc, sel)

    o_win, _ = banded_attention(qr.reshape(b * g, r, s, dh),
                                apply_rope(k_win, cos, sin).reshape(b * g, s, dh),
                                v_win.reshape(b * g, s, dh), WIN_SIZE - 1, BAND_BLOCK)
    o_win = o_win.reshape(b, g, r, s, dh)

    gates = jax.nn.sigmoid(gate_logits.astype(jnp.float32)).reshape(b, s, g, r, 3)
    gates = gates.transpose(4, 0, 2, 3, 1)[..., None]
    o = gates[0] * o_cmp + gates[1] * o_slc + gates[2] * o_win
    return o.reshape(b, hc, s, dh)


def setup_inputs(seed: int = 0) -> dict:
    key = jax.random.key(seed)
    ks = jax.random.split(key, 16)
    f32 = jnp.float32

    def nrm(k, shape, fan_in):
        return jax.random.normal(k, shape, f32) * fan_in ** -0.5

    def gain(k):
        return 1.0 + 0.05 * jax.random.normal(k, (DEPTH, D_MODEL), f32)

    flat_cmp = CMP_BLOCK * HEAD_DIM
    mix_width = N_HEADS * HEAD_DIM
    return {
        'x': jax.random.normal(ks[0], (BATCH, SEQ, D_MODEL), f32),
        'w_in': nrm(ks[1], (DEPTH, D_MODEL, IN_WIDTH), D_MODEL),
        'w_out': nrm(ks[2], (DEPTH, mix_width, D_MODEL), mix_width),
        'cmp_pe_k': 0.1 * jax.random.normal(ks[3], (DEPTH, CMP_BLOCK, HEAD_DIM), f32),
        'cmp_w1_k': nrm(ks[4], (DEPTH, flat_cmp, CMP_HIDDEN), flat_cmp),
        'cmp_w2_k': nrm(ks[5], (DEPTH, CMP_HIDDEN, HEAD_DIM), CMP_HIDDEN),
        'cmp_pe_v': 0.1 * jax.random.normal(ks[6], (DEPTH, CMP_BLOCK, HEAD_DIM), f32),
        'cmp_w1_v': nrm(ks[7], (DEPTH, flat_cmp, CMP_HIDDEN), flat_cmp),
        'cmp_w2_v': nrm(ks[8], (DEPTH, CMP_HIDDEN, HEAD_DIM), CMP_HIDDEN),
        'w_gate': nrm(ks[9], (DEPTH, D_MODEL, D_FF), D_MODEL),
        'w_up': nrm(ks[10], (DEPTH, D_MODEL, D_FF), D_MODEL),
        'w_down': nrm(ks[11], (DEPTH, D_FF, D_MODEL), D_FF),
        'g_pre_mix': gain(ks[12]),
        'g_post_mix': gain(ks[13]),
        'g_pre_ffn': gain(ks[14]),
        'g_post_ffn': gain(ks[15]),
    }


def reference(x, w_in, w_out, cmp_pe_k, cmp_w1_k, cmp_w2_k, cmp_pe_v, cmp_w1_v, cmp_w2_v,
              w_gate, w_up, w_down, g_pre_mix, g_post_mix, g_pre_ffn, g_post_ffn):
    b, s, _ = x.shape
    cos, sin = rope_tables(s, HEAD_DIM)
    icos, isin = rope_tables(s, IDX_DIM)
    splits = [int(v) for v in np.cumsum(IN_WIDTHS)[:-1]]

    def heads(t, n):
        return t.reshape(b, s, n, -1).transpose(0, 2, 1, 3)

    def merge(o):
        return o.transpose(0, 2, 1, 3).reshape(b, s, -1)

    for layer in range(DEPTH):
        h = rms_norm(x, g_pre_mix[layer])
        (a_q, a_k, a_v, i_q, i_k, i_w, b_q, b_k, b_v, c_q,
         c_kc, c_vc, c_ks, c_vs, c_kw, c_vw, c_g) = jnp.split(h @ w_in[layer], splits, axis=-1)

        o_a = dsa_attention(apply_rope(heads(a_q, A_HEADS), cos, sin),
                            apply_rope(a_k, cos, sin), a_v,
                            apply_rope(heads(i_q, IDX_HEADS), icos, isin),
                            apply_rope(i_k, icos, isin), i_w)
        o_b = dilated_mixture(apply_rope(heads(b_q, B_HEADS), cos, sin),
                              apply_rope(heads(b_k, B_HEADS), cos, sin),
                              heads(b_v, B_HEADS))
        o_c = nsa_attention(heads(c_q, C_HEADS),
                            heads(c_kc, C_KV_GROUPS), heads(c_vc, C_KV_GROUPS),
                            heads(c_ks, C_KV_GROUPS), heads(c_vs, C_KV_GROUPS),
                            heads(c_kw, C_KV_GROUPS), heads(c_vw, C_KV_GROUPS),
                            c_g, cos, sin,
                            cmp_pe_k[layer], cmp_w1_k[layer], cmp_w2_k[layer],
                            cmp_pe_v[layer], cmp_w1_v[layer], cmp_w2_v[layer])

        mixed = jnp.concatenate([merge(o_a), merge(o_b), merge(o_c)], axis=-1).astype(x.dtype)
        x = x + rms_norm(mixed @ w_out[layer], g_post_mix[layer])

        h = rms_norm(x, g_pre_ffn[layer])
        f = (jax.nn.silu(h @ w_gate[layer]) * (h @ w_up[layer])) @ w_down[layer]
        x = x + rms_norm(f, g_post_ffn[layer])
    return x
```

```cpp
#include <hip/hip_runtime.h>
#include <cstdio>
namespace pg8 {
#define PG8_LAS __attribute__((address_space(3)))
typedef unsigned short bf16_t;
typedef short bf16x8 __attribute__((ext_vector_type(8)));
typedef float f32x4 __attribute__((ext_vector_type(4)));
typedef unsigned u32x4 __attribute__((ext_vector_type(4)));
constexpr int BM = 256, BK = 64, HALF = 128, HTB = HALF * BK * 2  , STAGE_BYTES = 8 * HTB, NXCD = 8, WGM = 8;

__host__ __device__ __forceinline__ int lds_byte(int r, int c) { const int st = (r >> 4) * 2 + (c >> 5), rr = r & 15, cc = c & 31, ob = rr * 64 + cc * 2; return st * 1024 + (ob ^ (((ob >> 9) & 1) << 5)); }
__host__ __device__ __forceinline__ void stage_rc(int b, int& R, int& C) { const int st = b / 1024, sb = b % 1024, swz = sb ^ (((sb >> 9) & 1) << 5); R = (st >> 1) * 16 + swz / 64; C = (st & 1) * 32 + (swz % 64) / 2; }
__host__ __device__ __forceinline__ int perm32(int rho) { const int n = rho >> 4, i = rho & 15; return 8 * (i >> 2) + 4 * n + (i & 3); }

struct Unit { int pm, pn; };
struct Gemm { const bf16_t* A; const bf16_t* Bt; int M, N, K; };

struct StaticOrder {
    int nM, nN, nwg, G, c;
    __host__ __device__ void init(int M, int N, int G_, int c_) { nM = M / BM; nN = N / BM; nwg = nM * nN; G = G_; c = c_; }
    __host__ __device__ bool next(int i, Unit& u) const {
        const long L = (long)i * G + c; if (L >= nwg) return false;
        int wgid = (int)L; { const int q = nwg / NXCD, r = nwg % NXCD, xcd = wgid % NXCD, off = wgid / NXCD; wgid = (xcd < r ? xcd * (q + 1) : r * (q + 1) + (xcd - r) * q) + off; }
        const int nig = WGM * nN, gid = wgid / nig, fm = gid * WGM, gsz = (nM - fm) < WGM ? (nM - fm) : WGM;
        u.pm = fm + ((wgid % nig) % gsz); u.pn = (wgid % nig) / gsz; return true;
    }
    __device__ __forceinline__ void a_ready(const Unit&) const {}
    __device__ __forceinline__ void done(const Unit&) const {}
};
struct CountedOrder : StaticOrder {
    const unsigned* ready; unsigned need; unsigned* tmo;
    __device__ __forceinline__ void a_ready(const Unit& u) const {
        if (threadIdx.x < 64) {
            const unsigned long long t0 = __builtin_amdgcn_s_memrealtime(); unsigned polls = 0;
            while ((unsigned)__builtin_amdgcn_readfirstlane(__hip_atomic_load(ready + 64 * u.pm, __ATOMIC_RELAXED, __HIP_MEMORY_SCOPE_AGENT)) < need) {
                if ((++polls & 255u) == 0u && __builtin_amdgcn_readfirstlane(__hip_atomic_load(tmo, __ATOMIC_RELAXED, __HIP_MEMORY_SCOPE_AGENT)) != 0u) break;
                if (__builtin_amdgcn_s_memrealtime() - t0 > 2000000ull) {
                    if (threadIdx.x == 0) { unsigned expect = 0u; __hip_atomic_compare_exchange_strong(tmo + 1, &expect, 0x600u | (unsigned)(u.pm & 0xff), __ATOMIC_RELAXED, __ATOMIC_RELAXED, __HIP_MEMORY_SCOPE_AGENT); __hip_atomic_store(tmo, 1u, __ATOMIC_RELAXED, __HIP_MEMORY_SCOPE_AGENT); }
                    break; }
                __builtin_amdgcn_s_sleep(2); }
            __builtin_amdgcn_fence(__ATOMIC_ACQUIRE, "agent");
            asm volatile("s_waitcnt vmcnt(0)" ::: "memory");
        }
#if !defined(BROKEN_HOOK_NO_BARRIER)
        asm volatile("" ::: "memory"); __builtin_amdgcn_s_barrier(); asm volatile("" ::: "memory");
#endif
    }
};

__device__ __forceinline__ unsigned cvt_pk_bf16(float lo, float hi) { unsigned r; asm volatile("v_cvt_pk_bf16_f32 %0, %1, %2" : "=v"(r) : "v"(lo), "v"(hi)); return r; }
typedef float f32x2 __attribute__((ext_vector_type(2)));
__device__ __forceinline__ f32x2 gelu_pk(f32x2 v) {
    const f32x2 av = __builtin_elementwise_abs(v), d = av * 0.2316418882f + 1.0f;
    f32x2 t; t.x = __builtin_amdgcn_rcpf(d.x); t.y = __builtin_amdgcn_rcpf(d.y);
    f32x2 q = t * 0.5307027145f + (-0.7265760135f); q = q * t + 0.7107068705f; q = q * t + (-0.142248368f); q = q * t + 0.127414796f; q = q * t;
    const f32x2 s = (v * v) * (-0.72134752044f);
    f32x2 e; e.x = __builtin_amdgcn_exp2f(s.x); e.y = __builtin_amdgcn_exp2f(s.y);
    const f32x2 m = v * (q * e), r = v - m;
    f32x2 o; o.x = v.x < 0.f ? m.x : r.x; o.y = v.y < 0.f ? m.y : r.y; return o;
}

struct EpiF32 {
    static constexpr bool PERM = false, AFTER_DRAIN = false;
    float* C; int ldc; const float* bias;
    __device__ __forceinline__ void operator()(const f32x4 (&acc)[2][2][4][2], const Unit& u, int wr, int wc, int fr, int fq) const {
        const int row0 = u.pm * BM + wr * 64 + fr, col0 = u.pn * BM + wc * 32 + 4 * fq;
        f32x4 bv[2][2];
#pragma unroll
        for (int bj = 0; bj < 2; ++bj)
#pragma unroll
            for (int n = 0; n < 2; ++n) bv[bj][n] = bias ? *(const f32x4*)(bias + col0 + bj * HALF + n * 16) : (f32x4){0.f, 0.f, 0.f, 0.f};
#pragma unroll
        for (int ai = 0; ai < 2; ++ai)
#pragma unroll
            for (int m = 0; m < 4; ++m) { float* rowp = C + (size_t)(row0 + ai * HALF + m * 16) * ldc + col0;
#pragma unroll
                for (int bj = 0; bj < 2; ++bj)
#pragma unroll
                    for (int n = 0; n < 2; ++n) *(f32x4*)(rowp + bj * HALF + n * 16) = acc[ai][bj][m][n] + bv[bj][n]; }
    }
};
template <int ACT  > struct EpiBf16 {
    static constexpr bool PERM = true, AFTER_DRAIN = false;
    bf16_t* O; int ldc; const float* bias; int split_cols; size_t split_stride;
    __device__ __forceinline__ void operator()(const f32x4 (&acc)[2][2][4][2], const Unit& u, int wr, int wc, int fr, int fq) const {
        const int row0 = u.pm * BM + wr * 64 + fr; int colt = u.pn * BM; bf16_t* base = O;
        if (split_cols) { const int t = colt / split_cols; base += (size_t)t * split_stride; colt -= t * split_cols; }
        const int col0 = colt + wc * 32 + 8 * fq, bcol0 = u.pn * BM + wc * 32 + 8 * fq;
        f32x4 bv[2][2];
#pragma unroll
        for (int bj = 0; bj < 2; ++bj)
#pragma unroll
            for (int n = 0; n < 2; ++n) bv[bj][n] = bias ? *(const f32x4*)(bias + bcol0 + bj * HALF + 4 * n) : (f32x4){0.f, 0.f, 0.f, 0.f};
#pragma unroll
        for (int ai = 0; ai < 2; ++ai)
#pragma unroll
            for (int m = 0; m < 4; ++m) { bf16_t* rowp = base + (size_t)(row0 + ai * HALF + m * 16) * ldc + col0;
#pragma unroll
                for (int bj = 0; bj < 2; ++bj) { f32x4 v0 = acc[ai][bj][m][0] + bv[bj][0], v1 = acc[ai][bj][m][1] + bv[bj][1];
                    if (ACT == 1) { f32x2 a = gelu_pk((f32x2){v0[0], v0[1]}), b = gelu_pk((f32x2){v0[2], v0[3]}), c = gelu_pk((f32x2){v1[0], v1[1]}), d = gelu_pk((f32x2){v1[2], v1[3]});
                        v0 = (f32x4){a.x, a.y, b.x, b.y}; v1 = (f32x4){c.x, c.y, d.x, d.y}; }
                    if (ACT == 2) {
#pragma unroll
                        for (int j = 0; j < 4; ++j) { v0[j] = 0.5f * v0[j] * (1.0f + erff(v0[j] * 0.70710678f)); v1[j] = 0.5f * v1[j] * (1.0f + erff(v1[j] * 0.70710678f)); } }
                    u32x4 w; w.x = cvt_pk_bf16(v0[0], v0[1]); w.y = cvt_pk_bf16(v0[2], v0[3]); w.z = cvt_pk_bf16(v1[0], v1[1]); w.w = cvt_pk_bf16(v1[2], v1[3]);
                    *(u32x4*)(rowp + bj * HALF) = w; } }
    }
};

struct PanelStats {
    unsigned* xbuf;
    unsigned* cnt;
    unsigned* tmo;
    int ntn; float eps;
    unsigned code;
    __device__ __forceinline__ bool run(const f32x4 (&v)[2][2][4][2], const Unit& u, int wr, int wc, int fr, int fq, PG8_LAS unsigned char* lds, int wid, int lane) const {
        typedef float f32x2v __attribute__((ext_vector_type(2)));
        PG8_LAS f32x2v* P = (PG8_LAS f32x2v*)lds;
        PG8_LAS f32x2v* S = (PG8_LAS f32x2v*)(lds + 8192);
        PG8_LAS unsigned* flag = (PG8_LAS unsigned*)(lds + 8192 + 2048);
#pragma unroll
        for (int ai = 0; ai < 2; ++ai)
#pragma unroll
            for (int m = 0; m < 4; ++m) {
                float s = 0.f;
#pragma unroll
                for (int bj = 0; bj < 2; ++bj)
#pragma unroll
                    for (int n = 0; n < 2; ++n) { const f32x4 x = v[ai][bj][m][n]; s += (x[0] + x[1]) + (x[2] + x[3]); }
                s += __shfl_xor(s, 16); s += __shfl_xor(s, 32);
                const float mw = s * (1.0f / 64.0f); float q = 0.f;
#pragma unroll
                for (int bj = 0; bj < 2; ++bj)
#pragma unroll
                    for (int n = 0; n < 2; ++n) { const f32x4 d = v[ai][bj][m][n] - mw; q += (d[0] * d[0] + d[1] * d[1]) + (d[2] * d[2] + d[3] * d[3]); }
                q += __shfl_xor(q, 16); q += __shfl_xor(q, 32);
                if (fq == 0) P[(ai * HALF + wr * 64 + m * 16 + fr) * 4 + wc] = (f32x2v){mw, q};
            }
        asm volatile("s_waitcnt lgkmcnt(0)" ::: "memory"); __builtin_amdgcn_s_barrier(); asm volatile("" ::: "memory");
#if defined(BROKEN_NO_WAIT)
        if (blockIdx.x >= 64) { const long long t0 = clock64(); while (clock64() - t0 < 60000) __builtin_amdgcn_s_sleep(8); }
#endif
        const int row = wid * 32 + (lane & 31);
        if (lane < 32) {
            const f32x2v a = P[row * 4 + 0], b = P[row * 4 + 1], c = P[row * 4 + 2], d = P[row * 4 + 3];
            const float mt = (a.x + b.x + c.x + d.x) * 0.25f;
            const float da = a.x - mt, db = b.x - mt, dc = c.x - mt, dd = d.x - mt;
            const float m2 = (a.y + b.y) + (c.y + d.y) + 64.0f * ((da * da + db * db) + (dc * dc + dd * dd));
            unsigned long long* slot = (unsigned long long*)xbuf + ((size_t)(u.pm * BM + row) * 4 + u.pn);
            __hip_atomic_store(slot, ((unsigned long long)__float_as_uint(m2) << 32) | __float_as_uint(mt), __ATOMIC_RELAXED, __HIP_MEMORY_SCOPE_AGENT);
        }
        asm volatile("s_waitcnt vmcnt(0)" ::: "memory");
        if (lane == 0) __hip_atomic_fetch_add(cnt + 64 * u.pm, 1u, __ATOMIC_RELAXED, __HIP_MEMORY_SCOPE_AGENT);
        if (wid == 0) {
            bool dead = false; const unsigned long long t0 = __builtin_amdgcn_s_memrealtime(); const unsigned want = 8u * (unsigned)ntn;
            for (;;) {
#if defined(BROKEN_NO_WAIT)
                break;
#endif
                if ((unsigned)__builtin_amdgcn_readfirstlane(__hip_atomic_load(cnt + 64 * u.pm, __ATOMIC_RELAXED, __HIP_MEMORY_SCOPE_AGENT)) >= want) break;
                if (__builtin_amdgcn_s_memrealtime() - t0 > 2000000ull) {
                    if (lane == 0) { unsigned expect = 0u; __hip_atomic_compare_exchange_strong(tmo + 1, &expect, code | (unsigned)(u.pm & 0xff), __ATOMIC_RELAXED, __ATOMIC_RELAXED, __HIP_MEMORY_SCOPE_AGENT);
                                     __hip_atomic_store(tmo, 1u, __ATOMIC_RELAXED, __HIP_MEMORY_SCOPE_AGENT); }
                    dead = true; break; }
                __builtin_amdgcn_s_sleep(2);
            }
            __builtin_amdgcn_fence(__ATOMIC_ACQUIRE, "agent");
            if (lane == 0) flag[0] = dead ? 1u : 0u;
        }
        asm volatile("s_waitcnt vmcnt(0) lgkmcnt(0)" ::: "memory"); __builtin_amdgcn_s_barrier(); asm volatile("" ::: "memory");
        const bool bad = flag[0] != 0u;
        if (lane < 32) {
            const unsigned long long* slot = (const unsigned long long*)xbuf + (size_t)(u.pm * BM + row) * 4; float mt[4], m2[4]; float ms = 0.f;
#pragma unroll
            for (int t = 0; t < 4; ++t) { if (t < ntn) { const unsigned long long w = __hip_atomic_load(slot + t, __ATOMIC_RELAXED, __HIP_MEMORY_SCOPE_AGENT); mt[t] = __uint_as_float((unsigned)w); m2[t] = __uint_as_float((unsigned)(w >> 32)); } else { mt[t] = 0.f; m2[t] = 0.f; } ms += mt[t]; }
            const float mean = ms / (float)ntn; float q = 0.f;
#pragma unroll
            for (int t = 0; t < 4; ++t) if (t < ntn) { const float dm = mt[t] - mean; q += m2[t] + 256.0f * dm * dm; }
            S[row] = (f32x2v){mean, 1.0f / sqrtf(q / (256.0f * (float)ntn) + eps)};
        }
        asm volatile("s_waitcnt lgkmcnt(0)" ::: "memory"); __builtin_amdgcn_s_barrier(); asm volatile("" ::: "memory");
        return bad;
    }
};
struct EpiLnRes {
    static constexpr bool PERM = false, AFTER_DRAIN = true;
    const float* base; float* out; int ldc; const float* bias; PanelStats st; unsigned poison;
    __device__ __forceinline__ void refuse(size_t i0, size_t stride, int M, int N) const { const float q = __builtin_nanf(""); for (size_t i = i0; i < (size_t)M * N; i += stride) out[(i / N) * ldc + i % N] = q;
        if (i0 == 0) { unsigned expect = 0u; __hip_atomic_compare_exchange_strong(st.tmo + 1, &expect, 0x7f0u, __ATOMIC_RELAXED, __ATOMIC_RELAXED, __HIP_MEMORY_SCOPE_AGENT); __hip_atomic_store(st.tmo, 1u, __ATOMIC_RELAXED, __HIP_MEMORY_SCOPE_AGENT); } }
    __device__ __forceinline__ void fused(f32x4 (&acc)[2][2][4][2], const Unit& u, int wr, int wc, int fr, int fq, PG8_LAS unsigned char* lds, int wid, int lane) const {
        typedef float f32x2v __attribute__((ext_vector_type(2)));
        const PG8_LAS f32x2v* S = (const PG8_LAS f32x2v*)(lds + 8192);
        const int col0 = u.pn * BM + wc * 32 + 4 * fq;
#pragma unroll
        for (int bj = 0; bj < 2; ++bj)
#pragma unroll
            for (int n = 0; n < 2; ++n) { const f32x4 bv = bias ? *(const f32x4*)(bias + col0 + bj * HALF + n * 16) : (f32x4){0.f, 0.f, 0.f, 0.f};
#pragma unroll
                for (int ai = 0; ai < 2; ++ai)
#pragma unroll
                    for (int m = 0; m < 4; ++m) acc[ai][bj][m][n] += bv; }
        const bool bad = st.run(acc, u, wr, wc, fr, fq, lds, wid, lane) || poison != 0u;
        const float qnan = __builtin_nanf("");
#pragma unroll
        for (int ai = 0; ai < 2; ++ai)
#pragma unroll
            for (int m = 0; m < 4; ++m) { const int r = ai * HALF + wr * 64 + m * 16 + fr; const f32x2v sr = S[r]; const size_t off = (size_t)(u.pm * BM + r) * ldc + col0;
#pragma unroll
                for (int bj = 0; bj < 2; ++bj)
#pragma unroll
                    for (int n = 0; n < 2; ++n) { const f32x4 bs = *(const f32x4*)(base + off + bj * HALF + n * 16); f32x4 o = bs + (acc[ai][bj][m][n] - sr.x) * sr.y;
                        if (bad) o = (f32x4){qnan, qnan, qnan, qnan}; *(f32x4*)(out + off + bj * HALF + n * 16) = o; }
                asm volatile("" ::: "memory"); }
    }
};
struct EpiLnResLn {
    static constexpr bool PERM = false, AFTER_DRAIN = true;
    const float* base; float* out; bf16_t* xn; int ldc; const float* bias; PanelStats st1, st2; unsigned poison;
    __device__ __forceinline__ void refuse(size_t i0, size_t stride, int M, int N) const { const float q = __builtin_nanf(""); for (size_t i = i0; i < (size_t)M * N; i += stride) { const size_t o = (i / N) * ldc + i % N; out[o] = q; xn[o] = (bf16_t)0x7fc0u; }
        if (i0 == 0) { unsigned expect = 0u; __hip_atomic_compare_exchange_strong(st1.tmo + 1, &expect, 0x7f0u, __ATOMIC_RELAXED, __ATOMIC_RELAXED, __HIP_MEMORY_SCOPE_AGENT); __hip_atomic_store(st1.tmo, 1u, __ATOMIC_RELAXED, __HIP_MEMORY_SCOPE_AGENT); } }
    __device__ __forceinline__ void fused(f32x4 (&acc)[2][2][4][2], const Unit& u, int wr, int wc, int fr, int fq, PG8_LAS unsigned char* lds, int wid, int lane) const {
        typedef float f32x2v __attribute__((ext_vector_type(2))); typedef unsigned u32x2v __attribute__((ext_vector_type(2)));
        const PG8_LAS f32x2v* S = (const PG8_LAS f32x2v*)(lds + 8192);
        const int col0 = u.pn * BM + wc * 32 + 4 * fq;
#pragma unroll
        for (int bj = 0; bj < 2; ++bj)
#pragma unroll
            for (int n = 0; n < 2; ++n) { const f32x4 bv = bias ? *(const f32x4*)(bias + col0 + bj * HALF + n * 16) : (f32x4){0.f, 0.f, 0.f, 0.f};
#pragma unroll
                for (int ai = 0; ai < 2; ++ai)
#pragma unroll
                    for (int m = 0; m < 4; ++m) acc[ai][bj][m][n] += bv; }
        bool bad = st1.run(acc, u, wr, wc, fr, fq, lds, wid, lane) || poison != 0u;
        const float qnan = __builtin_nanf("");
#pragma unroll
        for (int ai = 0; ai < 2; ++ai)
#pragma unroll
            for (int m = 0; m < 4; ++m) { const int r = ai * HALF + wr * 64 + m * 16 + fr; const f32x2v sr = S[r]; const size_t off = (size_t)(u.pm * BM + r) * ldc + col0;
#pragma unroll
                for (int bj = 0; bj < 2; ++bj)
#pragma unroll
                    for (int n = 0; n < 2; ++n) { const f32x4 bs = *(const f32x4*)(base + off + bj * HALF + n * 16); acc[ai][bj][m][n] = bs + (acc[ai][bj][m][n] - sr.x) * sr.y; }
                asm volatile("" : "+v"(acc[ai][0][m][0]), "+v"(acc[ai][0][m][1]), "+v"(acc[ai][1][m][0]), "+v"(acc[ai][1][m][1]));
                if (m & 1) asm volatile("" ::: "memory"); }
        const bool bad1 = bad;
        bad = st2.run(acc, u, wr, wc, fr, fq, lds, wid, lane) || bad;
#pragma unroll
        for (int ai = 0; ai < 2; ++ai)
#pragma unroll
            for (int m = 0; m < 4; ++m) { const int r = ai * HALF + wr * 64 + m * 16 + fr; const f32x2v sr = S[r]; const size_t off = (size_t)(u.pm * BM + r) * ldc + col0;
#pragma unroll
                for (int bj = 0; bj < 2; ++bj)
#pragma unroll
                    for (int n = 0; n < 2; ++n) { const f32x4 x1 = acc[ai][bj][m][n]; *(f32x4*)(out + off + bj * HALF + n * 16) = bad1 ? (f32x4){qnan, qnan, qnan, qnan} : x1;
                        const f32x4 o = (x1 - sr.x) * sr.y; u32x2v w; w.x = cvt_pk_bf16(o[0], o[1]); w.y = cvt_pk_bf16(o[2], o[3]);
                        if (bad) { w.x = 0x7fc07fc0u; w.y = 0x7fc07fc0u; } *(u32x2v*)(xn + off + bj * HALF + n * 16) = w; }
                asm volatile("" ::: "memory"); }
    }
};

template <class Epi, class Sched, bool STAMP = false>
__device__ __forceinline__ void gemm_phase(PG8_LAS unsigned char* lds, const Gemm g, const Sched& S, const Epi& E, unsigned long long* stamps) {
    int tid_o = threadIdx.x; asm volatile("" : "+v"(tid_o)); const int tid = tid_o, wid = __builtin_amdgcn_readfirstlane(tid >> 6), lane = tid & 63, wr = wid >> 2, wc = wid & 3, fr = lane & 15, fq = lane >> 4;
    const int K = g.K, nt = K / BK;
    int ts_lo = 0, ts_hi = 0, nts = 0; const unsigned long long rt_entry = STAMP ? (unsigned long long)wall_clock64() : 0ull;
#define PG8_STAMP() do { if (STAMP && wid == 0 && nts < 64) { const unsigned long long _c = (unsigned long long)clock64(); \
        ts_lo = (lane == nts) ? (int)(unsigned)_c : ts_lo; ts_hi = (lane == nts) ? (int)(unsigned)(_c >> 32) : ts_hi; ++nts; } } while (0)
    PG8_STAMP();
    unsigned voffA[2], voffB[2];
#pragma unroll
    for (int i = 0; i < 2; ++i) { int R, C; stage_rc(tid * 16 + i * 8192, R, C); const int Rb = Epi::PERM ? ((R & ~31) + perm32(R & 31)) : R;
        voffA[i] = (unsigned)(R * K + C) * 2u; voffB[i] = (unsigned)(Rb * K + C) * 2u; }
    const size_t kstep = (size_t)(BK * 2);
    const size_t hstep = (size_t)HALF * K * 2;
    const size_t tstep = 2 * hstep;
    const unsigned ldsw = (unsigned)wid * 1024u;
    const int aoff = lds_byte(wr * 64 + fr, fq * 8), boff = lds_byte(wc * 32 + fr, fq * 8);
#define PG8_SA(b, h) (((b) * 2 + (h)) * HTB)
#define PG8_SB(b, h) ((4 + (b) * 2 + (h)) * HTB)
#define PG8_STAGE(bufoff, gbase, voff) do { _Pragma("unroll") for (int _i = 0; _i < 2; ++_i) \
        __builtin_amdgcn_global_load_lds((const unsigned*)((const char*)(gbase) + (voff)[_i]), (PG8_LAS unsigned*)(lds + (bufoff) + ldsw + _i * 8192), 16, 0, 0); } while (0)
#define PG8_LDA(dst, b, h) do { _Pragma("unroll") for (int m = 0; m < 4; ++m) _Pragma("unroll") for (int k = 0; k < 2; ++k) dst[m][k] = *(const PG8_LAS bf16x8*)(lds + PG8_SA(b, h) + aoff + m * 2048 + k * 1024); } while (0)
#define PG8_LDB(dst, b, h) do { _Pragma("unroll") for (int n = 0; n < 2; ++n) _Pragma("unroll") for (int k = 0; k < 2; ++k) dst[n][k] = *(const PG8_LAS bf16x8*)(lds + PG8_SB(b, h) + boff + n * 2048 + k * 1024); } while (0)
#define PG8_MMA(ai, bj, At, Bt) do { __builtin_amdgcn_s_setprio(1); _Pragma("unroll") for (int m = 0; m < 4; ++m) _Pragma("unroll") for (int n = 0; n < 2; ++n) _Pragma("unroll") for (int k = 0; k < 2; ++k) \
        acc[ai][bj][m][n] = __builtin_amdgcn_mfma_f32_16x16x32_bf16(Bt[n][k], At[m][k], acc[ai][bj][m][n], 0, 0, 0); __builtin_amdgcn_s_setprio(0); } while (0)
#define PG8_WAIT_V(n) asm volatile("s_waitcnt vmcnt(" #n ")" ::: "memory")
#define PG8_WAIT_L(n) asm volatile("s_waitcnt lgkmcnt(" #n ")" ::: "memory")
#define PG8_BAR __builtin_amdgcn_s_barrier()
#define PG8_SCHED __builtin_amdgcn_sched_barrier(0)
    Unit cur, nxt; int ui = 0;
    if (!S.next(0, cur)) return;
    f32x4 acc[2][2][4][2];
#pragma unroll
    for (int a = 0; a < 2; ++a)
#pragma unroll
        for (int b = 0; b < 2; ++b)
#pragma unroll
            for (int m = 0; m < 4; ++m)
#pragma unroll
                for (int n = 0; n < 2; ++n) acc[a][b][m][n] = (f32x4){0.f, 0.f, 0.f, 0.f};
    bf16x8 At[4][2], B0[2][2], B1[2][2];
    const char* cA = (const char*)g.A + (size_t)cur.pm * tstep; const char* cB = (const char*)g.Bt + (size_t)cur.pn * tstep;
    S.a_ready(cur);
    PG8_STAGE(PG8_SB(0, 0), cB, voffB); PG8_STAGE(PG8_SA(0, 0), cA, voffA); PG8_STAGE(PG8_SB(0, 1), cB + hstep, voffB); PG8_STAGE(PG8_SA(0, 1), cA + hstep, voffA);
    if (wr == 1) PG8_BAR;
    PG8_WAIT_V(4); PG8_BAR;
    PG8_STAGE(PG8_SB(1, 0), cB + kstep, voffB); PG8_STAGE(PG8_SA(1, 0), cA + kstep, voffA); PG8_STAGE(PG8_SB(1, 1), cB + hstep + kstep, voffB);
    PG8_WAIT_V(6); PG8_BAR;
    PG8_STAMP();
    for (;;) {
        const bool has_next = S.next(ui + 1, nxt);
        const char* nA = has_next ? (const char*)g.A + (size_t)nxt.pm * tstep : cA; const char* nB = has_next ? (const char*)g.Bt + (size_t)nxt.pn * tstep : cB;
        for (int t = 0; t < nt; t += 2) {
            const bool last = (t == nt - 2);
            const char* a1 = cA + (size_t)(t + 1) * kstep;
            const char* a2 = last ? nA : cA + (size_t)(t + 2) * kstep; const char* b2 = last ? nB : cB + (size_t)(t + 2) * kstep;
            const char* a3 = a2 + kstep; const char* b3 = b2 + kstep;
            if (last && has_next) S.a_ready(nxt);
            PG8_LDB(B0, 0, 0); PG8_SCHED; PG8_LDA(At, 0, 0); PG8_STAGE(PG8_SA(1, 1), a1 + hstep, voffA);
            PG8_WAIT_L(8); PG8_BAR; PG8_WAIT_L(0); PG8_MMA(0, 0, At, B0); PG8_BAR; PG8_SCHED;
            PG8_LDB(B1, 0, 1); PG8_STAGE(PG8_SB(0, 0), b2, voffB);
            PG8_BAR; PG8_WAIT_L(0); PG8_MMA(0, 1, At, B1); PG8_BAR;
            PG8_LDA(At, 0, 1); PG8_STAGE(PG8_SA(0, 0), a2, voffA);
            PG8_BAR; PG8_WAIT_L(0); PG8_MMA(1, 0, At, B0); PG8_BAR; PG8_SCHED;
            PG8_STAGE(PG8_SB(0, 1), b2 + hstep, voffB);
            PG8_WAIT_V(6); PG8_BAR; PG8_MMA(1, 1, At, B1); PG8_BAR;
            PG8_LDB(B0, 1, 0); PG8_SCHED; PG8_LDA(At, 1, 0); PG8_STAGE(PG8_SA(0, 1), a2 + hstep, voffA);
            PG8_WAIT_L(8); PG8_BAR; PG8_WAIT_L(0); PG8_MMA(0, 0, At, B0); PG8_BAR; PG8_SCHED;
            PG8_LDB(B1, 1, 1); PG8_STAGE(PG8_SB(1, 0), b3, voffB);
            PG8_BAR; PG8_WAIT_L(0); PG8_MMA(0, 1, At, B1); PG8_BAR;
            PG8_LDA(At, 1, 1); PG8_STAGE(PG8_SA(1, 0), a3, voffA);
            PG8_BAR; PG8_WAIT_L(0); PG8_MMA(1, 0, At, B0); PG8_BAR; PG8_SCHED;
            PG8_STAGE(PG8_SB(1, 1), b3 + hstep, voffB);
            PG8_WAIT_V(6); PG8_BAR; PG8_MMA(1, 1, At, B1); PG8_BAR;
        }
        PG8_STAMP();
        if constexpr (!Epi::AFTER_DRAIN) { E(acc, cur, wr, wc, fr, fq); S.done(cur); }
        PG8_STAMP();
        if (!has_next) break;
#pragma unroll
        for (int a = 0; a < 2; ++a)
#pragma unroll
            for (int b = 0; b < 2; ++b)
#pragma unroll
                for (int m = 0; m < 4; ++m)
#pragma unroll
                    for (int n = 0; n < 2; ++n) acc[a][b][m][n] = (f32x4){0.f, 0.f, 0.f, 0.f};
        cur = nxt; cA = nA; cB = nB; ++ui;
    }
    PG8_WAIT_V(0);
    if (wr == 0) PG8_BAR;
    PG8_BAR;
    if constexpr (Epi::AFTER_DRAIN) { E.fused(acc, cur, wr, wc, fr, fq, lds, wid, lane); S.done(cur); }
    PG8_STAMP();
    if (STAMP && wid == 0) { stamps[lane] = lane < nts ? (((unsigned long long)(unsigned)ts_hi << 32) | (unsigned)ts_lo) : 0ull;
        if (lane == 62) stamps[62] = rt_entry; if (lane == 63) stamps[63] = (unsigned long long)wall_clock64(); }
#undef PG8_STAMP
#undef PG8_SA
#undef PG8_SB
#undef PG8_STAGE
#undef PG8_LDA
#undef PG8_LDB
#undef PG8_MMA
#undef PG8_WAIT_V
#undef PG8_WAIT_L
#undef PG8_BAR
#undef PG8_SCHED
}
}
#define XB_TMO      128
#define XB_XCNT(j)  (256  + 64 * (j))
#define XB_XSUB(j)  (1280 + 64 * (j))
#define XB_XGEN(j)  (2304 + 64 * (j))
#define XB_TOP      3328
#define XB_TOPGEN   3392
#define XCD_BAR_WORDS 3456
#define XB_SPIN_CAP (1u << 23)
#define LAS __attribute__((address_space(3)))

__device__ __forceinline__ unsigned xb_ld(unsigned* p)              { return __hip_atomic_load(p, __ATOMIC_RELAXED, __HIP_MEMORY_SCOPE_AGENT); }
__device__ __forceinline__ unsigned xb_add(unsigned* p, unsigned v) { return __hip_atomic_fetch_add(p, v, __ATOMIC_RELAXED, __HIP_MEMORY_SCOPE_AGENT); }
__device__ __forceinline__ unsigned xb_xcc_id() { return (unsigned)__builtin_amdgcn_s_getreg((3 << 11) | 20) & 0xFu; }
#define XB_SPIN(cond, bar) do { unsigned _sp = 0; while (cond) { __builtin_amdgcn_s_sleep(1); \
    if ((++_sp & 255u) == 0u) { if (xb_ld(&(bar)[XB_TMO])) break; if (_sp > XB_SPIN_CAP) { atomicAdd(&(bar)[XB_TMO], 1u); break; } } } } while (0)

struct XcdBarrier {
    unsigned* bar; unsigned x;
    volatile LAS unsigned* st;
};

__device__ __forceinline__ XcdBarrier xcd_barrier_post(unsigned* bar, volatile LAS unsigned* st) {
    XcdBarrier b; b.bar = bar; b.x = xb_xcc_id(); b.st = st;
    if (threadIdx.x == 0) (void)xb_add(&bar[XB_XCNT(b.x)], 1u);
    return b;
}
__device__ __forceinline__ void xcd_barrier_complete(unsigned* bar, unsigned x, unsigned& nloc, unsigned& nx) {
    const unsigned G = gridDim.x * gridDim.y * gridDim.z;
    unsigned sum, cnt, mine, sp = 0u;
    for (;;) {
        sum = 0u; cnt = 0u; mine = 0u;
#pragma unroll
        for (unsigned j = 0; j < 16; ++j) { const unsigned c = xb_ld(&bar[XB_XCNT(j)]); sum += c; cnt += (c > 0u) ? 1u : 0u; mine = (j == x) ? c : mine; }
        if (sum == G) break;
        __builtin_amdgcn_s_sleep(1);
        if ((++sp & 255u) == 0u) { if (xb_ld(&bar[XB_TMO])) break; if (sp > XB_SPIN_CAP) { atomicAdd(&bar[XB_TMO], 1u); break; } }
    }
    nloc = mine > 0u ? mine : 1u; nx = cnt > 0u ? cnt : 1u;
}

__device__ __forceinline__ void xcd_barrier(const XcdBarrier& b) {
    asm volatile("s_waitcnt vmcnt(0)" ::: "memory");
    __syncthreads();
    if (threadIdx.x == 0) {
        unsigned* bar = b.bar;
        __builtin_amdgcn_s_waitcnt(0);
        unsigned nloc = b.st[0], nx = b.st[1];
        if (nloc == 0u) { xcd_barrier_complete(bar, b.x, nloc, nx); b.st[0] = nloc; b.st[1] = nx; }
        const unsigned old = xb_add(&bar[XB_XSUB(b.x)], 1u);
        const unsigned gen = old / nloc;
        if (old + 1u == (gen + 1u) * nloc) {
            __builtin_amdgcn_fence(__ATOMIC_RELEASE, "agent");
            asm volatile("s_waitcnt vmcnt(0)" ::: "memory");
            const unsigned og = xb_add(&bar[XB_TOP], 1u);
            const unsigned tg = og / nx;
            if (og + 1u == (tg + 1u) * nx) xb_add(&bar[XB_TOPGEN], 1u);
            else XB_SPIN(xb_ld(&bar[XB_TOPGEN]) == tg, bar);
            __builtin_amdgcn_fence(__ATOMIC_ACQUIRE, "agent");
            xb_add(&bar[XB_XGEN(b.x)], 1u);
            asm volatile("s_waitcnt vmcnt(0)" ::: "memory");
        } else {
            XB_SPIN(xb_ld(&bar[XB_XGEN(b.x)]) == gen, bar);
            __builtin_amdgcn_fence(__ATOMIC_ACQUIRE, "agent");
            asm volatile("s_waitcnt vmcnt(0)" ::: "memory");
        }
    }
    __syncthreads();
}

namespace mk {
typedef unsigned short bf16_t;
typedef short bf16x8 __attribute__((ext_vector_type(8)));
typedef float f32x4 __attribute__((ext_vector_type(4)));
typedef float f32x2 __attribute__((ext_vector_type(2)));
typedef unsigned u32x4 __attribute__((ext_vector_type(4)));
typedef unsigned u32x2 __attribute__((ext_vector_type(2)));
typedef __bf16 bf16x2n __attribute__((ext_vector_type(2)));
#define DI __device__ __forceinline__
DI int otid() { int t = threadIdx.x; asm volatile("" : "+v"(t)); return t; }

constexpr int NB = 8, S = 2048, DM = 2048, T = NB * S, DEPTH = 4;
constexpr int NPAD = 6144, INW = 5992, FF = 5632, NGU = 2 * FF;
constexpr int NSEG = 47;
constexpr float QSCALE = 0.08838834764831845f * 1.4426950408889634f;
constexpr float NEG = -1.0e30f;
constexpr float RMS_EPS = 1e-6f;

constexpr size_t AL(size_t x) { return (x + 255) & ~(size_t)255; }
constexpr size_t WS_CTL   = 0;
constexpr size_t CTL_BYTES = 65536;
constexpr size_t WS_COS128 = WS_CTL + CTL_BYTES;
constexpr size_t WS_SIN128 = WS_COS128 + (size_t)S * 64 * 4;
constexpr size_t WS_COS64  = WS_SIN128 + (size_t)S * 64 * 4;
constexpr size_t WS_SIN64  = WS_COS64 + (size_t)S * 32 * 4;
constexpr size_t WS_WIN   = WS_SIN64 + (size_t)S * 32 * 4;
constexpr size_t WS_WOUT  = WS_WIN + (size_t)NPAD * DM * 2;
constexpr size_t WS_WGU   = WS_WOUT + (size_t)DM * DM * 2;
constexpr size_t WS_WDN   = WS_WGU + (size_t)NGU * DM * 2;
constexpr size_t WS_CW1K  = WS_WDN + (size_t)DM * FF * 2;
constexpr size_t WS_CW1V  = WS_CW1K + (size_t)256 * 4096 * 2;
constexpr size_t WS_CW2K  = WS_CW1V + (size_t)256 * 4096 * 2;
constexpr size_t WS_CW2V  = WS_CW2K + (size_t)128 * 256 * 2;
constexpr size_t WS_CB1   = WS_CW2V + (size_t)128 * 256 * 2;
constexpr size_t WS_H     = AL(WS_CB1 + 2 * 256 * 4);
constexpr size_t WS_MIX   = WS_H + (size_t)T * DM * 2;
constexpr size_t WS_BIG   = WS_MIX + (size_t)T * DM * 2;
constexpr size_t WS_P     = WS_BIG;
constexpr size_t WS_SC    = WS_BIG;
constexpr size_t WS_HID   = WS_BIG;
constexpr size_t WS_PREP  = WS_BIG + (size_t)T * NPAD * 2;
constexpr size_t WS_Y     = WS_PREP;
constexpr size_t SZ_H4 = (size_t)T * 512 * 2, SZ_H1 = (size_t)T * 128 * 2, SZ_H8 = (size_t)T * 1024 * 2, SZ_H2 = (size_t)T * 256 * 2;
constexpr size_t WS_AQ   = WS_PREP;
constexpr size_t WS_AK   = WS_AQ + SZ_H4;
constexpr size_t WS_AVT  = WS_AK + SZ_H1;
constexpr size_t WS_IQ   = WS_AVT + SZ_H1;
constexpr size_t WS_IK   = WS_IQ + SZ_H8;
constexpr size_t WS_IW   = WS_IK + (size_t)T * 64 * 2;
constexpr size_t WS_GATE = WS_IW + (size_t)T * 16 * 4;
constexpr size_t WS_BQ   = WS_GATE + (size_t)T * 24 * 4;
constexpr size_t WS_BK1  = WS_BQ + SZ_H4;
constexpr size_t WS_BK4  = WS_BK1 + SZ_H4;
constexpr size_t WS_BK16 = WS_BK4 + SZ_H4;
constexpr size_t WS_BVT1 = WS_BK16 + SZ_H4;
constexpr size_t WS_BVT4 = WS_BVT1 + SZ_H4;
constexpr size_t WS_BVT16 = WS_BVT4 + SZ_H4;
constexpr size_t WS_CQ   = WS_BVT16 + SZ_H4;
constexpr size_t WS_CQR  = WS_CQ + SZ_H8;
constexpr size_t WS_KC   = WS_CQR + SZ_H8;
constexpr size_t WS_VC   = WS_KC + SZ_H2 + 65536;
constexpr size_t WS_CKS  = WS_VC + SZ_H2 + 65536;
constexpr size_t WS_CVST = WS_CKS + SZ_H2;
constexpr size_t WS_CKW  = WS_CVST + SZ_H2;
constexpr size_t WS_CVWT = WS_CKW + SZ_H2;
constexpr size_t WS_PREP_END = WS_CVWT + SZ_H2;
constexpr size_t WS_BITS = WS_PREP_END;
constexpr size_t WS_OB4  = WS_BITS + (size_t)T * 64 * 4;
constexpr size_t WS_OB16 = WS_OB4 + SZ_H4;
constexpr size_t WS_LSE4 = WS_OB16 + SZ_H4;
constexpr size_t WS_LSE16 = WS_LSE4 + (size_t)T * 4 * 4;
constexpr size_t WS_OC   = WS_LSE16 + (size_t)T * 4 * 4;
constexpr size_t WS_G1K  = WS_OC + SZ_H8;
constexpr size_t WS_G1V  = WS_G1K + (size_t)2048 * 256 * 2;
constexpr size_t WS_KCC  = WS_G1V + (size_t)2048 * 256 * 2;
constexpr size_t WS_VCT  = WS_KCC + (size_t)16 * 128 * 128 * 2;
constexpr size_t WS_SEL  = WS_VCT + (size_t)16 * 128 * 128 * 2;
constexpr size_t WS_END  = AL(WS_SEL + (size_t)16 * S * 4);
static_assert(WS_HID + (size_t)T * FF * 2 <= WS_PREP, "hidden must fit inside P");
static_assert(WS_Y + (size_t)T * DM * 2 <= WS_PREP_END, "Y must fit inside the prep region");

constexpr int LDS_BAR_OFF = 131072;
constexpr int LDS_BYTES = 131072 + 256;

DI unsigned pk2(float a, float b) { f32x2 v = {a, b}; bf16x2n r = __builtin_convertvector(v, bf16x2n); return __builtin_bit_cast(unsigned, r); }
DI float bflo(unsigned w) { return __uint_as_float(w << 16); }
DI float bfhi(unsigned w) { return __uint_as_float(w & 0xffff0000u); }
DI float bf2f(bf16_t v) { return __uint_as_float(((unsigned)v) << 16); }
DI float wave_sum(float v) {
#pragma unroll
    for (int o = 1; o < 64; o <<= 1) v += __shfl_xor(v, o);
    return v;
}
DI float fexp2(float x) { return __builtin_amdgcn_exp2f(x); }
DI float frcp(float x) { return __builtin_amdgcn_rcpf(x); }
DI void unpack8(const u32x4 w, float (&x)[8]) { x[0] = bflo(w.x); x[1] = bfhi(w.x); x[2] = bflo(w.y); x[3] = bfhi(w.y); x[4] = bflo(w.z); x[5] = bfhi(w.z); x[6] = bflo(w.w); x[7] = bfhi(w.w); }
DI u32x4 pack8(const float (&x)[8]) { u32x4 w; w.x = pk2(x[0], x[1]); w.y = pk2(x[2], x[3]); w.z = pk2(x[4], x[5]); w.w = pk2(x[6], x[7]); return w; }
#define MFMA16(a, b, c) __builtin_amdgcn_mfma_f32_16x16x32_bf16((a), (b), (c), 0, 0, 0)

struct Ptrs {
    const float* in[16];
    float* out;
    unsigned char* ws;
};
template <class TT> DI TT* wsp(const Ptrs& P, size_t off) { return (TT*)(P.ws + off); }

DI void phase_rope_tables(const Ptrs& P) {
    float* c128 = wsp<float>(P, WS_COS128); float* s128 = wsp<float>(P, WS_SIN128); float* c64 = wsp<float>(P, WS_COS64); float* s64 = wsp<float>(P, WS_SIN64);
    const int gt = blockIdx.x * blockDim.x + otid(), ng = gridDim.x * blockDim.x;
    for (int i = gt; i < S * 64; i += ng) { const int t = i >> 6, k = i & 63; const float inv = exp2f(-(float)k * (13.287712379549449f / 64.0f));
        const double a = (double)t * (double)inv * 0.15915494309189535; const float fr = (float)(a - floor(a));
        c128[i] = __builtin_amdgcn_cosf(fr); s128[i] = __builtin_amdgcn_sinf(fr); }
    for (int i = gt; i < S * 32; i += ng) { const int t = i >> 5, k = i & 31; const float inv = exp2f(-(float)k * (13.287712379549449f / 32.0f));
        const double a = (double)t * (double)inv * 0.15915494309189535; const float fr = (float)(a - floor(a));
        c64[i] = __builtin_amdgcn_cosf(fr); s64[i] = __builtin_amdgcn_sinf(fr); }
}

DI int incol(int pc) {
    if (pc < 1792) return pc;
    if (pc < 5888) return pc + 80;
    const int o = pc - 5888;
    if (o < 64) return 1792 + o;
    if (o < 80) return 1856 + (o - 64);
    if (o < 104) return 5968 + (o - 80);
    return -1;
}
DI void conv_tile(const float* src, int srcN, int K, bf16_t* dst, int n0, int k0, int srcc0, int kind, float* tile) {
    const int tid = otid(), nn = tid & 63, kk = tid >> 6;
    const int sc = (kind == 0) ? incol(n0 + nn) : (srcc0 + nn);
#pragma unroll
    for (int i = 0; i < 8; ++i) { const int k = kk + 8 * i; tile[nn * 65 + k] = (sc >= 0) ? src[(size_t)(k0 + k) * srcN + sc] : 0.f; }
    __syncthreads();
    const int n2 = tid >> 3, c8 = tid & 7; float v[8];
#pragma unroll
    for (int e = 0; e < 8; ++e) v[e] = tile[n2 * 65 + 8 * c8 + e];
    *(u32x4*)(dst + (size_t)(n0 + n2) * K + k0 + 8 * c8) = pack8(v);
    __syncthreads();
}
DI void phase_wconv(const Ptrs& P, int layer, unsigned char* lds) {
    float* tile = (float*)lds;
    const float* w_in = P.in[1] + (size_t)layer * DM * INW; const float* w_out = P.in[2] + (size_t)layer * DM * DM;
    const float* w1k = P.in[4] + (size_t)layer * 4096 * 256; const float* w2k = P.in[5] + (size_t)layer * 256 * 128;
    const float* w1v = P.in[7] + (size_t)layer * 4096 * 256; const float* w2v = P.in[8] + (size_t)layer * 256 * 128;
    const float* wg = P.in[9] + (size_t)layer * DM * FF; const float* wu = P.in[10] + (size_t)layer * DM * FF; const float* wd = P.in[11] + (size_t)layer * FF * DM;
    constexpr int I0 = (NPAD / 64) * (DM / 64), I1 = (DM / 64) * (DM / 64), I2 = (NGU / 64) * (DM / 64), I3 = (DM / 64) * (FF / 64), I4 = 4 * 64, I6 = 2 * 4, I8 = 64;
    constexpr int NIT = I0 + I1 + I2 + I3 + 2 * I4 + 2 * I6 + I8;
    for (int it = blockIdx.x; it < NIT; it += gridDim.x) {
        int r = it;
        if (r < I0) { const int nt = r / (DM / 64), kt = r % (DM / 64); conv_tile(w_in, INW, DM, wsp<bf16_t>(P, WS_WIN), nt * 64, kt * 64, 0, 0, tile); continue; } r -= I0;
        if (r < I1) { const int nt = r / (DM / 64), kt = r % (DM / 64); conv_tile(w_out, DM, DM, wsp<bf16_t>(P, WS_WOUT), nt * 64, kt * 64, nt * 64, 1, tile); continue; } r -= I1;
        if (r < I2) { const int nt = r / (DM / 64), kt = r % (DM / 64); const int n0 = nt * 64, tl = n0 >> 8, o = n0 & 255;
            conv_tile(o < 128 ? wg : wu, FF, DM, wsp<bf16_t>(P, WS_WGU), n0, kt * 64, tl * 128 + (o & 127), 1, tile); continue; } r -= I2;
        if (r < I3) { const int nt = r / (FF / 64), kt = r % (FF / 64); conv_tile(wd, DM, FF, wsp<bf16_t>(P, WS_WDN), nt * 64, kt * 64, nt * 64, 1, tile); continue; } r -= I3;
        if (r < I4) { const int nt = r / 64, kt = r % 64; conv_tile(w1k, 256, 4096, wsp<bf16_t>(P, WS_CW1K), nt * 64, kt * 64, nt * 64, 1, tile); continue; } r -= I4;
        if (r < I4) { const int nt = r / 64, kt = r % 64; conv_tile(w1v, 256, 4096, wsp<bf16_t>(P, WS_CW1V), nt * 64, kt * 64, nt * 64, 1, tile); continue; } r -= I4;
        if (r < I6) { const int nt = r / 4, kt = r % 4; conv_tile(w2k, 128, 256, wsp<bf16_t>(P, WS_CW2K), nt * 64, kt * 64, nt * 64, 1, tile); continue; } r -= I6;
        if (r < I6) { const int nt = r / 4, kt = r % 4; conv_tile(w2v, 128, 256, wsp<bf16_t>(P, WS_CW2V), nt * 64, kt * 64, nt * 64, 1, tile); continue; } r -= I6;
        {
            const int wid = otid() >> 6, lane = otid() & 63, o = r * 8 + wid, kv = o >> 8, n = o & 255;
            const float* pe = P.in[kv ? 6 : 3] + (size_t)layer * 4096; const float* w1 = kv ? w1v : w1k;
            float s = 0.f;
            for (int k = lane; k < 4096; k += 64) s += pe[k] * w1[(size_t)k * 256 + n];
            s = wave_sum(s);
            if (lane == 0) wsp<float>(P, WS_CB1)[o] = s;
        }
    }
}

DI void phase_norm(const float* xin, float* xout, const bf16_t* Y, const float* g_post, const float* g_pre, bf16_t* H) {
    const int lane = otid() & 63, gw = blockIdx.x * 8 + (otid() >> 6), ngw = gridDim.x * 8;
    for (int row = gw; row < T; row += ngw) {
        float xv[4][8];
#pragma unroll
        for (int j = 0; j < 4; ++j) { const int col = 8 * (lane + 64 * j); const f32x4 a = *(const f32x4*)(xin + (size_t)row * DM + col), b = *(const f32x4*)(xin + (size_t)row * DM + col + 4);
            xv[j][0] = a[0]; xv[j][1] = a[1]; xv[j][2] = a[2]; xv[j][3] = a[3]; xv[j][4] = b[0]; xv[j][5] = b[1]; xv[j][6] = b[2]; xv[j][7] = b[3]; }
        if (Y) {
            float yv[4][8]; float ss = 0.f;
#pragma unroll
            for (int j = 0; j < 4; ++j) { const int col = 8 * (lane + 64 * j); const u32x4 w = *(const u32x4*)(Y + (size_t)row * DM + col); unpack8(w, yv[j]);
#pragma unroll
                for (int e = 0; e < 8; ++e) ss += yv[j][e] * yv[j][e]; }
            const float rstd = rsqrtf(wave_sum(ss) * (1.0f / DM) + RMS_EPS);
#pragma unroll
            for (int j = 0; j < 4; ++j) { const int col = 8 * (lane + 64 * j); const f32x4 ga = *(const f32x4*)(g_post + col), gb = *(const f32x4*)(g_post + col + 4);
#pragma unroll
                for (int e = 0; e < 4; ++e) { xv[j][e] += yv[j][e] * rstd * ga[e]; xv[j][4 + e] += yv[j][4 + e] * rstd * gb[e]; }
                *(f32x4*)(xout + (size_t)row * DM + col) = (f32x4){xv[j][0], xv[j][1], xv[j][2], xv[j][3]};
                *(f32x4*)(xout + (size_t)row * DM + col + 4) = (f32x4){xv[j][4], xv[j][5], xv[j][6], xv[j][7]}; }
        }
        if (H) {
            float ss = 0.f;
#pragma unroll
            for (int j = 0; j < 4; ++j)
#pragma unroll
                for (int e = 0; e < 8; ++e) ss += xv[j][e] * xv[j][e];
            const float rstd = rsqrtf(wave_sum(ss) * (1.0f / DM) + RMS_EPS);
#pragma unroll
            for (int j = 0; j < 4; ++j) { const int col = 8 * (lane + 64 * j); const f32x4 ga = *(const f32x4*)(g_pre + col), gb = *(const f32x4*)(g_pre + col + 4); float hv[8];
#pragma unroll
                for (int e = 0; e < 4; ++e) { hv[e] = xv[j][e] * rstd * ga[e]; hv[4 + e] = xv[j][4 + e] * rstd * gb[e]; }
                *(u32x4*)(H + (size_t)row * DM + col) = pack8(hv); }
        }
    }
}

struct EpiSwiglu {
    static constexpr bool PERM = true, AFTER_DRAIN = false;
    bf16_t* O; int ldc;
    __device__ __forceinline__ void operator()(const pg8::f32x4 (&acc)[2][2][4][2], const pg8::Unit& u, int wr, int wc, int fr, int fq) const {
        const int row0 = u.pm * 256 + wr * 64 + fr, col0 = u.pn * 128 + wc * 32 + 8 * fq;
#pragma unroll
        for (int ai = 0; ai < 2; ++ai)
#pragma unroll
            for (int m = 0; m < 4; ++m) { bf16_t* rowp = O + (size_t)(row0 + ai * 128 + m * 16) * ldc + col0; float h[8];
#pragma unroll
                for (int n = 0; n < 2; ++n)
#pragma unroll
                    for (int i = 0; i < 4; ++i) { const float g = acc[ai][0][m][n][i], up = acc[ai][1][m][n][i]; h[4 * n + i] = g * frcp(1.0f + fexp2(-1.4426950408889634f * g)) * up; }
                *(u32x4*)rowp = pack8(h); }
    }
};

constexpr int TP = 136;
DI void lds_row8(const bf16_t* tile, int tok, int ch, float (&x)[8]) { const u32x4 w = *(const u32x4*)(tile + tok * TP + ch * 8); unpack8(w, x); }
template <int HD> DI void rope_chunk(const bf16_t* tile, int tok, int ch, int hc0, const float* cs, const float* sn, int t, float scale, float (&o)[8]) {
    constexpr int NCH = HD / 8, HALF_CH = NCH / 2;
    const int cc = ch - hc0; float own[8], par[8];
    lds_row8(tile, tok, ch, own); lds_row8(tile, tok, hc0 + (cc ^ HALF_CH), par);
    const int ci = (cc & (HALF_CH - 1)) * 8; const float* cp = cs + (size_t)t * (HD / 2) + ci; const float* sp = sn + (size_t)t * (HD / 2) + ci;
    const f32x4 c0 = *(const f32x4*)cp, c1 = *(const f32x4*)(cp + 4), s0 = *(const f32x4*)sp, s1 = *(const f32x4*)(sp + 4);
    const float sg = (cc < HALF_CH) ? -1.0f : 1.0f;
#pragma unroll
    for (int e = 0; e < 4; ++e) { o[e] = (own[e] * c0[e] + sg * par[e] * s0[e]) * scale; o[4 + e] = (own[4 + e] * c1[e] + sg * par[4 + e] * s1[e]) * scale; }
}
DI void vt_nat(const bf16_t* tile, bf16_t* dst_head  , int s0) {
    const int d = otid() >> 2, q = otid() & 3; unsigned w[4];
#pragma unroll
    for (int e = 0; e < 4; ++e) w[e] = (unsigned)tile[(8 * q + 2 * e) * TP + d] | ((unsigned)tile[(8 * q + 2 * e + 1) * TP + d] << 16);
    *(u32x4*)(dst_head + (size_t)(s0 >> 5) * 4096 + d * 32 + 8 * q) = (u32x4){w[0], w[1], w[2], w[3]};
}
DI void vt_p4(const bf16_t* tile, bf16_t* dst_head, int s0) {
    const int d = otid() >> 2, r = otid() & 3; unsigned w[4];
#pragma unroll
    for (int e = 0; e < 4; ++e) w[e] = (unsigned)tile[(r + 4 * (2 * e)) * TP + d] | ((unsigned)tile[(r + 4 * (2 * e + 1)) * TP + d] << 16);
    const int p0 = r * 512 + (s0 >> 2);
    *(u32x4*)(dst_head + (size_t)(p0 >> 5) * 4096 + d * 32 + (p0 & 31)) = (u32x4){w[0], w[1], w[2], w[3]};
}
DI void vt_p16(const bf16_t* tile, bf16_t* dst_head, int s0) {
    const int d = otid() >> 2, q = otid() & 3;
#pragma unroll
    for (int rr = 0; rr < 4; ++rr) { const int r = 4 * q + rr; const unsigned w = (unsigned)tile[r * TP + d] | ((unsigned)tile[(r + 16) * TP + d] << 16);
        const int p0 = r * 128 + (s0 >> 4);
        *(unsigned*)(dst_head + (size_t)(p0 >> 5) * 4096 + d * 32 + (p0 & 31)) = w; }
}
DI void phase_prep(const Ptrs& P, unsigned char* lds) {
    bf16_t* tile = (bf16_t*)lds;
    const bf16_t* Pm = wsp<bf16_t>(P, WS_P);
    const float* c128 = wsp<float>(P, WS_COS128); const float* s128 = wsp<float>(P, WS_SIN128); const float* c64 = wsp<float>(P, WS_COS64); const float* s64 = wsp<float>(P, WS_SIN64);
    const int tid = otid(), tok = tid >> 4, ch = tid & 15;
    for (int it = blockIdx.x; it < (T / 32) * NSEG; it += gridDim.x) {
        const int tl = it / NSEG, seg = it % NSEG, b = tl >> 6, s0 = (tl & 63) * 32, t = s0 + tok; const size_t row = (size_t)b * S + t;
        *(u32x4*)(tile + tok * TP + ch * 8) = *(const u32x4*)(Pm + row * NPAD + seg * 128 + ch * 8);
        __syncthreads();
        float o[8];
        if (seg < 4) { rope_chunk<128>(tile, tok, ch, 0, c128, s128, t, QSCALE, o); *(u32x4*)(wsp<bf16_t>(P, WS_AQ) + (((size_t)b * 4 + seg) * S + t) * 128 + ch * 8) = pack8(o); }
        else if (seg == 4) { rope_chunk<128>(tile, tok, ch, 0, c128, s128, t, 1.0f, o); *(u32x4*)(wsp<bf16_t>(P, WS_AK) + row * 128 + ch * 8) = pack8(o); }
        else if (seg == 5) { vt_nat(tile, wsp<bf16_t>(P, WS_AVT) + (size_t)b * S * 128, s0); }
        else if (seg < 14) { const int hc0 = ch & 8, head = 2 * (seg - 6) + (ch >> 3); rope_chunk<64>(tile, tok, ch, hc0, c64, s64, t, 1.0f, o);
            *(u32x4*)(wsp<bf16_t>(P, WS_IQ) + (((size_t)b * 16 + head) * S + t) * 64 + (ch & 7) * 8) = pack8(o); }
        else if (seg < 18) { rope_chunk<128>(tile, tok, ch, 0, c128, s128, t, QSCALE, o); *(u32x4*)(wsp<bf16_t>(P, WS_BQ) + (((size_t)b * 4 + (seg - 14)) * S + t) * 128 + ch * 8) = pack8(o); }
        else if (seg < 22) { rope_chunk<128>(tile, tok, ch, 0, c128, s128, t, 1.0f, o); const u32x4 w = pack8(o); const size_t hb = ((size_t)b * 4 + (seg - 18)) * S;
            *(u32x4*)(wsp<bf16_t>(P, WS_BK1) + (hb + t) * 128 + ch * 8) = w;
            *(u32x4*)(wsp<bf16_t>(P, WS_BK4) + (hb + (t & 3) * 512 + (t >> 2)) * 128 + ch * 8) = w;
            *(u32x4*)(wsp<bf16_t>(P, WS_BK16) + (hb + (t & 15) * 128 + (t >> 4)) * 128 + ch * 8) = w; }
        else if (seg < 26) { const size_t hb = ((size_t)b * 4 + (seg - 22)) * S * 128;
            vt_nat(tile, wsp<bf16_t>(P, WS_BVT1) + hb, s0); vt_p4(tile, wsp<bf16_t>(P, WS_BVT4) + hb, s0); vt_p16(tile, wsp<bf16_t>(P, WS_BVT16) + hb, s0); }
        else if (seg < 34) { const size_t hb = (((size_t)b * 8 + (seg - 26)) * S + t) * 128 + ch * 8; float x[8]; lds_row8(tile, tok, ch, x);
#pragma unroll
            for (int e = 0; e < 8; ++e) x[e] *= QSCALE;
            *(u32x4*)(wsp<bf16_t>(P, WS_CQ) + hb) = pack8(x);
            rope_chunk<128>(tile, tok, ch, 0, c128, s128, t, QSCALE, o); *(u32x4*)(wsp<bf16_t>(P, WS_CQR) + hb) = pack8(o); }
        else if (seg < 36) { *(u32x4*)(wsp<bf16_t>(P, WS_KC) + (((size_t)b * 2 + (seg - 34)) * S + t) * 128 + ch * 8) = *(const u32x4*)(tile + tok * TP + ch * 8); }
        else if (seg < 38) { *(u32x4*)(wsp<bf16_t>(P, WS_VC) + (((size_t)b * 2 + (seg - 36)) * S + t) * 128 + ch * 8) = *(const u32x4*)(tile + tok * TP + ch * 8); }
        else if (seg < 40) { rope_chunk<128>(tile, tok, ch, 0, c128, s128, t, 1.0f, o); *(u32x4*)(wsp<bf16_t>(P, WS_CKS) + (((size_t)b * 2 + (seg - 38)) * S + t) * 128 + ch * 8) = pack8(o); }
        else if (seg < 42) { vt_nat(tile, wsp<bf16_t>(P, WS_CVST) + ((size_t)b * 2 + (seg - 40)) * S * 128, s0); }
        else if (seg < 44) { rope_chunk<128>(tile, tok, ch, 0, c128, s128, t, 1.0f, o); *(u32x4*)(wsp<bf16_t>(P, WS_CKW) + (((size_t)b * 2 + (seg - 42)) * S + t) * 128 + ch * 8) = pack8(o); }
        else if (seg < 46) { vt_nat(tile, wsp<bf16_t>(P, WS_CVWT) + ((size_t)b * 2 + (seg - 44)) * S * 128, s0); }
        else {
            if (ch < 8) { rope_chunk<64>(tile, tok, ch, 0, c64, s64, t, 1.0f, o); *(u32x4*)(wsp<bf16_t>(P, WS_IK) + row * 64 + ch * 8) = pack8(o); }
            else if (ch < 10) { float x[8]; lds_row8(tile, tok, ch, x); float* d = wsp<float>(P, WS_IW) + row * 16 + (ch - 8) * 8;
                *(f32x4*)d = (f32x4){x[0], x[1], x[2], x[3]} * 0.03125f; *(f32x4*)(d + 4) = (f32x4){x[4], x[5], x[6], x[7]} * 0.03125f; }
            else if (ch < 13) { float x[8]; lds_row8(tile, tok, ch, x); float* d = wsp<float>(P, WS_GATE) + row * 24 + (ch - 10) * 8;
#pragma unroll
                for (int e = 0; e < 8; ++e) x[e] = frcp(1.0f + fexp2(-1.4426950408889634f * x[e]));
                *(f32x4*)d = (f32x4){x[0], x[1], x[2], x[3]}; *(f32x4*)(d + 4) = (f32x4){x[4], x[5], x[6], x[7]}; }
        }
        __syncthreads();
    }
}

struct FlashAcc { f32x4 o[8]; float m, l; };
DI void flash_init(FlashAcc& f) {
#pragma unroll
    for (int i = 0; i < 8; ++i) f.o[i] = (f32x4){0.f, 0.f, 0.f, 0.f};
    f.m = NEG; f.l = 0.f;
}
DI void load_q(bf16x8 (&qf)[4], const bf16_t* qrow, int q4) {
#pragma unroll
    for (int ks = 0; ks < 4; ++ks) qf[ks] = *(const bf16x8*)(qrow + 32 * ks + 8 * q4);
}
template <class Mask> DI void flash_tile(FlashAcc& f, const bf16x8 (&qf)[4], const bf16_t* ktile, const bf16_t* vtile, const Mask& mk, int lane) {
    const int r = lane & 15, q4 = lane >> 4;
    const int kr = 8 * (r >> 2) + (r & 3);
    bf16x8 kf[2][4], vf[8];
#pragma unroll
    for (int sub = 0; sub < 2; ++sub)
#pragma unroll
        for (int ks = 0; ks < 4; ++ks) kf[sub][ks] = *(const bf16x8*)(ktile + (kr + 4 * sub) * 128 + 32 * ks + 8 * q4);
#pragma unroll
    for (int db = 0; db < 8; ++db) vf[db] = *(const bf16x8*)(vtile + (16 * db + r) * 32 + 8 * q4);
    f32x4 s[2];
#pragma unroll
    for (int sub = 0; sub < 2; ++sub) { s[sub] = (f32x4){0.f, 0.f, 0.f, 0.f};
#pragma unroll
        for (int ks = 0; ks < 4; ++ks) s[sub] = MFMA16(kf[sub][ks], qf[ks], s[sub]); }
    float mx = NEG;
#pragma unroll
    for (int sub = 0; sub < 2; ++sub)
#pragma unroll
        for (int j = 0; j < 4; ++j) { const bool ok = mk(8 * q4 + 4 * sub + j); s[sub][j] = ok ? s[sub][j] : NEG; mx = fmaxf(mx, s[sub][j]); }
    mx = fmaxf(mx, __shfl_xor(mx, 16)); mx = fmaxf(mx, __shfl_xor(mx, 32));
    const float mnew = fmaxf(f.m, mx), alpha = fexp2(f.m - mnew);
    float p[8], rs = 0.f;
#pragma unroll
    for (int sub = 0; sub < 2; ++sub)
#pragma unroll
        for (int j = 0; j < 4; ++j) { const float e = (s[sub][j] > -5.0e29f) ? fexp2(s[sub][j] - mnew) : 0.f; p[4 * sub + j] = e; rs += e; }
    rs += __shfl_xor(rs, 16); rs += __shfl_xor(rs, 32);
    f.l = f.l * alpha + rs; f.m = mnew;
    const u32x4 pw = pack8(p); const bf16x8 pb = __builtin_bit_cast(bf16x8, pw);
#pragma unroll
    for (int db = 0; db < 8; ++db) { f.o[db] = f.o[db] * alpha; f.o[db] = MFMA16(vf[db], pb, f.o[db]); }
}
struct MaskBits { unsigned w; DI bool operator()(int ko) const { return (w >> ko) & 1u; } };
struct MaskBand { int hi, lo; DI bool operator()(int ko) const { return ko <= hi && ko >= lo; } };
struct MaskSel { int hi; bool on; DI bool operator()(int ko) const { return on && ko <= hi; } };

DI void a1_item(const Ptrs& P, int it) {
    const int wid = otid() >> 6, lane = otid() & 63, c = lane & 15, q4 = lane >> 4;
    const int b = it / 72; int rem = it % 72, qblk = 0;
    for (;; ++qblk) { const int nk = (qblk + 2) >> 1; if (rem < nk) break; rem -= nk; }
    const int kblk = rem, t0 = qblk * 128 + wid * 16, t = t0 + c;
    const bf16_t* IQ = wsp<bf16_t>(P, WS_IQ); const bf16_t* IK = wsp<bf16_t>(P, WS_IK); const float* IW = wsp<float>(P, WS_IW); float* SC = wsp<float>(P, WS_SC);
    bf16x8 iq[16][2]; float w[16];
#pragma unroll
    for (int h = 0; h < 16; ++h) { const bf16_t* p = IQ + (((size_t)b * 16 + h) * S + t) * 64 + 8 * q4; iq[h][0] = *(const bf16x8*)p; iq[h][1] = *(const bf16x8*)(p + 32); }
#pragma unroll
    for (int h4 = 0; h4 < 4; ++h4) { const f32x4 v = *(const f32x4*)(IW + ((size_t)b * S + t) * 16 + 4 * h4); w[4 * h4] = v[0]; w[4 * h4 + 1] = v[1]; w[4 * h4 + 2] = v[2]; w[4 * h4 + 3] = v[3]; }
    const int k16_lo = kblk * 16; int k16_hi = kblk * 16 + 15; const int lim = (t0 + 15) >> 4; if (k16_hi > lim) k16_hi = lim;
    for (int k16 = k16_lo; k16 <= k16_hi; ++k16) {
        const bf16_t* kp = IK + ((size_t)b * S + k16 * 16 + c) * 64 + 8 * q4;
        const bf16x8 k0 = *(const bf16x8*)kp, k1 = *(const bf16x8*)(kp + 32);
        f32x4 acc = (f32x4){0.f, 0.f, 0.f, 0.f};
#pragma unroll
        for (int h = 0; h < 16; ++h) { f32x4 s = (f32x4){0.f, 0.f, 0.f, 0.f}; s = MFMA16(k0, iq[h][0], s); s = MFMA16(k1, iq[h][1], s);
#pragma unroll
            for (int j = 0; j < 4; ++j) acc[j] += w[h] * fmaxf(s[j], 0.f); }
        *(f32x4*)(SC + ((size_t)b * S + t) * S + k16 * 16 + 4 * q4) = acc;
    }
}

DI void a2_row(const Ptrs& P, int row  ) {
    const int lane = otid() & 63, t = row & (S - 1);
    const float* sc = wsp<float>(P, WS_SC) + (size_t)row * S; unsigned long long* bits = wsp<unsigned long long>(P, WS_BITS) + (size_t)row * 32;
    unsigned long long mine = 0ull;
    if (t < 256) {
#pragma unroll
        for (int i = 0; i < 32; ++i) { const unsigned long long m = __ballot(64 * i + lane <= t); if (lane == i) mine = m; }
    } else {
        unsigned u[32];
#pragma unroll
        for (int i = 0; i < 32; ++i) { const int key = 64 * i + lane; unsigned x = 0u;
            if (key <= t) { const unsigned bts = __float_as_uint(sc[key]); x = (bts & 0x80000000u) ? ~bts : (bts | 0x80000000u); }
            u[i] = x; }
        unsigned prefix = 0u;
        for (int bit = 31; bit >= 0; --bit) { const unsigned cand = prefix | (1u << bit); int cnt = 0;
#pragma unroll
            for (int i = 0; i < 32; ++i) cnt += __builtin_popcountll(__ballot(u[i] >= cand));
            if (cnt >= 256) prefix = cand; }
        int cgt = 0;
#pragma unroll
        for (int i = 0; i < 32; ++i) cgt += __builtin_popcountll(__ballot(u[i] > prefix));
        const int need = 256 - cgt; int carried = 0; const unsigned long long lt = (lane == 0) ? 0ull : (~0ull >> (64 - lane));
#pragma unroll
        for (int i = 0; i < 32; ++i) { const bool eq = (u[i] == prefix); const unsigned long long meq = __ballot(eq);
            const int rk = carried + __builtin_popcountll(meq & lt); carried += __builtin_popcountll(meq);
            const bool sel = ((u[i] > prefix) || (eq && rk < need)) && (64 * i + lane <= t);
            const unsigned long long m = __ballot(sel); if (lane == i) mine = m; }
    }
    if (lane < 32) bits[lane] = mine;
}

DI void store_o(bf16_t* dst  , const FlashAcc& f, float scale, int q4) {
#pragma unroll
    for (int db = 0; db < 8; ++db) { u32x2 w; w.x = pk2(f.o[db][0] * scale, f.o[db][1] * scale); w.y = pk2(f.o[db][2] * scale, f.o[db][3] * scale); *(u32x2*)(dst + 16 * db + 4 * q4) = w; }
}
DI void a3_item(const Ptrs& P, int it) {
    const int wid = otid() >> 6, lane = otid() & 63, c = lane & 15, q4 = lane >> 4;
    const int qblk = 15 - (it >> 5), bh = it & 31, b = bh >> 2, h = bh & 3, t0 = qblk * 128 + wid * 16, t = t0 + c;
    bf16x8 qf[4]; load_q(qf, wsp<bf16_t>(P, WS_AQ) + (((size_t)b * 4 + h) * S + t) * 128, q4);
    const unsigned* brow = wsp<unsigned>(P, WS_BITS) + ((size_t)b * S + t) * 64;
    const bf16_t* K = wsp<bf16_t>(P, WS_AK) + (size_t)b * S * 128; const bf16_t* V = wsp<bf16_t>(P, WS_AVT) + (size_t)b * S * 128;
    FlashAcc f; flash_init(f);
    const int nkt = (t0 + 15) >> 5;
    for (int kt = 0; kt <= nkt; ++kt) {
        MaskBits mk; mk.w = brow[kt];
        if (__ballot(mk.w != 0u) == 0ull) continue;
        flash_tile(f, qf, K + (size_t)kt * 4096, V + (size_t)kt * 4096, mk, lane);
    }
    store_o(wsp<bf16_t>(P, WS_MIX) + ((size_t)b * S + t) * DM + h * 128, f, f.l > 0.f ? 1.0f / f.l : 0.f, q4);
}

template <int DIL> DI void b_item(const Ptrs& P, int it) {
    const int wid = otid() >> 6, lane = otid() & 63, c = lane & 15, q4 = lane >> 4;
    constexpr int M = S / DIL;
    const int bh = it >> 4, b = bh >> 2, h = bh & 3, p0 = (it & 15) * 128 + wid * 16, r = p0 / M, i0 = p0 - r * M, p = p0 + c, t = (i0 + c) * DIL + r;
    bf16x8 qf[4]; load_q(qf, wsp<bf16_t>(P, WS_BQ) + (((size_t)b * 4 + h) * S + t) * 128, q4);
    const bf16_t* K = wsp<bf16_t>(P, DIL == 1 ? WS_BK1 : (DIL == 4 ? WS_BK4 : WS_BK16)) + ((size_t)b * 4 + h) * S * 128;
    const bf16_t* V = wsp<bf16_t>(P, DIL == 1 ? WS_BVT1 : (DIL == 4 ? WS_BVT4 : WS_BVT16)) + ((size_t)b * 4 + h) * S * 128;
    FlashAcc f; flash_init(f);
    const int lo = r * M + (i0 > 128 ? i0 - 128 : 0);
    for (int kt = lo >> 5; kt <= ((p0 + 15) >> 5); ++kt) {
        MaskBand mk; mk.hi = p - 32 * kt; mk.lo = p - 128 - 32 * kt;
        flash_tile(f, qf, K + (size_t)kt * 4096, V + (size_t)kt * 4096, mk, lane);
    }
    const float inv = 1.0f / f.l, lse = f.m + __builtin_amdgcn_logf(f.l);
    const size_t row = (size_t)b * S + t;
    if (DIL != 1) {
        store_o(wsp<bf16_t>(P, DIL == 4 ? WS_OB4 : WS_OB16) + row * 512 + h * 128, f, inv, q4);
        if (q4 == 0) wsp<float>(P, DIL == 4 ? WS_LSE4 : WS_LSE16)[row * 4 + h] = lse;
    } else {
        const float l4 = wsp<float>(P, WS_LSE4)[row * 4 + h], l16 = wsp<float>(P, WS_LSE16)[row * 4 + h];
        const float mm = fmaxf(lse, fmaxf(l4, l16)), w1 = fexp2(lse - mm), w4 = fexp2(l4 - mm), w16 = fexp2(l16 - mm), wi = 1.0f / (w1 + w4 + w16);
        const bf16_t* o4 = wsp<bf16_t>(P, WS_OB4) + row * 512 + h * 128; const bf16_t* o16 = wsp<bf16_t>(P, WS_OB16) + row * 512 + h * 128;
        bf16_t* dst = wsp<bf16_t>(P, WS_MIX) + row * DM + 512 + h * 128;
        const float a1 = w1 * wi * inv, a4 = w4 * wi, a16 = w16 * wi;
#pragma unroll
        for (int db = 0; db < 8; ++db) { const u32x2 x4 = *(const u32x2*)(o4 + 16 * db + 4 * q4), x16 = *(const u32x2*)(o16 + 16 * db + 4 * q4);
            const float v0 = f.o[db][0] * a1 + bflo(x4.x) * a4 + bflo(x16.x) * a16, v1 = f.o[db][1] * a1 + bfhi(x4.x) * a4 + bfhi(x16.x) * a16;
            const float v2 = f.o[db][2] * a1 + bflo(x4.y) * a4 + bflo(x16.y) * a16, v3 = f.o[db][3] * a1 + bfhi(x4.y) * a4 + bfhi(x16.y) * a16;
            u32x2 w; w.x = pk2(v0, v1); w.y = pk2(v2, v3); *(u32x2*)(dst + 16 * db + 4 * q4) = w; }
    }
}

DI float gelu_tanh(float x) { const float u2 = 2.0f * 0.7978845608028654f * (x + 0.044715f * x * x * x); const float e = fexp2(u2 * 1.4426950408889634f); return x - x * frcp(e + 1.0f); }
DI void c1a_item(const Ptrs& P, int it) {
    const int wid = otid() >> 6, lane = otid() & 63, c = lane & 15, q4 = lane >> 4;
    const int kv = it >> 6, bg = (it >> 2) & 15, wt = (it & 3) * 8 + wid, rt = wt >> 2, ct = wt & 3;
    const bf16_t* A = wsp<bf16_t>(P, kv ? WS_VC : WS_KC) + ((size_t)bg * S + 16 * (16 * rt + c)) * 128 + 8 * q4;
    const bf16_t* Bt = wsp<bf16_t>(P, kv ? WS_CW1V : WS_CW1K) + (size_t)(64 * ct + c) * 4096 + 8 * q4;
    f32x4 acc[4];
#pragma unroll
    for (int n = 0; n < 4; ++n) acc[n] = (f32x4){0.f, 0.f, 0.f, 0.f};
#pragma unroll 4
    for (int ks = 0; ks < 128; ++ks) { const bf16x8 a = *(const bf16x8*)(A + 32 * ks);
#pragma unroll
        for (int n = 0; n < 4; ++n) { const bf16x8 bt = *(const bf16x8*)(Bt + (size_t)(16 * n) * 4096 + 32 * ks); acc[n] = MFMA16(bt, a, acc[n]); } }
    const float* bias = wsp<float>(P, WS_CB1) + kv * 256; bf16_t* G1 = wsp<bf16_t>(P, kv ? WS_G1V : WS_G1K) + ((size_t)bg * 128 + 16 * rt + c) * 256;
#pragma unroll
    for (int n = 0; n < 4; ++n) { const int col = 64 * ct + 16 * n + 4 * q4; const f32x4 bv = *(const f32x4*)(bias + col);
        u32x2 w; w.x = pk2(gelu_tanh(acc[n][0] + bv[0]), gelu_tanh(acc[n][1] + bv[1])); w.y = pk2(gelu_tanh(acc[n][2] + bv[2]), gelu_tanh(acc[n][3] + bv[3])); *(u32x2*)(G1 + col) = w; }
}
DI void c1b_item(const Ptrs& P, int it) {
    const int wid = otid() >> 6, lane = otid() & 63, c = lane & 15, q4 = lane >> 4;
    const int kv = it >> 4, rt = (it & 15) * 8 + wid, row = 16 * rt + c, bg = row >> 7, cc = row & 127;
    const bf16_t* A = wsp<bf16_t>(P, kv ? WS_G1V : WS_G1K) + (size_t)row * 256 + 8 * q4;
    const bf16_t* Bt = wsp<bf16_t>(P, kv ? WS_CW2V : WS_CW2K) + (size_t)c * 256 + 8 * q4;
    f32x4 acc[8];
#pragma unroll
    for (int n = 0; n < 8; ++n) acc[n] = (f32x4){0.f, 0.f, 0.f, 0.f};
#pragma unroll
    for (int ks = 0; ks < 8; ++ks) { const bf16x8 a = *(const bf16x8*)(A + 32 * ks);
#pragma unroll
        for (int n = 0; n < 8; ++n) { const bf16x8 bt = *(const bf16x8*)(Bt + (size_t)(16 * n) * 256 + 32 * ks); acc[n] = MFMA16(bt, a, acc[n]); } }
    const bool zr = (cc == 127);
    if (!kv) { bf16_t* dst = wsp<bf16_t>(P, WS_KCC) + ((size_t)bg * 128 + cc) * 128;
#pragma unroll
        for (int n = 0; n < 8; ++n) { u32x2 w; w.x = zr ? 0u : pk2(acc[n][0], acc[n][1]); w.y = zr ? 0u : pk2(acc[n][2], acc[n][3]); *(u32x2*)(dst + 16 * n + 4 * q4) = w; }
    } else { bf16_t* dst = wsp<bf16_t>(P, WS_VCT) + ((size_t)bg * 4 + (cc >> 5)) * 4096 + (cc & 31);
#pragma unroll
        for (int n = 0; n < 8; ++n)
#pragma unroll
            for (int j = 0; j < 4; ++j) dst[(16 * n + 4 * q4 + j) * 32] = zr ? (bf16_t)0 : (bf16_t)(pk2(acc[n][j], 0.f) & 0xffffu);
    }
}

DI void c2_item(const Ptrs& P, int it, unsigned char* lds) {
    const int wid = otid() >> 6, lane = otid() & 63, c = lane & 15, q4 = lane >> 4, r16 = lane & 15;
    const int bg = it >> 4, b = bg >> 1, g = bg & 1, t0 = (it & 15) * 128 + wid * 16, t = t0 + c, kr0 = 8 * (r16 >> 2) + (r16 & 3);
    const bf16_t* KCC = wsp<bf16_t>(P, WS_KCC) + (size_t)bg * 128 * 128 + (size_t)kr0 * 128 + 8 * q4; const bf16_t* VCT = wsp<bf16_t>(P, WS_VCT) + (size_t)bg * 4 * 4096 + r16 * 32 + 8 * q4;
    const float* gates = wsp<float>(P, WS_GATE) + ((size_t)b * S + t) * 24;
    const int cmax = (t >= 31) ? ((t - 31) >> 4) : -1;
    f32x4 ia[4][2];
#pragma unroll
    for (int kt = 0; kt < 4; ++kt) { ia[kt][0] = (f32x4){0.f, 0.f, 0.f, 0.f}; ia[kt][1] = (f32x4){0.f, 0.f, 0.f, 0.f}; }
#pragma unroll 1
    for (int rr = 0; rr < 4; ++rr) {
        const int hh = g * 4 + rr;
        asm volatile("" : "+v"(KCC), "+v"(VCT));
        bf16x8 qf[4]; load_q(qf, wsp<bf16_t>(P, WS_CQ) + (((size_t)b * 8 + hh) * S + t) * 128, q4);
        f32x4 s[4][2]; float mx = NEG;
#pragma unroll
        for (int kt = 0; kt < 4; ++kt)
#pragma unroll
            for (int sub = 0; sub < 2; ++sub) { f32x4 a = (f32x4){0.f, 0.f, 0.f, 0.f};
#pragma unroll
                for (int ks = 0; ks < 4; ++ks) { const bf16x8 kf = *(const bf16x8*)(KCC + (32 * kt + 4 * sub) * 128 + 32 * ks); a = MFMA16(kf, qf[ks], a); }
#pragma unroll
                for (int j = 0; j < 4; ++j) { const int cc = 32 * kt + 8 * q4 + 4 * sub + j; const bool ok = (cc <= cmax) && (cc < 127); a[j] = ok ? a[j] : NEG; mx = fmaxf(mx, a[j]); }
                s[kt][sub] = a; __builtin_amdgcn_sched_barrier(0); }
        mx = fmaxf(mx, __shfl_xor(mx, 16)); mx = fmaxf(mx, __shfl_xor(mx, 32));
        float den = 0.f;
#pragma unroll
        for (int kt = 0; kt < 4; ++kt)
#pragma unroll
            for (int sub = 0; sub < 2; ++sub)
#pragma unroll
                for (int j = 0; j < 4; ++j) { const float e = (s[kt][sub][j] > -5.0e29f) ? fexp2(s[kt][sub][j] - mx) : 0.f; s[kt][sub][j] = e; den += e; }
        den += __shfl_xor(den, 16); den += __shfl_xor(den, 32);
        const float inv = den > 0.f ? 1.0f / den : 0.f;
        f32x4 o[8];
#pragma unroll
        for (int db = 0; db < 8; ++db) o[db] = (f32x4){0.f, 0.f, 0.f, 0.f};
#pragma unroll
        for (int kt = 0; kt < 4; ++kt) { float p[8];
#pragma unroll
            for (int sub = 0; sub < 2; ++sub) { s[kt][sub] = s[kt][sub] * inv; ia[kt][sub] += s[kt][sub];
#pragma unroll
                for (int j = 0; j < 4; ++j) p[4 * sub + j] = s[kt][sub][j]; }
            const u32x4 pw = pack8(p); const bf16x8 pb = __builtin_bit_cast(bf16x8, pw);
#pragma unroll
            for (int db = 0; db < 8; ++db) { const bf16x8 vf = *(const bf16x8*)(VCT + kt * 4096 + (16 * db) * 32); o[db] = MFMA16(vf, pb, o[db]); }
            __builtin_amdgcn_sched_barrier(0); }
        const float g0 = gates[hh * 3 + 0]; bf16_t* dst = wsp<bf16_t>(P, WS_OC) + ((size_t)b * S + t) * 1024 + hh * 128;
#pragma unroll
        for (int db = 0; db < 8; ++db) { u32x2 w; w.x = pk2(o[db][0] * g0, o[db][1] * g0); w.y = pk2(o[db][2] * g0, o[db][3] * g0); *(u32x2*)(dst + 16 * db + 4 * q4) = w; }
    }
    float* impw = (float*)lds + wid * (16 * 33);
#pragma unroll
    for (int kt = 0; kt < 4; ++kt) {
        const float own = __shfl(ia[kt][1][3], (lane + 48) & 63);
        const float wrp = (kt > 0) ? __shfl(ia[kt > 0 ? kt - 1 : 0][1][3], (lane + 48) & 63) : 0.f;
        const float prev0 = (q4 == 0) ? wrp : own;
        const float v0 = (ia[kt][0][0] + ia[kt][0][1]) + (ia[kt][0][2] + ia[kt][0][3]) + prev0;
        const float v1 = (ia[kt][1][0] + ia[kt][1][1]) + (ia[kt][1][2] + ia[kt][1][3]) + ia[kt][0][3];
        impw[c * 33 + 8 * kt + 2 * q4] = v0; impw[c * 33 + 8 * kt + 2 * q4 + 1] = v1;
    }
    asm volatile("s_waitcnt lgkmcnt(0)" ::: "memory");
    __builtin_amdgcn_wave_barrier();
    const int cur = t >> 6; unsigned key[32];
#pragma unroll
    for (int n = 0; n < 32; ++n) { const float x = impw[c * 33 + n]; const float v = (n > cur) ? -__builtin_inff() : ((n == 0 || n == cur || n + 1 == cur) ? __builtin_inff() : x);
        const unsigned bts = __float_as_uint(v); const unsigned o = (bts & 0x80000000u) ? ~bts : (bts | 0x80000000u); key[n] = (o & ~31u) | (unsigned)(31 - n); }
    unsigned selbits = 0u;
#pragma unroll
    for (int e = 0; e < 8; ++e) { const int myn = 8 * q4 + e; const float x = impw[c * 33 + myn];
        const float v = (myn > cur) ? -__builtin_inff() : ((myn == 0 || myn == cur || myn + 1 == cur) ? __builtin_inff() : x);
        const unsigned bts = __float_as_uint(v); const unsigned o = (bts & 0x80000000u) ? ~bts : (bts | 0x80000000u); const unsigned km = (o & ~31u) | (unsigned)(31 - myn);
        int rank = 0;
#pragma unroll
        for (int n = 0; n < 32; ++n) rank += (key[n] > km) ? 1 : 0;
        if (rank < 16) selbits |= 1u << myn; }
    selbits |= __shfl_xor(selbits, 16); selbits |= __shfl_xor(selbits, 32);
    if (q4 == 0) wsp<unsigned>(P, WS_SEL)[(size_t)bg * S + t] = selbits;
    __builtin_amdgcn_wave_barrier();
}

DI void c45_item(const Ptrs& P, int it) {
    const int wid = otid() >> 6, lane = otid() & 63, c = lane & 15, q4 = lane >> 4;
    const int qblk = 15 - (it >> 6), bhh = it & 63, b = bhh >> 3, hh = bhh & 7, g = hh >> 2, t0 = qblk * 128 + wid * 16, t = t0 + c;
    bf16x8 qf[4]; load_q(qf, wsp<bf16_t>(P, WS_CQR) + (((size_t)b * 8 + hh) * S + t) * 128, q4);
    const unsigned sel = wsp<unsigned>(P, WS_SEL)[((size_t)b * 2 + g) * S + t];
    const size_t gb = ((size_t)b * 2 + g) * S * 128;
    const bf16_t* Ks = wsp<bf16_t>(P, WS_CKS) + gb; const bf16_t* Vs = wsp<bf16_t>(P, WS_CVST) + gb; const bf16_t* Kw = wsp<bf16_t>(P, WS_CKW) + gb; const bf16_t* Vw = wsp<bf16_t>(P, WS_CVWT) + gb;
    const int nkt = (t0 + 15) >> 5;
    FlashAcc f1; flash_init(f1);
    for (int kt = 0; kt <= nkt; ++kt) {
        MaskSel mk; mk.on = (sel >> (kt >> 1)) & 1u; mk.hi = t - 32 * kt;
        if (__ballot(mk.on) == 0ull) continue;
        flash_tile(f1, qf, Ks + (size_t)kt * 4096, Vs + (size_t)kt * 4096, mk, lane);
    }
    FlashAcc f2; flash_init(f2);
    for (int kt = (t0 > 511 ? (t0 - 511) >> 5 : 0); kt <= nkt; ++kt) {
        MaskBand mk; mk.hi = t - 32 * kt; mk.lo = t - 511 - 32 * kt;
        flash_tile(f2, qf, Kw + (size_t)kt * 4096, Vw + (size_t)kt * 4096, mk, lane);
    }
    const float* gates = wsp<float>(P, WS_GATE) + ((size_t)b * S + t) * 24 + hh * 3;
    const float a1 = gates[1] / f1.l, a2 = gates[2] / f2.l;
    const bf16_t* oc = wsp<bf16_t>(P, WS_OC) + ((size_t)b * S + t) * 1024 + hh * 128; bf16_t* dst = wsp<bf16_t>(P, WS_MIX) + ((size_t)b * S + t) * DM + 1024 + hh * 128;
#pragma unroll
    for (int db = 0; db < 8; ++db) { const u32x2 x = *(const u32x2*)(oc + 16 * db + 4 * q4);
        u32x2 w; w.x = pk2(bflo(x.x) + f1.o[db][0] * a1 + f2.o[db][0] * a2, bfhi(x.x) + f1.o[db][1] * a1 + f2.o[db][1] * a2);
        w.y = pk2(bflo(x.y) + f1.o[db][2] * a1 + f2.o[db][2] * a2, bfhi(x.y) + f1.o[db][3] * a1 + f2.o[db][3] * a2); *(u32x2*)(dst + 16 * db + 4 * q4) = w; }
}

constexpr int NPH = 12;
constexpr int NPHASES = 1 + DEPTH * NPH;
struct Args { const float* in[16]; float* out; unsigned char* ws; int ph_lo, ph_hi; };

__global__ void __launch_bounds__(512, 2) fwd(Args a) {
    extern __shared__ __attribute__((aligned(16))) unsigned char lds[];
    Ptrs P;
#pragma unroll
    for (int i = 0; i < 16; ++i) P.in[i] = a.in[i];
    P.out = a.out; P.ws = a.ws;
    const int lo = a.ph_lo, hi = a.ph_hi;
    volatile LAS unsigned* bst = (volatile LAS unsigned*)((LAS unsigned char*)lds + LDS_BAR_OFF);
    if (otid() < 4) bst[otid()] = 0u;
    __syncthreads();
    XcdBarrier bar; bar.bar = (unsigned*)(P.ws + WS_CTL); bar.x = 0; bar.st = bst;
    if (hi - lo > 1) bar = xcd_barrier_post((unsigned*)(P.ws + WS_CTL), bst);
#define IN(k) (lo <= (k) && (k) < hi)
#define SEAM(k) do { if (IN(k) && IN((k) + 1)) xcd_barrier(bar); } while (0)
    if (IN(0)) { phase_rope_tables(P); }
    SEAM(0);
    for (int layer = 0; layer < DEPTH; ++layer) {
        const int pb = 1 + layer * NPH;
        const float* xcur = (layer == 0) ? P.in[0] : P.out;
        if (IN(pb + 0)) { phase_wconv(P, layer, lds); if (layer == 0) phase_norm(P.in[0], nullptr, nullptr, nullptr, P.in[12], wsp<bf16_t>(P, WS_H)); }
        SEAM(pb + 0);
        if (IN(pb + 1)) { pg8::Gemm g{wsp<bf16_t>(P, WS_H), wsp<bf16_t>(P, WS_WIN), T, NPAD, DM}; pg8::StaticOrder So; So.init(T, NPAD, gridDim.x, blockIdx.x);
            pg8::EpiBf16<0> E{wsp<bf16_t>(P, WS_P), NPAD, nullptr, 0, 0}; pg8::gemm_phase<pg8::EpiBf16<0>, pg8::StaticOrder, false>((LAS unsigned char*)lds, g, So, E, nullptr); }
        SEAM(pb + 1);
        if (IN(pb + 2)) { phase_prep(P, lds); }
        SEAM(pb + 2);
        if (IN(pb + 3)) { constexpr int NA = NB * 72, NC = 128, NBI = 512, NI = NA + NC + 2 * NBI;
            for (int it = blockIdx.x; it < NI; it += gridDim.x) { if (it < NA) a1_item(P, it); else if (it < NA + NC) c1a_item(P, it - NA); else if (it < NA + NC + NBI) b_item<4>(P, it - NA - NC); else b_item<16>(P, it - NA - NC - NBI); } }
        SEAM(pb + 3);
        if (IN(pb + 4)) { for (int it = blockIdx.x; it < T / 8 + 32; it += gridDim.x) { if (it < 32) c1b_item(P, it); else { const int j = it - 32; a2_row(P, (T - 1) - (j * 8 + (otid() >> 6))); } } }
        SEAM(pb + 4);
        if (IN(pb + 5)) { constexpr int NA = 512, NC = 256, NBI = 512, NI = NA + NC + NBI;
            for (int it = blockIdx.x; it < NI; it += gridDim.x) { if (it < NA) a3_item(P, it); else if (it < NA + NC) c2_item(P, it - NA, lds); else b_item<1>(P, it - NA - NC); } }
        SEAM(pb + 5);
        if (IN(pb + 6)) { for (int it = blockIdx.x; it < 1024; it += gridDim.x) c45_item(P, it); }
        SEAM(pb + 6);
        if (IN(pb + 7)) { pg8::Gemm g{wsp<bf16_t>(P, WS_MIX), wsp<bf16_t>(P, WS_WOUT), T, DM, DM}; pg8::StaticOrder So; So.init(T, DM, gridDim.x, blockIdx.x);
            pg8::EpiBf16<0> E{wsp<bf16_t>(P, WS_Y), DM, nullptr, 0, 0}; pg8::gemm_phase<pg8::EpiBf16<0>, pg8::StaticOrder, false>((LAS unsigned char*)lds, g, So, E, nullptr); }
        SEAM(pb + 7);
        if (IN(pb + 8)) { phase_norm(xcur, P.out, wsp<bf16_t>(P, WS_Y), P.in[13] + (size_t)layer * DM, P.in[14] + (size_t)layer * DM, wsp<bf16_t>(P, WS_H)); }
        SEAM(pb + 8);
        if (IN(pb + 9)) { pg8::Gemm g{wsp<bf16_t>(P, WS_H), wsp<bf16_t>(P, WS_WGU), T, NGU, DM}; pg8::StaticOrder So; So.init(T, NGU, gridDim.x, blockIdx.x);
            EpiSwiglu E{wsp<bf16_t>(P, WS_HID), FF}; pg8::gemm_phase<EpiSwiglu, pg8::StaticOrder, false>((LAS unsigned char*)lds, g, So, E, nullptr); }
        SEAM(pb + 9);
        if (IN(pb + 10)) { pg8::Gemm g{wsp<bf16_t>(P, WS_HID), wsp<bf16_t>(P, WS_WDN), T, DM, FF}; pg8::StaticOrder So; So.init(T, DM, gridDim.x, blockIdx.x);
            pg8::EpiBf16<0> E{wsp<bf16_t>(P, WS_Y), DM, nullptr, 0, 0}; pg8::gemm_phase<pg8::EpiBf16<0>, pg8::StaticOrder, false>((LAS unsigned char*)lds, g, So, E, nullptr); }
        SEAM(pb + 10);
        if (IN(pb + 11)) { phase_norm(P.out, P.out, wsp<bf16_t>(P, WS_Y), P.in[15] + (size_t)layer * DM, (layer + 1 < DEPTH) ? P.in[12] + (size_t)(layer + 1) * DM : nullptr, (layer + 1 < DEPTH) ? wsp<bf16_t>(P, WS_H) : nullptr); }
        SEAM(pb + 11);
    }
#undef IN
#undef SEAM
}
}

#ifndef MK_ONE_LAUNCH
#define MK_ONE_LAUNCH 0
#endif
extern "C" void kernel_launch(void* const* d_in, const int* in_sizes, int n_in, void* d_out, int out_size, void* d_ws, size_t ws_size, hipStream_t stream) {
    static int grid = 0;
    if (grid == 0) {
        if (n_in != 16 || out_size != mk::T * mk::DM || ws_size < mk::WS_END) { fprintf(stderr, "kernel_launch: unexpected shapes (n_in %d, out %d, ws %zu < %zu)\n", n_in, out_size, ws_size, (size_t)mk::WS_END); grid = -1; return; }
        int dev = 0, cus = 0, per_cu = 0;
        if (hipGetDevice(&dev) != hipSuccess || hipDeviceGetAttribute(&cus, hipDeviceAttributeMultiprocessorCount, dev) != hipSuccess) { grid = -1; return; }
        if (hipFuncSetAttribute((const void*)mk::fwd, hipFuncAttributeMaxDynamicSharedMemorySize, mk::LDS_BYTES) != hipSuccess) { fprintf(stderr, "kernel_launch: hipFuncSetAttribute failed\n"); grid = -1; return; }
        if (hipOccupancyMaxActiveBlocksPerMultiprocessor(&per_cu, (const void*)mk::fwd, 512, mk::LDS_BYTES) != hipSuccess || per_cu < 1) { fprintf(stderr, "kernel_launch: occupancy query says %d blocks per CU\n", per_cu); }
        (void)hipGetLastError();
        grid = cus;
    }
    if (grid < 0) return;
    (void)in_sizes;
    hipMemsetAsync((char*)d_ws + mk::WS_CTL, 0, mk::CTL_BYTES, stream);
    mk::Args a{};
    for (int i = 0; i < 16; ++i) a.in[i] = (const float*)d_in[i];
    a.out = (float*)d_out; a.ws = (unsigned char*)d_ws;
#if MK_ONE_LAUNCH
    a.ph_lo = 0; a.ph_hi = mk::NPHASES;
    hipLaunchKernelGGL(mk::fwd, dim3(grid), dim3(512), mk::LDS_BYTES, stream, a);
#else
    for (int ph = 0; ph < mk::NPHASES; ++ph) { a.ph_lo = ph; a.ph_hi = ph + 1; hipLaunchKernelGGL(mk::fwd, dim3(grid), dim3(512), mk::LDS_BYTES, stream, a); }
#endif
}
```

```cpp
#include <hip/hip_runtime.h>
#include <cstdio>
#include <cstdint>
namespace pg8 {
#define PG8_LAS __attribute__((address_space(3)))
typedef unsigned short bf16_t;
typedef short bf16x8 __attribute__((ext_vector_type(8)));
typedef float f32x4 __attribute__((ext_vector_type(4)));
typedef unsigned u32x4 __attribute__((ext_vector_type(4)));
typedef int i32x4 __attribute__((ext_vector_type(4)));
typedef int i32x8 __attribute__((ext_vector_type(8)));
constexpr int BM = 256, BK = 64, HALF = 128, HTB = HALF * BK * 2  , STAGE_BYTES = 8 * HTB, NXCD = 8, WGM = 8;

__host__ __device__ __forceinline__ int lds_byte(int r, int c) { const int st = (r >> 4) * 2 + (c >> 5), rr = r & 15, cc = c & 31, ob = rr * 64 + cc * 2; return st * 1024 + (ob ^ (((ob >> 9) & 1) << 5)); }
__host__ __device__ __forceinline__ void stage_rc(int b, int& R, int& C) { const int st = b / 1024, sb = b % 1024, swz = sb ^ (((sb >> 9) & 1) << 5); R = (st >> 1) * 16 + swz / 64; C = (st & 1) * 32 + (swz % 64) / 2; }
__host__ __device__ __forceinline__ int perm32(int rho) { const int n = rho >> 4, i = rho & 15; return 8 * (i >> 2) + 4 * n + (i & 3); }

struct Unit { int pm, pn; };
struct Gemm { const bf16_t* A; const bf16_t* Bt; int M, N, K; int lda; };

struct StaticOrder {
    int nM, nN, nwg, G, c;
    __host__ __device__ void init(int M, int N, int G_, int c_) { nM = M / BM; nN = N / BM; nwg = nM * nN; G = G_; c = c_; }
    __host__ __device__ bool next(int i, Unit& u) const {
        const long L = (long)i * G + c; if (L >= nwg) return false;
        int wgid = (int)L; { const int q = nwg / NXCD, r = nwg % NXCD, xcd = wgid % NXCD, off = wgid / NXCD; wgid = (xcd < r ? xcd * (q + 1) : r * (q + 1) + (xcd - r) * q) + off; }
        const int nig = WGM * nN, gid = wgid / nig, fm = gid * WGM, gsz = (nM - fm) < WGM ? (nM - fm) : WGM;
        u.pm = fm + ((wgid % nig) % gsz); u.pn = (wgid % nig) / gsz; return true;
    }
    __device__ __forceinline__ void a_ready(const Unit&) const {}
    __device__ __forceinline__ void done(const Unit&) const {}
};
struct CountedOrder : StaticOrder {
    const unsigned* ready; unsigned need; unsigned* tmo;
    __device__ __forceinline__ void a_ready(const Unit& u) const {
        if (threadIdx.x < 64) {
            const unsigned long long t0 = __builtin_amdgcn_s_memrealtime(); unsigned polls = 0;
            while ((unsigned)__builtin_amdgcn_readfirstlane(__hip_atomic_load(ready + 64 * u.pm, __ATOMIC_RELAXED, __HIP_MEMORY_SCOPE_AGENT)) < need) {
                if ((++polls & 255u) == 0u && __builtin_amdgcn_readfirstlane(__hip_atomic_load(tmo, __ATOMIC_RELAXED, __HIP_MEMORY_SCOPE_AGENT)) != 0u) break;
                if (__builtin_amdgcn_s_memrealtime() - t0 > 2000000ull) {
                    if (threadIdx.x == 0) { unsigned expect = 0u; __hip_atomic_compare_exchange_strong(tmo + 1, &expect, 0x600u | (unsigned)(u.pm & 0xff), __ATOMIC_RELAXED, __ATOMIC_RELAXED, __HIP_MEMORY_SCOPE_AGENT); __hip_atomic_store(tmo, 1u, __ATOMIC_RELAXED, __HIP_MEMORY_SCOPE_AGENT); }
                    break; }
                __builtin_amdgcn_s_sleep(2); }
            __builtin_amdgcn_fence(__ATOMIC_ACQUIRE, "agent");
            asm volatile("s_waitcnt vmcnt(0)" ::: "memory");
        }
#if !defined(BROKEN_HOOK_NO_BARRIER)
        asm volatile("" ::: "memory"); __builtin_amdgcn_s_barrier(); asm volatile("" ::: "memory");
#endif
    }
};

__device__ __forceinline__ unsigned cvt_pk_bf16(float lo, float hi) { unsigned r; asm volatile("v_cvt_pk_bf16_f32 %0, %1, %2" : "=v"(r) : "v"(lo), "v"(hi)); return r; }
typedef float f32x2 __attribute__((ext_vector_type(2)));
__device__ __forceinline__ f32x2 gelu_pk(f32x2 v) {
    const f32x2 av = __builtin_elementwise_abs(v), d = av * 0.2316418882f + 1.0f;
    f32x2 t; t.x = __builtin_amdgcn_rcpf(d.x); t.y = __builtin_amdgcn_rcpf(d.y);
    f32x2 q = t * 0.5307027145f + (-0.7265760135f); q = q * t + 0.7107068705f; q = q * t + (-0.142248368f); q = q * t + 0.127414796f; q = q * t;
    const f32x2 s = (v * v) * (-0.72134752044f);
    f32x2 e; e.x = __builtin_amdgcn_exp2f(s.x); e.y = __builtin_amdgcn_exp2f(s.y);
    const f32x2 m = v * (q * e), r = v - m;
    f32x2 o; o.x = v.x < 0.f ? m.x : r.x; o.y = v.y < 0.f ? m.y : r.y; return o;
}

struct EpiF32 {
    static constexpr bool PERM = false, AFTER_DRAIN = false;
    float* C; int ldc; const float* bias;
    __device__ __forceinline__ void operator()(const f32x4 (&acc)[2][2][4][2], const Unit& u, int wr, int wc, int fr, int fq) const {
        const int row0 = u.pm * BM + wr * 64 + fr, col0 = u.pn * BM + wc * 32 + 4 * fq;
        f32x4 bv[2][2];
#pragma unroll
        for (int bj = 0; bj < 2; ++bj)
#pragma unroll
            for (int n = 0; n < 2; ++n) bv[bj][n] = bias ? *(const f32x4*)(bias + col0 + bj * HALF + n * 16) : (f32x4){0.f, 0.f, 0.f, 0.f};
#pragma unroll
        for (int ai = 0; ai < 2; ++ai)
#pragma unroll
            for (int m = 0; m < 4; ++m) { float* rowp = C + (size_t)(row0 + ai * HALF + m * 16) * ldc + col0;
#pragma unroll
                for (int bj = 0; bj < 2; ++bj)
#pragma unroll
                    for (int n = 0; n < 2; ++n) *(f32x4*)(rowp + bj * HALF + n * 16) = acc[ai][bj][m][n] + bv[bj][n]; }
    }
};
template <int ACT  > struct EpiBf16 {
    static constexpr bool PERM = true, AFTER_DRAIN = false;
    bf16_t* O; int ldc; const float* bias; int split_cols; size_t split_stride;
    __device__ __forceinline__ void operator()(const f32x4 (&acc)[2][2][4][2], const Unit& u, int wr, int wc, int fr, int fq) const {
        const int row0 = u.pm * BM + wr * 64 + fr; int colt = u.pn * BM; bf16_t* base = O;
        if (split_cols) { const int t = colt / split_cols; base += (size_t)t * split_stride; colt -= t * split_cols; }
        const int col0 = colt + wc * 32 + 8 * fq, bcol0 = u.pn * BM + wc * 32 + 8 * fq;
        f32x4 bv[2][2];
#pragma unroll
        for (int bj = 0; bj < 2; ++bj)
#pragma unroll
            for (int n = 0; n < 2; ++n) bv[bj][n] = bias ? *(const f32x4*)(bias + bcol0 + bj * HALF + 4 * n) : (f32x4){0.f, 0.f, 0.f, 0.f};
#pragma unroll
        for (int ai = 0; ai < 2; ++ai)
#pragma unroll
            for (int m = 0; m < 4; ++m) { bf16_t* rowp = base + (size_t)(row0 + ai * HALF + m * 16) * ldc + col0;
#pragma unroll
                for (int bj = 0; bj < 2; ++bj) { f32x4 v0 = acc[ai][bj][m][0] + bv[bj][0], v1 = acc[ai][bj][m][1] + bv[bj][1];
                    if (ACT == 1) { f32x2 a = gelu_pk((f32x2){v0[0], v0[1]}), b = gelu_pk((f32x2){v0[2], v0[3]}), c = gelu_pk((f32x2){v1[0], v1[1]}), d = gelu_pk((f32x2){v1[2], v1[3]});
                        v0 = (f32x4){a.x, a.y, b.x, b.y}; v1 = (f32x4){c.x, c.y, d.x, d.y}; }
                    if (ACT == 2) {
#pragma unroll
                        for (int j = 0; j < 4; ++j) { v0[j] = 0.5f * v0[j] * (1.0f + erff(v0[j] * 0.70710678f)); v1[j] = 0.5f * v1[j] * (1.0f + erff(v1[j] * 0.70710678f)); } }
                    u32x4 w; w.x = cvt_pk_bf16(v0[0], v0[1]); w.y = cvt_pk_bf16(v0[2], v0[3]); w.z = cvt_pk_bf16(v1[0], v1[1]); w.w = cvt_pk_bf16(v1[2], v1[3]);
                    *(u32x4*)(rowp + bj * HALF) = w; } }
    }
};

struct PanelStats {
    unsigned* xbuf;
    unsigned* cnt;
    unsigned* tmo;
    int ntn; float eps;
    unsigned code;
    __device__ __forceinline__ bool run(const f32x4 (&v)[2][2][4][2], const Unit& u, int wr, int wc, int fr, int fq, PG8_LAS unsigned char* lds, int wid, int lane) const {
        typedef float f32x2v __attribute__((ext_vector_type(2)));
        PG8_LAS f32x2v* P = (PG8_LAS f32x2v*)lds;
        PG8_LAS f32x2v* S = (PG8_LAS f32x2v*)(lds + 8192);
        PG8_LAS unsigned* flag = (PG8_LAS unsigned*)(lds + 8192 + 2048);
#pragma unroll
        for (int ai = 0; ai < 2; ++ai)
#pragma unroll
            for (int m = 0; m < 4; ++m) {
                float s = 0.f;
#pragma unroll
                for (int bj = 0; bj < 2; ++bj)
#pragma unroll
                    for (int n = 0; n < 2; ++n) { const f32x4 x = v[ai][bj][m][n]; s += (x[0] + x[1]) + (x[2] + x[3]); }
                s += __shfl_xor(s, 16); s += __shfl_xor(s, 32);
                const float mw = s * (1.0f / 64.0f); float q = 0.f;
#pragma unroll
                for (int bj = 0; bj < 2; ++bj)
#pragma unroll
                    for (int n = 0; n < 2; ++n) { const f32x4 d = v[ai][bj][m][n] - mw; q += (d[0] * d[0] + d[1] * d[1]) + (d[2] * d[2] + d[3] * d[3]); }
                q += __shfl_xor(q, 16); q += __shfl_xor(q, 32);
                if (fq == 0) P[(ai * HALF + wr * 64 + m * 16 + fr) * 4 + wc] = (f32x2v){mw, q};
            }
        asm volatile("s_waitcnt lgkmcnt(0)" ::: "memory"); __builtin_amdgcn_s_barrier(); asm volatile("" ::: "memory");
#if defined(BROKEN_NO_WAIT)
        if (blockIdx.x >= 64) { const long long t0 = clock64(); while (clock64() - t0 < 60000) __builtin_amdgcn_s_sleep(8); }
#endif
        const int row = wid * 32 + (lane & 31);
        if (lane < 32) {
            const f32x2v a = P[row * 4 + 0], b = P[row * 4 + 1], c = P[row * 4 + 2], d = P[row * 4 + 3];
            const float mt = (a.x + b.x + c.x + d.x) * 0.25f;
            const float da = a.x - mt, db = b.x - mt, dc = c.x - mt, dd = d.x - mt;
            const float m2 = (a.y + b.y) + (c.y + d.y) + 64.0f * ((da * da + db * db) + (dc * dc + dd * dd));
            unsigned long long* slot = (unsigned long long*)xbuf + ((size_t)(u.pm * BM + row) * 4 + u.pn);
            __hip_atomic_store(slot, ((unsigned long long)__float_as_uint(m2) << 32) | __float_as_uint(mt), __ATOMIC_RELAXED, __HIP_MEMORY_SCOPE_AGENT);
        }
        asm volatile("s_waitcnt vmcnt(0)" ::: "memory");
        if (lane == 0) __hip_atomic_fetch_add(cnt + 64 * u.pm, 1u, __ATOMIC_RELAXED, __HIP_MEMORY_SCOPE_AGENT);
        if (wid == 0) {
            bool dead = false; const unsigned long long t0 = __builtin_amdgcn_s_memrealtime(); const unsigned want = 8u * (unsigned)ntn;
            for (;;) {
#if defined(BROKEN_NO_WAIT)
                break;
#endif
                if ((unsigned)__builtin_amdgcn_readfirstlane(__hip_atomic_load(cnt + 64 * u.pm, __ATOMIC_RELAXED, __HIP_MEMORY_SCOPE_AGENT)) >= want) break;
                if (__builtin_amdgcn_s_memrealtime() - t0 > 2000000ull) {
                    if (lane == 0) { unsigned expect = 0u; __hip_atomic_compare_exchange_strong(tmo + 1, &expect, code | (unsigned)(u.pm & 0xff), __ATOMIC_RELAXED, __ATOMIC_RELAXED, __HIP_MEMORY_SCOPE_AGENT);
                                     __hip_atomic_store(tmo, 1u, __ATOMIC_RELAXED, __HIP_MEMORY_SCOPE_AGENT); }
                    dead = true; break; }
                __builtin_amdgcn_s_sleep(2);
            }
            __builtin_amdgcn_fence(__ATOMIC_ACQUIRE, "agent");
            if (lane == 0) flag[0] = dead ? 1u : 0u;
        }
        asm volatile("s_waitcnt vmcnt(0) lgkmcnt(0)" ::: "memory"); __builtin_amdgcn_s_barrier(); asm volatile("" ::: "memory");
        const bool bad = flag[0] != 0u;
        if (lane < 32) {
            const unsigned long long* slot = (const unsigned long long*)xbuf + (size_t)(u.pm * BM + row) * 4; float mt[4], m2[4]; float ms = 0.f;
#pragma unroll
            for (int t = 0; t < 4; ++t) { if (t < ntn) { const unsigned long long w = __hip_atomic_load(slot + t, __ATOMIC_RELAXED, __HIP_MEMORY_SCOPE_AGENT); mt[t] = __uint_as_float((unsigned)w); m2[t] = __uint_as_float((unsigned)(w >> 32)); } else { mt[t] = 0.f; m2[t] = 0.f; } ms += mt[t]; }
            const float mean = ms / (float)ntn; float q = 0.f;
#pragma unroll
            for (int t = 0; t < 4; ++t) if (t < ntn) { const float dm = mt[t] - mean; q += m2[t] + 256.0f * dm * dm; }
            S[row] = (f32x2v){mean, 1.0f / sqrtf(q / (256.0f * (float)ntn) + eps)};
        }
        asm volatile("s_waitcnt lgkmcnt(0)" ::: "memory"); __builtin_amdgcn_s_barrier(); asm volatile("" ::: "memory");
        return bad;
    }
};
struct EpiLnRes {
    static constexpr bool PERM = false, AFTER_DRAIN = true;
    const float* base; float* out; int ldc; const float* bias; PanelStats st; unsigned poison;
    __device__ __forceinline__ void refuse(size_t i0, size_t stride, int M, int N) const { const float q = __builtin_nanf(""); for (size_t i = i0; i < (size_t)M * N; i += stride) out[(i / N) * ldc + i % N] = q;
        if (i0 == 0) { unsigned expect = 0u; __hip_atomic_compare_exchange_strong(st.tmo + 1, &expect, 0x7f0u, __ATOMIC_RELAXED, __ATOMIC_RELAXED, __HIP_MEMORY_SCOPE_AGENT); __hip_atomic_store(st.tmo, 1u, __ATOMIC_RELAXED, __HIP_MEMORY_SCOPE_AGENT); } }
    __device__ __forceinline__ void fused(f32x4 (&acc)[2][2][4][2], const Unit& u, int wr, int wc, int fr, int fq, PG8_LAS unsigned char* lds, int wid, int lane) const {
        typedef float f32x2v __attribute__((ext_vector_type(2)));
        const PG8_LAS f32x2v* S = (const PG8_LAS f32x2v*)(lds + 8192);
        const int col0 = u.pn * BM + wc * 32 + 4 * fq;
#pragma unroll
        for (int bj = 0; bj < 2; ++bj)
#pragma unroll
            for (int n = 0; n < 2; ++n) { const f32x4 bv = bias ? *(const f32x4*)(bias + col0 + bj * HALF + n * 16) : (f32x4){0.f, 0.f, 0.f, 0.f};
#pragma unroll
                for (int ai = 0; ai < 2; ++ai)
#pragma unroll
                    for (int m = 0; m < 4; ++m) acc[ai][bj][m][n] += bv; }
        const bool bad = st.run(acc, u, wr, wc, fr, fq, lds, wid, lane) || poison != 0u;
        const float qnan = __builtin_nanf("");
#pragma unroll
        for (int ai = 0; ai < 2; ++ai)
#pragma unroll
            for (int m = 0; m < 4; ++m) { const int r = ai * HALF + wr * 64 + m * 16 + fr; const f32x2v sr = S[r]; const size_t off = (size_t)(u.pm * BM + r) * ldc + col0;
#pragma unroll
                for (int bj = 0; bj < 2; ++bj)
#pragma unroll
                    for (int n = 0; n < 2; ++n) { const f32x4 bs = *(const f32x4*)(base + off + bj * HALF + n * 16); f32x4 o = bs + (acc[ai][bj][m][n] - sr.x) * sr.y;
                        if (bad) o = (f32x4){qnan, qnan, qnan, qnan}; *(f32x4*)(out + off + bj * HALF + n * 16) = o; }
                asm volatile("" ::: "memory"); }
    }
};
struct EpiLnResLn {
    static constexpr bool PERM = false, AFTER_DRAIN = true;
    const float* base; float* out; bf16_t* xn; int ldc; const float* bias; PanelStats st1, st2; unsigned poison;
    __device__ __forceinline__ void refuse(size_t i0, size_t stride, int M, int N) const { const float q = __builtin_nanf(""); for (size_t i = i0; i < (size_t)M * N; i += stride) { const size_t o = (i / N) * ldc + i % N; out[o] = q; xn[o] = (bf16_t)0x7fc0u; }
        if (i0 == 0) { unsigned expect = 0u; __hip_atomic_compare_exchange_strong(st1.tmo + 1, &expect, 0x7f0u, __ATOMIC_RELAXED, __ATOMIC_RELAXED, __HIP_MEMORY_SCOPE_AGENT); __hip_atomic_store(st1.tmo, 1u, __ATOMIC_RELAXED, __HIP_MEMORY_SCOPE_AGENT); } }
    __device__ __forceinline__ void fused(f32x4 (&acc)[2][2][4][2], const Unit& u, int wr, int wc, int fr, int fq, PG8_LAS unsigned char* lds, int wid, int lane) const {
        typedef float f32x2v __attribute__((ext_vector_type(2))); typedef unsigned u32x2v __attribute__((ext_vector_type(2)));
        const PG8_LAS f32x2v* S = (const PG8_LAS f32x2v*)(lds + 8192);
        const int col0 = u.pn * BM + wc * 32 + 4 * fq;
#pragma unroll
        for (int bj = 0; bj < 2; ++bj)
#pragma unroll
            for (int n = 0; n < 2; ++n) { const f32x4 bv = bias ? *(const f32x4*)(bias + col0 + bj * HALF + n * 16) : (f32x4){0.f, 0.f, 0.f, 0.f};
#pragma unroll
                for (int ai = 0; ai < 2; ++ai)
#pragma unroll
                    for (int m = 0; m < 4; ++m) acc[ai][bj][m][n] += bv; }
        bool bad = st1.run(acc, u, wr, wc, fr, fq, lds, wid, lane) || poison != 0u;
        const float qnan = __builtin_nanf("");
#pragma unroll
        for (int ai = 0; ai < 2; ++ai)
#pragma unroll
            for (int m = 0; m < 4; ++m) { const int r = ai * HALF + wr * 64 + m * 16 + fr; const f32x2v sr = S[r]; const size_t off = (size_t)(u.pm * BM + r) * ldc + col0;
#pragma unroll
                for (int bj = 0; bj < 2; ++bj)
#pragma unroll
                    for (int n = 0; n < 2; ++n) { const f32x4 bs = *(const f32x4*)(base + off + bj * HALF + n * 16); acc[ai][bj][m][n] = bs + (acc[ai][bj][m][n] - sr.x) * sr.y; }
                asm volatile("" : "+v"(acc[ai][0][m][0]), "+v"(acc[ai][0][m][1]), "+v"(acc[ai][1][m][0]), "+v"(acc[ai][1][m][1]));
                if (m & 1) asm volatile("" ::: "memory"); }
        const bool bad1 = bad;
        bad = st2.run(acc, u, wr, wc, fr, fq, lds, wid, lane) || bad;
#pragma unroll
        for (int ai = 0; ai < 2; ++ai)
#pragma unroll
            for (int m = 0; m < 4; ++m) { const int r = ai * HALF + wr * 64 + m * 16 + fr; const f32x2v sr = S[r]; const size_t off = (size_t)(u.pm * BM + r) * ldc + col0;
#pragma unroll
                for (int bj = 0; bj < 2; ++bj)
#pragma unroll
                    for (int n = 0; n < 2; ++n) { const f32x4 x1 = acc[ai][bj][m][n]; *(f32x4*)(out + off + bj * HALF + n * 16) = bad1 ? (f32x4){qnan, qnan, qnan, qnan} : x1;
                        const f32x4 o = (x1 - sr.x) * sr.y; u32x2v w; w.x = cvt_pk_bf16(o[0], o[1]); w.y = cvt_pk_bf16(o[2], o[3]);
                        if (bad) { w.x = 0x7fc07fc0u; w.y = 0x7fc07fc0u; } *(u32x2v*)(xn + off + bj * HALF + n * 16) = w; }
                asm volatile("" ::: "memory"); }
    }
};

template <class E, class = void> struct is_staged { static constexpr bool value = false; };
template <class E> struct is_staged<E, decltype((void)E::STAGED)> { static constexpr bool value = true; };
template <class Epi, class Sched, bool STAMP = false, int F8 = 0  >
__device__ __forceinline__ void gemm_phase(PG8_LAS unsigned char* lds, const Gemm g, const Sched& S, const Epi& E, unsigned long long* stamps) {
    int tid_o = threadIdx.x; asm volatile("" : "+v"(tid_o)); const int tid = tid_o, wid = __builtin_amdgcn_readfirstlane(tid >> 6), lane = tid & 63, wr = wid >> 2, wc = wid & 3, fr = lane & 15, fq = lane >> 4;
    const int K = g.K, nt = K / BK, LDA = g.lda ? g.lda : g.K;
    int ts_lo = 0, ts_hi = 0, nts = 0; const unsigned long long rt_entry = STAMP ? (unsigned long long)wall_clock64() : 0ull;
#define PG8_STAMP() do { if (STAMP && wid == 0 && nts < 64) { const unsigned long long _c = (unsigned long long)clock64(); \
        ts_lo = (lane == nts) ? (int)(unsigned)_c : ts_lo; ts_hi = (lane == nts) ? (int)(unsigned)(_c >> 32) : ts_hi; ++nts; } } while (0)
    PG8_STAMP();
    unsigned voffA[2], voffB[2];
#pragma unroll
    for (int i = 0; i < 2; ++i) { int R, C; stage_rc(tid * 16 + i * 8192, R, C); const int Rb = Epi::PERM ? ((R & ~31) + perm32(R & 31)) : R;
        voffA[i] = (unsigned)(R * LDA + C) * 2u; voffB[i] = (unsigned)(Rb * K + C) * 2u; }
    const size_t kstep = (size_t)(BK * 2);
    const size_t hstep = (size_t)HALF * K * 2;
    const size_t tstep = 2 * hstep;
    const size_t hstepA = (size_t)HALF * LDA * 2, tstepA = 2 * hstepA;
    const unsigned ldsw = (unsigned)wid * 1024u;
    const int aoff = lds_byte(wr * 64 + fr, fq * 8), boff = lds_byte(wc * 32 + fr, fq * 8);
#define PG8_SA(b, h) (((b) * 2 + (h)) * HTB)
#define PG8_SB(b, h) ((4 + (b) * 2 + (h)) * HTB)
#define PG8_STAGE(bufoff, gbase, voff) do { _Pragma("unroll") for (int _i = 0; _i < 2; ++_i) \
        __builtin_amdgcn_global_load_lds((const unsigned*)((const char*)(gbase) + (voff)[_i]), (PG8_LAS unsigned*)(lds + (bufoff) + ldsw + _i * 8192), 16, 0, 0); } while (0)
#define PG8_LDA(dst, b, h) do { _Pragma("unroll") for (int m = 0; m < 4; ++m) _Pragma("unroll") for (int k = 0; k < 2; ++k) dst[m][k] = *(const PG8_LAS bf16x8*)(lds + PG8_SA(b, h) + aoff + m * 2048 + k * 1024); } while (0)
#define PG8_LDB(dst, b, h) do { _Pragma("unroll") for (int n = 0; n < 2; ++n) _Pragma("unroll") for (int k = 0; k < 2; ++k) dst[n][k] = *(const PG8_LAS bf16x8*)(lds + PG8_SB(b, h) + boff + n * 2048 + k * 1024); } while (0)
#define PG8_CAT(x, y) __builtin_shufflevector(__builtin_bit_cast(i32x4, (x)), __builtin_bit_cast(i32x4, (y)), 0, 1, 2, 3, 4, 5, 6, 7)
#define PG8_MMA(ai, bj, At, Bt) do { __builtin_amdgcn_s_setprio(1); _Pragma("unroll") for (int m = 0; m < 4; ++m) _Pragma("unroll") for (int n = 0; n < 2; ++n) { \
        if constexpr (F8 == 2) { _Pragma("unroll") for (int k = 0; k < 2; ++k) acc[ai][bj][m][n] = __builtin_bit_cast(f32x4, __builtin_amdgcn_mfma_i32_16x16x64_i8(__builtin_bit_cast(i32x4, Bt[n][k]), __builtin_bit_cast(i32x4, At[m][k]), __builtin_bit_cast(i32x4, acc[ai][bj][m][n]), 0, 0, 0)); } \
        else if constexpr (F8 == 1) { const i32x8 _a = PG8_CAT(Bt[n][0], Bt[n][1]), _b = PG8_CAT(At[m][0], At[m][1]); asm volatile("v_mfma_f32_16x16x128_f8f6f4 %0, %1, %2, %0" : "+v"(acc[ai][bj][m][n]) : "v"(_a), "v"(_b)); } \
        else { _Pragma("unroll") for (int k = 0; k < 2; ++k) acc[ai][bj][m][n] = __builtin_amdgcn_mfma_f32_16x16x32_bf16(Bt[n][k], At[m][k], acc[ai][bj][m][n], 0, 0, 0); } } \
        __builtin_amdgcn_s_setprio(0); } while (0)
#define PG8_WAIT_V(n) asm volatile("s_waitcnt vmcnt(" #n ")" ::: "memory")
#define PG8_WAIT_L(n) asm volatile("s_waitcnt lgkmcnt(" #n ")" ::: "memory")
#define PG8_BAR __builtin_amdgcn_s_barrier()
#define PG8_SCHED __builtin_amdgcn_sched_barrier(0)
    Unit cur, nxt; int ui = 0;
    if (!S.next(0, cur)) return;
    f32x4 acc[2][2][4][2];
#pragma unroll
    for (int a = 0; a < 2; ++a)
#pragma unroll
        for (int b = 0; b < 2; ++b)
#pragma unroll
            for (int m = 0; m < 4; ++m)
#pragma unroll
                for (int n = 0; n < 2; ++n) acc[a][b][m][n] = (f32x4){0.f, 0.f, 0.f, 0.f};
    bf16x8 At[4][2], B0[2][2], B1[2][2];
    const char* cA = (const char*)g.A + (size_t)cur.pm * tstepA; const char* cB = (const char*)g.Bt + (size_t)cur.pn * tstep;
    S.a_ready(cur);
    PG8_STAGE(PG8_SB(0, 0), cB, voffB); PG8_STAGE(PG8_SA(0, 0), cA, voffA); PG8_STAGE(PG8_SB(0, 1), cB + hstep, voffB); PG8_STAGE(PG8_SA(0, 1), cA + hstepA, voffA);
    if (wr == 1) PG8_BAR;
    PG8_WAIT_V(4); PG8_BAR;
    PG8_STAGE(PG8_SB(1, 0), cB + kstep, voffB); PG8_STAGE(PG8_SA(1, 0), cA + kstep, voffA); PG8_STAGE(PG8_SB(1, 1), cB + hstep + kstep, voffB);
    PG8_WAIT_V(6); PG8_BAR;
    PG8_STAMP();
    for (;;) {
        const bool has_next = S.next(ui + 1, nxt);
        const char* nA = has_next ? (const char*)g.A + (size_t)nxt.pm * tstepA : cA; const char* nB = has_next ? (const char*)g.Bt + (size_t)nxt.pn * tstep : cB;
        for (int t = 0; t < nt; t += 2) {
            const bool last = (t == nt - 2);
            const char* a1 = cA + (size_t)(t + 1) * kstep;
            const char* a2 = last ? nA : cA + (size_t)(t + 2) * kstep; const char* b2 = last ? nB : cB + (size_t)(t + 2) * kstep;
            const char* a3 = a2 + kstep; const char* b3 = b2 + kstep;
            if (last && has_next) S.a_ready(nxt);
            PG8_LDB(B0, 0, 0); PG8_SCHED; PG8_LDA(At, 0, 0); PG8_STAGE(PG8_SA(1, 1), a1 + hstepA, voffA);
            PG8_WAIT_L(8); PG8_BAR; PG8_WAIT_L(0); PG8_MMA(0, 0, At, B0); PG8_BAR; PG8_SCHED;
            PG8_LDB(B1, 0, 1); PG8_STAGE(PG8_SB(0, 0), b2, voffB);
            PG8_BAR; PG8_WAIT_L(0); PG8_MMA(0, 1, At, B1); PG8_BAR;
            PG8_LDA(At, 0, 1); PG8_STAGE(PG8_SA(0, 0), a2, voffA);
            PG8_BAR; PG8_WAIT_L(0); PG8_MMA(1, 0, At, B0); PG8_BAR; PG8_SCHED;
            PG8_STAGE(PG8_SB(0, 1), b2 + hstep, voffB);
            PG8_WAIT_V(6); PG8_BAR; PG8_MMA(1, 1, At, B1); PG8_BAR;
            PG8_LDB(B0, 1, 0); PG8_SCHED; PG8_LDA(At, 1, 0); PG8_STAGE(PG8_SA(0, 1), a2 + hstepA, voffA);
            PG8_WAIT_L(8); PG8_BAR; PG8_WAIT_L(0); PG8_MMA(0, 0, At, B0); PG8_BAR; PG8_SCHED;
            PG8_LDB(B1, 1, 1); PG8_STAGE(PG8_SB(1, 0), b3, voffB);
            PG8_BAR; PG8_WAIT_L(0); PG8_MMA(0, 1, At, B1); PG8_BAR;
            PG8_LDA(At, 1, 1); PG8_STAGE(PG8_SA(1, 0), a3, voffA);
            PG8_BAR; PG8_WAIT_L(0); PG8_MMA(1, 0, At, B0); PG8_BAR; PG8_SCHED;
            PG8_STAGE(PG8_SB(1, 1), b3 + hstep, voffB);
            PG8_WAIT_V(6); PG8_BAR; PG8_MMA(1, 1, At, B1); PG8_BAR;
        }
        PG8_STAMP();
        if constexpr (F8 == 1) asm volatile("s_nop 15\n\ts_nop 15" ::: "memory");
        if constexpr (Epi::AFTER_DRAIN) {}
        else if constexpr (is_staged<Epi>::value) {
            if (wr == 0) PG8_BAR;
            E.staged(acc, cur, wr, wc, fr, fq, lds + STAGE_BYTES + 256, wid, lane);
            if (wr == 1) PG8_BAR;
            S.done(cur); }
        else if constexpr (!Epi::AFTER_DRAIN) { E(acc, cur, wr, wc, fr, fq); S.done(cur); }
        PG8_STAMP();
        if (!has_next) break;
#pragma unroll
        for (int a = 0; a < 2; ++a)
#pragma unroll
            for (int b = 0; b < 2; ++b)
#pragma unroll
                for (int m = 0; m < 4; ++m)
#pragma unroll
                    for (int n = 0; n < 2; ++n) acc[a][b][m][n] = (f32x4){0.f, 0.f, 0.f, 0.f};
        cur = nxt; cA = nA; cB = nB; ++ui;
    }
    PG8_WAIT_V(0);
    if (wr == 0) PG8_BAR;
    PG8_BAR;
    if constexpr (Epi::AFTER_DRAIN) { E.fused(acc, cur, wr, wc, fr, fq, lds, wid, lane); S.done(cur); }
    PG8_STAMP();
    if (STAMP && wid == 0) { stamps[lane] = lane < nts ? (((unsigned long long)(unsigned)ts_hi << 32) | (unsigned)ts_lo) : 0ull;
        if (lane == 62) stamps[62] = rt_entry; if (lane == 63) stamps[63] = (unsigned long long)wall_clock64(); }
#undef PG8_STAMP
#undef PG8_SA
#undef PG8_SB
#undef PG8_STAGE
#undef PG8_LDA
#undef PG8_LDB
#undef PG8_MMA
#undef PG8_CAT
#undef PG8_WAIT_V
#undef PG8_WAIT_L
#undef PG8_BAR
#undef PG8_SCHED
}
}
#define XB_TMO      128
#define XB_XCNT(j)  (256  + 64 * (j))
#define XB_XSUB(j)  (1280 + 64 * (j))
#define XB_XGEN(j)  (2304 + 64 * (j))
#define XB_TOP      3328
#define XB_TOPGEN   3392
#define XCD_BAR_WORDS 3456
#define XB_SPIN_CAP (1u << 23)
#define LAS __attribute__((address_space(3)))

__device__ __forceinline__ unsigned xb_ld(unsigned* p)              { return __hip_atomic_load(p, __ATOMIC_RELAXED, __HIP_MEMORY_SCOPE_AGENT); }
__device__ __forceinline__ unsigned xb_add(unsigned* p, unsigned v) { return __hip_atomic_fetch_add(p, v, __ATOMIC_RELAXED, __HIP_MEMORY_SCOPE_AGENT); }
__device__ __forceinline__ unsigned xb_xcc_id() { return (unsigned)__builtin_amdgcn_s_getreg((3 << 11) | 20) & 0xFu; }
#define XB_SPIN(cond, bar) do { unsigned _sp = 0; while (cond) { __builtin_amdgcn_s_sleep(1); \
    if ((++_sp & 255u) == 0u) { if (xb_ld(&(bar)[XB_TMO])) break; if (_sp > XB_SPIN_CAP) { atomicAdd(&(bar)[XB_TMO], 1u); break; } } } } while (0)

struct XcdBarrier {
    unsigned* bar; unsigned x;
    volatile LAS unsigned* st;
};

__device__ __forceinline__ XcdBarrier xcd_barrier_post(unsigned* bar, volatile LAS unsigned* st) {
    XcdBarrier b; b.bar = bar; b.x = xb_xcc_id(); b.st = st;
    if (threadIdx.x == 0) (void)xb_add(&bar[XB_XCNT(b.x)], 1u);
    return b;
}
__device__ __forceinline__ void xcd_barrier_complete(unsigned* bar, unsigned x, unsigned& nloc, unsigned& nx) {
    const unsigned G = gridDim.x * gridDim.y * gridDim.z;
    unsigned sum, cnt, mine, sp = 0u;
    for (;;) {
        sum = 0u; cnt = 0u; mine = 0u;
#pragma unroll
        for (unsigned j = 0; j < 16; ++j) { const unsigned c = xb_ld(&bar[XB_XCNT(j)]); sum += c; cnt += (c > 0u) ? 1u : 0u; mine = (j == x) ? c : mine; }
        if (sum == G) break;
        __builtin_amdgcn_s_sleep(1);
        if ((++sp & 255u) == 0u) { if (xb_ld(&bar[XB_TMO])) break; if (sp > XB_SPIN_CAP) { atomicAdd(&bar[XB_TMO], 1u); break; } }
    }
    nloc = mine > 0u ? mine : 1u; nx = cnt > 0u ? cnt : 1u;
}

__device__ __forceinline__ void xcd_barrier(const XcdBarrier& b) {
    asm volatile("s_waitcnt vmcnt(0)" ::: "memory");
    __syncthreads();
    if (threadIdx.x == 0) {
        unsigned* bar = b.bar;
        __builtin_amdgcn_s_waitcnt(0);
        unsigned nloc = b.st[0], nx = b.st[1];
        if (nloc == 0u) { xcd_barrier_complete(bar, b.x, nloc, nx); b.st[0] = nloc; b.st[1] = nx; }
        const unsigned old = xb_add(&bar[XB_XSUB(b.x)], 1u);
        const unsigned gen = old / nloc;
        if (old + 1u == (gen + 1u) * nloc) {
            __builtin_amdgcn_fence(__ATOMIC_RELEASE, "agent");
            asm volatile("s_waitcnt vmcnt(0)" ::: "memory");
            const unsigned og = xb_add(&bar[XB_TOP], 1u);
            const unsigned tg = og / nx;
            if (og + 1u == (tg + 1u) * nx) xb_add(&bar[XB_TOPGEN], 1u);
            else XB_SPIN(xb_ld(&bar[XB_TOPGEN]) == tg, bar);
            __builtin_amdgcn_fence(__ATOMIC_ACQUIRE, "agent");
            xb_add(&bar[XB_XGEN(b.x)], 1u);
            asm volatile("s_waitcnt vmcnt(0)" ::: "memory");
        } else {
            XB_SPIN(xb_ld(&bar[XB_XGEN(b.x)]) == gen, bar);
            __builtin_amdgcn_fence(__ATOMIC_ACQUIRE, "agent");
            asm volatile("s_waitcnt vmcnt(0)" ::: "memory");
        }
    }
    __syncthreads();
}

namespace fa {
typedef unsigned short bf16;
typedef short bf16x8 __attribute__((ext_vector_type(8)));
typedef short s16x4 __attribute__((ext_vector_type(4)));
typedef float f32x16 __attribute__((ext_vector_type(16)));
typedef float f32x4 __attribute__((ext_vector_type(4)));
typedef unsigned u32x4 __attribute__((ext_vector_type(4)));
typedef unsigned u32x2 __attribute__((ext_vector_type(2)));
constexpr int D = 128, SEQ = 2048;
constexpr float SCALE = 0.08838834764831845f, THR = 8.f;
constexpr int NW = 8, QBLK = 32, KVBLK = 64, QB = NW * QBLK;
constexpr int SHM_V = KVBLK * D * 2, SHM_K = KVBLK * D * 2;
constexpr int LDS_BYTES = 2 * SHM_V + 2 * SHM_K + NW * 64 * 4;
enum { M_WIN = 0, M_SEL = 1, M_BITS = 2 };

#define KSWZ(row, colB) ((row) * 256 + ((colB) ^ (((row) & 7) << 4)))
#define SBAR() __builtin_amdgcn_sched_barrier(0)
__device__ __forceinline__ int v_st(int k, int c) { const int kk = (k & ~0xC) | ((k & 4) << 1) | ((k & 8) >> 1); return ((kk >> 3) * 4 + (c >> 5)) * 512 + ((kk & 7) * 32 + (c & 31)) * 2; }
__device__ __forceinline__ int v_rd_base(int lane) { return ((lane & 3) << 3) | (((lane >> 2) & 3) << 6) | (((lane >> 4) & 1) << 5) | (((lane >> 5) & 1) << 8); }
constexpr int v_rd_off(int d0, int ks, int half) { return d0 * 512 + ks * 4096 + half * 2048; }
__device__ __forceinline__ int crow(int r, int hi) { return (r & 3) + 8 * (r >> 2) + 4 * hi; }
__device__ __forceinline__ unsigned cvtpk(float lo, float hi) { unsigned r; asm volatile("v_cvt_pk_bf16_f32 %0, %1, %2" : "=v"(r) : "v"(lo), "v"(hi)); return r; }
__device__ __forceinline__ int opq(int x) { asm volatile("" : "+v"(x)); return x; }
__device__ __forceinline__ bf16x8 load8(const bf16* p) { return *reinterpret_cast<const bf16x8*>(p); }

__device__ __forceinline__ void mask_tile(f32x16& p0, f32x16& p1, int dq, unsigned W) {
    const float NEG = -__builtin_inff();
#pragma unroll
    for (int r = 0; r < 16; ++r) {
        const int c = (r & 3) + 8 * (r >> 2);
        if ((unsigned)(dq - c) >= W) p0[r] = NEG;
        if ((unsigned)(dq - c - 32) >= W) p1[r] = NEG;
    }
}
__device__ __forceinline__ void mask_all(f32x16& p0, f32x16& p1) {
    const float NEG = -__builtin_inff();
#pragma unroll
    for (int r = 0; r < 16; ++r) { p0[r] = NEG; p1[r] = NEG; }
}
__device__ __forceinline__ void mask_bits(f32x16& p0, f32x16& p1, unsigned wlo, unsigned whi, int hi) {
    const float NEG = -__builtin_inff();
    const unsigned a = wlo >> (4 * hi), b = whi >> (4 * hi);
#pragma unroll
    for (int r = 0; r < 16; ++r) {
        const int c = (r & 3) + 8 * (r >> 2);
        if (!((a >> c) & 1u)) p0[r] = NEG;
        if (!((b >> c) & 1u)) p1[r] = NEG;
    }
}
__device__ __forceinline__ void partialSM(f32x16& p0, f32x16& p1, float& m_reg, float& mn, float& alpha) {
    float pmax = p0[0]; for (int r = 1; r < 16; ++r) pmax = fmaxf(pmax, p0[r]); for (int r = 0; r < 16; ++r) pmax = fmaxf(pmax, p1[r]);
    { auto rr = __builtin_amdgcn_permlane32_swap(__float_as_uint(pmax), __float_as_uint(pmax), false, false);
      pmax = fmaxf(__uint_as_float(rr[0]), __uint_as_float(rr[1])); }
    constexpr float C2 = 1.4426950408889634f * SCALE;
    if (__builtin_expect(__all((pmax - m_reg) * SCALE <= THR), 1)) { mn = m_reg; alpha = 1.f; }
    else { mn = fmaxf(m_reg, pmax); alpha = __builtin_amdgcn_exp2f((m_reg - mn) * C2); m_reg = mn; }
    const float mnL = -mn * C2;
    for (int r = 0; r < 16; ++r) p0[r] = fmaf(p0[r], C2, mnL); for (int r = 0; r < 16; ++r) p1[r] = fmaf(p1[r], C2, mnL);
    for (int r = 0; r < 16; ++r) p0[r] = __builtin_amdgcn_exp2f(p0[r]);
}
__device__ __forceinline__ void finishSM(f32x16& p0, f32x16& p1, float alpha, float& l_reg, bf16x8& pa0, bf16x8& pa1, bf16x8& pa2, bf16x8& pa3) {
    for (int r = 0; r < 16; ++r) p1[r] = __builtin_amdgcn_exp2f(p1[r]);
    float ps = 0; for (int r = 0; r < 16; ++r) ps += p0[r]; for (int r = 0; r < 16; ++r) ps += p1[r];
    { auto rr = __builtin_amdgcn_permlane32_swap(__float_as_uint(ps), __float_as_uint(ps), false, false);
      ps = __uint_as_float(rr[0]) + __uint_as_float(rr[1]); }
    l_reg = l_reg * alpha + ps;
#define PK4(P, B_, OUT) do { unsigned a0 = cvtpk(P[B_+0], P[B_+1]), a1 = cvtpk(P[B_+2], P[B_+3]);                          \
        unsigned b0 = cvtpk(P[B_+4], P[B_+5]), b1 = cvtpk(P[B_+6], P[B_+7]);                                             \
        auto r0 = __builtin_amdgcn_permlane32_swap(a0, b0, false, false); auto r1 = __builtin_amdgcn_permlane32_swap(a1, b1, false, false); \
        u32x4 w = {r0[0], r1[0], r0[1], r1[1]}; OUT = *reinterpret_cast<bf16x8*>(&w); } while (0)
    PK4(p0, 0, pa0); PK4(p0, 8, pa1); PK4(p1, 0, pa2); PK4(p1, 8, pa3);
#undef PK4
}
template <int KB>
__device__ __forceinline__ void qkt(f32x16& p0, f32x16& p1, const char* K_lds, int r32, int hi, const bf16x8* qr, bool act) {
    if (!act) { mask_all(p0, p1); return; }
    p0 = f32x16{}; p1 = f32x16{};
    const char* kb[4];
#pragma unroll
    for (int dd = 0; dd < 4; ++dd) kb[dd] = K_lds + KB * SHM_K + KSWZ(r32, (dd * 16 + hi * 8) * 2);
#pragma unroll
    for (int d0 = 0; d0 < 8; ++d0) { const char* a = kb[d0 & 3] + (d0 >> 2) * 128;
        bf16x8 b0 = *reinterpret_cast<const bf16x8*>(a);
        bf16x8 b1 = *reinterpret_cast<const bf16x8*>(a + 32 * 256);
        p0 = __builtin_amdgcn_mfma_f32_32x32x16_bf16(b0, qr[d0], p0, 0, 0, 0);
        p1 = __builtin_amdgcn_mfma_f32_32x32x16_bf16(b1, qr[d0], p1, 0, 0, 0); }
}
template <int VB>
__device__ __forceinline__ void pv_tile(f32x16* o, int vb0, bf16x8 pa0, bf16x8 pa1, bf16x8 pa2, bf16x8 pa3, bool act) {
    if (!act) return;
#define TRRD(dst, off) asm volatile("ds_read_b64_tr_b16 %0, %1 offset:%2" : "=&v"(dst) : "v"(vb0), "i"(off) : "memory")
#define PV_D0(d0) do { s16x4 l0, l1, l2, l3, h0, h1, h2, h3; constexpr int b_ = VB * SHM_V + v_rd_off(d0, 0, 0); \
        TRRD(l0, b_); TRRD(h0, b_ + 2048); TRRD(l1, b_ + 4096); TRRD(h1, b_ + 6144); TRRD(l2, b_ + 8192); TRRD(h2, b_ + 10240); TRRD(l3, b_ + 12288); TRRD(h3, b_ + 14336); \
        asm volatile("s_waitcnt lgkmcnt(0)" ::: "memory"); SBAR();   \
        o[d0] = __builtin_amdgcn_mfma_f32_32x32x16_bf16(pa0, (bf16x8){l0[0], l0[1], l0[2], l0[3], h0[0], h0[1], h0[2], h0[3]}, o[d0], 0, 0, 0);   \
        o[d0] = __builtin_amdgcn_mfma_f32_32x32x16_bf16(pa1, (bf16x8){l1[0], l1[1], l1[2], l1[3], h1[0], h1[1], h1[2], h1[3]}, o[d0], 0, 0, 0);   \
        o[d0] = __builtin_amdgcn_mfma_f32_32x32x16_bf16(pa2, (bf16x8){l2[0], l2[1], l2[2], l2[3], h2[0], h2[1], h2[2], h2[3]}, o[d0], 0, 0, 0);   \
        o[d0] = __builtin_amdgcn_mfma_f32_32x32x16_bf16(pa3, (bf16x8){l3[0], l3[1], l3[2], l3[3], h3[0], h3[1], h3[2], h3[3]}, o[d0], 0, 0, 0); } while (0)
    PV_D0(0); PV_D0(1); PV_D0(2); PV_D0(3);
#undef PV_D0
#undef TRRD
}

struct BlockRef { const bf16* Q; const bf16* K; const bf16* V; bf16* O; float* LSE; const unsigned* aux; int P0, ldo, lstr, mode, Wu, m, ecode; };
struct EpiPtrs { const bf16* oc; const bf16* owin; const float* gate; const bf16* ob4; const bf16* ob16; const float* lse4; const float* lse16; };
struct Seam { bf16x8 qr[8]; bf16x8 st_v0, st_v1, st_k0, st_k1; };
__device__ __forceinline__ int jlo_of(const BlockRef& r) { if (r.mode != M_WIN) return 0; int lowk = r.P0 - r.Wu + 1; const int cls = r.P0 & ~(r.m - 1); if (lowk < cls) lowk = cls;
    return lowk > 0 ? lowk / KVBLK : 0; }
__device__ __forceinline__ int tok_of(const BlockRef& r, int p) { return (p & (r.m - 1)) * (SEQ / r.m) + p / r.m; }
#define LDG(base, off) (*reinterpret_cast<const bf16x8*>(reinterpret_cast<const char*>(base) + (off)))
#define VMW() asm volatile("s_waitcnt vmcnt(0)" ::: "memory")
#define VMWN(n) asm volatile("s_waitcnt vmcnt(%0)" :: "i"(n) : "memory")
#define SLOAD_H(R, k0) do { const int t_ = opq(tid); const int p0_ = (k0) + (t_ >> 4), p1_ = p0_ + 32, lm_ = 31 - __builtin_clz((R).m), ld_ = 11 - lm_;                                 \
                         const unsigned c_ = (unsigned)((t_ & 15) * 16);                                                                                                                 \
                         const unsigned o0_ = (unsigned)((((p0_ & ((R).m - 1)) << ld_) + (p0_ >> lm_)) * (D * 2)) + c_, o1_ = (unsigned)((((p1_ & ((R).m - 1)) << ld_) + (p1_ >> lm_)) * (D * 2)) + c_; \
                         S.st_v0 = LDG((R).V, o0_); S.st_v1 = LDG((R).V, o1_); S.st_k0 = LDG((R).K, o0_); S.st_k1 = LDG((R).K, o1_); } while (0)
#define SWRITE_HK(bf) do { const int t_ = opq(tid); const int kws_ = KSWZ(t_ >> 4, (t_ & 15) * 16); *(bf16x8*)(K_lds + (bf) * SHM_K + kws_) = S.st_k0; *(bf16x8*)(K_lds + (bf) * SHM_K + kws_ + 32 * 256) = S.st_k1; } while (0)
#define SWRITE_HV(bf) do { const int t_ = opq(tid); *(bf16x8*)(V_lds + (bf) * SHM_V + v_st(t_ >> 4, (t_ & 15) * 8)) = S.st_v0; *(bf16x8*)(V_lds + (bf) * SHM_V + v_st(32 + (t_ >> 4), (t_ & 15) * 8)) = S.st_v1; } while (0)
#define SWRITE_H(bf) do { SWRITE_HV(bf); SWRITE_HK(bf); } while (0)
__device__ __forceinline__ void prime(const BlockRef& cur, char* lds, Seam& S, int tid) {
    const int wid = __builtin_amdgcn_readfirstlane(tid >> 6), lane = tid & 63, r32 = lane & 31, hi = lane >> 5;
    char* K_lds = lds + 2 * SHM_V;
    const int kb0 = jlo_of(cur) * KVBLK;
    const bf16* qrow = cur.Q + (size_t)tok_of(cur, cur.P0 + wid * QBLK + r32) * D + hi * 8;
    for (int d0 = 0; d0 < 8; ++d0) S.qr[d0] = load8(qrow + d0 * 16);
    SLOAD_H(cur, kb0); VMW(); SWRITE_HK(0);
    __syncthreads();
}
template <class NF> __device__ __forceinline__ void block(const BlockRef& cur, BlockRef& nxt, NF& nf, const EpiPtrs& ep, char* lds, Seam& S, int tid) {
    const int wid = __builtin_amdgcn_readfirstlane(tid >> 6), lane = tid & 63, r32 = lane & 31, hi = lane >> 5;
    const int mode = cur.mode, W = cur.Wu;
    const int j_lo = jlo_of(cur);
    int j_hi = (cur.P0 + QB - 1) / KVBLK + 1; if (j_hi > SEQ / KVBLK) j_hi = SEQ / KVBLK;
    const int NT = j_hi - j_lo;
    const int qlo = cur.P0 + wid * QBLK;
    const int cbase = qlo & (cur.m - 1);
    const bool force = cbase < W - 1;
    unsigned mrow = 0u;
    if (mode == M_SEL) mrow = cur.aux[qlo + r32];
    char* V_lds = lds; char* K_lds = lds + 2 * SHM_V;
    char* mstg = lds + (wid < 7 ? LDS_BYTES + wid * (32 * 272) : 131072 + 256);
    if (mode == M_BITS) {
        const int l_ = opq(lane); const char* src_ = (const char*)cur.aux + (size_t)(qlo + (l_ >> 4)) * 256 + (l_ & 15) * 16; char* dst_ = mstg + (l_ >> 4) * 272 + (l_ & 15) * 16;
#pragma unroll
        for (int i = 0; i < 8; ++i) *(u32x4*)(dst_ + i * 4 * 272) = *(const u32x4*)(src_ + (size_t)i * 4 * 256); }
    float* ws = (float*)(lds + 2 * SHM_V + 2 * SHM_K) + wid * 64; float* li_l = ws, * al_l = ws + 32;
    float m_reg = -1e30f, l_reg = 0; f32x16 o[4] = {};
#define VB0 ((int)(uintptr_t)V_lds + v_rd_base(opq(lane)))
#define RESC(a) do { if (__any((a) < 1.f)) { if (hi == 0) al_l[r32] = (a); asm volatile("s_waitcnt lgkmcnt(0)" ::: "memory");              \
                     for (int d_ = 0; d_ < 4; ++d_) for (int r = 0; r < 16; ++r) o[d_][r] *= al_l[crow(r, hi)]; } } while (0)
#define KBASE(t) ((j_lo + (t)) * KVBLK)
#define ACT(t) ((mode == M_WIN) ? (KBASE(t) <= qlo + QBLK - 1 && KBASE(t) + KVBLK - 1 >= qlo - W + 1) : ((mode == M_SEL) ? (__any((mrow >> (j_lo + (t))) & 1u) && KBASE(t) <= qlo + QBLK - 1) : (KBASE(t) <= qlo + QBLK - 1)))
#define MASKT(P0_, P1_, t) do { const int kb_ = KBASE(t); if (ACT(t)) { const int l_ = opq(lane); const int qm = qlo + (l_ & 31) - 4 * (l_ >> 5);                                                                                        \
        if (mode == M_WIN) { if (force || kb_ + KVBLK - 1 > qlo || kb_ <= qlo + QBLK - 1 - W) { int rx_ = r32; asm volatile("" : "+v"(rx_));                   \
                const unsigned cp_ = (unsigned)(cbase + rx_ + 1); mask_tile(P0_, P1_, qm - kb_, cp_ < (unsigned)W ? cp_ : (unsigned)W); } }                     \
        else if (mode == M_SEL) { if (kb_ + KVBLK - 1 > qlo) mask_tile(P0_, P1_, qm - kb_, 0x7fffffffu); if (!((mrow >> (j_lo + (t))) & 1u)) mask_all(P0_, P1_); } \
        else { const u32x2 w_ = *(const u32x2*)(mstg + (l_ & 31) * 272 + 8 * (j_lo + (t))); mask_bits(P0_, P1_, w_.x, w_.y, hi); } } } while (0)
    constexpr int NQL = 8;
#define SEAM_K0() do { VMWN(NQL); SWRITE_HK(0); SBAR(); } while (0)
    f32x16 pA0, pA1, pB0, pB1; float mnA, mnB, alA, alB; bf16x8 pa0, pa1, pa2, pa3;
    SWRITE_HV(0); SBAR();
    if (NT > 1) { SLOAD_H(cur, KBASE(1)); }
    SBAR(); qkt<0>(pA0, pA1, K_lds, opq(r32), hi, S.qr, ACT(0));
    MASKT(pA0, pA1, 0); partialSM(pA0, pA1, m_reg, mnA, alA);
    if (NT > 1) { VMW(); SWRITE_H(1); }
    __syncthreads();
#define HALF_STEP(PX0, PX1, mnX, alX, PY0, PY1, alY, t, KB, VB, SB) do {                                                      \
        SBAR(); qkt<KB>(PX0, PX1, K_lds, opq(r32), hi, S.qr, ACT(t));                                                 \
        finishSM(PY0, PY1, alY, l_reg, pa0, pa1, pa2, pa3); SBAR();                                                           \
        if ((t) + 1 < NT) { SLOAD_H(cur, KBASE((t) + 1)); SBAR(); }                                                        \
        pv_tile<VB>(o, VB0, pa0, pa1, pa2, pa3, ACT((t) - 1)); MASKT(PX0, PX1, (t)); partialSM(PX0, PX1, m_reg, mnX, alX);    \
        __syncthreads();                                                                                                      \
        if ((t) + 1 < NT) { VMW(); SWRITE_H(SB); }                                                                            \
        RESC(alX); __syncthreads(); } while (0)
    for (int t = 1; t + 1 < NT; t += 2) {
        HALF_STEP(pB0, pB1, mnB, alB, pA0, pA1, alA, t, 1, 0, 0);
        HALF_STEP(pA0, pA1, mnA, alA, pB0, pB1, alB, t + 1, 0, 1, 1);
    }
    const bool even = (NT & 1) == 0;
    if (even) { SBAR(); qkt<1>(pB0, pB1, K_lds, opq(r32), hi, S.qr, ACT(NT - 1)); SBAR(); }
    nxt = nf(cur); const int kbn = jlo_of(nxt) * KVBLK;
    SLOAD_H(nxt, kbn); SBAR();
    { const bf16* qrow = nxt.Q + (size_t)tok_of(nxt, nxt.P0 + wid * QBLK + r32) * D + hi * 8;
#pragma unroll
      for (int d0 = 0; d0 < 8; ++d0) S.qr[d0] = load8(qrow + d0 * 16); }
    SBAR();
    finishSM(pA0, pA1, alA, l_reg, pa0, pa1, pa2, pa3); SBAR();
    pv_tile<0>(o, VB0, pa0, pa1, pa2, pa3, ACT(even ? NT - 2 : NT - 1));
    if (even) { MASKT(pB0, pB1, NT - 1); partialSM(pB0, pB1, m_reg, mnB, alB); __syncthreads(); RESC(alB);
        finishSM(pB0, pB1, alB, l_reg, pa0, pa1, pa2, pa3); SBAR(); pv_tile<1>(o, VB0, pa0, pa1, pa2, pa3, ACT(NT - 1)); }
    SBAR(); SEAM_K0();
    if (hi == 0) li_l[r32] = l_reg; asm volatile("s_waitcnt lgkmcnt(0)" ::: "memory");
    if (cur.LSE && hi == 0) cur.LSE[(size_t)tok_of(cur, qlo + r32) * cur.lstr] = m_reg * (1.4426950408889634f * SCALE) + __builtin_amdgcn_logf(l_reg);
    float rli[16];
#pragma unroll
    for (int r = 0; r < 16; ++r) rli[r] = __builtin_amdgcn_rcpf(li_l[crow(r, hi)]);
    const int emode = cur.ecode & 15;
    if (emode == 0) {
        char* stg = lds + (wid < 7 ? LDS_BYTES + wid * (32 * 272) : 131072 + 256);
        { const int l_ = opq(lane); char* wp_ = stg + (4 * (l_ >> 5)) * 272 + (l_ & 31) * 2;
#pragma unroll
          for (int r = 0; r < 16; ++r)
#pragma unroll
            for (int d0 = 0; d0 < 4; ++d0) *(unsigned short*)(wp_ + ((r & 3) + 8 * (r >> 2)) * 272 + d0 * 64) = (unsigned short)cvtpk(o[d0][r] * rli[r], 0.f); }
        asm volatile("s_waitcnt lgkmcnt(0)" ::: "memory");
        { const int l_ = opq(lane); const char* rp_ = stg + (l_ >> 4) * 272 + (l_ & 15) * 16;
#pragma unroll
          for (int i = 0; i < 8; ++i) { const u32x4 v = *(const u32x4*)(rp_ + i * 4 * 272);
              *(u32x4*)(cur.O + (size_t)tok_of(cur, qlo + i * 4 + (l_ >> 4)) * cur.ldo + (l_ & 15) * 8) = v; } }
    } else {
        const int ehead = (cur.ecode >> 4) & 15, etb = (cur.ecode >> 8) * SEQ;
        if (emode == 3) { if (hi == 0) al_l[r32] = m_reg * (1.4426950408889634f * SCALE) + __builtin_amdgcn_logf(l_reg); }
        char* stg = lds + (wid < 7 ? LDS_BYTES + wid * (32 * 272) : 131072 + 256);
        { const int l_ = opq(lane); char* wp_ = stg + (4 * (l_ >> 5)) * 272 + (l_ & 31) * 2;
#pragma unroll
          for (int r = 0; r < 16; ++r)
#pragma unroll
            for (int d0 = 0; d0 < 4; ++d0) *(unsigned short*)(wp_ + ((r & 3) + 8 * (r >> 2)) * 272 + d0 * 64) = (unsigned short)cvtpk(o[d0][r] * rli[r], 0.f); }
        asm volatile("s_waitcnt lgkmcnt(0)" ::: "memory");
        const int l_ = opq(lane), rq = l_ >> 4, c8 = (l_ & 15) * 8;
        const char* rp_ = stg + rq * 272 + (l_ & 15) * 16;
#pragma unroll
        for (int ib = 0; ib < 8; ib += 4) {
            u32x4 wo[4], wa[4], wb[4]; float s0[4], s1[4], l1[4];
#pragma unroll
            for (int k = 0; k < 4; ++k) { const int row = (ib + k) * 4 + rq; const size_t tg = (size_t)(etb + qlo + row);
                wo[k] = *(const u32x4*)(rp_ + (ib + k) * 4 * 272);
                if (emode == 2) { const float* gp = ep.gate + tg * 24 + ehead * 3; s0[k] = gp[1]; s1[k] = gp[2]; l1[k] = 0.f;
                    const size_t e = tg * 1024 + ehead * 128 + c8; wa[k] = *(const u32x4*)(ep.oc + e); wb[k] = *(const u32x4*)(ep.owin + e); }
                else { s0[k] = ep.lse4[tg * 4 + ehead]; s1[k] = ep.lse16[tg * 4 + ehead]; l1[k] = al_l[row];
                    const size_t e = tg * 512 + ehead * 128 + c8; wa[k] = *(const u32x4*)(ep.ob4 + e); wb[k] = *(const u32x4*)(ep.ob16 + e); } }
#pragma unroll
            for (int k = 0; k < 4; ++k) { const int row = (ib + k) * 4 + rq;
                float c0, ca, cb;
                if (emode == 2) { c0 = s0[k]; ca = 1.0f; cb = s1[k]; }
                else { const float mm = fmaxf(l1[k], fmaxf(s0[k], s1[k])), w1 = __builtin_amdgcn_exp2f(l1[k] - mm), w4 = __builtin_amdgcn_exp2f(s0[k] - mm), w16 = __builtin_amdgcn_exp2f(s1[k] - mm);
                    const float wi = __builtin_amdgcn_rcpf(w1 + w4 + w16); c0 = w1 * wi; ca = w4 * wi; cb = w16 * wi; }
                u32x4 w;
#pragma unroll
                for (int j = 0; j < 4; ++j) { const unsigned uo = wo[k][j], ua = wa[k][j], ub = wb[k][j];
                    const float x0 = c0 * __uint_as_float(uo << 16) + ca * __uint_as_float(ua << 16) + cb * __uint_as_float(ub << 16);
                    const float x1 = c0 * __uint_as_float(uo & 0xffff0000u) + ca * __uint_as_float(ua & 0xffff0000u) + cb * __uint_as_float(ub & 0xffff0000u);
                    w[j] = cvtpk(x0, x1); }
                *(u32x4*)(cur.O + (size_t)(qlo + row) * cur.ldo + c8) = w; }
        }
    }
    __syncthreads();
#undef RESC
#undef KBASE
#undef ACT
#undef MASKT
#undef SEAM_K0
#undef HALF_STEP
#undef VB0
}
#undef LDG
#undef VMW
#undef VMWN
#undef SLOAD_H
#undef SWRITE_HK
#undef SWRITE_HV
#undef SWRITE_H
#undef KSWZ
}
#ifndef MK_DUP_PH
#define MK_DUP_PH 0
#endif
namespace mk {
typedef unsigned short bf16_t;
typedef short bf16x8 __attribute__((ext_vector_type(8)));
typedef float f32x4 __attribute__((ext_vector_type(4)));
typedef float f32x2 __attribute__((ext_vector_type(2)));
typedef unsigned u32x4 __attribute__((ext_vector_type(4)));
typedef unsigned u32x2 __attribute__((ext_vector_type(2)));
typedef __bf16 bf16x2n __attribute__((ext_vector_type(2)));
#define DI __device__ __forceinline__
DI int otid() { int t = threadIdx.x; asm volatile("" : "+v"(t)); return t; }

constexpr int NB = 8, S = 2048, DM = 2048, T = NB * S, DEPTH = 4;
constexpr int NPAD = 6144, INW = 5992, FF = 5632, NGU = 2 * FF;
constexpr int NSEG = 47;
constexpr float QSCALE = 0.08838834764831845f * 1.4426950408889634f;
constexpr float NEG = -1.0e30f;
constexpr float RMS_EPS = 1e-6f;

constexpr size_t AL(size_t x) { return (x + 255) & ~(size_t)255; }
constexpr size_t WS_CTL   = 0;
constexpr size_t CTL_BYTES = 65536;
constexpr size_t WS_COS128 = WS_CTL + CTL_BYTES;
constexpr size_t WS_SIN128 = WS_COS128 + (size_t)S * 64 * 4;
constexpr size_t WS_COS64  = WS_SIN128 + (size_t)S * 64 * 4;
constexpr size_t WS_SIN64  = WS_COS64 + (size_t)S * 32 * 4;
constexpr size_t WS_WIN   = WS_SIN64 + (size_t)S * 32 * 4;
constexpr size_t WS_WOUT  = WS_WIN + (size_t)NPAD * DM * 2;
constexpr size_t WS_WGU   = WS_WOUT + (size_t)DM * DM * 2;
constexpr size_t WS_WDN   = WS_WGU + (size_t)NGU * DM * 2;
constexpr size_t WS_CW1K  = WS_WDN + (size_t)DM * FF * 2;
constexpr size_t WS_CW1V  = WS_CW1K + (size_t)256 * 4096 * 2;
constexpr size_t WS_CW2K  = WS_CW1V + (size_t)256 * 4096 * 2;
constexpr size_t WS_CW2V  = WS_CW2K + (size_t)128 * 256 * 2;
constexpr size_t WS_CB1   = WS_CW2V + (size_t)128 * 256 * 2;
constexpr size_t WS_H     = AL(WS_CB1 + 2 * 256 * 4);
constexpr size_t WS_MIX   = WS_H + (size_t)T * DM * 2;
constexpr size_t WS_BIG   = WS_MIX + (size_t)T * DM * 2;
constexpr size_t WS_P     = WS_BIG;
constexpr size_t WS_SC    = WS_BIG;
constexpr size_t WS_HID   = WS_BIG;
constexpr size_t WS_PREP  = WS_BIG + (size_t)T * NPAD * 2;
constexpr size_t WS_Y     = WS_PREP;
constexpr size_t SZ_H4 = (size_t)T * 512 * 2, SZ_H1 = (size_t)T * 128 * 2, SZ_H8 = (size_t)T * 1024 * 2, SZ_H2 = (size_t)T * 256 * 2;
constexpr size_t WS_AQ   = WS_PREP;
constexpr size_t WS_AK   = WS_AQ + SZ_H4;
constexpr size_t WS_AVT  = WS_AK + SZ_H1;
constexpr size_t WS_IQ   = WS_AVT + SZ_H1;
constexpr size_t WS_IK   = WS_IQ + SZ_H8;
constexpr size_t WS_IW   = WS_IK + (size_t)T * 64 * 2;
constexpr size_t WS_GATE = WS_IW + (size_t)T * 16 * 4;
constexpr size_t WS_BQ   = WS_GATE + (size_t)T * 24 * 4;
constexpr size_t WS_BK1  = WS_BQ + SZ_H4;
constexpr size_t WS_BVT1 = WS_BK1 + SZ_H4;
constexpr size_t WS_BK4  = WS_BK1, WS_BK16 = WS_BK1, WS_BVT4 = WS_BVT1, WS_BVT16 = WS_BVT1;
constexpr size_t WS_CQ   = WS_BVT1 + SZ_H4;
constexpr size_t WS_CQR  = WS_CQ + SZ_H8;
constexpr size_t WS_KC   = WS_CQR + SZ_H8;
constexpr size_t WS_VC   = WS_KC + SZ_H2 + 65536;
constexpr size_t WS_CKS  = WS_VC + SZ_H2 + 65536;
constexpr size_t WS_CVST = WS_CKS + SZ_H2;
constexpr size_t WS_CKW  = WS_CVST + SZ_H2;
constexpr size_t WS_CVWT = WS_CKW + SZ_H2;
constexpr size_t WS_PREP_END = WS_CVWT + SZ_H2;
constexpr size_t WS_BITS = WS_PREP_END;
constexpr size_t WS_OB4  = WS_BITS + (size_t)T * 64 * 4;
constexpr size_t WS_OB16 = WS_OB4 + SZ_H4;
constexpr size_t WS_LSE4 = WS_OB16 + SZ_H4;
constexpr size_t WS_LSE16 = WS_LSE4 + (size_t)T * 4 * 4;
constexpr size_t WS_LSE1 = WS_LSE16 + (size_t)T * 4 * 4;
constexpr size_t WS_OB1  = WS_LSE1 + (size_t)T * 4 * 4;
constexpr size_t WS_OSLC = WS_OB1 + SZ_H4;
constexpr size_t WS_OWIN = WS_OSLC + SZ_H8;
constexpr size_t WS_OC   = WS_OWIN + SZ_H8;
constexpr size_t WS_G1K  = WS_OC + SZ_H8;
constexpr size_t WS_G1V  = WS_G1K + (size_t)2048 * 256 * 2;
constexpr size_t WS_KCC  = WS_G1V + (size_t)2048 * 256 * 2;
constexpr size_t WS_VCT  = WS_KCC + (size_t)16 * 128 * 128 * 2;
constexpr size_t WS_SEL  = WS_VCT + (size_t)16 * 128 * 128 * 2;
constexpr size_t WS_XB   = AL(WS_SEL + (size_t)16 * S * 4);
constexpr size_t WS_END  = AL(WS_XB + (size_t)T * DM * 2);
static_assert(WS_HID + (size_t)T * FF * 2 <= WS_PREP, "hidden must fit inside P");
static_assert(WS_Y + (size_t)T * DM * 2 <= WS_PREP_END, "Y must fit inside the prep region");

constexpr int LDS_BAR_OFF = 131072;
constexpr int LDS_BYTES = 131072 + 256 + 128 * 144;   static_assert(2 * 32 * 272 <= 128 * 144 && 32 * 528 <= 128 * 144, "the in-projection's staging tile shares the region");

DI unsigned pk2(float a, float b) { f32x2 v = {a, b}; bf16x2n r = __builtin_convertvector(v, bf16x2n); return __builtin_bit_cast(unsigned, r); }
DI float bflo(unsigned w) { return __uint_as_float(w << 16); }
DI float bfhi(unsigned w) { return __uint_as_float(w & 0xffff0000u); }
DI float bf2f(bf16_t v) { return __uint_as_float(((unsigned)v) << 16); }
DI float wave_sum(float v) {
#pragma unroll
    for (int o = 1; o < 64; o <<= 1) v += __shfl_xor(v, o);
    return v;
}
DI float fexp2(float x) { return __builtin_amdgcn_exp2f(x); }
DI float frcp(float x) { return __builtin_amdgcn_rcpf(x); }
DI void unpack8(const u32x4 w, float (&x)[8]) { x[0] = bflo(w.x); x[1] = bfhi(w.x); x[2] = bflo(w.y); x[3] = bfhi(w.y); x[4] = bflo(w.z); x[5] = bfhi(w.z); x[6] = bflo(w.w); x[7] = bfhi(w.w); }
DI u32x4 pack8(const float (&x)[8]) { u32x4 w; w.x = pk2(x[0], x[1]); w.y = pk2(x[2], x[3]); w.z = pk2(x[4], x[5]); w.w = pk2(x[6], x[7]); return w; }
#define MFMA16(a, b, c) __builtin_amdgcn_mfma_f32_16x16x32_bf16((a), (b), (c), 0, 0, 0)
DI unsigned pk4_i8(float a, float b, float c, float d) {
    const float M = 12582912.0f;
    const unsigned ua = __float_as_uint(__builtin_amdgcn_fmed3f(a, -127.0f, 127.0f) + M), ub = __float_as_uint(__builtin_amdgcn_fmed3f(b, -127.0f, 127.0f) + M),
                   uc = __float_as_uint(__builtin_amdgcn_fmed3f(c, -127.0f, 127.0f) + M), ud = __float_as_uint(__builtin_amdgcn_fmed3f(d, -127.0f, 127.0f) + M);
    return (ua & 0xffu) | ((ub & 0xffu) << 8) | ((uc & 0xffu) << 16) | (ud << 24); }
constexpr size_t CTL_WMAX = 12288;
constexpr float F8_SW = 1024.0f, F8_SH = 16.0f, F8_SHID = 8.0f;
DI unsigned pk4_f8(float a, float b, float c, float d) {
    a = __builtin_amdgcn_fmed3f(a, -448.0f, 448.0f); b = __builtin_amdgcn_fmed3f(b, -448.0f, 448.0f); c = __builtin_amdgcn_fmed3f(c, -448.0f, 448.0f); d = __builtin_amdgcn_fmed3f(d, -448.0f, 448.0f);
    int w = __builtin_amdgcn_cvt_pk_fp8_f32(a, b, 0, false); w = __builtin_amdgcn_cvt_pk_fp8_f32(c, d, w, true); return (unsigned)w; }

struct Ptrs {
    const float* in[16];
    float* out;
    unsigned char* ws;
};
template <class TT> DI TT* wsp(const Ptrs& P, size_t off) { return (TT*)(P.ws + off); }

DI void phase_rope_tables(const Ptrs& P) {
    float* c128 = wsp<float>(P, WS_COS128); float* s128 = wsp<float>(P, WS_SIN128); float* c64 = wsp<float>(P, WS_COS64); float* s64 = wsp<float>(P, WS_SIN64);
    const int gt = blockIdx.x * blockDim.x + otid(), ng = gridDim.x * blockDim.x;
    for (int i = gt; i < S * 64; i += ng) { const int t = i >> 6, k = i & 63; const float inv = exp2f(-(float)k * (13.287712379549449f / 64.0f));
        const double a = (double)t * (double)inv * 0.15915494309189535; const float fr = (float)(a - floor(a));
        c128[i] = __builtin_amdgcn_cosf(fr); s128[i] = __builtin_amdgcn_sinf(fr); }
    for (int i = gt; i < S * 32; i += ng) { const int t = i >> 5, k = i & 31; const float inv = exp2f(-(float)k * (13.287712379549449f / 32.0f));
        const double a = (double)t * (double)inv * 0.15915494309189535; const float fr = (float)(a - floor(a));
        c64[i] = __builtin_amdgcn_cosf(fr); s64[i] = __builtin_amdgcn_sinf(fr); }
}

DI int incol(int pc) {
    const int tile = pc >> 8, q = pc & 255, bj = q >> 7, r = q & 127, wc = r >> 5, p = r & 31;
    if (tile == 23) { if (wc == 0) return 1792 + 32 * bj + p; if (wc == 1) { if (bj == 0) return p < 16 ? 1856 + p : -1; return p < 24 ? 5968 + p : -1; } return -1; }
    const int seg = 2 * tile + (wc >> 1), base = (seg < 14) ? seg * 128 : seg * 128 + 80;
    if (seg >= 6 && seg < 14) return base + 64 * (wc & 1) + 32 * bj + p;
    return base + 64 * bj + 32 * (wc & 1) + p;
}
DI int q_next(unsigned* ctr, unsigned char* lds, int tid) {
    volatile int* slot = (volatile int*)(lds + LDS_BAR_OFF + 64);
    __syncthreads();
    if (tid == 0) *slot = (int)__hip_atomic_fetch_add(ctr, 1u, __ATOMIC_RELAXED, __HIP_MEMORY_SCOPE_AGENT);
    __syncthreads();
    return __builtin_amdgcn_readfirstlane(*slot);
}
struct ConvIt { const float* src; bf16_t* dst; int srcN, K, n0, k0, sc, f8; float wmax; };
DI ConvIt conv_decode(const Ptrs& P, int layer, int it, int tid) {
    const float* w_in = P.in[1] + (size_t)layer * DM * INW; const float* w_out = P.in[2] + (size_t)layer * DM * DM;
    const float* w1k = P.in[4] + (size_t)layer * 4096 * 256; const float* w2k = P.in[5] + (size_t)layer * 256 * 128;
    const float* w1v = P.in[7] + (size_t)layer * 4096 * 256; const float* w2v = P.in[8] + (size_t)layer * 256 * 128;
    const float* wg = P.in[9] + (size_t)layer * DM * FF; const float* wu = P.in[10] + (size_t)layer * DM * FF; const float* wd = P.in[11] + (size_t)layer * FF * DM;
    constexpr int I0 = (NPAD / 64) * (DM / 128), I1 = (DM / 64) * (DM / 128), I2 = (NGU / 64) * (DM / 128), I3 = (DM / 64) * (FF / 128), I4 = 4 * 32, I6 = 2 * 2;
    const int nq = (tid & 15) * 4;
    ConvIt c; c.f8 = 0; c.wmax = 0.f; int r = it;
    if (r < I0) { const int nt = r / (DM / 128), kt = r % (DM / 128); c.src = w_in; c.dst = wsp<bf16_t>(P, WS_WIN); c.srcN = INW; c.K = DM; c.n0 = nt * 64; c.k0 = kt * 128; c.sc = incol(c.n0 + nq); c.f8 = 2;
        c.wmax = __uint_as_float(__builtin_amdgcn_readfirstlane(__hip_atomic_load((unsigned*)(P.ws + WS_CTL) + CTL_WMAX + layer * 64 + 1, __ATOMIC_RELAXED, __HIP_MEMORY_SCOPE_AGENT))); return c; } r -= I0;
    if (r < I4) { const int nt = r / 32, kt = r % 32; c.src = w1k; c.dst = wsp<bf16_t>(P, WS_CW1K); c.srcN = 256; c.K = 4096; c.n0 = nt * 64; c.k0 = kt * 128; c.sc = c.n0 + nq; return c; } r -= I4;
    if (r < I4) { const int nt = r / 32, kt = r % 32; c.src = w1v; c.dst = wsp<bf16_t>(P, WS_CW1V); c.srcN = 256; c.K = 4096; c.n0 = nt * 64; c.k0 = kt * 128; c.sc = c.n0 + nq; return c; } r -= I4;
    if (r < I6) { const int nt = r / 2, kt = r % 2; c.src = w2k; c.dst = wsp<bf16_t>(P, WS_CW2K); c.srcN = 128; c.K = 256; c.n0 = nt * 64; c.k0 = kt * 128; c.sc = c.n0 + nq; return c; } r -= I6;
    if (r < I6) { const int nt = r / 2, kt = r % 2; c.src = w2v; c.dst = wsp<bf16_t>(P, WS_CW2V); c.srcN = 128; c.K = 256; c.n0 = nt * 64; c.k0 = kt * 128; c.sc = c.n0 + nq; return c; } r -= I6;
    if (r < I1) { const int nt = r / (DM / 128), kt = r % (DM / 128); c.src = w_out; c.dst = wsp<bf16_t>(P, WS_WOUT); c.srcN = DM; c.K = DM; c.n0 = nt * 64; c.k0 = kt * 128; c.sc = c.n0 + nq; return c; } r -= I1;
    constexpr int DA = (I1 + I2 + I3) / 4 - I1; static_assert(DA >= 0 && DA <= I3, "late-set split");
    if (r >= DA && r < DA + I2) { r -= DA; const int nt = r / (DM / 128), kt = r % (DM / 128); const int n0 = nt * 64, tl = n0 >> 8, o = n0 & 255;
        c.src = (o < 128) ? wg : wu; c.dst = wsp<bf16_t>(P, WS_WGU); c.srcN = FF; c.K = DM; c.n0 = n0; c.k0 = kt * 128; c.sc = tl * 128 + (o & 127) + nq; c.f8 = 2; c.wmax = __uint_as_float(__builtin_amdgcn_readfirstlane(__hip_atomic_load((unsigned*)(P.ws + WS_CTL) + CTL_WMAX + layer * 64, __ATOMIC_RELAXED, __HIP_MEMORY_SCOPE_AGENT))); return c; }
    if (r >= DA) r -= I2;
    { const int nt = r / (FF / 128), kt = r % (FF / 128); c.src = wd; c.dst = wsp<bf16_t>(P, WS_WDN); c.srcN = DM; c.K = FF; c.n0 = nt * 64; c.k0 = kt * 128; c.sc = c.n0 + nq; c.f8 = 1; return c; }
}
constexpr int CONV_EARLY = (NPAD / 64) * (DM / 128) + 2 * 4 * 32 + 2 * 2 * 2;
constexpr int CONV_NIT = (NPAD / 64) * (DM / 128) + (DM / 64) * (DM / 128) + (NGU / 64) * (DM / 128) + (DM / 64) * (FF / 128) + 2 * 4 * 32 + 2 * 2 * 2;
DI void conv_load(const ConvIt& c, int tid, f32x4 (&v)[4]) {
    const int kr = tid >> 4;
#pragma unroll
    for (int i = 0; i < 4; ++i) v[i] = (c.sc >= 0) ? __builtin_nontemporal_load((const f32x4*)(c.src + (size_t)(c.k0 + kr + 32 * i) * c.srcN + c.sc)) : (f32x4){0.f, 0.f, 0.f, 0.f};
}
DI void conv_store(const ConvIt& c, int tid, const f32x4 (&v)[4], float* tile  ) {
    const int nq = (tid & 15) * 4, kr = tid >> 4;
#pragma unroll
    for (int i = 0; i < 4; ++i)
#pragma unroll
        for (int e = 0; e < 4; ++e) tile[(nq + e) * 129 + kr + 32 * i] = v[i][e];
    __syncthreads();
    const int n2 = tid >> 3, c8 = tid & 7;
#pragma unroll
    for (int j = 0; j < 2; ++j) { float x[8];
#pragma unroll
        for (int e = 0; e < 8; ++e) x[e] = tile[n2 * 129 + 8 * c8 + 64 * j + e];
        if (c.f8 == 2) { const float sw = 127.0f / fmaxf(c.wmax, 1e-30f); u32x2 w; w.x = pk4_i8(x[0] * sw, x[1] * sw, x[2] * sw, x[3] * sw); w.y = pk4_i8(x[4] * sw, x[5] * sw, x[6] * sw, x[7] * sw);
            *(u32x2*)((unsigned char*)c.dst + (size_t)(c.n0 + n2) * c.K + c.k0 + 8 * c8 + 64 * j) = w; }
        else if (c.f8) { u32x2 w; w.x = pk4_f8(x[0] * F8_SW, x[1] * F8_SW, x[2] * F8_SW, x[3] * F8_SW); w.y = pk4_f8(x[4] * F8_SW, x[5] * F8_SW, x[6] * F8_SW, x[7] * F8_SW);
            *(u32x2*)((unsigned char*)c.dst + (size_t)(c.n0 + n2) * c.K + c.k0 + 8 * c8 + 64 * j) = w; }
        else *(u32x4*)(c.dst + (size_t)(c.n0 + n2) * c.K + c.k0 + 8 * c8 + 64 * j) = pack8(x); }
}
DI void conv_range(const Ptrs& P, int layer, unsigned char* lds, int first, int end, int step) {
    const int tid = otid();
    float* tileA = (float*)lds; float* tileB = (float*)lds + 64 * 129;
    int it = first;
    if (it < end) {
        ConvIt ca = conv_decode(P, layer, it, tid), cb = ca; f32x4 va[4], vb[4];
        conv_load(ca, tid, va);
        for (;;) {
            const bool nb = it + step < end; if (nb) { cb = conv_decode(P, layer, it + step, tid); conv_load(cb, tid, vb); }
            conv_store(ca, tid, va, tileA);
            if (!nb) break;
            it += step;
            const bool na = it + step < end; if (na) { ca = conv_decode(P, layer, it + step, tid); conv_load(ca, tid, va); }
            conv_store(cb, tid, vb, tileB);
            if (!na) break;
            it += step;
        }
    }
    __syncthreads();
}
constexpr int CONV_FILL_TILES = 4, CONV_FILL_ITEMS = (CONV_NIT - CONV_EARLY) / CONV_FILL_TILES, CONV_FILL_PER_PHASE = CONV_FILL_ITEMS / 4;
static_assert((CONV_NIT - CONV_EARLY) % (CONV_FILL_TILES * 4) == 0, "filler items must split evenly over the four attention phases");
constexpr int WMAX_ITEMS = 512;
DI void wmax_item(const Ptrs& P, int layer, int it, unsigned char* lds) {
    constexpr int N4 = DM * FF / 4, PER = N4 / WMAX_ITEMS; static_assert(N4 % WMAX_ITEMS == 0 && PER % (512 * 11) == 0, "slice shape");
    const int tid = otid();
    const f32x4* wg = (const f32x4*)(P.in[9] + (size_t)layer * DM * FF) + (size_t)it * PER + tid; const f32x4* wu = (const f32x4*)(P.in[10] + (size_t)layer * DM * FF) + (size_t)it * PER + tid;
    float m = 0.f;
#pragma unroll 1
    for (int h = 0; h < PER / 512; h += 11) { f32x4 a[11], b[11];
#pragma unroll
        for (int j = 0; j < 11; ++j) { a[j] = wg[(h + j) * 512]; b[j] = wu[(h + j) * 512]; }
#pragma unroll
        for (int j = 0; j < 11; ++j) { m = fmaxf(m, fmaxf(fmaxf(fabsf(a[j][0]), fabsf(a[j][1])), fmaxf(fabsf(a[j][2]), fabsf(a[j][3])))); m = fmaxf(m, fmaxf(fmaxf(fabsf(b[j][0]), fabsf(b[j][1])), fmaxf(fabsf(b[j][2]), fabsf(b[j][3])))); } }
    unsigned* slot = (unsigned*)(lds + LDS_BAR_OFF + 128);
    if (tid == 0) *slot = 0u;
    __syncthreads();
    __hip_atomic_fetch_max(slot, __float_as_uint(m), __ATOMIC_RELAXED, __HIP_MEMORY_SCOPE_WORKGROUP);
    __syncthreads();
    if (tid == 0) __hip_atomic_fetch_max((unsigned*)(P.ws + WS_CTL) + CTL_WMAX + layer * 64, *slot, __ATOMIC_RELAXED, __HIP_MEMORY_SCOPE_AGENT);
}
DI void wmax_in_item(const Ptrs& P, int layer, int it, unsigned char* lds) {
    constexpr int N4 = DM * INW / 4, PER = N4 / WMAX_ITEMS; static_assert(N4 % WMAX_ITEMS == 0 && PER <= 12 * 512, "slice shape");
    const int tid = otid();
    const f32x4* w = (const f32x4*)(P.in[1] + (size_t)layer * DM * INW) + (size_t)it * PER;
    float m = 0.f; f32x4 a[12];
#pragma unroll
    for (int j = 0; j < 12; ++j) { int i = tid + 512 * j; i = i < PER ? i : PER - 1; a[j] = w[i]; }
#pragma unroll
    for (int j = 0; j < 12; ++j) m = fmaxf(m, fmaxf(fmaxf(fabsf(a[j][0]), fabsf(a[j][1])), fmaxf(fabsf(a[j][2]), fabsf(a[j][3]))));
    unsigned* slot = (unsigned*)(lds + LDS_BAR_OFF + 128);
    if (tid == 0) *slot = 0u;
    __syncthreads();
    __hip_atomic_fetch_max(slot, __float_as_uint(m), __ATOMIC_RELAXED, __HIP_MEMORY_SCOPE_WORKGROUP);
    __syncthreads();
    if (tid == 0) __hip_atomic_fetch_max((unsigned*)(P.ws + WS_CTL) + CTL_WMAX + layer * 64 + 1, *slot, __ATOMIC_RELAXED, __HIP_MEMORY_SCOPE_AGENT);
    __syncthreads();
}
DI void bias1_item(const Ptrs& P, int layer, int j) {
    const int tid = otid(), wid = tid >> 6, lane = tid & 63, o = j * 8 + wid, kv = o >> 8, n = o & 255;
    const float* pe = P.in[kv ? 6 : 3] + (size_t)layer * 4096; const float* w1 = P.in[kv ? 7 : 4] + (size_t)layer * 4096 * 256;
    float sacc = 0.f;
    for (int k = lane; k < 4096; k += 64) sacc += pe[k] * w1[(size_t)k * 256 + n];
    sacc = wave_sum(sacc);
    if (lane == 0) wsp<float>(P, WS_CB1)[o] = sacc;
}
constexpr int EARLY_ITEMS = CONV_EARLY / CONV_FILL_TILES; static_assert(CONV_EARLY % CONV_FILL_TILES == 0, "early set in filler items");
DI void conv_filler(const Ptrs& P, int layer, unsigned char* lds, unsigned* ctr, int part) {
    const bool nxt = layer + 1 < DEPTH;
    int extra = 0;
    if (part == 0) extra = WMAX_ITEMS; else if (nxt) extra = (part == 1) ? WMAX_ITEMS : (part == 2 ? EARLY_ITEMS / 2 : EARLY_ITEMS - EARLY_ITEMS / 2 + 64);
    for (int it = q_next(ctr, lds, otid()); it < CONV_FILL_PER_PHASE + extra; it = q_next(ctr, lds, otid())) {
        const int j = it - CONV_FILL_PER_PHASE;
        if (j >= 0 && part == 0) { wmax_item(P, layer, j, lds); continue; }
        if (j >= 0 && part == 1) { wmax_in_item(P, layer + 1, j, lds); continue; }
        int lyr = layer, t0 = CONV_EARLY + (part * CONV_FILL_PER_PHASE + it) * CONV_FILL_TILES;
        if (j >= 0) { const int e = (part == 2) ? j : j + EARLY_ITEMS / 2; if (e >= EARLY_ITEMS) { bias1_item(P, layer + 1, e - EARLY_ITEMS); continue; } lyr = layer + 1; t0 = e * CONV_FILL_TILES; }
        conv_range(P, lyr, lds, t0, t0 + CONV_FILL_TILES, 1); }
}
DI void phase_wconv(const Ptrs& P, int layer, unsigned char* lds) {
    const int tid = otid();
    conv_range(P, layer, lds, blockIdx.x, CONV_EARLY, gridDim.x);
    __syncthreads();
    if (blockIdx.x < 64) {
        const int wid = tid >> 6, lane = tid & 63, o = blockIdx.x * 8 + wid, kv = o >> 8, n = o & 255;
        const float* pe = P.in[kv ? 6 : 3] + (size_t)layer * 4096; const float* w1 = P.in[kv ? 7 : 4] + (size_t)layer * 4096 * 256;
        float sacc = 0.f;
        for (int k = lane; k < 4096; k += 64) sacc += pe[k] * w1[(size_t)k * 256 + n];
        sacc = wave_sum(sacc);
        if (lane == 0) wsp<float>(P, WS_CB1)[o] = sacc;
    }
}

template <bool XI, bool XO, int H8 = 0  > DI void phase_norm(const void* xin_, void* xout_, const bf16_t* Y, const float* g_post, const float* g_pre, bf16_t* H) {
    const float* xin = (const float*)xin_; float* xout = (float*)xout_; const bf16_t* xinb = (const bf16_t*)xin_; bf16_t* xoutb = (bf16_t*)xout_;
    const int lane = otid() & 63, gw = blockIdx.x * 8 + (otid() >> 6), ngw = gridDim.x * 8;
    for (int row = gw; row < T; row += ngw) {
        float xv[4][8];
#pragma unroll
        for (int j = 0; j < 4; ++j) { const int col = 8 * (lane + 64 * j);
            if (XI) { unpack8(*(const u32x4*)(xinb + (size_t)row * DM + col), xv[j]); }
            else { const f32x4 a = *(const f32x4*)(xin + (size_t)row * DM + col), b = *(const f32x4*)(xin + (size_t)row * DM + col + 4);
                xv[j][0] = a[0]; xv[j][1] = a[1]; xv[j][2] = a[2]; xv[j][3] = a[3]; xv[j][4] = b[0]; xv[j][5] = b[1]; xv[j][6] = b[2]; xv[j][7] = b[3]; } }
        if (Y) {
            float yv[4][8]; float ss = 0.f;
#pragma unroll
            for (int j = 0; j < 4; ++j) { const int col = 8 * (lane + 64 * j); const u32x4 w = *(const u32x4*)(Y + (size_t)row * DM + col); unpack8(w, yv[j]);
#pragma unroll
                for (int e = 0; e < 8; ++e) ss += yv[j][e] * yv[j][e]; }
            const float rstd = rsqrtf(wave_sum(ss) * (1.0f / DM) + RMS_EPS);
#pragma unroll
            for (int j = 0; j < 4; ++j) { const int col = 8 * (lane + 64 * j); const f32x4 ga = *(const f32x4*)(g_post + col), gb = *(const f32x4*)(g_post + col + 4);
#pragma unroll
                for (int e = 0; e < 4; ++e) { xv[j][e] += yv[j][e] * rstd * ga[e]; xv[j][4 + e] += yv[j][4 + e] * rstd * gb[e]; }
                if (XO) { *(u32x4*)(xoutb + (size_t)row * DM + col) = pack8(xv[j]); unpack8(pack8(xv[j]), xv[j]); }
                else { *(f32x4*)(xout + (size_t)row * DM + col) = (f32x4){xv[j][0], xv[j][1], xv[j][2], xv[j][3]};
                    *(f32x4*)(xout + (size_t)row * DM + col + 4) = (f32x4){xv[j][4], xv[j][5], xv[j][6], xv[j][7]}; } }
        }
        if (H) {
            float ss = 0.f;
#pragma unroll
            for (int j = 0; j < 4; ++j)
#pragma unroll
                for (int e = 0; e < 8; ++e) ss += xv[j][e] * xv[j][e];
            const float rstd = rsqrtf(wave_sum(ss) * (1.0f / DM) + RMS_EPS);
            if (H8 == 2) { float am = 0.f;
#pragma unroll
                for (int j = 0; j < 4; ++j) { const int col = 8 * (lane + 64 * j); const f32x4 ga = *(const f32x4*)(g_pre + col), gb = *(const f32x4*)(g_pre + col + 4);
#pragma unroll
                    for (int e = 0; e < 4; ++e) { xv[j][e] *= rstd * ga[e]; xv[j][4 + e] *= rstd * gb[e]; am = fmaxf(am, fmaxf(fabsf(xv[j][e]), fabsf(xv[j][4 + e]))); } }
#pragma unroll
                for (int o = 1; o < 64; o <<= 1) am = fmaxf(am, __shfl_xor(am, o));
                am = fmaxf(am, 1e-30f); const float sa = 127.0f / am;
                if (lane == 0) ((float*)((unsigned char*)H + (size_t)T * DM))[row] = am * (1.0f / 127.0f);
#pragma unroll
                for (int j = 0; j < 4; ++j) { const int col = 8 * (lane + 64 * j); u32x2 w; w.x = pk4_i8(xv[j][0] * sa, xv[j][1] * sa, xv[j][2] * sa, xv[j][3] * sa); w.y = pk4_i8(xv[j][4] * sa, xv[j][5] * sa, xv[j][6] * sa, xv[j][7] * sa);
                    *(u32x2*)((unsigned char*)H + (size_t)row * DM + col) = w; }
            } else
#pragma unroll
            for (int j = 0; j < 4; ++j) { const int col = 8 * (lane + 64 * j); const f32x4 ga = *(const f32x4*)(g_pre + col), gb = *(const f32x4*)(g_pre + col + 4); float hv[8];
#pragma unroll
                for (int e = 0; e < 4; ++e) { hv[e] = xv[j][e] * rstd * ga[e]; hv[4 + e] = xv[j][4 + e] * rstd * gb[e]; }
                if (H8) { u32x2 w; w.x = pk4_f8(hv[0] * F8_SH, hv[1] * F8_SH, hv[2] * F8_SH, hv[3] * F8_SH); w.y = pk4_f8(hv[4] * F8_SH, hv[5] * F8_SH, hv[6] * F8_SH, hv[7] * F8_SH);
                    *(u32x2*)((unsigned char*)H + (size_t)row * DM + col) = w; }
                else *(u32x4*)(H + (size_t)row * DM + col) = pack8(hv); }
        }
    }
}

struct EpiSwiglu {
    static constexpr bool PERM = true, AFTER_DRAIN = false;
    bf16_t* O; int ldc;
    __device__ __forceinline__ void operator()(const pg8::f32x4 (&acc)[2][2][4][2], const pg8::Unit& u, int wr, int wc, int fr, int fq) const {
        const int row0 = u.pm * 256 + wr * 64 + fr, col0 = u.pn * 128 + wc * 32 + 8 * fq;
#pragma unroll
        for (int ai = 0; ai < 2; ++ai)
#pragma unroll
            for (int m = 0; m < 4; ++m) { bf16_t* rowp = O + (size_t)(row0 + ai * 128 + m * 16) * ldc + col0; float h[8];
#pragma unroll
                for (int n = 0; n < 2; ++n)
#pragma unroll
                    for (int i = 0; i < 4; ++i) { const float g = acc[ai][0][m][n][i], up = acc[ai][1][m][n][i]; h[4 * n + i] = g * frcp(1.0f + fexp2(-1.4426950408889634f * g)) * up; }
                *(u32x4*)rowp = pack8(h); }
    }
};

struct EpiSwiglu8 {
    static constexpr bool PERM = true, AFTER_DRAIN = false;
    unsigned char* O; int ldc;
    __device__ __forceinline__ void operator()(const pg8::f32x4 (&acc)[2][2][4][2], const pg8::Unit& u, int wr, int wc, int fr, int fq) const {
        const int row0 = u.pm * 256 + wr * 64 + fr, col0 = u.pn * 128 + wc * 32 + 8 * fq;
        constexpr float US = 1.0f / (F8_SH * F8_SW);
#pragma unroll
        for (int ai = 0; ai < 2; ++ai)
#pragma unroll
            for (int m = 0; m < 4; ++m) { unsigned char* rowp = O + (size_t)(row0 + ai * 128 + m * 16) * ldc + col0; float h[8];
#pragma unroll
                for (int n = 0; n < 2; ++n)
#pragma unroll
                    for (int i = 0; i < 4; ++i) { const float g = acc[ai][0][m][n][i] * US, up = acc[ai][1][m][n][i] * (US * F8_SHID); h[4 * n + i] = g * frcp(1.0f + fexp2(-1.4426950408889634f * g)) * up; }
                u32x2 w; w.x = pk4_f8(h[0], h[1], h[2], h[3]); w.y = pk4_f8(h[4], h[5], h[6], h[7]);
                *(u32x2*)rowp = w; }
    }
};
struct EpiSwigluI8 {
    static constexpr bool PERM = true, AFTER_DRAIN = false, STAGED = true;
    static constexpr int PITCH = 144;
    unsigned char* O; int ldc; const float* rs; float ws;
    __device__ __forceinline__ void staged(const pg8::f32x4 (&acc)[2][2][4][2], const pg8::Unit& u, int wr, int wc, int fr, int fq, PG8_LAS unsigned char* ep, int wid, int lane) const {
        const int row0 = u.pm * 256 + wr * 64 + fr;
        float scv[8];
#pragma unroll
        for (int i = 0; i < 8; ++i) scv[i] = rs[row0 + (i >> 2) * 128 + (i & 3) * 16] * ws;
#pragma unroll
        for (int ai = 0; ai < 2; ++ai) {
#pragma unroll
            for (int m = 0; m < 4; ++m) { float h[8]; const float sc = scv[ai * 4 + m];
#pragma unroll
                for (int n = 0; n < 2; ++n)
#pragma unroll
                    for (int i = 0; i < 4; ++i) { const float g = (float)__float_as_int(acc[ai][0][m][n][i]) * sc, up = (float)__float_as_int(acc[ai][1][m][n][i]) * (sc * F8_SHID); h[4 * n + i] = g * frcp(1.0f + fexp2(-1.4426950408889634f * g)) * up; }
                u32x2 w; w.x = pk4_f8(h[0], h[1], h[2], h[3]); w.y = pk4_f8(h[4], h[5], h[6], h[7]);
                *(PG8_LAS u32x2*)(ep + (wr * 64 + m * 16 + fr) * PITCH + wc * 32 + 8 * fq) = w; }
            asm volatile("s_waitcnt lgkmcnt(0)" ::: "memory"); __builtin_amdgcn_s_barrier(); asm volatile("" ::: "memory");
            u32x4 v[2];
#pragma unroll
            for (int h2 = 0; h2 < 2; ++h2) v[h2] = *(const PG8_LAS u32x4*)(ep + (wid * 16 + h2 * 8 + (lane >> 3)) * PITCH + (lane & 7) * 16);
            asm volatile("s_waitcnt lgkmcnt(0)" ::: "memory"); __builtin_amdgcn_s_barrier(); asm volatile("" ::: "memory");
#pragma unroll
            for (int h2 = 0; h2 < 2; ++h2) *(u32x4*)(O + (size_t)(u.pm * 256 + ai * 128 + wid * 16 + h2 * 8 + (lane >> 3)) * ldc + u.pn * 128 + (lane & 7) * 16) = v[h2];
        }
    }
    __device__ __forceinline__ void operator()(const pg8::f32x4 (&acc)[2][2][4][2], const pg8::Unit& u, int wr, int wc, int fr, int fq) const {
        const int row0 = u.pm * 256 + wr * 64 + fr, col0 = u.pn * 128 + wc * 32 + 8 * fq;
#pragma unroll
        for (int ai = 0; ai < 2; ++ai)
#pragma unroll
            for (int m = 0; m < 4; ++m) { const int row = row0 + ai * 128 + m * 16; unsigned char* rowp = O + (size_t)row * ldc + col0; float h[8]; const float sc = rs[row] * ws;
#pragma unroll
                for (int n = 0; n < 2; ++n)
#pragma unroll
                    for (int i = 0; i < 4; ++i) { const float g = (float)__float_as_int(acc[ai][0][m][n][i]) * sc, up = (float)__float_as_int(acc[ai][1][m][n][i]) * (sc * F8_SHID); h[4 * n + i] = g * frcp(1.0f + fexp2(-1.4426950408889634f * g)) * up; }
                u32x2 w; w.x = pk4_f8(h[0], h[1], h[2], h[3]); w.y = pk4_f8(h[4], h[5], h[6], h[7]);
                *(u32x2*)rowp = w; }
    }
};
struct EpiRowsBf16 {
    static constexpr bool PERM = true, AFTER_DRAIN = false, STAGED = true;
    static constexpr int RPITCH = 528;
    bf16_t* O; int ldc; float US;
    __device__ __forceinline__ void staged(const pg8::f32x4 (&acc)[2][2][4][2], const pg8::Unit& u, int wr, int wc, int fr_in, int fq_in, PG8_LAS unsigned char* ep, int wid, int lane_in) const {
        int fr = fr_in, fq = fq_in, lane = lane_in; asm volatile("" : "+v"(fr), "+v"(fq), "+v"(lane));
        PG8_LAS unsigned char* wt = ep + (wr * 16 + fr) * RPITCH + (wc * 32 + 8 * fq) * 2;
        const int rrow = wid * 4 + (lane >> 5);
        const PG8_LAS unsigned char* rt = ep + rrow * RPITCH + (lane & 31) * 16;
        bf16_t* obase = O + (size_t)(u.pm * 256 + (rrow >> 4) * 64 + (rrow & 15)) * ldc + u.pn * 256 + (lane & 31) * 8;
#pragma unroll
        for (int idx = 0; idx < 8; ++idx) { const int ai = idx >> 2, m = idx & 3;
#pragma unroll
            for (int bj = 0; bj < 2; ++bj) { const pg8::f32x4 v0 = acc[ai][bj][m][0] * US, v1 = acc[ai][bj][m][1] * US;
                u32x4 w; w.x = pg8::cvt_pk_bf16(v0[0], v0[1]); w.y = pg8::cvt_pk_bf16(v0[2], v0[3]); w.z = pg8::cvt_pk_bf16(v1[0], v1[1]); w.w = pg8::cvt_pk_bf16(v1[2], v1[3]);
                *(PG8_LAS u32x4*)(wt + bj * 256) = w; }
            asm volatile("s_waitcnt lgkmcnt(0)" ::: "memory"); __builtin_amdgcn_s_barrier(); asm volatile("" ::: "memory");
            const u32x4 r0 = *(const PG8_LAS u32x4*)rt, r1 = *(const PG8_LAS u32x4*)(rt + 2 * RPITCH);
            asm volatile("s_waitcnt lgkmcnt(0)" ::: "memory"); __builtin_amdgcn_s_barrier(); asm volatile("" ::: "memory");
            bf16_t* d = obase + (size_t)(ai * 128 + m * 16) * ldc;
            *(u32x4*)d = r0; *(u32x4*)(d + (size_t)2 * ldc) = r1; }
    }
};
struct EpiDown8 {
    static constexpr bool PERM = true, AFTER_DRAIN = false;
    bf16_t* O; int ldc;
    __device__ __forceinline__ void operator()(const pg8::f32x4 (&acc)[2][2][4][2], const pg8::Unit& u, int wr, int wc, int fr, int fq) const {
        const int row0 = u.pm * 256 + wr * 64 + fr, col0 = u.pn * 256 + wc * 32 + 8 * fq;
        constexpr float US = 1.0f / (F8_SHID * F8_SW);
#pragma unroll
        for (int ai = 0; ai < 2; ++ai)
#pragma unroll
            for (int m = 0; m < 4; ++m) { bf16_t* rowp = O + (size_t)(row0 + ai * 128 + m * 16) * ldc + col0;
#pragma unroll
                for (int bj = 0; bj < 2; ++bj) { const pg8::f32x4 v0 = acc[ai][bj][m][0] * US, v1 = acc[ai][bj][m][1] * US;
                    u32x4 w; w.x = pg8::cvt_pk_bf16(v0[0], v0[1]); w.y = pg8::cvt_pk_bf16(v0[2], v0[3]); w.z = pg8::cvt_pk_bf16(v1[0], v1[1]); w.w = pg8::cvt_pk_bf16(v1[2], v1[3]);
                    *(u32x4*)(rowp + bj * 128) = w; } }
    }
};

DI float gelu_tanh(float x) { const float u2 = 2.0f * 0.7978845608028654f * (x + 0.044715f * x * x * x); const float e = fexp2(u2 * 1.4426950408889634f); return x - x * frcp(e + 1.0f); }
struct EpiGelu {
    static constexpr bool PERM = true, AFTER_DRAIN = false;
    bf16_t* O; int ldc; const float* bias;
    __device__ __forceinline__ void operator()(const pg8::f32x4 (&acc)[2][2][4][2], const pg8::Unit& u, int wr, int wc, int fr, int fq) const {
        const int row0 = u.pm * 256 + wr * 64 + fr, col0 = u.pn * 256 + wc * 32 + 8 * fq;
#pragma unroll
        for (int bj = 0; bj < 2; ++bj) { const f32x4 b0 = *(const f32x4*)(bias + col0 + bj * 128), b1 = *(const f32x4*)(bias + col0 + bj * 128 + 4);
#pragma unroll
            for (int ai = 0; ai < 2; ++ai)
#pragma unroll
                for (int m = 0; m < 4; ++m) { float h[8];
#pragma unroll
                    for (int i = 0; i < 4; ++i) { h[i] = gelu_tanh(acc[ai][bj][m][0][i] + b0[i]); h[4 + i] = gelu_tanh(acc[ai][bj][m][1][i] + b1[i]); }
                    *(u32x4*)(O + (size_t)(row0 + ai * 128 + m * 16) * ldc + col0 + bj * 128) = pack8(h); } }
    }
};


struct EpiPrep {
    static constexpr bool PERM = true, AFTER_DRAIN = false, STAGED = true;
    static constexpr int TPITCH = 272, HTILE = 32 * 272;
    unsigned char* ws_; const float* rs; float ws;
    template <class TT> __device__ __forceinline__ TT* wp(size_t off) const { return (TT*)(ws_ + off); }
    __device__ __forceinline__ static void st8(bf16_t* p, const f32x4 a, const f32x4 b) { u32x4 w; w.x = pk2(a[0], a[1]); w.y = pk2(a[2], a[3]); w.z = pk2(b[0], b[1]); w.w = pk2(b[2], b[3]); *(u32x4*)p = w; }
    __device__ __forceinline__ static f32x4 cv(const pg8::f32x4 v, float sc) { f32x4 r; r[0] = (float)__float_as_int(v[0]) * sc; r[1] = (float)__float_as_int(v[1]) * sc; r[2] = (float)__float_as_int(v[2]) * sc; r[3] = (float)__float_as_int(v[3]) * sc; return r; }
    __device__ __forceinline__ static int kind_of(int seg) {
        return (seg >= 6 && seg < 14) ? 2 : ((seg == 5 || (seg >= 22 && seg < 26) || (seg >= 34 && seg < 38) || seg == 40 || seg == 41 || seg == 44 || seg == 45) ? 1 : 0); }
    __device__ __forceinline__ void operator()(const pg8::f32x4 (&acc)[2][2][4][2], const pg8::Unit& u, int wr, int wc, int fr_in, int fq_in) const {
        int fr = fr_in, fq = fq_in; asm volatile("" : "+v"(fr), "+v"(fq));
        const int b = u.pm >> 3, tb = (u.pm & 7) * 256 + wr * 64 + fr;
        const float* rsp = rs + (size_t)b * S + tb; float nsc = rsp[0] * ws;
        if (u.pn == 23) {
            if (wc >= 2) return;
            const int dd = 8 * fq;
#pragma unroll
            for (int idx = 0; idx < 8; ++idx) { const int ai = idx >> 2, m = idx & 3, t = tb + ai * 128 + m * 16, row = b * S + t;
                const float sc = nsc; if (idx < 7) nsc = rsp[((idx + 1) >> 2) * 128 + ((idx + 1) & 3) * 16] * ws;
                const f32x4 a0 = cv(acc[ai][0][m][0], sc), a1 = cv(acc[ai][0][m][1], sc), c0 = cv(acc[ai][1][m][0], sc), c1 = cv(acc[ai][1][m][1], sc);
                if (wc == 0) { const float* cp = wp<float>(WS_COS64) + (size_t)t * 32 + dd; const float* sp = wp<float>(WS_SIN64) + (size_t)t * 32 + dd;
                    const f32x4 cs0 = *(const f32x4*)cp, cs1 = *(const f32x4*)(cp + 4), sn0 = *(const f32x4*)sp, sn1 = *(const f32x4*)(sp + 4);
                    bf16_t* d = wp<bf16_t>(WS_IK) + (size_t)row * 64 + dd; st8(d, a0 * cs0 - c0 * sn0, a1 * cs1 - c1 * sn1); st8(d + 32, c0 * cs0 + a0 * sn0, c1 * cs1 + a1 * sn1); }
                else { if (fq < 2) { float* d = wp<float>(WS_IW) + (size_t)row * 16 + dd; *(f32x4*)d = a0 * 0.03125f; *(f32x4*)(d + 4) = a1 * 0.03125f; }
                    if (fq < 3) { float* d = wp<float>(WS_GATE) + (size_t)row * 24 + dd; f32x4 g0, g1;
#pragma unroll
                        for (int i = 0; i < 4; ++i) { g0[i] = frcp(1.0f + fexp2(-1.4426950408889634f * c0[i])); g1[i] = frcp(1.0f + fexp2(-1.4426950408889634f * c1[i])); }
                        *(f32x4*)d = g0; *(f32x4*)(d + 4) = g1; } }
                __builtin_amdgcn_sched_barrier(0); }
            return;
        }
        const int seg = 2 * u.pn + (wc >> 1), kind = kind_of(seg);
        if (kind == 2) {
            const int head = 4 * (u.pn - 3) + wc, dd = 8 * fq;
#pragma unroll
            for (int idx = 0; idx < 8; ++idx) { const int ai = idx >> 2, m = idx & 3, t = tb + ai * 128 + m * 16;
                const float sc = nsc; if (idx < 7) nsc = rsp[((idx + 1) >> 2) * 128 + ((idx + 1) & 3) * 16] * ws;
                const f32x4 a0 = cv(acc[ai][0][m][0], sc), a1 = cv(acc[ai][0][m][1], sc), c0 = cv(acc[ai][1][m][0], sc), c1 = cv(acc[ai][1][m][1], sc);
                const float* cp = wp<float>(WS_COS64) + (size_t)t * 32 + dd; const float* sp = wp<float>(WS_SIN64) + (size_t)t * 32 + dd;
                const f32x4 cs0 = *(const f32x4*)cp, cs1 = *(const f32x4*)(cp + 4), sn0 = *(const f32x4*)sp, sn1 = *(const f32x4*)(sp + 4);
                bf16_t* d = wp<bf16_t>(WS_IQ) + (((size_t)b * 16 + head) * S + t) * 64 + dd; st8(d, a0 * cs0 - c0 * sn0, a1 * cs1 - c1 * sn1); st8(d + 32, c0 * cs0 + a0 * sn0, c1 * cs1 + a1 * sn1);
                __builtin_amdgcn_sched_barrier(0); }
            return;
        }
        const int d0 = 32 * (wc & 1) + 8 * fq;
        size_t dst = 0; int nh = 1, hd = 0;
        if (seg < 4) { dst = WS_AQ; nh = 4; hd = seg; } else if (seg == 4) { dst = WS_AK; } else if (seg == 5) { dst = WS_AVT; }
        else if (seg < 18) { dst = WS_BQ; nh = 4; hd = seg - 14; } else if (seg < 22) { dst = WS_BK1; nh = 4; hd = seg - 18; } else if (seg < 26) { dst = WS_BVT1; nh = 4; hd = seg - 22; }
        else if (seg < 34) { dst = WS_CQR; nh = 8; hd = seg - 26; } else if (seg < 36) { dst = WS_KC; nh = 2; hd = seg - 34; } else if (seg < 38) { dst = WS_VC; nh = 2; hd = seg - 36; }
        else if (seg < 40) { dst = WS_CKS; nh = 2; hd = seg - 38; } else if (seg < 42) { dst = WS_CVST; nh = 2; hd = seg - 40; } else if (seg < 44) { dst = WS_CKW; nh = 2; hd = seg - 42; } else { dst = WS_CVWT; nh = 2; hd = seg - 44; }
        bf16_t* dbase = wp<bf16_t>(dst) + ((size_t)(b * nh + hd) * S) * 128 + d0;
        const bool cq = (seg >= 26 && seg < 34);
        bf16_t* qbase = wp<bf16_t>(WS_CQ) + ((size_t)(b * 8 + (seg - 26)) * S) * 128 + d0;
        const float* cb = wp<float>(WS_COS128) + d0; const float* sb = wp<float>(WS_SIN128) + d0;
        f32x4 ncs0 = *(const f32x4*)(cb + (size_t)tb * 64), ncs1 = *(const f32x4*)(cb + (size_t)tb * 64 + 4), nsn0 = *(const f32x4*)(sb + (size_t)tb * 64), nsn1 = *(const f32x4*)(sb + (size_t)tb * 64 + 4);
#pragma unroll
        for (int idx = 0; idx < 8; ++idx) { const int ai = idx >> 2, m = idx & 3, t = tb + ai * 128 + m * 16;
            const float sc = nsc; if (idx < 7) nsc = rsp[((idx + 1) >> 2) * 128 + ((idx + 1) & 3) * 16] * ws;
            const f32x4 a0 = cv(acc[ai][0][m][0], sc), a1 = cv(acc[ai][0][m][1], sc), c0 = cv(acc[ai][1][m][0], sc), c1 = cv(acc[ai][1][m][1], sc);
            bf16_t* d = dbase + (size_t)t * 128;
            const f32x4 cs0 = ncs0, cs1 = ncs1, sn0 = nsn0, sn1 = nsn1;
            if (idx < 7) { const size_t tn = (size_t)(tb + ((idx + 1) >> 2) * 128 + ((idx + 1) & 3) * 16) * 64;
                ncs0 = *(const f32x4*)(cb + tn); ncs1 = *(const f32x4*)(cb + tn + 4); nsn0 = *(const f32x4*)(sb + tn); nsn1 = *(const f32x4*)(sb + tn + 4); }
            if (kind == 0) {
                st8(d, a0 * cs0 - c0 * sn0, a1 * cs1 - c1 * sn1); st8(d + 64, c0 * cs0 + a0 * sn0, c1 * cs1 + a1 * sn1);
                if (cq) { bf16_t* q = qbase + (size_t)t * 128; st8(q, a0 * QSCALE, a1 * QSCALE); st8(q + 64, c0 * QSCALE, c1 * QSCALE); } }
            else { st8(d, a0, a1); st8(d + 64, c0, c1); }
            __builtin_amdgcn_sched_barrier(0); }
    }
    __device__ __forceinline__ static void seg_dst(int seg, size_t& dst, int& nh, int& hd) {
        dst = 0; nh = 1; hd = 0;
        if (seg < 4) { dst = WS_AQ; nh = 4; hd = seg; } else if (seg == 4) { dst = WS_AK; } else if (seg == 5) { dst = WS_AVT; }
        else if (seg < 18) { dst = WS_BQ; nh = 4; hd = seg - 14; } else if (seg < 22) { dst = WS_BK1; nh = 4; hd = seg - 18; } else if (seg < 26) { dst = WS_BVT1; nh = 4; hd = seg - 22; }
        else if (seg < 34) { dst = WS_CQR; nh = 8; hd = seg - 26; } else if (seg < 36) { dst = WS_KC; nh = 2; hd = seg - 34; } else if (seg < 38) { dst = WS_VC; nh = 2; hd = seg - 36; }
        else if (seg < 40) { dst = WS_CKS; nh = 2; hd = seg - 38; } else if (seg < 42) { dst = WS_CVST; nh = 2; hd = seg - 40; } else if (seg < 44) { dst = WS_CKW; nh = 2; hd = seg - 42; } else { dst = WS_CVWT; nh = 2; hd = seg - 44; }
    }
    __device__ __forceinline__ void staged(const pg8::f32x4 (&acc)[2][2][4][2], const pg8::Unit& u, int wr, int wc, int fr_in, int fq_in, PG8_LAS unsigned char* ep, int wid, int lane_in) const {
        if (u.pn == 23 || (u.pn >= 3 && u.pn <= 6)) { (*this)(acc, u, wr, wc, fr_in, fq_in); return; }
        int fr = fr_in, fq = fq_in, lane = lane_in; asm volatile("" : "+v"(fr), "+v"(fq), "+v"(lane));
        const int b = u.pm >> 3, tb = (u.pm & 7) * 256 + wr * 64 + fr;
        const float* rsp = rs + (size_t)b * S + tb; float nsc = rsp[0] * ws;
        const int seg = 2 * u.pn + (wc >> 1), kind = kind_of(seg), d0 = 32 * (wc & 1) + 8 * fq;
        size_t dstR; int nhR, hdR; seg_dst(2 * u.pn + (wid >> 2), dstR, nhR, hdR);
        bf16_t* dbaseR = wp<bf16_t>(dstR) + ((size_t)(b * nhR + hdR) * S) * 128 + (lane & 15) * 8;
        const bool cq = (seg >= 26 && seg < 34);
        bf16_t* qbase = wp<bf16_t>(WS_CQ) + ((size_t)(b * 8 + (seg - 26)) * S) * 128 + d0;
        const float* cb = wp<float>(WS_COS128) + d0; const float* sb = wp<float>(WS_SIN128) + d0;
        f32x4 ncs0 = *(const f32x4*)(cb + (size_t)tb * 64), ncs1 = *(const f32x4*)(cb + (size_t)tb * 64 + 4), nsn0 = *(const f32x4*)(sb + (size_t)tb * 64), nsn1 = *(const f32x4*)(sb + (size_t)tb * 64 + 4);
        PG8_LAS unsigned char* wt = ep + (wc >> 1) * HTILE + (wr * 16 + fr) * TPITCH + d0 * 2;
        const PG8_LAS unsigned char* rt = ep + (wid >> 2) * HTILE + ((wid & 3) * 8 + (lane >> 4)) * TPITCH + (lane & 15) * 16;
        const int rrow = (wid & 3) * 8 + (lane >> 4), tR0 = (u.pm & 7) * 256 + (rrow >> 4) * 64 + (rrow & 15);
#pragma unroll
        for (int idx = 0; idx < 8; ++idx) { const int ai = idx >> 2, m = idx & 3, t = tb + ai * 128 + m * 16;
            const float sc = nsc; if (idx < 7) nsc = rsp[((idx + 1) >> 2) * 128 + ((idx + 1) & 3) * 16] * ws;
            const f32x4 a0 = cv(acc[ai][0][m][0], sc), a1 = cv(acc[ai][0][m][1], sc), c0 = cv(acc[ai][1][m][0], sc), c1 = cv(acc[ai][1][m][1], sc);
            const f32x4 cs0 = ncs0, cs1 = ncs1, sn0 = nsn0, sn1 = nsn1;
            if (idx < 7) { const size_t tn = (size_t)(tb + ((idx + 1) >> 2) * 128 + ((idx + 1) & 3) * 16) * 64;
                ncs0 = *(const f32x4*)(cb + tn); ncs1 = *(const f32x4*)(cb + tn + 4); nsn0 = *(const f32x4*)(sb + tn); nsn1 = *(const f32x4*)(sb + tn + 4); }
            f32x4 x0, x1, y0, y1;
            if (kind == 0) { x0 = a0 * cs0 - c0 * sn0; x1 = a1 * cs1 - c1 * sn1; y0 = c0 * cs0 + a0 * sn0; y1 = c1 * cs1 + a1 * sn1;
                if (cq) { bf16_t* q = qbase + (size_t)t * 128; st8(q, a0 * QSCALE, a1 * QSCALE); st8(q + 64, c0 * QSCALE, c1 * QSCALE); } }
            else { x0 = a0; x1 = a1; y0 = c0; y1 = c1; }
            u32x4 w1, w2; w1.x = pk2(x0[0], x0[1]); w1.y = pk2(x0[2], x0[3]); w1.z = pk2(x1[0], x1[1]); w1.w = pk2(x1[2], x1[3]); w2.x = pk2(y0[0], y0[1]); w2.y = pk2(y0[2], y0[3]); w2.z = pk2(y1[0], y1[1]); w2.w = pk2(y1[2], y1[3]);
            *(PG8_LAS u32x4*)wt = w1; *(PG8_LAS u32x4*)(wt + 128) = w2;
            asm volatile("s_waitcnt lgkmcnt(0)" ::: "memory"); __builtin_amdgcn_s_barrier(); asm volatile("" ::: "memory");
            const u32x4 v0 = *(const PG8_LAS u32x4*)rt, v1 = *(const PG8_LAS u32x4*)(rt + 4 * TPITCH);
            asm volatile("s_waitcnt lgkmcnt(0)" ::: "memory"); __builtin_amdgcn_s_barrier(); asm volatile("" ::: "memory");
            bf16_t* dR = dbaseR + (size_t)(tR0 + ai * 128 + m * 16) * 128;
            *(u32x4*)dR = v0; *(u32x4*)(dR + 4 * 128) = v1; }
    }
};

constexpr int TP = 136;
DI void lds_row8(const bf16_t* tile, int tok, int ch, float (&x)[8]) { const u32x4 w = *(const u32x4*)(tile + tok * TP + ch * 8); unpack8(w, x); }
template <int HD> DI void rope_chunk(const bf16_t* tile, int tok, int ch, int hc0, const float* cs, const float* sn, int t, float scale, float (&o)[8]) {
    constexpr int NCH = HD / 8, HALF_CH = NCH / 2;
    const int cc = ch - hc0; float own[8], par[8];
    lds_row8(tile, tok, ch, own); lds_row8(tile, tok, hc0 + (cc ^ HALF_CH), par);
    const int ci = (cc & (HALF_CH - 1)) * 8; const float* cp = cs + (size_t)t * (HD / 2) + ci; const float* sp = sn + (size_t)t * (HD / 2) + ci;
    const f32x4 c0 = *(const f32x4*)cp, c1 = *(const f32x4*)(cp + 4), s0 = *(const f32x4*)sp, s1 = *(const f32x4*)(sp + 4);
    const float sg = (cc < HALF_CH) ? -1.0f : 1.0f;
#pragma unroll
    for (int e = 0; e < 4; ++e) { o[e] = (own[e] * c0[e] + sg * par[e] * s0[e]) * scale; o[4 + e] = (own[4 + e] * c1[e] + sg * par[4 + e] * s1[e]) * scale; }
}
DI void phase_prep(const Ptrs& P, unsigned char* lds) {
    bf16_t* tile = (bf16_t*)lds;
    const bf16_t* Pm = wsp<bf16_t>(P, WS_P);
    const float* c128 = wsp<float>(P, WS_COS128); const float* s128 = wsp<float>(P, WS_SIN128); const float* c64 = wsp<float>(P, WS_COS64); const float* s64 = wsp<float>(P, WS_SIN64);
    const int tid = otid(), tok = tid >> 4, ch = tid & 15;
    for (int it = blockIdx.x; it < (T / 32) * NSEG; it += gridDim.x) {
        const int tl = it / NSEG, seg = it % NSEG, b = tl >> 6, s0 = (tl & 63) * 32, t = s0 + tok; const size_t row = (size_t)b * S + t;
        *(u32x4*)(tile + tok * TP + ch * 8) = *(const u32x4*)(Pm + row * NPAD + seg * 128 + ch * 8);
        __syncthreads();
        float o[8];
        if (seg < 4) { rope_chunk<128>(tile, tok, ch, 0, c128, s128, t, 1.0f, o); *(u32x4*)(wsp<bf16_t>(P, WS_AQ) + (((size_t)b * 4 + seg) * S + t) * 128 + ch * 8) = pack8(o); }
        else if (seg == 4) { rope_chunk<128>(tile, tok, ch, 0, c128, s128, t, 1.0f, o); *(u32x4*)(wsp<bf16_t>(P, WS_AK) + row * 128 + ch * 8) = pack8(o); }
        else if (seg == 5) { *(u32x4*)(wsp<bf16_t>(P, WS_AVT) + row * 128 + ch * 8) = *(const u32x4*)(tile + tok * TP + ch * 8); }
        else if (seg < 14) { const int hc0 = ch & 8, head = 2 * (seg - 6) + (ch >> 3); rope_chunk<64>(tile, tok, ch, hc0, c64, s64, t, 1.0f, o);
            *(u32x4*)(wsp<bf16_t>(P, WS_IQ) + (((size_t)b * 16 + head) * S + t) * 64 + (ch & 7) * 8) = pack8(o); }
        else if (seg < 18) { rope_chunk<128>(tile, tok, ch, 0, c128, s128, t, 1.0f, o); *(u32x4*)(wsp<bf16_t>(P, WS_BQ) + (((size_t)b * 4 + (seg - 14)) * S + t) * 128 + ch * 8) = pack8(o); }
        else if (seg < 22) { rope_chunk<128>(tile, tok, ch, 0, c128, s128, t, 1.0f, o); const u32x4 w = pack8(o); const size_t hb = ((size_t)b * 4 + (seg - 18)) * S;
            *(u32x4*)(wsp<bf16_t>(P, WS_BK1) + (hb + t) * 128 + ch * 8) = w;
            *(u32x4*)(wsp<bf16_t>(P, WS_BK4) + (hb + (t & 3) * 512 + (t >> 2)) * 128 + ch * 8) = w;
            *(u32x4*)(wsp<bf16_t>(P, WS_BK16) + (hb + (t & 15) * 128 + (t >> 4)) * 128 + ch * 8) = w; }
        else if (seg < 26) { const u32x4 w = *(const u32x4*)(tile + tok * TP + ch * 8); const size_t hb = ((size_t)b * 4 + (seg - 22)) * S;
            *(u32x4*)(wsp<bf16_t>(P, WS_BVT1) + (hb + t) * 128 + ch * 8) = w;
            *(u32x4*)(wsp<bf16_t>(P, WS_BVT4) + (hb + (t & 3) * 512 + (t >> 2)) * 128 + ch * 8) = w;
            *(u32x4*)(wsp<bf16_t>(P, WS_BVT16) + (hb + (t & 15) * 128 + (t >> 4)) * 128 + ch * 8) = w; }
        else if (seg < 34) { const size_t hb = (((size_t)b * 8 + (seg - 26)) * S + t) * 128 + ch * 8; float x[8]; lds_row8(tile, tok, ch, x);
#pragma unroll
            for (int e = 0; e < 8; ++e) x[e] *= QSCALE;
            *(u32x4*)(wsp<bf16_t>(P, WS_CQ) + hb) = pack8(x);
            rope_chunk<128>(tile, tok, ch, 0, c128, s128, t, 1.0f, o); *(u32x4*)(wsp<bf16_t>(P, WS_CQR) + hb) = pack8(o); }
        else if (seg < 36) { *(u32x4*)(wsp<bf16_t>(P, WS_KC) + (((size_t)b * 2 + (seg - 34)) * S + t) * 128 + ch * 8) = *(const u32x4*)(tile + tok * TP + ch * 8); }
        else if (seg < 38) { *(u32x4*)(wsp<bf16_t>(P, WS_VC) + (((size_t)b * 2 + (seg - 36)) * S + t) * 128 + ch * 8) = *(const u32x4*)(tile + tok * TP + ch * 8); }
        else if (seg < 40) { rope_chunk<128>(tile, tok, ch, 0, c128, s128, t, 1.0f, o); *(u32x4*)(wsp<bf16_t>(P, WS_CKS) + (((size_t)b * 2 + (seg - 38)) * S + t) * 128 + ch * 8) = pack8(o); }
        else if (seg < 42) { *(u32x4*)(wsp<bf16_t>(P, WS_CVST) + (((size_t)b * 2 + (seg - 40)) * S + t) * 128 + ch * 8) = *(const u32x4*)(tile + tok * TP + ch * 8); }
        else if (seg < 44) { rope_chunk<128>(tile, tok, ch, 0, c128, s128, t, 1.0f, o); *(u32x4*)(wsp<bf16_t>(P, WS_CKW) + (((size_t)b * 2 + (seg - 42)) * S + t) * 128 + ch * 8) = pack8(o); }
        else if (seg < 46) { *(u32x4*)(wsp<bf16_t>(P, WS_CVWT) + (((size_t)b * 2 + (seg - 44)) * S + t) * 128 + ch * 8) = *(const u32x4*)(tile + tok * TP + ch * 8); }
        else {
            if (ch < 8) { rope_chunk<64>(tile, tok, ch, 0, c64, s64, t, 1.0f, o); *(u32x4*)(wsp<bf16_t>(P, WS_IK) + row * 64 + ch * 8) = pack8(o); }
            else if (ch < 10) { float x[8]; lds_row8(tile, tok, ch, x); float* d = wsp<float>(P, WS_IW) + row * 16 + (ch - 8) * 8;
                *(f32x4*)d = (f32x4){x[0], x[1], x[2], x[3]} * 0.03125f; *(f32x4*)(d + 4) = (f32x4){x[4], x[5], x[6], x[7]} * 0.03125f; }
            else if (ch < 13) { float x[8]; lds_row8(tile, tok, ch, x); float* d = wsp<float>(P, WS_GATE) + row * 24 + (ch - 10) * 8;
#pragma unroll
                for (int e = 0; e < 8; ++e) x[e] = frcp(1.0f + fexp2(-1.4426950408889634f * x[e]));
                *(f32x4*)d = (f32x4){x[0], x[1], x[2], x[3]}; *(f32x4*)(d + 4) = (f32x4){x[4], x[5], x[6], x[7]}; }
        }
        __syncthreads();
    }
}

DI void a1_item(const Ptrs& P, int it) {
    const int wid = otid() >> 6, lane = otid() & 63, c = lane & 15, q4 = lane >> 4;
    const int b = it & 7; int rem = it >> 3, qblk = 15, np = 2;
    for (;; --qblk) { np = ((((qblk + 2) >> 1) + 1) >> 1); if (rem < np) break; rem -= np; }
    const int nk = (qblk + 2) >> 1, kb_lo = rem * nk / np, kb_hi = (rem + 1) * nk / np - 1, t0 = qblk * 128 + wid * 16, t = t0 + c;
    const bf16_t* IQ = wsp<bf16_t>(P, WS_IQ); const bf16_t* IK = wsp<bf16_t>(P, WS_IK); const float* IW = wsp<float>(P, WS_IW); float* SC = wsp<float>(P, WS_SC);
    bf16x8 iq[16][2]; float w[16];
#pragma unroll
    for (int h = 0; h < 16; ++h) { const bf16_t* p = IQ + (((size_t)b * 16 + h) * S + t) * 64 + 8 * q4; iq[h][0] = *(const bf16x8*)p; iq[h][1] = *(const bf16x8*)(p + 32); }
#pragma unroll
    for (int h4 = 0; h4 < 4; ++h4) { const f32x4 v = *(const f32x4*)(IW + ((size_t)b * S + t) * 16 + 4 * h4); w[4 * h4] = v[0]; w[4 * h4 + 1] = v[1]; w[4 * h4 + 2] = v[2]; w[4 * h4 + 3] = v[3]; }
    const int k16_lo = kb_lo * 16; int k16_hi = kb_hi * 16 + 15; const int lim = (t0 + 15) >> 4; if (k16_hi > lim) k16_hi = lim;
    const bf16_t* kp = IK + ((size_t)b * S + k16_lo * 16 + c) * 64 + 8 * q4;
    bf16x8 nk0 = *(const bf16x8*)kp, nk1 = *(const bf16x8*)(kp + 32);
    for (int k16 = k16_lo; k16 <= k16_hi; ++k16) {
        const bf16x8 k0 = nk0, k1 = nk1;
        if (k16 < k16_hi) { kp += 16 * 64; nk0 = *(const bf16x8*)kp; nk1 = *(const bf16x8*)(kp + 32); }
        f32x4 acc = (f32x4){0.f, 0.f, 0.f, 0.f};
#pragma unroll
        for (int h = 0; h < 16; ++h) { f32x4 s = (f32x4){0.f, 0.f, 0.f, 0.f}; s = MFMA16(k0, iq[h][0], s); s = MFMA16(k1, iq[h][1], s);
#pragma unroll
            for (int j = 0; j < 4; ++j) acc[j] += w[h] * fmaxf(s[j], 0.f); }
        *(f32x4*)(SC + ((size_t)b * S + t) * S + k16 * 16 + 4 * q4) = acc;
    }
}

DI void a2_load(const Ptrs& P, int row, int lane, unsigned (&raw)[32]) {
    const int t = row & (S - 1); const float* sc = wsp<float>(P, WS_SC) + (size_t)row * S;
#pragma unroll
    for (int i = 0; i < 32; ++i) { const int key = 64 * i + lane; raw[i] = __float_as_uint(sc[(key <= t) ? key : lane]); }
}
DI void a2_select(const Ptrs& P, int row  , int lane, const unsigned (&raw)[32]) {
    const int t = row & (S - 1);
    unsigned long long* bits = wsp<unsigned long long>(P, WS_BITS) + (size_t)row * 32;
    unsigned long long mine = 0ull;
    if (t < 256) {
#pragma unroll
        for (int i = 0; i < 32; ++i) { const unsigned long long m = __ballot(64 * i + lane <= t); if (lane == i) mine = m; }
    } else {
        unsigned u[32];
#pragma unroll
        for (int i = 0; i < 32; ++i) { const int key = 64 * i + lane; const unsigned bts = raw[i]; const unsigned x = (bts & 0x80000000u) ? ~bts : (bts | 0x80000000u); u[i] = (key <= t) ? x : 0u; }
        unsigned prefix = 0u; bool exact = false;
        for (int bit = 31; bit >= 0; --bit) { const unsigned cand = prefix | (1u << bit); int cnt = 0;
#pragma unroll
            for (int i = 0; i < 32; ++i) cnt += __builtin_popcountll(__ballot(u[i] >= cand));
            if (cnt >= 256) prefix = cand;
            if (cnt == 256) { exact = true; break; } }
        int cgt = 0;
        if (exact) prefix -= 1u;
#pragma unroll
        for (int i = 0; i < 32; ++i) cgt += __builtin_popcountll(__ballot(u[i] > prefix));
        const int need = 256 - cgt; int carried = 0; const unsigned long long lt = (lane == 0) ? 0ull : (~0ull >> (64 - lane));
#pragma unroll
        for (int i = 0; i < 32; ++i) { const bool eq = (u[i] == prefix); const unsigned long long meq = __ballot(eq);
            const int rk = carried + __builtin_popcountll(meq & lt); carried += __builtin_popcountll(meq);
            const bool sel = ((u[i] > prefix) || (eq && rk < need)) && (64 * i + lane <= t);
            const unsigned long long m = __ballot(sel); if (lane == i) mine = m; }
    }
    if (lane < 32) bits[lane] = mine;
}
DI void a2_item(const Ptrs& P, int j) {
    const int lane = otid() & 63, wid = otid() >> 6, base = (T - 1) - 32 * j - wid;
    unsigned ra[32], rb[32];
    a2_load(P, base, lane, ra);
    a2_load(P, base - 8, lane, rb);  a2_select(P, base, lane, ra);
    a2_load(P, base - 16, lane, ra); a2_select(P, base - 8, lane, rb);
    a2_load(P, base - 24, lane, rb); a2_select(P, base - 16, lane, ra);
    a2_select(P, base - 24, lane, rb);
}
DI void c1b_item(const Ptrs& P, int it) {
    const int wid = otid() >> 6, lane = otid() & 63, c = lane & 15, q4 = lane >> 4;
    const int kv = it >> 4, rt = (it & 15) * 8 + wid, row = 16 * rt + c, bg = row >> 7, cc = row & 127;
    const bf16_t* A = wsp<bf16_t>(P, kv ? WS_G1V : WS_G1K) + (size_t)row * 256 + 8 * q4;
    const bf16_t* Bt = wsp<bf16_t>(P, kv ? WS_CW2V : WS_CW2K) + (size_t)c * 256 + 8 * q4;
    f32x4 acc[8];
#pragma unroll
    for (int n = 0; n < 8; ++n) acc[n] = (f32x4){0.f, 0.f, 0.f, 0.f};
#pragma unroll
    for (int ks = 0; ks < 8; ++ks) { const bf16x8 a = *(const bf16x8*)(A + 32 * ks);
#pragma unroll
        for (int n = 0; n < 8; ++n) { const bf16x8 bt = *(const bf16x8*)(Bt + (size_t)(16 * n) * 256 + 32 * ks); acc[n] = MFMA16(bt, a, acc[n]); } }
    const bool zr = (cc == 127);
    if (!kv) { bf16_t* dst = wsp<bf16_t>(P, WS_KCC) + ((size_t)bg * 128 + cc) * 128;
#pragma unroll
        for (int n = 0; n < 8; ++n) { u32x2 w; w.x = zr ? 0u : pk2(acc[n][0], acc[n][1]); w.y = zr ? 0u : pk2(acc[n][2], acc[n][3]); *(u32x2*)(dst + 16 * n + 4 * q4) = w; }
    } else { bf16_t* dst = wsp<bf16_t>(P, WS_VCT) + ((size_t)bg * 4 + (cc >> 5)) * 4096 + (cc & 31);
#pragma unroll
        for (int n = 0; n < 8; ++n)
#pragma unroll
            for (int j = 0; j < 4; ++j) dst[(16 * n + 4 * q4 + j) * 32] = zr ? (bf16_t)0 : (bf16_t)(pk2(acc[n][j], 0.f) & 0xffffu);
    }
}

DI void load_q(bf16x8 (&qf)[4], const bf16_t* qrow, int q4) {
#pragma unroll
    for (int ks = 0; ks < 4; ++ks) qf[ks] = *(const bf16x8*)(qrow + 32 * ks + 8 * q4);
}
DI void c2_item(const Ptrs& P, int it, unsigned char* lds) {
    const int wid = otid() >> 6, lane = otid() & 63, c = lane & 15, q4 = lane >> 4, r16 = lane & 15;
    const int bg = it >> 4, b = bg >> 1, g = bg & 1, t0 = (it & 15) * 128 + wid * 16, t = t0 + c, kr0 = 8 * (r16 >> 2) + (r16 & 3);
    constexpr int KP = 136;
    bf16_t* Kl = (bf16_t*)(lds + 32768); bf16_t* Vl = (bf16_t*)(lds + 32768 + 128 * KP * 2);
    { const int tid = otid(); const bf16_t* Kg = wsp<bf16_t>(P, WS_KCC) + (size_t)bg * 128 * 128; const bf16_t* Vg = wsp<bf16_t>(P, WS_VCT) + (size_t)bg * 4 * 4096;
      __syncthreads();
#pragma unroll
      for (int i = 0; i < 4; ++i) { const int e = (tid + 512 * i) * 8, row = e >> 7, col = e & 127; *(u32x4*)(Kl + row * KP + col) = *(const u32x4*)(Kg + e); *(u32x4*)(Vl + e) = *(const u32x4*)(Vg + e); }
      __syncthreads(); }
    const LAS bf16_t* KCC = (const LAS bf16_t*)Kl + kr0 * KP + 8 * q4; const LAS bf16_t* VCT = (const LAS bf16_t*)Vl + r16 * 32 + 8 * q4;
    const float* gates = wsp<float>(P, WS_GATE) + ((size_t)b * S + t) * 24;
    const int cmax = (t >= 31) ? ((t - 31) >> 4) : -1;
    f32x4 ia[4][2];
#pragma unroll
    for (int kt = 0; kt < 4; ++kt) { ia[kt][0] = (f32x4){0.f, 0.f, 0.f, 0.f}; ia[kt][1] = (f32x4){0.f, 0.f, 0.f, 0.f}; }
    bf16x8 qfa[4][4]; float g0a[4];
#pragma unroll
    for (int rr = 0; rr < 4; ++rr) { load_q(qfa[rr], wsp<bf16_t>(P, WS_CQ) + (((size_t)b * 8 + g * 4 + rr) * S + t) * 128, q4); g0a[rr] = gates[(g * 4 + rr) * 3 + 0]; }
#pragma unroll
    for (int rr = 0; rr < 4; ++rr) {
        const int hh = g * 4 + rr;
        asm volatile("" : "+v"(KCC), "+v"(VCT));
        bf16x8 qf[4];
#pragma unroll
        for (int ks = 0; ks < 4; ++ks) qf[ks] = qfa[rr][ks];
        f32x4 s[4][2]; float mx = NEG;
#pragma unroll
        for (int kt = 0; kt < 4; ++kt)
#pragma unroll
            for (int sub = 0; sub < 2; ++sub) { f32x4 a = (f32x4){0.f, 0.f, 0.f, 0.f};
#pragma unroll
                for (int ks = 0; ks < 4; ++ks) { const bf16x8 kf = *(const LAS bf16x8*)(KCC + (32 * kt + 4 * sub) * KP + 32 * ks); a = MFMA16(kf, qf[ks], a); }
#pragma unroll
                for (int j = 0; j < 4; ++j) { const int cc = 32 * kt + 8 * q4 + 4 * sub + j; const bool ok = (cc <= cmax) && (cc < 127); a[j] = ok ? a[j] : NEG; mx = fmaxf(mx, a[j]); }
                s[kt][sub] = a; __builtin_amdgcn_sched_barrier(0); }
        mx = fmaxf(mx, __shfl_xor(mx, 16)); mx = fmaxf(mx, __shfl_xor(mx, 32));
        float den = 0.f;
#pragma unroll
        for (int kt = 0; kt < 4; ++kt)
#pragma unroll
            for (int sub = 0; sub < 2; ++sub)
#pragma unroll
                for (int j = 0; j < 4; ++j) { const float e = (s[kt][sub][j] > -5.0e29f) ? fexp2(s[kt][sub][j] - mx) : 0.f; s[kt][sub][j] = e; den += e; }
        den += __shfl_xor(den, 16); den += __shfl_xor(den, 32);
        const float inv = den > 0.f ? 1.0f / den : 0.f;
        f32x4 o[8];
#pragma unroll
        for (int db = 0; db < 8; ++db) o[db] = (f32x4){0.f, 0.f, 0.f, 0.f};
#pragma unroll
        for (int kt = 0; kt < 4; ++kt) { float p[8];
#pragma unroll
            for (int sub = 0; sub < 2; ++sub) { s[kt][sub] = s[kt][sub] * inv; ia[kt][sub] += s[kt][sub];
#pragma unroll
                for (int j = 0; j < 4; ++j) p[4 * sub + j] = s[kt][sub][j]; }
            const u32x4 pw = pack8(p); const bf16x8 pb = __builtin_bit_cast(bf16x8, pw);
#pragma unroll
            for (int db = 0; db < 8; ++db) { const bf16x8 vf = *(const LAS bf16x8*)(VCT + kt * 4096 + (16 * db) * 32); o[db] = MFMA16(vf, pb, o[db]); }
            __builtin_amdgcn_sched_barrier(0); }
        const float g0 = g0a[rr]; bf16_t* dst = wsp<bf16_t>(P, WS_OC) + ((size_t)b * S + t) * 1024 + hh * 128;
#pragma unroll
        for (int db = 0; db < 8; ++db) { u32x2 w; w.x = pk2(o[db][0] * g0, o[db][1] * g0); w.y = pk2(o[db][2] * g0, o[db][3] * g0); *(u32x2*)(dst + 16 * db + 4 * q4) = w; }
    }
    float* impw = (float*)lds + wid * (16 * 33);
#pragma unroll
    for (int kt = 0; kt < 4; ++kt) {
        const float own = __shfl(ia[kt][1][3], (lane + 48) & 63);
        const float wrp = (kt > 0) ? __shfl(ia[kt > 0 ? kt - 1 : 0][1][3], (lane + 48) & 63) : 0.f;
        const float prev0 = (q4 == 0) ? wrp : own;
        const float v0 = (ia[kt][0][0] + ia[kt][0][1]) + (ia[kt][0][2] + ia[kt][0][3]) + prev0;
        const float v1 = (ia[kt][1][0] + ia[kt][1][1]) + (ia[kt][1][2] + ia[kt][1][3]) + ia[kt][0][3];
        impw[c * 33 + 8 * kt + 2 * q4] = v0; impw[c * 33 + 8 * kt + 2 * q4 + 1] = v1;
    }
    asm volatile("s_waitcnt lgkmcnt(0)" ::: "memory");
    __builtin_amdgcn_wave_barrier();
    const int cur = t >> 6; unsigned key[32];
#pragma unroll
    for (int n = 0; n < 32; ++n) { const float x = impw[c * 33 + n]; const float v = (n > cur) ? -__builtin_inff() : ((n == 0 || n == cur || n + 1 == cur) ? __builtin_inff() : x);
        const unsigned bts = __float_as_uint(v); const unsigned o = (bts & 0x80000000u) ? ~bts : (bts | 0x80000000u); key[n] = (o & ~31u) | (unsigned)(31 - n); }
    unsigned selbits = 0u;
#pragma unroll
    for (int e = 0; e < 8; ++e) { const int myn = 8 * q4 + e; const float x = impw[c * 33 + myn];
        const float v = (myn > cur) ? -__builtin_inff() : ((myn == 0 || myn == cur || myn + 1 == cur) ? __builtin_inff() : x);
        const unsigned bts = __float_as_uint(v); const unsigned o = (bts & 0x80000000u) ? ~bts : (bts | 0x80000000u); const unsigned km = (o & ~31u) | (unsigned)(31 - myn);
        int rank = 0;
#pragma unroll
        for (int n = 0; n < 32; ++n) rank += (key[n] > km) ? 1 : 0;
        if (rank < 16) selbits |= 1u << myn; }
    selbits |= __shfl_xor(selbits, 16); selbits |= __shfl_xor(selbits, 32);
    if (q4 == 0) wsp<unsigned>(P, WS_SEL)[(size_t)bg * S + t] = selbits;
    __builtin_amdgcn_wave_barrier();
}


enum { FK_B1 = 0, FK_B4 = 1, FK_B16 = 2, FK_C5 = 3, FK_C4 = 4, FK_A3 = 5 };
DI fa::BlockRef fa_ref(const Ptrs& P, int kind, int idx) {
    fa::BlockRef r; r.LSE = nullptr; r.aux = nullptr; r.lstr = 0; r.m = S; r.ecode = 0;
    if (kind <= FK_B16) {
        const int bh = idx & 31, pb = idx >> 5, b = bh >> 2, h = bh & 3; const size_t hb = (size_t)bh * S * 128, tb = (size_t)b * S;
        r.Q = wsp<bf16_t>(P, WS_BQ) + hb;
        r.K = wsp<bf16_t>(P, WS_BK1) + hb; r.V = wsp<bf16_t>(P, WS_BVT1) + hb;
        r.O = wsp<bf16_t>(P, kind == FK_B1 ? WS_OB1 : (kind == FK_B4 ? WS_OB4 : WS_OB16)) + tb * 512 + h * 128; r.ldo = 512;
        r.LSE = wsp<float>(P, kind == FK_B1 ? WS_LSE1 : (kind == FK_B4 ? WS_LSE4 : WS_LSE16)) + tb * 4 + h; r.lstr = 4;
        r.P0 = pb * 256; r.mode = fa::M_WIN; r.Wu = 129; r.m = (kind == FK_B1) ? S : (kind == FK_B4 ? S / 4 : S / 16);
        if (kind == FK_B1) { r.O = wsp<bf16_t>(P, WS_MIX) + tb * DM + 512 + h * 128; r.ldo = DM; r.LSE = nullptr; r.ecode = 3 | (h << 4) | (b << 8); }
    } else if (kind == FK_C5 || kind == FK_C4) {
        const int bhh = idx & 63, qb = 7 - (idx >> 6), b = bhh >> 3, hh = bhh & 7, g = hh >> 2; const size_t gb = ((size_t)b * 2 + g) * S * 128, tb = (size_t)b * S;
        r.Q = wsp<bf16_t>(P, WS_CQR) + (size_t)bhh * S * 128;
        r.K = wsp<bf16_t>(P, kind == FK_C5 ? WS_CKW : WS_CKS) + gb; r.V = wsp<bf16_t>(P, kind == FK_C5 ? WS_CVWT : WS_CVST) + gb;
        r.O = wsp<bf16_t>(P, kind == FK_C5 ? WS_OWIN : WS_OSLC) + tb * 1024 + hh * 128; r.ldo = 1024;
        r.P0 = qb * 256; r.mode = (kind == FK_C5) ? fa::M_WIN : fa::M_SEL; r.Wu = (kind == FK_C5) ? 512 : 0x40000000;
        r.aux = wsp<unsigned>(P, WS_SEL) + ((size_t)b * 2 + g) * S;
        if (kind == FK_C4) { r.O = wsp<bf16_t>(P, WS_MIX) + tb * DM + 1024 + hh * 128; r.ldo = DM; r.ecode = 2 | (hh << 4) | (b << 8); }
    } else {
        const int bh = idx & 31, qb = 7 - (idx >> 5), b = bh >> 2, h = bh & 3; const size_t tb = (size_t)b * S;
        r.Q = wsp<bf16_t>(P, WS_AQ) + (size_t)bh * S * 128; r.K = wsp<bf16_t>(P, WS_AK) + tb * 128; r.V = wsp<bf16_t>(P, WS_AVT) + tb * 128;
        r.O = wsp<bf16_t>(P, WS_MIX) + tb * DM + h * 128; r.ldo = DM;
        r.P0 = qb * 256; r.mode = fa::M_BITS; r.Wu = 0x40000000; r.aux = wsp<unsigned>(P, WS_BITS) + tb * 64;
    }
    return r;
}
struct FaList { int kind[4]; int n[4]; int ng; };
DI fa::BlockRef fa_list_ref(const Ptrs& P, const FaList& L, int i) {
    int g = 0;
#pragma unroll
    for (int k = 0; k < 3; ++k) if (g == k && k + 1 < L.ng && i >= L.n[k]) { i -= L.n[k]; g = k + 1; }
    const int kind = (g == 0) ? L.kind[0] : (g == 1 ? L.kind[1] : (g == 2 ? L.kind[2] : L.kind[3]));
    return fa_ref(P, kind, i);
}
struct FaNext {
    const Ptrs* P; const FaList* L; unsigned* ctr; unsigned char* lds; int total, tid; bool last;
    DI fa::BlockRef operator()(const fa::BlockRef& cur) { const int ni = q_next(ctr, lds, tid); last = ni >= total; return last ? cur : fa_list_ref(*P, *L, ni); }
};
DI void fa_stream(const Ptrs& P, const FaList& L, unsigned* ctr, unsigned char* lds) {
    const int tid = otid();
    int total = 0;
#pragma unroll
    for (int k = 0; k < 4; ++k) if (k < L.ng) total += L.n[k];
    const int i = q_next(ctr, lds, tid);
    if (i >= total) return;
    fa::BlockRef cur = fa_list_ref(P, L, i), nxt = cur;
    fa::Seam Sm;
    fa::prime(cur, (char*)lds, Sm, tid);
    fa::EpiPtrs ep; ep.oc = wsp<bf16_t>(P, WS_OC); ep.owin = wsp<bf16_t>(P, WS_OWIN); ep.gate = wsp<float>(P, WS_GATE); ep.ob4 = wsp<bf16_t>(P, WS_OB4); ep.ob16 = wsp<bf16_t>(P, WS_OB16); ep.lse4 = wsp<float>(P, WS_LSE4); ep.lse16 = wsp<float>(P, WS_LSE16);
    FaNext nf; nf.P = &P; nf.L = &L; nf.ctr = ctr; nf.lds = lds; nf.total = total; nf.tid = tid; nf.last = false;
    for (;;) {
        fa::block(cur, nxt, nf, ep, (char*)lds, Sm, tid);
        if (nf.last) break;
        cur = nxt;
    }
}

DI void phase_merge(const Ptrs& P) {
    const int tid = otid(), lane = tid & 63, gw = blockIdx.x * 8 + (tid >> 6), ngw = gridDim.x * 8;
    for (int row = gw; row < T; row += ngw) {
        bf16_t* dst = wsp<bf16_t>(P, WS_MIX) + (size_t)row * DM;
        {
            const int h = lane >> 4, col = 8 * lane;
            const float l1 = wsp<float>(P, WS_LSE1)[(size_t)row * 4 + h], l4 = wsp<float>(P, WS_LSE4)[(size_t)row * 4 + h], l16 = wsp<float>(P, WS_LSE16)[(size_t)row * 4 + h];
            const float mm = fmaxf(l1, fmaxf(l4, l16)), w1 = fexp2(l1 - mm), w4 = fexp2(l4 - mm), w16 = fexp2(l16 - mm), wi = 1.0f / (w1 + w4 + w16);
            float a[8], b4[8], c16[8], o[8];
            unpack8(*(const u32x4*)(wsp<bf16_t>(P, WS_OB1) + (size_t)row * 512 + col), a); unpack8(*(const u32x4*)(wsp<bf16_t>(P, WS_OB4) + (size_t)row * 512 + col), b4);
            unpack8(*(const u32x4*)(wsp<bf16_t>(P, WS_OB16) + (size_t)row * 512 + col), c16);
#pragma unroll
            for (int e = 0; e < 8; ++e) o[e] = (a[e] * w1 + b4[e] * w4 + c16[e] * w16) * wi;
            *(u32x4*)(dst + 512 + col) = pack8(o);
        }
#pragma unroll
        for (int j = 0; j < 2; ++j) {
            const int col = 8 * (lane + 64 * j), hh = col >> 7;
            const float* gt = wsp<float>(P, WS_GATE) + (size_t)row * 24 + hh * 3; const float g1 = gt[1], g2 = gt[2];
            float a[8], b[8], c[8], o[8];
            unpack8(*(const u32x4*)(wsp<bf16_t>(P, WS_OC) + (size_t)row * 1024 + col), a); unpack8(*(const u32x4*)(wsp<bf16_t>(P, WS_OSLC) + (size_t)row * 1024 + col), b);
            unpack8(*(const u32x4*)(wsp<bf16_t>(P, WS_OWIN) + (size_t)row * 1024 + col), c);
#pragma unroll
            for (int e = 0; e < 8; ++e) o[e] = a[e] + g1 * b[e] + g2 * c[e];
            *(u32x4*)(dst + 1024 + col) = pack8(o);
        }
    }
}

constexpr int NPH = 13;
constexpr int NPHASES = 1 + DEPTH * NPH;
struct Args { const float* in[16]; float* out; unsigned char* ws; int ph_lo, ph_hi; };

__global__ void __launch_bounds__(512, 2) fwd(Args a) {
    extern __shared__ __attribute__((aligned(16))) unsigned char lds[];
    Ptrs P;
#pragma unroll
    for (int i = 0; i < 16; ++i) P.in[i] = a.in[i];
    P.out = a.out; P.ws = a.ws;
    const int lo = a.ph_lo, hi = a.ph_hi;
    volatile LAS unsigned* bst = (volatile LAS unsigned*)((LAS unsigned char*)lds + LDS_BAR_OFF);
    if (otid() < 4) bst[otid()] = 0u;
    __syncthreads();
    XcdBarrier bar; bar.bar = (unsigned*)(P.ws + WS_CTL); bar.x = 0; bar.st = bst;
    if (hi - lo > 1) bar = xcd_barrier_post((unsigned*)(P.ws + WS_CTL), bst);
#define IN(k) (lo <= (k) && (k) < hi)
#define SEAM(k) do { if (IN(k) && IN((k) + 1)) xcd_barrier(bar); } while (0)
    if (IN(0)) { phase_rope_tables(P); for (int it = blockIdx.x; it < WMAX_ITEMS; it += gridDim.x) wmax_in_item(P, 0, it, lds); }
    SEAM(0);
    for (int layer = 0; layer < DEPTH; ++layer) {
        const int pb = 1 + layer * NPH;
        const float* xcur = (layer == 0) ? P.in[0] : P.out;
        if (layer == 0) { if (IN(pb + 0)) { phase_wconv(P, layer, lds); phase_norm<false, false, 2>(P.in[0], nullptr, nullptr, nullptr, P.in[12], wsp<bf16_t>(P, WS_H)); }
            SEAM(pb + 0); }
#if MK_DUP_PH == 100
        phase_wconv(P, layer, lds); xcd_barrier(bar);
#endif
        if (IN(pb + 1)) { pg8::Gemm g{wsp<bf16_t>(P, WS_H), wsp<bf16_t>(P, WS_WIN), T, NPAD, DM / 2}; pg8::StaticOrder So; So.init(T, NPAD, gridDim.x, blockIdx.x);
            const float wmx = __uint_as_float(__builtin_amdgcn_readfirstlane(__hip_atomic_load((unsigned*)(P.ws + WS_CTL) + CTL_WMAX + layer * 64 + 1, __ATOMIC_RELAXED, __HIP_MEMORY_SCOPE_AGENT)));
            EpiPrep E{P.ws, (const float*)(P.ws + WS_H + (size_t)T * DM), fmaxf(wmx, 1e-30f) * (1.0f / 127.0f)}; pg8::gemm_phase<EpiPrep, pg8::StaticOrder, false, 2>((LAS unsigned char*)lds, g, So, E, nullptr); }
        SEAM(pb + 1);
#if MK_DUP_PH == 101
        { pg8::Gemm g{wsp<bf16_t>(P, WS_H), wsp<bf16_t>(P, WS_WIN), T, NPAD, DM}; pg8::StaticOrder So; So.init(T, NPAD, gridDim.x, blockIdx.x);
            EpiPrep E{P.ws}; pg8::gemm_phase<EpiPrep, pg8::StaticOrder, false>((LAS unsigned char*)lds, g, So, E, nullptr); } xcd_barrier(bar);
#endif
#define ATT_BODY \
          \
        if (ATT_IN(3)) { unsigned* ctr = (unsigned*)(P.ws + WS_CTL) + 4096 + (layer * 16 + ATT_CB + 0) * 64; \
            if (ATT_PART(1) && blockIdx.x < 16) { const int kv = blockIdx.x >> 3; pg8::Gemm g{wsp<bf16_t>(P, kv ? WS_VC : WS_KC), wsp<bf16_t>(P, kv ? WS_CW1V : WS_CW1K), 2048, 256, 4096, 2048}; \
                pg8::StaticOrder So; So.init(2048, 256, 8, blockIdx.x & 7); EpiGelu E{wsp<bf16_t>(P, kv ? WS_G1V : WS_G1K), 256, wsp<float>(P, WS_CB1) + kv * 256}; \
                pg8::gemm_phase<EpiGelu, pg8::StaticOrder, false>((LAS unsigned char*)lds, g, So, E, nullptr); } \
            FaList L; L.ng = 2; L.kind[0] = FK_B4; L.n[0] = 256; L.kind[1] = FK_B16; L.n[1] = 256; L.kind[2] = 0; L.n[2] = 0; L.kind[3] = 0; L.n[3] = 0; \
            if (ATT_PART(2)) fa_stream(P, L, ctr, lds); \
            if (ATT_PART(3)) for (int it = q_next(ctr + 64, lds, otid()); it < NB * 40; it = q_next(ctr + 64, lds, otid())) a1_item(P, it); \
            conv_filler(P, layer, lds, (unsigned*)(P.ws + WS_CTL) + 8192 + (layer * 4 + 0) * 64, 0); } \
        ATT_SEAM(3); \
          \
        if (ATT_IN(4)) { unsigned* ctr = (unsigned*)(P.ws + WS_CTL) + 4096 + (layer * 16 + ATT_CB + 2) * 64; \
            FaList L; L.ng = 1; L.kind[0] = FK_B1; L.n[0] = 256; L.kind[1] = 0; L.n[1] = 0; L.kind[2] = 0; L.n[2] = 0; L.kind[3] = 0; L.n[3] = 0; \
            if (ATT_PART(2)) fa_stream(P, L, ctr, lds); \
            if (ATT_PART(3)) for (int it = q_next(ctr + 64, lds, otid()); it < T / 32 + 32; it = q_next(ctr + 64, lds, otid())) { if (it < 32) c1b_item(P, it); else a2_item(P, it - 32); } \
            conv_filler(P, layer, lds, (unsigned*)(P.ws + WS_CTL) + 8192 + (layer * 4 + 1) * 64, 1); } \
        ATT_SEAM(4); \
          \
        if (ATT_IN(5)) { unsigned* ctr = (unsigned*)(P.ws + WS_CTL) + 4096 + (layer * 16 + ATT_CB + 4) * 64; \
            FaList L; L.ng = 2; L.kind[0] = FK_A3; L.n[0] = 256; L.kind[1] = FK_C5; L.n[1] = 512; L.kind[2] = 0; L.n[2] = 0; L.kind[3] = 0; L.n[3] = 0; \
            if (ATT_PART(3)) for (int it = q_next(ctr + 64, lds, otid()); it < 256; it = q_next(ctr + 64, lds, otid())) c2_item(P, it, lds);     \
            if (ATT_PART(2)) fa_stream(P, L, ctr, lds); \
            conv_filler(P, layer, lds, (unsigned*)(P.ws + WS_CTL) + 8192 + (layer * 4 + 2) * 64, 2); } \
        ATT_SEAM(5); \
          \
        if (ATT_IN(6)) { unsigned* ctr = (unsigned*)(P.ws + WS_CTL) + 4096 + (layer * 16 + ATT_CB + 6) * 64; \
            FaList L; L.ng = 1; L.kind[0] = FK_C4; L.n[0] = 512; L.kind[1] = 0; L.n[1] = 0; L.kind[2] = 0; L.n[2] = 0; L.kind[3] = 0; L.n[3] = 0; \
            if (ATT_PART(2)) fa_stream(P, L, ctr, lds); \
            conv_filler(P, layer, lds, (unsigned*)(P.ws + WS_CTL) + 8192 + (layer * 4 + 3) * 64, 3); } \
        ATT_SEAM(6); \
          \

#define ATT_IN(k) IN(pb + (k))
#define ATT_SEAM(k) SEAM(pb + (k))
#define ATT_CB 0
#define ATT_PART(p) true
        ATT_BODY
#undef ATT_IN
#undef ATT_SEAM
#undef ATT_CB
#undef ATT_PART
#if MK_DUP_PH >= 30 && MK_DUP_PH <= 79
#define ATT_IN(k) ((k) == MK_DUP_PH / 10)
#define ATT_SEAM(k) do { if ((k) == MK_DUP_PH / 10) xcd_barrier(bar); } while (0)
#define ATT_CB 8
#define ATT_PART(p) ((p) == MK_DUP_PH % 10)
        ATT_BODY
#undef ATT_IN
#undef ATT_SEAM
#undef ATT_CB
#undef ATT_PART
#endif
#if MK_DUP_PH >= 3 && MK_DUP_PH <= 7
#define ATT_IN(k) ((k) == MK_DUP_PH)
#define ATT_SEAM(k) do { if ((k) == MK_DUP_PH) xcd_barrier(bar); } while (0)
#define ATT_CB 8
#define ATT_PART(p) true
        ATT_BODY
#undef ATT_IN
#undef ATT_SEAM
#undef ATT_CB
#undef ATT_PART
#endif
        if (IN(pb + 8)) { pg8::Gemm g{wsp<bf16_t>(P, WS_MIX), wsp<bf16_t>(P, WS_WOUT), T, DM, DM}; pg8::StaticOrder So; So.init(T, DM, gridDim.x, blockIdx.x);
            EpiRowsBf16 E{wsp<bf16_t>(P, WS_Y), DM, 1.0f}; pg8::gemm_phase<EpiRowsBf16, pg8::StaticOrder, false>((LAS unsigned char*)lds, g, So, E, nullptr); }
        SEAM(pb + 8);
#if MK_DUP_PH == 108
        { pg8::Gemm g{wsp<bf16_t>(P, WS_MIX), wsp<bf16_t>(P, WS_WOUT), T, DM, DM}; pg8::StaticOrder So; So.init(T, DM, gridDim.x, blockIdx.x);
            pg8::EpiBf16<0> E{wsp<bf16_t>(P, WS_Y), DM, nullptr, 0, 0}; pg8::gemm_phase<pg8::EpiBf16<0>, pg8::StaticOrder, false>((LAS unsigned char*)lds, g, So, E, nullptr); } xcd_barrier(bar);
#endif
        if (IN(pb + 9)) { if (layer == 0) phase_norm<false, true, 2>(P.in[0], wsp<bf16_t>(P, WS_XB), wsp<bf16_t>(P, WS_Y), P.in[13] + (size_t)layer * DM, P.in[14] + (size_t)layer * DM, wsp<bf16_t>(P, WS_H));
            else phase_norm<true, true, 2>(wsp<bf16_t>(P, WS_XB), wsp<bf16_t>(P, WS_XB), wsp<bf16_t>(P, WS_Y), P.in[13] + (size_t)layer * DM, P.in[14] + (size_t)layer * DM, wsp<bf16_t>(P, WS_H)); }
        SEAM(pb + 9);
#if MK_DUP_PH == 109
        phase_norm<true, true>(wsp<bf16_t>(P, WS_XB), wsp<bf16_t>(P, WS_BIG), wsp<bf16_t>(P, WS_Y), P.in[13] + (size_t)layer * DM, P.in[14] + (size_t)layer * DM, wsp<bf16_t>(P, WS_MIX)); xcd_barrier(bar);
#endif
        if (IN(pb + 10)) { pg8::Gemm g{wsp<bf16_t>(P, WS_H), wsp<bf16_t>(P, WS_WGU), T, NGU, DM / 2}; pg8::StaticOrder So; So.init(T, NGU, gridDim.x, blockIdx.x);
            const float wmx = __uint_as_float(__builtin_amdgcn_readfirstlane(__hip_atomic_load((unsigned*)(P.ws + WS_CTL) + CTL_WMAX + layer * 64, __ATOMIC_RELAXED, __HIP_MEMORY_SCOPE_AGENT)));
            EpiSwigluI8 E{wsp<unsigned char>(P, WS_HID), FF, (const float*)(P.ws + WS_H + (size_t)T * DM), fmaxf(wmx, 1e-30f) * (1.0f / 127.0f)}; pg8::gemm_phase<EpiSwigluI8, pg8::StaticOrder, false, 2>((LAS unsigned char*)lds, g, So, E, nullptr); }
        SEAM(pb + 10);
#if MK_DUP_PH == 110
        { pg8::Gemm g{wsp<bf16_t>(P, WS_H), wsp<bf16_t>(P, WS_WGU), T, NGU, DM}; pg8::StaticOrder So; So.init(T, NGU, gridDim.x, blockIdx.x);
            EpiSwiglu E{wsp<bf16_t>(P, WS_HID), FF}; pg8::gemm_phase<EpiSwiglu, pg8::StaticOrder, false>((LAS unsigned char*)lds, g, So, E, nullptr); } xcd_barrier(bar);
#endif
        if (IN(pb + 11)) { pg8::Gemm g{wsp<bf16_t>(P, WS_HID), wsp<bf16_t>(P, WS_WDN), T, DM, FF / 2}; pg8::StaticOrder So; So.init(T, DM, gridDim.x, blockIdx.x);
            EpiRowsBf16 E{wsp<bf16_t>(P, WS_Y), DM, 1.0f / (F8_SHID * F8_SW)}; pg8::gemm_phase<EpiRowsBf16, pg8::StaticOrder, false, 1>((LAS unsigned char*)lds, g, So, E, nullptr); }
        SEAM(pb + 11);
#if MK_DUP_PH == 111
        { pg8::Gemm g{wsp<bf16_t>(P, WS_HID), wsp<bf16_t>(P, WS_WDN), T, DM, FF}; pg8::StaticOrder So; So.init(T, DM, gridDim.x, blockIdx.x);
            pg8::EpiBf16<0> E{wsp<bf16_t>(P, WS_Y), DM, nullptr, 0, 0}; pg8::gemm_phase<pg8::EpiBf16<0>, pg8::StaticOrder, false>((LAS unsigned char*)lds, g, So, E, nullptr); } xcd_barrier(bar);
#endif
        if (IN(pb + 12)) { if (layer + 1 < DEPTH) phase_norm<true, true, 2>(wsp<bf16_t>(P, WS_XB), wsp<bf16_t>(P, WS_XB), wsp<bf16_t>(P, WS_Y), P.in[15] + (size_t)layer * DM, P.in[12] + (size_t)(layer + 1) * DM, wsp<bf16_t>(P, WS_H));
            else phase_norm<true, false>(wsp<bf16_t>(P, WS_XB), P.out, wsp<bf16_t>(P, WS_Y), P.in[15] + (size_t)layer * DM, nullptr, nullptr); }
        SEAM(pb + 12);
#if MK_DUP_PH == 120
        for (int i = 0; i < 10; ++i) xcd_barrier(bar);
#endif
    }
#undef IN
#undef SEAM
}
}

#ifndef MK_ONE_LAUNCH
#define MK_ONE_LAUNCH 1
#endif
extern "C" void kernel_launch(void* const* d_in, const int* in_sizes, int n_in, void* d_out, int out_size, void* d_ws, size_t ws_size, hipStream_t stream) {
    static int grid = 0;
    if (grid == 0) {
        if (n_in != 16 || out_size != mk::T * mk::DM || ws_size < mk::WS_END) { fprintf(stderr, "kernel_launch: unexpected shapes (n_in %d, out %d, ws %zu < %zu)\n", n_in, out_size, ws_size, (size_t)mk::WS_END); grid = -1; return; }
        int dev = 0, cus = 0, per_cu = 0;
        if (hipGetDevice(&dev) != hipSuccess || hipDeviceGetAttribute(&cus, hipDeviceAttributeMultiprocessorCount, dev) != hipSuccess) { grid = -1; return; }
        if (hipFuncSetAttribute((const void*)mk::fwd, hipFuncAttributeMaxDynamicSharedMemorySize, mk::LDS_BYTES) != hipSuccess) { fprintf(stderr, "kernel_launch: hipFuncSetAttribute failed\n"); grid = -1; return; }
        if (hipOccupancyMaxActiveBlocksPerMultiprocessor(&per_cu, (const void*)mk::fwd, 512, mk::LDS_BYTES) != hipSuccess || per_cu < 1) { fprintf(stderr, "kernel_launch: occupancy query says %d blocks per CU\n", per_cu); }
        (void)hipGetLastError();
        grid = cus;
    }
    if (grid < 0) return;
    (void)in_sizes;
    hipMemsetAsync((char*)d_ws + mk::WS_CTL, 0, mk::CTL_BYTES, stream);
    mk::Args a{};
    for (int i = 0; i < 16; ++i) a.in[i] = (const float*)d_in[i];
    a.out = (float*)d_out; a.ws = (unsigned char*)d_ws;
#if MK_ONE_LAUNCH
    a.ph_lo = 0; a.ph_hi = mk::NPHASES;
    hipLaunchKernelGGL(mk::fwd, dim3(grid), dim3(512), mk::LDS_BYTES, stream, a);
#else
    for (int ph = 0; ph < mk::NPHASES; ++ph) { a.ph_lo = ph; a.ph_hi = ph + 1; hipLaunchKernelGGL(mk::fwd, dim3(grid), dim3(512), mk::LDS_BYTES, stream, a); }
#endif
}
```

```cpp
#include <hip/hip_runtime.h>
#include <cstdio>
#include <cstdint>
namespace pg8 {
#define PG8_LAS __attribute__((address_space(3)))
typedef unsigned short bf16_t;
typedef short bf16x8 __attribute__((ext_vector_type(8)));
typedef float f32x4 __attribute__((ext_vector_type(4)));
typedef unsigned u32x4 __attribute__((ext_vector_type(4)));
typedef int i32x4 __attribute__((ext_vector_type(4)));
typedef int i32x8 __attribute__((ext_vector_type(8)));
constexpr int BM = 256, BK = 64, HALF = 128, HTB = HALF * BK * 2  , STAGE_BYTES = 8 * HTB, NXCD = 8, WGM = 4;

__host__ __device__ __forceinline__ int lds_byte(int r, int c) { const int st = (r >> 4) * 2 + (c >> 5), rr = r & 15, cc = c & 31, ob = rr * 64 + cc * 2; return st * 1024 + (ob ^ (((ob >> 9) & 1) << 5)); }
__host__ __device__ __forceinline__ void stage_rc(int b, int& R, int& C) { const int st = b / 1024, sb = b % 1024, swz = sb ^ (((sb >> 9) & 1) << 5); R = (st >> 1) * 16 + swz / 64; C = (st & 1) * 32 + (swz % 64) / 2; }
__host__ __device__ __forceinline__ int perm32(int rho) { const int n = rho >> 4, i = rho & 15; return 8 * (i >> 2) + 4 * n + (i & 3); }

struct Unit { int pm, pn; };
struct Gemm { const bf16_t* A; const bf16_t* Bt; int M, N, K; int lda; };

struct StaticOrder {
    int nM, nN, nwg, G, c;
    __host__ __device__ void init(int M, int N, int G_, int c_) { nM = M / BM; nN = N / BM; nwg = nM * nN; G = G_; c = c_; }
    __host__ __device__ bool next(int i, Unit& u) const {
        const long L = (long)i * G + c; if (L >= nwg) return false;
        int wgid = (int)L; { const int q = nwg / NXCD, r = nwg % NXCD, xcd = wgid % NXCD, off = wgid / NXCD; wgid = (xcd < r ? xcd * (q + 1) : r * (q + 1) + (xcd - r) * q) + off; }
        const int nig = WGM * nN, gid = wgid / nig, fm = gid * WGM, gsz = (nM - fm) < WGM ? (nM - fm) : WGM;
        u.pm = fm + ((wgid % nig) % gsz); u.pn = (wgid % nig) / gsz; return true;
    }
    __device__ __forceinline__ void a_ready(const Unit&) const {}
    __device__ __forceinline__ void done(const Unit&) const {}
};
struct CountedOrder : StaticOrder {
    const unsigned* ready; unsigned need; unsigned* tmo;
    __device__ __forceinline__ void a_ready(const Unit& u) const {
        if (threadIdx.x < 64) {
            const unsigned long long t0 = __builtin_amdgcn_s_memrealtime(); unsigned polls = 0;
            while ((unsigned)__builtin_amdgcn_readfirstlane(__hip_atomic_load(ready + 64 * u.pm, __ATOMIC_RELAXED, __HIP_MEMORY_SCOPE_AGENT)) < need) {
                if ((++polls & 255u) == 0u && __builtin_amdgcn_readfirstlane(__hip_atomic_load(tmo, __ATOMIC_RELAXED, __HIP_MEMORY_SCOPE_AGENT)) != 0u) break;
                if (__builtin_amdgcn_s_memrealtime() - t0 > 2000000ull) {
                    if (threadIdx.x == 0) { unsigned expect = 0u; __hip_atomic_compare_exchange_strong(tmo + 1, &expect, 0x600u | (unsigned)(u.pm & 0xff), __ATOMIC_RELAXED, __ATOMIC_RELAXED, __HIP_MEMORY_SCOPE_AGENT); __hip_atomic_store(tmo, 1u, __ATOMIC_RELAXED, __HIP_MEMORY_SCOPE_AGENT); }
                    break; }
                __builtin_amdgcn_s_sleep(2); }
            __builtin_amdgcn_fence(__ATOMIC_ACQUIRE, "agent");
            asm volatile("s_waitcnt vmcnt(0)" ::: "memory");
        }
#if !defined(BROKEN_HOOK_NO_BARRIER)
        asm volatile("" ::: "memory"); __builtin_amdgcn_s_barrier(); asm volatile("" ::: "memory");
#endif
    }
};

__device__ __forceinline__ unsigned cvt_pk_bf16(float lo, float hi) { unsigned r; asm volatile("v_cvt_pk_bf16_f32 %0, %1, %2" : "=v"(r) : "v"(lo), "v"(hi)); return r; }
typedef float f32x2 __attribute__((ext_vector_type(2)));
__device__ __forceinline__ f32x2 gelu_pk(f32x2 v) {
    const f32x2 av = __builtin_elementwise_abs(v), d = av * 0.2316418882f + 1.0f;
    f32x2 t; t.x = __builtin_amdgcn_rcpf(d.x); t.y = __builtin_amdgcn_rcpf(d.y);
    f32x2 q = t * 0.5307027145f + (-0.7265760135f); q = q * t + 0.7107068705f; q = q * t + (-0.142248368f); q = q * t + 0.127414796f; q = q * t;
    const f32x2 s = (v * v) * (-0.72134752044f);
    f32x2 e; e.x = __builtin_amdgcn_exp2f(s.x); e.y = __builtin_amdgcn_exp2f(s.y);
    const f32x2 m = v * (q * e), r = v - m;
    f32x2 o; o.x = v.x < 0.f ? m.x : r.x; o.y = v.y < 0.f ? m.y : r.y; return o;
}

struct EpiF32 {
    static constexpr bool PERM = false, AFTER_DRAIN = false;
    float* C; int ldc; const float* bias;
    __device__ __forceinline__ void operator()(const f32x4 (&acc)[2][2][4][2], const Unit& u, int wr, int wc, int fr, int fq) const {
        const int row0 = u.pm * BM + wr * 64 + fr, col0 = u.pn * BM + wc * 32 + 4 * fq;
        f32x4 bv[2][2];
#pragma unroll
        for (int bj = 0; bj < 2; ++bj)
#pragma unroll
            for (int n = 0; n < 2; ++n) bv[bj][n] = bias ? *(const f32x4*)(bias + col0 + bj * HALF + n * 16) : (f32x4){0.f, 0.f, 0.f, 0.f};
#pragma unroll
        for (int ai = 0; ai < 2; ++ai)
#pragma unroll
            for (int m = 0; m < 4; ++m) { float* rowp = C + (size_t)(row0 + ai * HALF + m * 16) * ldc + col0;
#pragma unroll
                for (int bj = 0; bj < 2; ++bj)
#pragma unroll
                    for (int n = 0; n < 2; ++n) *(f32x4*)(rowp + bj * HALF + n * 16) = acc[ai][bj][m][n] + bv[bj][n]; }
    }
};
template <int ACT  > struct EpiBf16 {
    static constexpr bool PERM = true, AFTER_DRAIN = false;
    bf16_t* O; int ldc; const float* bias; int split_cols; size_t split_stride;
    __device__ __forceinline__ void operator()(const f32x4 (&acc)[2][2][4][2], const Unit& u, int wr, int wc, int fr, int fq) const {
        const int row0 = u.pm * BM + wr * 64 + fr; int colt = u.pn * BM; bf16_t* base = O;
        if (split_cols) { const int t = colt / split_cols; base += (size_t)t * split_stride; colt -= t * split_cols; }
        const int col0 = colt + wc * 32 + 8 * fq, bcol0 = u.pn * BM + wc * 32 + 8 * fq;
        f32x4 bv[2][2];
#pragma unroll
        for (int bj = 0; bj < 2; ++bj)
#pragma unroll
            for (int n = 0; n < 2; ++n) bv[bj][n] = bias ? *(const f32x4*)(bias + bcol0 + bj * HALF + 4 * n) : (f32x4){0.f, 0.f, 0.f, 0.f};
#pragma unroll
        for (int ai = 0; ai < 2; ++ai)
#pragma unroll
            for (int m = 0; m < 4; ++m) { bf16_t* rowp = base + (size_t)(row0 + ai * HALF + m * 16) * ldc + col0;
#pragma unroll
                for (int bj = 0; bj < 2; ++bj) { f32x4 v0 = acc[ai][bj][m][0] + bv[bj][0], v1 = acc[ai][bj][m][1] + bv[bj][1];
                    if (ACT == 1) { f32x2 a = gelu_pk((f32x2){v0[0], v0[1]}), b = gelu_pk((f32x2){v0[2], v0[3]}), c = gelu_pk((f32x2){v1[0], v1[1]}), d = gelu_pk((f32x2){v1[2], v1[3]});
                        v0 = (f32x4){a.x, a.y, b.x, b.y}; v1 = (f32x4){c.x, c.y, d.x, d.y}; }
                    if (ACT == 2) {
#pragma unroll
                        for (int j = 0; j < 4; ++j) { v0[j] = 0.5f * v0[j] * (1.0f + erff(v0[j] * 0.70710678f)); v1[j] = 0.5f * v1[j] * (1.0f + erff(v1[j] * 0.70710678f)); } }
                    u32x4 w; w.x = cvt_pk_bf16(v0[0], v0[1]); w.y = cvt_pk_bf16(v0[2], v0[3]); w.z = cvt_pk_bf16(v1[0], v1[1]); w.w = cvt_pk_bf16(v1[2], v1[3]);
                    *(u32x4*)(rowp + bj * HALF) = w; } }
    }
};

struct PanelStats {
    unsigned* xbuf;
    unsigned* cnt;
    unsigned* tmo;
    int ntn; float eps;
    unsigned code;
    __device__ __forceinline__ bool run(const f32x4 (&v)[2][2][4][2], const Unit& u, int wr, int wc, int fr, int fq, PG8_LAS unsigned char* lds, int wid, int lane) const {
        typedef float f32x2v __attribute__((ext_vector_type(2)));
        PG8_LAS f32x2v* P = (PG8_LAS f32x2v*)lds;
        PG8_LAS f32x2v* S = (PG8_LAS f32x2v*)(lds + 8192);
        PG8_LAS unsigned* flag = (PG8_LAS unsigned*)(lds + 8192 + 2048);
#pragma unroll
        for (int ai = 0; ai < 2; ++ai)
#pragma unroll
            for (int m = 0; m < 4; ++m) {
                float s = 0.f;
#pragma unroll
                for (int bj = 0; bj < 2; ++bj)
#pragma unroll
                    for (int n = 0; n < 2; ++n) { const f32x4 x = v[ai][bj][m][n]; s += (x[0] + x[1]) + (x[2] + x[3]); }
                s += __shfl_xor(s, 16); s += __shfl_xor(s, 32);
                const float mw = s * (1.0f / 64.0f); float q = 0.f;
#pragma unroll
                for (int bj = 0; bj < 2; ++bj)
#pragma unroll
                    for (int n = 0; n < 2; ++n) { const f32x4 d = v[ai][bj][m][n] - mw; q += (d[0] * d[0] + d[1] * d[1]) + (d[2] * d[2] + d[3] * d[3]); }
                q += __shfl_xor(q, 16); q += __shfl_xor(q, 32);
                if (fq == 0) P[(ai * HALF + wr * 64 + m * 16 + fr) * 4 + wc] = (f32x2v){mw, q};
            }
        asm volatile("s_waitcnt lgkmcnt(0)" ::: "memory"); __builtin_amdgcn_s_barrier(); asm volatile("" ::: "memory");
#if defined(BROKEN_NO_WAIT)
        if (blockIdx.x >= 64) { const long long t0 = clock64(); while (clock64() - t0 < 60000) __builtin_amdgcn_s_sleep(8); }
#endif
        const int row = wid * 32 + (lane & 31);
        if (lane < 32) {
            const f32x2v a = P[row * 4 + 0], b = P[row * 4 + 1], c = P[row * 4 + 2], d = P[row * 4 + 3];
            const float mt = (a.x + b.x + c.x + d.x) * 0.25f;
            const float da = a.x - mt, db = b.x - mt, dc = c.x - mt, dd = d.x - mt;
            const float m2 = (a.y + b.y) + (c.y + d.y) + 64.0f * ((da * da + db * db) + (dc * dc + dd * dd));
            unsigned long long* slot = (unsigned long long*)xbuf + ((size_t)(u.pm * BM + row) * 4 + u.pn);
            __hip_atomic_store(slot, ((unsigned long long)__float_as_uint(m2) << 32) | __float_as_uint(mt), __ATOMIC_RELAXED, __HIP_MEMORY_SCOPE_AGENT);
        }
        asm volatile("s_waitcnt vmcnt(0)" ::: "memory");
        if (lane == 0) __hip_atomic_fetch_add(cnt + 64 * u.pm, 1u, __ATOMIC_RELAXED, __HIP_MEMORY_SCOPE_AGENT);
        if (wid == 0) {
            bool dead = false; const unsigned long long t0 = __builtin_amdgcn_s_memrealtime(); const unsigned want = 8u * (unsigned)ntn;
            for (;;) {
#if defined(BROKEN_NO_WAIT)
                break;
#endif
                if ((unsigned)__builtin_amdgcn_readfirstlane(__hip_atomic_load(cnt + 64 * u.pm, __ATOMIC_RELAXED, __HIP_MEMORY_SCOPE_AGENT)) >= want) break;
                if (__builtin_amdgcn_s_memrealtime() - t0 > 2000000ull) {
                    if (lane == 0) { unsigned expect = 0u; __hip_atomic_compare_exchange_strong(tmo + 1, &expect, code | (unsigned)(u.pm & 0xff), __ATOMIC_RELAXED, __ATOMIC_RELAXED, __HIP_MEMORY_SCOPE_AGENT);
                                     __hip_atomic_store(tmo, 1u, __ATOMIC_RELAXED, __HIP_MEMORY_SCOPE_AGENT); }
                    dead = true; break; }
                __builtin_amdgcn_s_sleep(2);
            }
            __builtin_amdgcn_fence(__ATOMIC_ACQUIRE, "agent");
            if (lane == 0) flag[0] = dead ? 1u : 0u;
        }
        asm volatile("s_waitcnt vmcnt(0) lgkmcnt(0)" ::: "memory"); __builtin_amdgcn_s_barrier(); asm volatile("" ::: "memory");
        const bool bad = flag[0] != 0u;
        if (lane < 32) {
            const unsigned long long* slot = (const unsigned long long*)xbuf + (size_t)(u.pm * BM + row) * 4; float mt[4], m2[4]; float ms = 0.f;
#pragma unroll
            for (int t = 0; t < 4; ++t) { if (t < ntn) { const unsigned long long w = __hip_atomic_load(slot + t, __ATOMIC_RELAXED, __HIP_MEMORY_SCOPE_AGENT); mt[t] = __uint_as_float((unsigned)w); m2[t] = __uint_as_float((unsigned)(w >> 32)); } else { mt[t] = 0.f; m2[t] = 0.f; } ms += mt[t]; }
            const float mean = ms / (float)ntn; float q = 0.f;
#pragma unroll
            for (int t = 0; t < 4; ++t) if (t < ntn) { const float dm = mt[t] - mean; q += m2[t] + 256.0f * dm * dm; }
            S[row] = (f32x2v){mean, 1.0f / sqrtf(q / (256.0f * (float)ntn) + eps)};
        }
        asm volatile("s_waitcnt lgkmcnt(0)" ::: "memory"); __builtin_amdgcn_s_barrier(); asm volatile("" ::: "memory");
        return bad;
    }
};
struct EpiLnRes {
    static constexpr bool PERM = false, AFTER_DRAIN = true;
    const float* base; float* out; int ldc; const float* bias; PanelStats st; unsigned poison;
    __device__ __forceinline__ void refuse(size_t i0, size_t stride, int M, int N) const { const float q = __builtin_nanf(""); for (size_t i = i0; i < (size_t)M * N; i += stride) out[(i / N) * ldc + i % N] = q;
        if (i0 == 0) { unsigned expect = 0u; __hip_atomic_compare_exchange_strong(st.tmo + 1, &expect, 0x7f0u, __ATOMIC_RELAXED, __ATOMIC_RELAXED, __HIP_MEMORY_SCOPE_AGENT); __hip_atomic_store(st.tmo, 1u, __ATOMIC_RELAXED, __HIP_MEMORY_SCOPE_AGENT); } }
    __device__ __forceinline__ void fused(f32x4 (&acc)[2][2][4][2], const Unit& u, int wr, int wc, int fr, int fq, PG8_LAS unsigned char* lds, int wid, int lane) const {
        typedef float f32x2v __attribute__((ext_vector_type(2)));
        const PG8_LAS f32x2v* S = (const PG8_LAS f32x2v*)(lds + 8192);
        const int col0 = u.pn * BM + wc * 32 + 4 * fq;
#pragma unroll
        for (int bj = 0; bj < 2; ++bj)
#pragma unroll
            for (int n = 0; n < 2; ++n) { const f32x4 bv = bias ? *(const f32x4*)(bias + col0 + bj * HALF + n * 16) : (f32x4){0.f, 0.f, 0.f, 0.f};
#pragma unroll
                for (int ai = 0; ai < 2; ++ai)
#pragma unroll
                    for (int m = 0; m < 4; ++m) acc[ai][bj][m][n] += bv; }
        const bool bad = st.run(acc, u, wr, wc, fr, fq, lds, wid, lane) || poison != 0u;
        const float qnan = __builtin_nanf("");
#pragma unroll
        for (int ai = 0; ai < 2; ++ai)
#pragma unroll
            for (int m = 0; m < 4; ++m) { const int r = ai * HALF + wr * 64 + m * 16 + fr; const f32x2v sr = S[r]; const size_t off = (size_t)(u.pm * BM + r) * ldc + col0;
#pragma unroll
                for (int bj = 0; bj < 2; ++bj)
#pragma unroll
                    for (int n = 0; n < 2; ++n) { const f32x4 bs = *(const f32x4*)(base + off + bj * HALF + n * 16); f32x4 o = bs + (acc[ai][bj][m][n] - sr.x) * sr.y;
                        if (bad) o = (f32x4){qnan, qnan, qnan, qnan}; *(f32x4*)(out + off + bj * HALF + n * 16) = o; }
                asm volatile("" ::: "memory"); }
    }
};
struct EpiLnResLn {
    static constexpr bool PERM = false, AFTER_DRAIN = true;
    const float* base; float* out; bf16_t* xn; int ldc; const float* bias; PanelStats st1, st2; unsigned poison;
    __device__ __forceinline__ void refuse(size_t i0, size_t stride, int M, int N) const { const float q = __builtin_nanf(""); for (size_t i = i0; i < (size_t)M * N; i += stride) { const size_t o = (i / N) * ldc + i % N; out[o] = q; xn[o] = (bf16_t)0x7fc0u; }
        if (i0 == 0) { unsigned expect = 0u; __hip_atomic_compare_exchange_strong(st1.tmo + 1, &expect, 0x7f0u, __ATOMIC_RELAXED, __ATOMIC_RELAXED, __HIP_MEMORY_SCOPE_AGENT); __hip_atomic_store(st1.tmo, 1u, __ATOMIC_RELAXED, __HIP_MEMORY_SCOPE_AGENT); } }
    __device__ __forceinline__ void fused(f32x4 (&acc)[2][2][4][2], const Unit& u, int wr, int wc, int fr, int fq, PG8_LAS unsigned char* lds, int wid, int lane) const {
        typedef float f32x2v __attribute__((ext_vector_type(2))); typedef unsigned u32x2v __attribute__((ext_vector_type(2)));
        const PG8_LAS f32x2v* S = (const PG8_LAS f32x2v*)(lds + 8192);
        const int col0 = u.pn * BM + wc * 32 + 4 * fq;
#pragma unroll
        for (int bj = 0; bj < 2; ++bj)
#pragma unroll
            for (int n = 0; n < 2; ++n) { const f32x4 bv = bias ? *(const f32x4*)(bias + col0 + bj * HALF + n * 16) : (f32x4){0.f, 0.f, 0.f, 0.f};
#pragma unroll
                for (int ai = 0; ai < 2; ++ai)
#pragma unroll
                    for (int m = 0; m < 4; ++m) acc[ai][bj][m][n] += bv; }
        bool bad = st1.run(acc, u, wr, wc, fr, fq, lds, wid, lane) || poison != 0u;
        const float qnan = __builtin_nanf("");
#pragma unroll
        for (int ai = 0; ai < 2; ++ai)
#pragma unroll
            for (int m = 0; m < 4; ++m) { const int r = ai * HALF + wr * 64 + m * 16 + fr; const f32x2v sr = S[r]; const size_t off = (size_t)(u.pm * BM + r) * ldc + col0;
#pragma unroll
                for (int bj = 0; bj < 2; ++bj)
#pragma unroll
                    for (int n = 0; n < 2; ++n) { const f32x4 bs = *(const f32x4*)(base + off + bj * HALF + n * 16); acc[ai][bj][m][n] = bs + (acc[ai][bj][m][n] - sr.x) * sr.y; }
                asm volatile("" : "+v"(acc[ai][0][m][0]), "+v"(acc[ai][0][m][1]), "+v"(acc[ai][1][m][0]), "+v"(acc[ai][1][m][1]));
                if (m & 1) asm volatile("" ::: "memory"); }
        const bool bad1 = bad;
        bad = st2.run(acc, u, wr, wc, fr, fq, lds, wid, lane) || bad;
#pragma unroll
        for (int ai = 0; ai < 2; ++ai)
#pragma unroll
            for (int m = 0; m < 4; ++m) { const int r = ai * HALF + wr * 64 + m * 16 + fr; const f32x2v sr = S[r]; const size_t off = (size_t)(u.pm * BM + r) * ldc + col0;
#pragma unroll
                for (int bj = 0; bj < 2; ++bj)
#pragma unroll
                    for (int n = 0; n < 2; ++n) { const f32x4 x1 = acc[ai][bj][m][n]; *(f32x4*)(out + off + bj * HALF + n * 16) = bad1 ? (f32x4){qnan, qnan, qnan, qnan} : x1;
                        const f32x4 o = (x1 - sr.x) * sr.y; u32x2v w; w.x = cvt_pk_bf16(o[0], o[1]); w.y = cvt_pk_bf16(o[2], o[3]);
                        if (bad) { w.x = 0x7fc07fc0u; w.y = 0x7fc07fc0u; } *(u32x2v*)(xn + off + bj * HALF + n * 16) = w; }
                asm volatile("" ::: "memory"); }
    }
};

template <class E, class = void> struct is_staged { static constexpr bool value = false; };
template <class E> struct is_staged<E, decltype((void)E::STAGED)> { static constexpr bool value = true; };
template <class Epi, class Sched, bool STAMP = false, int F8 = 0  >
__device__ __forceinline__ void gemm_phase(PG8_LAS unsigned char* lds, const Gemm g, const Sched& S, const Epi& E, unsigned long long* stamps) {
    int tid_o = threadIdx.x; asm volatile("" : "+v"(tid_o)); const int tid = tid_o, wid = __builtin_amdgcn_readfirstlane(tid >> 6), lane = tid & 63, wr = wid >> 2, wc = wid & 3, fr = lane & 15, fq = lane >> 4;
    const int K = g.K, nt = K / BK, LDA = g.lda ? g.lda : g.K;
    int ts_lo = 0, ts_hi = 0, nts = 0; const unsigned long long rt_entry = STAMP ? (unsigned long long)wall_clock64() : 0ull;
#define PG8_STAMP() do { if (STAMP && wid == 0 && nts < 64) { const unsigned long long _c = (unsigned long long)clock64(); \
        ts_lo = (lane == nts) ? (int)(unsigned)_c : ts_lo; ts_hi = (lane == nts) ? (int)(unsigned)(_c >> 32) : ts_hi; ++nts; } } while (0)
    PG8_STAMP();
    unsigned voffA[2], voffB[2];
#pragma unroll
    for (int i = 0; i < 2; ++i) { int R, C; stage_rc(tid * 16 + i * 8192, R, C); const int Rb = Epi::PERM ? ((R & ~31) + perm32(R & 31)) : R;
        voffA[i] = (unsigned)(R * LDA + C) * 2u; voffB[i] = (unsigned)(Rb * K + C) * 2u; }
    const size_t kstep = (size_t)(BK * 2);
    const size_t hstep = (size_t)HALF * K * 2;
    const size_t tstep = 2 * hstep;
    const size_t hstepA = (size_t)HALF * LDA * 2, tstepA = 2 * hstepA;
    const unsigned ldsw = (unsigned)wid * 1024u;
    const int aoff = lds_byte(wr * 64 + fr, fq * 8), boff = lds_byte(wc * 32 + fr, fq * 8);
#define PG8_SA(b, h) (((b) * 2 + (h)) * HTB)
#define PG8_SB(b, h) ((4 + (b) * 2 + (h)) * HTB)
#define PG8_STAGE(bufoff, gbase, voff) do { _Pragma("unroll") for (int _i = 0; _i < 2; ++_i) \
        __builtin_amdgcn_global_load_lds((const unsigned*)((const char*)(gbase) + (voff)[_i]), (PG8_LAS unsigned*)(lds + (bufoff) + ldsw + _i * 8192), 16, 0, 0); } while (0)
#define PG8_LDA(dst, b, h) do { _Pragma("unroll") for (int m = 0; m < 4; ++m) _Pragma("unroll") for (int k = 0; k < 2; ++k) dst[m][k] = *(const PG8_LAS bf16x8*)(lds + PG8_SA(b, h) + aoff + m * 2048 + k * 1024); } while (0)
#define PG8_LDB(dst, b, h) do { _Pragma("unroll") for (int n = 0; n < 2; ++n) _Pragma("unroll") for (int k = 0; k < 2; ++k) dst[n][k] = *(const PG8_LAS bf16x8*)(lds + PG8_SB(b, h) + boff + n * 2048 + k * 1024); } while (0)
#define PG8_CAT(x, y) __builtin_shufflevector(__builtin_bit_cast(i32x4, (x)), __builtin_bit_cast(i32x4, (y)), 0, 1, 2, 3, 4, 5, 6, 7)
#define PG8_MMA(ai, bj, At, Bt) do { __builtin_amdgcn_s_setprio(1); _Pragma("unroll") for (int m = 0; m < 4; ++m) _Pragma("unroll") for (int n = 0; n < 2; ++n) { \
        if constexpr (F8 == 2) { _Pragma("unroll") for (int k = 0; k < 2; ++k) acc[ai][bj][m][n] = __builtin_bit_cast(f32x4, __builtin_amdgcn_mfma_i32_16x16x64_i8(__builtin_bit_cast(i32x4, Bt[n][k]), __builtin_bit_cast(i32x4, At[m][k]), __builtin_bit_cast(i32x4, acc[ai][bj][m][n]), 0, 0, 0)); } \
        else if constexpr (F8 == 1) { const i32x8 _a = PG8_CAT(Bt[n][0], Bt[n][1]), _b = PG8_CAT(At[m][0], At[m][1]); asm volatile("v_mfma_f32_16x16x128_f8f6f4 %0, %1, %2, %0" : "+v"(acc[ai][bj][m][n]) : "v"(_a), "v"(_b)); } \
        else { _Pragma("unroll") for (int k = 0; k < 2; ++k) acc[ai][bj][m][n] = __builtin_amdgcn_mfma_f32_16x16x32_bf16(Bt[n][k], At[m][k], acc[ai][bj][m][n], 0, 0, 0); } } \
        __builtin_amdgcn_s_setprio(0); } while (0)
#define PG8_WAIT_V(n) asm volatile("s_waitcnt vmcnt(" #n ")" ::: "memory")
#define PG8_WAIT_L(n) asm volatile("s_waitcnt lgkmcnt(" #n ")" ::: "memory")
#define PG8_BAR __builtin_amdgcn_s_barrier()
#define PG8_SCHED __builtin_amdgcn_sched_barrier(0)
    Unit cur, nxt; int ui = 0;
    if (!S.next(0, cur)) return;
    f32x4 acc[2][2][4][2];
#pragma unroll
    for (int a = 0; a < 2; ++a)
#pragma unroll
        for (int b = 0; b < 2; ++b)
#pragma unroll
            for (int m = 0; m < 4; ++m)
#pragma unroll
                for (int n = 0; n < 2; ++n) acc[a][b][m][n] = (f32x4){0.f, 0.f, 0.f, 0.f};
    bf16x8 At[4][2], B0[2][2], B1[2][2];
    const char* cA = (const char*)g.A + (size_t)cur.pm * tstepA; const char* cB = (const char*)g.Bt + (size_t)cur.pn * tstep;
    S.a_ready(cur);
    PG8_STAGE(PG8_SB(0, 0), cB, voffB); PG8_STAGE(PG8_SA(0, 0), cA, voffA); PG8_STAGE(PG8_SB(0, 1), cB + hstep, voffB); PG8_STAGE(PG8_SA(0, 1), cA + hstepA, voffA);
    if (wr == 1) PG8_BAR;
    PG8_WAIT_V(4); PG8_BAR;
    PG8_STAGE(PG8_SB(1, 0), cB + kstep, voffB); PG8_STAGE(PG8_SA(1, 0), cA + kstep, voffA); PG8_STAGE(PG8_SB(1, 1), cB + hstep + kstep, voffB);
    PG8_WAIT_V(6); PG8_BAR;
    PG8_STAMP();
    for (;;) {
        const bool has_next = S.next(ui + 1, nxt);
        const char* nA = has_next ? (const char*)g.A + (size_t)nxt.pm * tstepA : cA; const char* nB = has_next ? (const char*)g.Bt + (size_t)nxt.pn * tstep : cB;
        for (int t = 0; t < nt; t += 2) {
            const bool last = (t == nt - 2);
            const char* a1 = cA + (size_t)(t + 1) * kstep;
            const char* a2 = last ? nA : cA + (size_t)(t + 2) * kstep; const char* b2 = last ? nB : cB + (size_t)(t + 2) * kstep;
            const char* a3 = a2 + kstep; const char* b3 = b2 + kstep;
            if (last && has_next) S.a_ready(nxt);
            PG8_LDB(B0, 0, 0); PG8_SCHED; PG8_LDA(At, 0, 0); PG8_STAGE(PG8_SA(1, 1), a1 + hstepA, voffA);
            PG8_WAIT_L(8); PG8_BAR; PG8_WAIT_L(0); PG8_MMA(0, 0, At, B0); PG8_BAR; PG8_SCHED;
            PG8_LDB(B1, 0, 1); PG8_STAGE(PG8_SB(0, 0), b2, voffB);
            PG8_BAR; PG8_WAIT_L(0); PG8_MMA(0, 1, At, B1); PG8_BAR;
            PG8_LDA(At, 0, 1); PG8_STAGE(PG8_SA(0, 0), a2, voffA);
            PG8_BAR; PG8_WAIT_L(0); PG8_MMA(1, 0, At, B0); PG8_BAR; PG8_SCHED;
            PG8_STAGE(PG8_SB(0, 1), b2 + hstep, voffB);
            PG8_WAIT_V(6); PG8_BAR; PG8_MMA(1, 1, At, B1); PG8_BAR;
            PG8_LDB(B0, 1, 0); PG8_SCHED; PG8_LDA(At, 1, 0); PG8_STAGE(PG8_SA(0, 1), a2 + hstepA, voffA);
            PG8_WAIT_L(8); PG8_BAR; PG8_WAIT_L(0); PG8_MMA(0, 0, At, B0); PG8_BAR; PG8_SCHED;
            PG8_LDB(B1, 1, 1); PG8_STAGE(PG8_SB(1, 0), b3, voffB);
            PG8_BAR; PG8_WAIT_L(0); PG8_MMA(0, 1, At, B1); PG8_BAR;
            PG8_LDA(At, 1, 1); PG8_STAGE(PG8_SA(1, 0), a3, voffA);
            PG8_BAR; PG8_WAIT_L(0); PG8_MMA(1, 0, At, B0); PG8_BAR; PG8_SCHED;
            PG8_STAGE(PG8_SB(1, 1), b3 + hstep, voffB);
            PG8_WAIT_V(6); PG8_BAR; PG8_MMA(1, 1, At, B1); PG8_BAR;
        }
        PG8_STAMP();
        if constexpr (F8 == 1) asm volatile("s_nop 15\n\ts_nop 15" ::: "memory");
        if constexpr (Epi::AFTER_DRAIN) {}
        else if constexpr (is_staged<Epi>::value) {
            if (wr == 0) PG8_BAR;
            E.staged(acc, cur, wr, wc, fr, fq, lds + STAGE_BYTES + 256, wid, lane);
            if (wr == 1) PG8_BAR;
            S.done(cur); }
        else if constexpr (!Epi::AFTER_DRAIN) { E(acc, cur, wr, wc, fr, fq); S.done(cur); }
        PG8_STAMP();
        if (!has_next) break;
#pragma unroll
        for (int a = 0; a < 2; ++a)
#pragma unroll
            for (int b = 0; b < 2; ++b)
#pragma unroll
                for (int m = 0; m < 4; ++m)
#pragma unroll
                    for (int n = 0; n < 2; ++n) acc[a][b][m][n] = (f32x4){0.f, 0.f, 0.f, 0.f};
        cur = nxt; cA = nA; cB = nB; ++ui;
    }
    PG8_WAIT_V(0);
    if (wr == 0) PG8_BAR;
    PG8_BAR;
    if constexpr (Epi::AFTER_DRAIN) { E.fused(acc, cur, wr, wc, fr, fq, lds, wid, lane); S.done(cur); }
    PG8_STAMP();
    if (STAMP && wid == 0) { stamps[lane] = lane < nts ? (((unsigned long long)(unsigned)ts_hi << 32) | (unsigned)ts_lo) : 0ull;
        if (lane == 62) stamps[62] = rt_entry; if (lane == 63) stamps[63] = (unsigned long long)wall_clock64(); }
#undef PG8_STAMP
#undef PG8_SA
#undef PG8_SB
#undef PG8_STAGE
#undef PG8_LDA
#undef PG8_LDB
#undef PG8_MMA
#undef PG8_CAT
#undef PG8_WAIT_V
#undef PG8_WAIT_L
#undef PG8_BAR
#undef PG8_SCHED
}
}
#define XB_TMO      128
#define XB_XCNT(j)  (256  + 64 * (j))
#define XB_XSUB(j)  (1280 + 64 * (j))
#define XB_XGEN(j)  (2304 + 64 * (j))
#define XB_TOP      3328
#define XB_TOPGEN   3392
#define XCD_BAR_WORDS 3456
#define XB_SPIN_CAP (1u << 23)
#define LAS __attribute__((address_space(3)))

__device__ __forceinline__ unsigned xb_ld(unsigned* p)              { return __hip_atomic_load(p, __ATOMIC_RELAXED, __HIP_MEMORY_SCOPE_AGENT); }
__device__ __forceinline__ unsigned xb_add(unsigned* p, unsigned v) { return __hip_atomic_fetch_add(p, v, __ATOMIC_RELAXED, __HIP_MEMORY_SCOPE_AGENT); }
__device__ __forceinline__ unsigned xb_xcc_id() { return (unsigned)__builtin_amdgcn_s_getreg((3 << 11) | 20) & 0xFu; }
#define XB_SPIN(cond, bar) do { unsigned _sp = 0; while (cond) { __builtin_amdgcn_s_sleep(1); \
    if ((++_sp & 255u) == 0u) { if (xb_ld(&(bar)[XB_TMO])) break; if (_sp > XB_SPIN_CAP) { atomicAdd(&(bar)[XB_TMO], 1u); break; } } } } while (0)

struct XcdBarrier {
    unsigned* bar; unsigned x;
    volatile LAS unsigned* st;
};

__device__ __forceinline__ XcdBarrier xcd_barrier_post(unsigned* bar, volatile LAS unsigned* st) {
    XcdBarrier b; b.bar = bar; b.x = xb_xcc_id(); b.st = st;
    if (threadIdx.x == 0) (void)xb_add(&bar[XB_XCNT(b.x)], 1u);
    return b;
}
__device__ __forceinline__ void xcd_barrier_complete(unsigned* bar, unsigned x, unsigned& nloc, unsigned& nx) {
    const unsigned G = gridDim.x * gridDim.y * gridDim.z;
    unsigned sum, cnt, mine, sp = 0u;
    for (;;) {
        sum = 0u; cnt = 0u; mine = 0u;
#pragma unroll
        for (unsigned j = 0; j < 16; ++j) { const unsigned c = xb_ld(&bar[XB_XCNT(j)]); sum += c; cnt += (c > 0u) ? 1u : 0u; mine = (j == x) ? c : mine; }
        if (sum == G) break;
        __builtin_amdgcn_s_sleep(1);
        if ((++sp & 255u) == 0u) { if (xb_ld(&bar[XB_TMO])) break; if (sp > XB_SPIN_CAP) { atomicAdd(&bar[XB_TMO], 1u); break; } }
    }
    nloc = mine > 0u ? mine : 1u; nx = cnt > 0u ? cnt : 1u;
}

__device__ __forceinline__ void xcd_barrier(const XcdBarrier& b) {
    asm volatile("s_waitcnt vmcnt(0)" ::: "memory");
    __syncthreads();
    if (threadIdx.x == 0) {
        unsigned* bar = b.bar;
        __builtin_amdgcn_s_waitcnt(0);
        unsigned nloc = b.st[0], nx = b.st[1];
        if (nloc == 0u) { xcd_barrier_complete(bar, b.x, nloc, nx); b.st[0] = nloc; b.st[1] = nx; }
        const unsigned old = xb_add(&bar[XB_XSUB(b.x)], 1u);
        const unsigned gen = old / nloc;
        if (old + 1u == (gen + 1u) * nloc) {
            __builtin_amdgcn_fence(__ATOMIC_RELEASE, "agent");
            asm volatile("s_waitcnt vmcnt(0)" ::: "memory");
            const unsigned og = xb_add(&bar[XB_TOP], 1u);
            const unsigned tg = og / nx;
            if (og + 1u == (tg + 1u) * nx) xb_add(&bar[XB_TOPGEN], 1u);
            else XB_SPIN(xb_ld(&bar[XB_TOPGEN]) == tg, bar);
            __builtin_amdgcn_fence(__ATOMIC_ACQUIRE, "agent");
            xb_add(&bar[XB_XGEN(b.x)], 1u);
            asm volatile("s_waitcnt vmcnt(0)" ::: "memory");
        } else {
            XB_SPIN(xb_ld(&bar[XB_XGEN(b.x)]) == gen, bar);
            __builtin_amdgcn_fence(__ATOMIC_ACQUIRE, "agent");
            asm volatile("s_waitcnt vmcnt(0)" ::: "memory");
        }
    }
    __syncthreads();
}

namespace fa {
typedef unsigned short bf16;
typedef short bf16x8 __attribute__((ext_vector_type(8)));
typedef short s16x4 __attribute__((ext_vector_type(4)));
typedef float f32x16 __attribute__((ext_vector_type(16)));
typedef float f32x4 __attribute__((ext_vector_type(4)));
typedef unsigned u32x4 __attribute__((ext_vector_type(4)));
typedef unsigned u32x2 __attribute__((ext_vector_type(2)));
constexpr int D = 128, SEQ = 2048;
constexpr float SCALE = 0.08838834764831845f, THR = 8.f;
constexpr int NW = 8, QBLK = 32, KVBLK = 64, QB = NW * QBLK;
constexpr int SHM_V = KVBLK * D * 2, SHM_K = KVBLK * D * 2;
constexpr int LDS_BYTES = 2 * SHM_V + 2 * SHM_K + NW * 64 * 4;
enum { M_WIN = 0, M_SEL = 1, M_BITS = 2 };

#define KSWZ(row, colB) ((row) * 256 + ((colB) ^ (((row) & 7) << 4)))
#define SBAR() __builtin_amdgcn_sched_barrier(0)
__device__ __forceinline__ int v_st(int k, int c) { const int kk = (k & ~0xC) | ((k & 4) << 1) | ((k & 8) >> 1); return ((kk >> 3) * 4 + (c >> 5)) * 512 + ((kk & 7) * 32 + (c & 31)) * 2; }
__device__ __forceinline__ int v_rd_base(int lane) { return ((lane & 3) << 3) | (((lane >> 2) & 3) << 6) | (((lane >> 4) & 1) << 5) | (((lane >> 5) & 1) << 8); }
constexpr int v_rd_off(int d0, int ks, int half) { return d0 * 512 + ks * 4096 + half * 2048; }
__device__ __forceinline__ int crow(int r, int hi) { return (r & 3) + 8 * (r >> 2) + 4 * hi; }
__device__ __forceinline__ unsigned cvtpk(float lo, float hi) { unsigned r; asm volatile("v_cvt_pk_bf16_f32 %0, %1, %2" : "=v"(r) : "v"(lo), "v"(hi)); return r; }
__device__ __forceinline__ int opq(int x) { asm volatile("" : "+v"(x)); return x; }
__device__ __forceinline__ bf16x8 load8(const bf16* p) { return *reinterpret_cast<const bf16x8*>(p); }

__device__ __forceinline__ void mask_tile(f32x16& p0, f32x16& p1, int dq, unsigned W) {
    const float NEG = -__builtin_inff();
#pragma unroll
    for (int r = 0; r < 16; ++r) {
        const int c = (r & 3) + 8 * (r >> 2);
        if ((unsigned)(dq - c) >= W) p0[r] = NEG;
        if ((unsigned)(dq - c - 32) >= W) p1[r] = NEG;
    }
}
__device__ __forceinline__ void mask_all(f32x16& p0, f32x16& p1) {
    const float NEG = -__builtin_inff();
#pragma unroll
    for (int r = 0; r < 16; ++r) { p0[r] = NEG; p1[r] = NEG; }
}
__device__ __forceinline__ void mask_bits(f32x16& p0, f32x16& p1, unsigned wlo, unsigned whi, int hi) {
    const float NEG = -__builtin_inff();
    const unsigned a = wlo >> (4 * hi), b = whi >> (4 * hi);
#pragma unroll
    for (int r = 0; r < 16; ++r) {
        const int c = (r & 3) + 8 * (r >> 2);
        if (!((a >> c) & 1u)) p0[r] = NEG;
        if (!((b >> c) & 1u)) p1[r] = NEG;
    }
}
__device__ __forceinline__ void partialSM(f32x16& p0, f32x16& p1, float& m_reg, float& mn, float& alpha) {
    float pmax = p0[0]; for (int r = 1; r < 16; ++r) pmax = fmaxf(pmax, p0[r]); for (int r = 0; r < 16; ++r) pmax = fmaxf(pmax, p1[r]);
    { auto rr = __builtin_amdgcn_permlane32_swap(__float_as_uint(pmax), __float_as_uint(pmax), false, false);
      pmax = fmaxf(__uint_as_float(rr[0]), __uint_as_float(rr[1])); }
    constexpr float C2 = 1.4426950408889634f * SCALE;
    if (__builtin_expect(__all((pmax - m_reg) * SCALE <= THR), 1)) { mn = m_reg; alpha = 1.f; }
    else { mn = fmaxf(m_reg, pmax); alpha = __builtin_amdgcn_exp2f((m_reg - mn) * C2); m_reg = mn; }
    const float mnL = -mn * C2;
    for (int r = 0; r < 16; ++r) p0[r] = fmaf(p0[r], C2, mnL); for (int r = 0; r < 16; ++r) p1[r] = fmaf(p1[r], C2, mnL);
    for (int r = 0; r < 16; ++r) p0[r] = __builtin_amdgcn_exp2f(p0[r]);
}
__device__ __forceinline__ void finishSM(f32x16& p0, f32x16& p1, float alpha, float& l_reg, bf16x8& pa0, bf16x8& pa1, bf16x8& pa2, bf16x8& pa3) {
    for (int r = 0; r < 16; ++r) p1[r] = __builtin_amdgcn_exp2f(p1[r]);
    float ps = 0; for (int r = 0; r < 16; ++r) ps += p0[r]; for (int r = 0; r < 16; ++r) ps += p1[r];
    { auto rr = __builtin_amdgcn_permlane32_swap(__float_as_uint(ps), __float_as_uint(ps), false, false);
      ps = __uint_as_float(rr[0]) + __uint_as_float(rr[1]); }
    l_reg = l_reg * alpha + ps;
#define PK4(P, B_, OUT) do { unsigned a0 = cvtpk(P[B_+0], P[B_+1]), a1 = cvtpk(P[B_+2], P[B_+3]);                          \
        unsigned b0 = cvtpk(P[B_+4], P[B_+5]), b1 = cvtpk(P[B_+6], P[B_+7]);                                             \
        auto r0 = __builtin_amdgcn_permlane32_swap(a0, b0, false, false); auto r1 = __builtin_amdgcn_permlane32_swap(a1, b1, false, false); \
        u32x4 w = {r0[0], r1[0], r0[1], r1[1]}; OUT = *reinterpret_cast<bf16x8*>(&w); } while (0)
    PK4(p0, 0, pa0); PK4(p0, 8, pa1); PK4(p1, 0, pa2); PK4(p1, 8, pa3);
#undef PK4
}
template <int KB>
__device__ __forceinline__ void qkt(f32x16& p0, f32x16& p1, const char* K_lds, int r32, int hi, const bf16x8* qr, bool act) {
    if (!act) { mask_all(p0, p1); return; }
    p0 = f32x16{}; p1 = f32x16{};
    const char* kb[4];
#pragma unroll
    for (int dd = 0; dd < 4; ++dd) kb[dd] = K_lds + KB * SHM_K + KSWZ(r32, (dd * 16 + hi * 8) * 2);
#pragma unroll
    for (int d0 = 0; d0 < 8; ++d0) { const char* a = kb[d0 & 3] + (d0 >> 2) * 128;
        bf16x8 b0 = *reinterpret_cast<const bf16x8*>(a);
        bf16x8 b1 = *reinterpret_cast<const bf16x8*>(a + 32 * 256);
        p0 = __builtin_amdgcn_mfma_f32_32x32x16_bf16(b0, qr[d0], p0, 0, 0, 0);
        p1 = __builtin_amdgcn_mfma_f32_32x32x16_bf16(b1, qr[d0], p1, 0, 0, 0); }
}
template <int VB>
__device__ __forceinline__ void pv_tile(f32x16* o, int vb0, bf16x8 pa0, bf16x8 pa1, bf16x8 pa2, bf16x8 pa3, bool act) {
    if (!act) return;
#define TRRD(dst, off) asm volatile("ds_read_b64_tr_b16 %0, %1 offset:%2" : "=&v"(dst) : "v"(vb0), "i"(off) : "memory")
#define PV_D0(d0) do { s16x4 l0, l1, l2, l3, h0, h1, h2, h3; constexpr int b_ = VB * SHM_V + v_rd_off(d0, 0, 0); \
        TRRD(l0, b_); TRRD(h0, b_ + 2048); TRRD(l1, b_ + 4096); TRRD(h1, b_ + 6144); TRRD(l2, b_ + 8192); TRRD(h2, b_ + 10240); TRRD(l3, b_ + 12288); TRRD(h3, b_ + 14336); \
        asm volatile("s_waitcnt lgkmcnt(0)" ::: "memory"); SBAR();   \
        o[d0] = __builtin_amdgcn_mfma_f32_32x32x16_bf16(pa0, (bf16x8){l0[0], l0[1], l0[2], l0[3], h0[0], h0[1], h0[2], h0[3]}, o[d0], 0, 0, 0);   \
        o[d0] = __builtin_amdgcn_mfma_f32_32x32x16_bf16(pa1, (bf16x8){l1[0], l1[1], l1[2], l1[3], h1[0], h1[1], h1[2], h1[3]}, o[d0], 0, 0, 0);   \
        o[d0] = __builtin_amdgcn_mfma_f32_32x32x16_bf16(pa2, (bf16x8){l2[0], l2[1], l2[2], l2[3], h2[0], h2[1], h2[2], h2[3]}, o[d0], 0, 0, 0);   \
        o[d0] = __builtin_amdgcn_mfma_f32_32x32x16_bf16(pa3, (bf16x8){l3[0], l3[1], l3[2], l3[3], h3[0], h3[1], h3[2], h3[3]}, o[d0], 0, 0, 0); } while (0)
    PV_D0(0); PV_D0(1); PV_D0(2); PV_D0(3);
#undef PV_D0
#undef TRRD
}

struct BlockRef { const bf16* Q; const bf16* K; const bf16* V; bf16* O; float* LSE; const unsigned* aux; int P0, ldo, lstr, mode, Wu, m, ecode; };
struct EpiPtrs { const bf16* oc; const bf16* owin; const float* gate; const bf16* ob4; const bf16* ob16; const float* lse4; const float* lse16; };
struct Seam { bf16x8 qr[8]; bf16x8 st_v0, st_v1, st_k0, st_k1; };
__device__ __forceinline__ int jlo_of(const BlockRef& r) { if (r.mode != M_WIN) return 0; int lowk = r.P0 - r.Wu + 1; const int cls = r.P0 & ~(r.m - 1); if (lowk < cls) lowk = cls;
    return lowk > 0 ? lowk / KVBLK : 0; }
__device__ __forceinline__ int tok_of(const BlockRef& r, int p) { return (p & (r.m - 1)) * (SEQ / r.m) + p / r.m; }
#define LDG(base, off) (*reinterpret_cast<const bf16x8*>(reinterpret_cast<const char*>(base) + (off)))
#define VMW() asm volatile("s_waitcnt vmcnt(0)" ::: "memory")
#define VMWN(n) asm volatile("s_waitcnt vmcnt(%0)" :: "i"(n) : "memory")
#define SLOAD_H(R, k0) do { const int t_ = opq(tid); const int p0_ = (k0) + (t_ >> 4), p1_ = p0_ + 32, lm_ = 31 - __builtin_clz((R).m), ld_ = 11 - lm_;                                 \
                         const unsigned c_ = (unsigned)((t_ & 15) * 16);                                                                                                                 \
                         const unsigned o0_ = (unsigned)((((p0_ & ((R).m - 1)) << ld_) + (p0_ >> lm_)) * (D * 2)) + c_, o1_ = (unsigned)((((p1_ & ((R).m - 1)) << ld_) + (p1_ >> lm_)) * (D * 2)) + c_; \
                         S.st_v0 = LDG((R).V, o0_); S.st_v1 = LDG((R).V, o1_); S.st_k0 = LDG((R).K, o0_); S.st_k1 = LDG((R).K, o1_); } while (0)
#define SWRITE_HK(bf) do { const int t_ = opq(tid); const int kws_ = KSWZ(t_ >> 4, (t_ & 15) * 16); *(bf16x8*)(K_lds + (bf) * SHM_K + kws_) = S.st_k0; *(bf16x8*)(K_lds + (bf) * SHM_K + kws_ + 32 * 256) = S.st_k1; } while (0)
#define SWRITE_HV(bf) do { const int t_ = opq(tid); *(bf16x8*)(V_lds + (bf) * SHM_V + v_st(t_ >> 4, (t_ & 15) * 8)) = S.st_v0; *(bf16x8*)(V_lds + (bf) * SHM_V + v_st(32 + (t_ >> 4), (t_ & 15) * 8)) = S.st_v1; } while (0)
#define SWRITE_H(bf) do { SWRITE_HV(bf); SWRITE_HK(bf); } while (0)
__device__ __forceinline__ void prime(const BlockRef& cur, char* lds, Seam& S, int tid) {
    const int wid = __builtin_amdgcn_readfirstlane(tid >> 6), lane = tid & 63, r32 = lane & 31, hi = lane >> 5;
    char* K_lds = lds + 2 * SHM_V;
    const int kb0 = jlo_of(cur) * KVBLK;
    const bf16* qrow = cur.Q + (size_t)tok_of(cur, cur.P0 + wid * QBLK + r32) * D + hi * 8;
    for (int d0 = 0; d0 < 8; ++d0) S.qr[d0] = load8(qrow + d0 * 16);
    SLOAD_H(cur, kb0); VMW(); SWRITE_HK(0);
    __syncthreads();
}
template <class NF> __device__ __forceinline__ void block(const BlockRef& cur, BlockRef& nxt, NF& nf, const EpiPtrs& ep, char* lds, Seam& S, int tid) {
    const int wid = __builtin_amdgcn_readfirstlane(tid >> 6), lane = tid & 63, r32 = lane & 31, hi = lane >> 5;
    const int mode = cur.mode, W = cur.Wu;
    const int j_lo = jlo_of(cur);
    int j_hi = (cur.P0 + QB - 1) / KVBLK + 1; if (j_hi > SEQ / KVBLK) j_hi = SEQ / KVBLK;
    const int NT = j_hi - j_lo;
    const int qlo = cur.P0 + wid * QBLK;
    const int cbase = qlo & (cur.m - 1);
    const bool force = cbase < W - 1;
    unsigned mrow = 0u;
    if (mode == M_SEL) mrow = cur.aux[qlo + r32]; else if (mode == M_BITS) mrow = (unsigned)(qlo + r32) * 256u;
    char* V_lds = lds; char* K_lds = lds + 2 * SHM_V;
    float* ws = (float*)(lds + 2 * SHM_V + 2 * SHM_K) + wid * 64; float* li_l = ws, * al_l = ws + 32;
    float m_reg = -1e30f, l_reg = 0; f32x16 o[4] = {};
#define VB0 ((int)(uintptr_t)V_lds + v_rd_base(opq(lane)))
#define RESC(a) do { if (__any((a) < 1.f)) { if (hi == 0) al_l[r32] = (a); asm volatile("s_waitcnt lgkmcnt(0)" ::: "memory");              \
                     for (int d_ = 0; d_ < 4; ++d_) for (int r = 0; r < 16; ++r) o[d_][r] *= al_l[crow(r, hi)]; } } while (0)
#define KBASE(t) ((j_lo + (t)) * KVBLK)
#define ACT(t) ((mode == M_WIN) ? (KBASE(t) <= qlo + QBLK - 1 && KBASE(t) + KVBLK - 1 >= qlo - W + 1) : ((mode == M_SEL) ? (__any((mrow >> (j_lo + (t))) & 1u) && KBASE(t) <= qlo + QBLK - 1) : (KBASE(t) <= qlo + QBLK - 1)))
#define MASKT(P0_, P1_, t) do { const int kb_ = KBASE(t); if (ACT(t)) { const int l_ = opq(lane); const int qm = qlo + (l_ & 31) - 4 * (l_ >> 5);                                                                                        \
        if (mode == M_WIN) { if (force || kb_ + KVBLK - 1 > qlo || kb_ <= qlo + QBLK - 1 - W) { int rx_ = r32; asm volatile("" : "+v"(rx_));                   \
                const unsigned cp_ = (unsigned)(cbase + rx_ + 1); mask_tile(P0_, P1_, qm - kb_, cp_ < (unsigned)W ? cp_ : (unsigned)W); } }                     \
        else if (mode == M_SEL) { if (kb_ + KVBLK - 1 > qlo) mask_tile(P0_, P1_, qm - kb_, 0x7fffffffu); if (!((mrow >> (j_lo + (t))) & 1u)) mask_all(P0_, P1_); } \
        else { const u32x2 w_ = *(const u32x2*)((const char*)cur.aux + mrow + 8u * (unsigned)(j_lo + (t))); mask_bits(P0_, P1_, w_.x, w_.y, hi); } } } while (0)
    constexpr int NQL = 8;
#define SEAM_K0() do { VMWN(NQL); SWRITE_HK(0); SBAR(); } while (0)
    f32x16 pA0, pA1, pB0, pB1; float mnA, mnB, alA, alB; bf16x8 pa0, pa1, pa2, pa3;
    SWRITE_HV(0); SBAR();
    if (NT > 1) { SLOAD_H(cur, KBASE(1)); }
    SBAR(); qkt<0>(pA0, pA1, K_lds, opq(r32), hi, S.qr, ACT(0));
    MASKT(pA0, pA1, 0); partialSM(pA0, pA1, m_reg, mnA, alA);
    if (NT > 1) { VMW(); SWRITE_H(1); }
    __syncthreads();
#define HALF_STEP(PX0, PX1, mnX, alX, PY0, PY1, alY, t, KB, VB, SB) do {                                                      \
        SBAR(); qkt<KB>(PX0, PX1, K_lds, opq(r32), hi, S.qr, ACT(t));                                                 \
        finishSM(PY0, PY1, alY, l_reg, pa0, pa1, pa2, pa3); SBAR();                                                           \
        if ((t) + 1 < NT) { SLOAD_H(cur, KBASE((t) + 1)); SBAR(); }                                                        \
        pv_tile<VB>(o, VB0, pa0, pa1, pa2, pa3, ACT((t) - 1)); MASKT(PX0, PX1, (t)); partialSM(PX0, PX1, m_reg, mnX, alX);    \
        __syncthreads();                                                                                                      \
        if ((t) + 1 < NT) { VMW(); SWRITE_H(SB); }                                                                            \
        RESC(alX); __syncthreads(); } while (0)
    for (int t = 1; t + 1 < NT; t += 2) {
        HALF_STEP(pB0, pB1, mnB, alB, pA0, pA1, alA, t, 1, 0, 0);
        HALF_STEP(pA0, pA1, mnA, alA, pB0, pB1, alB, t + 1, 0, 1, 1);
    }
    const bool even = (NT & 1) == 0;
    if (even) { SBAR(); qkt<1>(pB0, pB1, K_lds, opq(r32), hi, S.qr, ACT(NT - 1)); SBAR(); }
    nxt = nf(cur); const int kbn = jlo_of(nxt) * KVBLK;
    SLOAD_H(nxt, kbn); SBAR();
    { const bf16* qrow = nxt.Q + (size_t)tok_of(nxt, nxt.P0 + wid * QBLK + r32) * D + hi * 8;
#pragma unroll
      for (int d0 = 0; d0 < 8; ++d0) S.qr[d0] = load8(qrow + d0 * 16); }
    SBAR();
    finishSM(pA0, pA1, alA, l_reg, pa0, pa1, pa2, pa3); SBAR();
    pv_tile<0>(o, VB0, pa0, pa1, pa2, pa3, ACT(even ? NT - 2 : NT - 1));
    if (even) { MASKT(pB0, pB1, NT - 1); partialSM(pB0, pB1, m_reg, mnB, alB); __syncthreads(); RESC(alB);
        finishSM(pB0, pB1, alB, l_reg, pa0, pa1, pa2, pa3); SBAR(); pv_tile<1>(o, VB0, pa0, pa1, pa2, pa3, ACT(NT - 1)); }
    SBAR(); SEAM_K0();
    if (hi == 0) li_l[r32] = l_reg; asm volatile("s_waitcnt lgkmcnt(0)" ::: "memory");
    if (cur.LSE && hi == 0) cur.LSE[(size_t)tok_of(cur, qlo + r32) * cur.lstr] = m_reg * (1.4426950408889634f * SCALE) + __builtin_amdgcn_logf(l_reg);
    float rli[16];
#pragma unroll
    for (int r = 0; r < 16; ++r) rli[r] = __builtin_amdgcn_rcpf(li_l[crow(r, hi)]);
    const int emode = cur.ecode & 15;
    if (emode == 0) {
        char* stg = lds + (wid < 7 ? LDS_BYTES + wid * (32 * 272) : 131072 + 256);
        { const int l_ = opq(lane); char* wp_ = stg + (4 * (l_ >> 5)) * 272 + (l_ & 31) * 2;
#pragma unroll
          for (int r = 0; r < 16; ++r)
#pragma unroll
            for (int d0 = 0; d0 < 4; ++d0) *(unsigned short*)(wp_ + ((r & 3) + 8 * (r >> 2)) * 272 + d0 * 64) = (unsigned short)cvtpk(o[d0][r] * rli[r], 0.f); }
        asm volatile("s_waitcnt lgkmcnt(0)" ::: "memory");
        { const int l_ = opq(lane); const char* rp_ = stg + (l_ >> 4) * 272 + (l_ & 15) * 16;
#pragma unroll
          for (int i = 0; i < 8; ++i) { const u32x4 v = *(const u32x4*)(rp_ + i * 4 * 272);
              *(u32x4*)(cur.O + (size_t)tok_of(cur, qlo + i * 4 + (l_ >> 4)) * cur.ldo + (l_ & 15) * 8) = v; } }
    } else {
        const int ehead = (cur.ecode >> 4) & 15, etb = (cur.ecode >> 8) * SEQ;
        if (emode == 3) { if (hi == 0) al_l[r32] = m_reg * (1.4426950408889634f * SCALE) + __builtin_amdgcn_logf(l_reg); }
        char* stg = lds + (wid < 7 ? LDS_BYTES + wid * (32 * 272) : 131072 + 256);
        { const int l_ = opq(lane); char* wp_ = stg + (4 * (l_ >> 5)) * 272 + (l_ & 31) * 2;
#pragma unroll
          for (int r = 0; r < 16; ++r)
#pragma unroll
            for (int d0 = 0; d0 < 4; ++d0) *(unsigned short*)(wp_ + ((r & 3) + 8 * (r >> 2)) * 272 + d0 * 64) = (unsigned short)cvtpk(o[d0][r] * rli[r], 0.f); }
        asm volatile("s_waitcnt lgkmcnt(0)" ::: "memory");
        const int l_ = opq(lane), rq = l_ >> 4, c8 = (l_ & 15) * 8;
        const char* rp_ = stg + rq * 272 + (l_ & 15) * 16;
#pragma unroll
        for (int ib = 0; ib < 8; ib += 4) {
            u32x4 wo[4], wa[4], wb[4]; float s0[4], s1[4], l1[4];
#pragma unroll
            for (int k = 0; k < 4; ++k) { const int row = (ib + k) * 4 + rq; const size_t tg = (size_t)(etb + qlo + row);
                wo[k] = *(const u32x4*)(rp_ + (ib + k) * 4 * 272);
                if (emode == 2) { const float* gp = ep.gate + tg * 24 + ehead * 3; s0[k] = gp[1]; s1[k] = gp[2]; l1[k] = 0.f;
                    const size_t e = tg * 1024 + ehead * 128 + c8; wa[k] = *(const u32x4*)(ep.oc + e); wb[k] = *(const u32x4*)(ep.owin + e); }
                else { s0[k] = ep.lse4[tg * 4 + ehead]; s1[k] = ep.lse16[tg * 4 + ehead]; l1[k] = al_l[row];
                    const size_t e = tg * 512 + ehead * 128 + c8; wa[k] = *(const u32x4*)(ep.ob4 + e); wb[k] = *(const u32x4*)(ep.ob16 + e); } }
#pragma unroll
            for (int k = 0; k < 4; ++k) { const int row = (ib + k) * 4 + rq;
                float c0, ca, cb;
                if (emode == 2) { c0 = s0[k]; ca = 1.0f; cb = s1[k]; }
                else { const float mm = fmaxf(l1[k], fmaxf(s0[k], s1[k])), w1 = __builtin_amdgcn_exp2f(l1[k] - mm), w4 = __builtin_amdgcn_exp2f(s0[k] - mm), w16 = __builtin_amdgcn_exp2f(s1[k] - mm);
                    const float wi = __builtin_amdgcn_rcpf(w1 + w4 + w16); c0 = w1 * wi; ca = w4 * wi; cb = w16 * wi; }
                u32x4 w;
#pragma unroll
                for (int j = 0; j < 4; ++j) { const unsigned uo = wo[k][j], ua = wa[k][j], ub = wb[k][j];
                    const float x0 = c0 * __uint_as_float(uo << 16) + ca * __uint_as_float(ua << 16) + cb * __uint_as_float(ub << 16);
                    const float x1 = c0 * __uint_as_float(uo & 0xffff0000u) + ca * __uint_as_float(ua & 0xffff0000u) + cb * __uint_as_float(ub & 0xffff0000u);
                    w[j] = cvtpk(x0, x1); }
                *(u32x4*)(cur.O + (size_t)(qlo + row) * cur.ldo + c8) = w; }
        }
    }
    __syncthreads();
#undef RESC
#undef KBASE
#undef ACT
#undef MASKT
#undef SEAM_K0
#undef HALF_STEP
#undef VB0
}
#undef LDG
#undef VMW
#undef VMWN
#undef SLOAD_H
#undef SWRITE_HK
#undef SWRITE_HV
#undef SWRITE_H
#undef KSWZ
}
#ifndef MK_DUP_PH
#define MK_DUP_PH 0
#endif
namespace mk {
typedef unsigned short bf16_t;
typedef short bf16x8 __attribute__((ext_vector_type(8)));
typedef float f32x4 __attribute__((ext_vector_type(4)));
typedef float f32x2 __attribute__((ext_vector_type(2)));
typedef unsigned u32x4 __attribute__((ext_vector_type(4)));
typedef unsigned u32x2 __attribute__((ext_vector_type(2)));
typedef __bf16 bf16x2n __attribute__((ext_vector_type(2)));
#define DI __device__ __forceinline__
DI int otid() { int t = threadIdx.x; asm volatile("" : "+v"(t)); return t; }

constexpr int NB = 8, S = 2048, DM = 2048, T = NB * S, DEPTH = 4;
constexpr int NPAD = 6144, INW = 5992, FF = 5632, NGU = 2 * FF;
constexpr int NSEG = 47;
constexpr float QSCALE = 0.08838834764831845f * 1.4426950408889634f;
constexpr float NEG = -1.0e30f;
constexpr float RMS_EPS = 1e-6f;

constexpr size_t AL(size_t x) { return (x + 255) & ~(size_t)255; }
constexpr size_t WS_CTL   = 0;
constexpr size_t CTL_BYTES = 65536;
constexpr size_t WS_COS128 = WS_CTL + CTL_BYTES;
constexpr size_t WS_SIN128 = WS_COS128 + (size_t)S * 64 * 4;
constexpr size_t WS_COS64  = WS_SIN128 + (size_t)S * 64 * 4;
constexpr size_t WS_SIN64  = WS_COS64 + (size_t)S * 32 * 4;
constexpr size_t WS_WIN   = WS_SIN64 + (size_t)S * 32 * 4;
constexpr size_t WS_WOUT  = WS_WIN + (size_t)NPAD * DM * 2;
constexpr size_t WS_WGU   = WS_WOUT + (size_t)DM * DM * 2;
constexpr size_t WS_WDN   = WS_WGU + (size_t)NGU * DM * 2;
constexpr size_t WS_CW1K  = WS_WDN + (size_t)DM * FF * 2;
constexpr size_t WS_CW1V  = WS_CW1K + (size_t)256 * 4096 * 2;
constexpr size_t WS_CW2K  = WS_CW1V + (size_t)256 * 4096 * 2;
constexpr size_t WS_CW2V  = WS_CW2K + (size_t)128 * 256 * 2;
constexpr size_t WS_CB1   = WS_CW2V + (size_t)128 * 256 * 2;
constexpr size_t WS_H     = AL(WS_CB1 + 2 * 256 * 4);
constexpr size_t WS_MIX   = WS_H + (size_t)T * DM * 2;
constexpr size_t WS_BIG   = WS_MIX + (size_t)T * DM * 2;
constexpr size_t WS_P     = WS_BIG;
constexpr size_t WS_SC    = WS_BIG;
constexpr size_t WS_HID   = WS_BIG;
constexpr size_t WS_PREP  = WS_BIG + (size_t)T * NPAD * 2;
constexpr size_t WS_Y     = WS_PREP;
constexpr size_t SZ_H4 = (size_t)T * 512 * 2, SZ_H1 = (size_t)T * 128 * 2, SZ_H8 = (size_t)T * 1024 * 2, SZ_H2 = (size_t)T * 256 * 2;
constexpr size_t WS_AQ   = WS_PREP;
constexpr size_t WS_AK   = WS_AQ + SZ_H4;
constexpr size_t WS_AVT  = WS_AK + SZ_H1;
constexpr size_t WS_IQ   = WS_AVT + SZ_H1;
constexpr size_t WS_IK   = WS_IQ + SZ_H8;
constexpr size_t WS_IW   = WS_IK + (size_t)T * 64 * 2;
constexpr size_t WS_GATE = WS_IW + (size_t)T * 16 * 4;
constexpr size_t WS_BQ   = WS_GATE + (size_t)T * 24 * 4;
constexpr size_t WS_BK1  = WS_BQ + SZ_H4;
constexpr size_t WS_BVT1 = WS_BK1 + SZ_H4;
constexpr size_t WS_BK4  = WS_BK1, WS_BK16 = WS_BK1, WS_BVT4 = WS_BVT1, WS_BVT16 = WS_BVT1;
constexpr size_t WS_CQ   = WS_BVT1 + SZ_H4;
constexpr size_t WS_CQR  = WS_CQ + SZ_H8;
constexpr size_t WS_KC   = WS_CQR + SZ_H8;
constexpr size_t WS_VC   = WS_KC + SZ_H2 + 65536;
constexpr size_t WS_CKS  = WS_VC + SZ_H2 + 65536;
constexpr size_t WS_CVST = WS_CKS + SZ_H2;
constexpr size_t WS_CKW  = WS_CVST + SZ_H2;
constexpr size_t WS_CVWT = WS_CKW + SZ_H2;
constexpr size_t WS_PREP_END = WS_CVWT + SZ_H2;
constexpr size_t WS_BITS = WS_PREP_END;
constexpr size_t WS_OB4  = WS_BITS + (size_t)T * 64 * 4;
constexpr size_t WS_OB16 = WS_OB4 + SZ_H4;
constexpr size_t WS_LSE4 = WS_OB16 + SZ_H4;
constexpr size_t WS_LSE16 = WS_LSE4 + (size_t)T * 4 * 4;
constexpr size_t WS_LSE1 = WS_LSE16 + (size_t)T * 4 * 4;
constexpr size_t WS_OB1  = WS_LSE1 + (size_t)T * 4 * 4;
constexpr size_t WS_OSLC = WS_OB1 + SZ_H4;
constexpr size_t WS_OWIN = WS_OSLC + SZ_H8;
constexpr size_t WS_OC   = WS_OWIN + SZ_H8;
constexpr size_t WS_G1K  = WS_OC + SZ_H8;
constexpr size_t WS_G1V  = WS_G1K + (size_t)2048 * 256 * 2;
constexpr size_t WS_KCC  = WS_G1V + (size_t)2048 * 256 * 2;
constexpr size_t WS_VCT  = WS_KCC + (size_t)16 * 128 * 128 * 2;
constexpr size_t WS_SEL  = WS_VCT + (size_t)16 * 128 * 128 * 2;
constexpr size_t WS_XB   = AL(WS_SEL + (size_t)16 * S * 4);
constexpr size_t WS_END  = AL(WS_XB + (size_t)T * DM * 2);
static_assert(WS_HID + (size_t)T * FF * 2 <= WS_PREP, "hidden must fit inside P");
static_assert(WS_Y + (size_t)T * DM * 2 <= WS_PREP_END, "Y must fit inside the prep region");

constexpr int LDS_BAR_OFF = 131072;
constexpr int LDS_BYTES = 131072 + 256 + 128 * 144;   static_assert(2 * 32 * 272 <= 128 * 144 && 32 * 528 <= 128 * 144, "the in-projection's staging tile shares the region");

DI unsigned pk2(float a, float b) { f32x2 v = {a, b}; bf16x2n r = __builtin_convertvector(v, bf16x2n); return __builtin_bit_cast(unsigned, r); }
DI float bflo(unsigned w) { return __uint_as_float(w << 16); }
DI float bfhi(unsigned w) { return __uint_as_float(w & 0xffff0000u); }
DI float bf2f(bf16_t v) { return __uint_as_float(((unsigned)v) << 16); }
DI float wave_sum(float v) {
#pragma unroll
    for (int o = 1; o < 64; o <<= 1) v += __shfl_xor(v, o);
    return v;
}
DI float fexp2(float x) { return __builtin_amdgcn_exp2f(x); }
DI float frcp(float x) { return __builtin_amdgcn_rcpf(x); }
DI void unpack8(const u32x4 w, float (&x)[8]) { x[0] = bflo(w.x); x[1] = bfhi(w.x); x[2] = bflo(w.y); x[3] = bfhi(w.y); x[4] = bflo(w.z); x[5] = bfhi(w.z); x[6] = bflo(w.w); x[7] = bfhi(w.w); }
DI u32x4 pack8(const float (&x)[8]) { u32x4 w; w.x = pk2(x[0], x[1]); w.y = pk2(x[2], x[3]); w.z = pk2(x[4], x[5]); w.w = pk2(x[6], x[7]); return w; }
#define MFMA16(a, b, c) __builtin_amdgcn_mfma_f32_16x16x32_bf16((a), (b), (c), 0, 0, 0)
DI unsigned pk4_i8(float a, float b, float c, float d) {
    const float M = 12582912.0f;
    const unsigned ua = __float_as_uint(__builtin_amdgcn_fmed3f(a, -127.0f, 127.0f) + M), ub = __float_as_uint(__builtin_amdgcn_fmed3f(b, -127.0f, 127.0f) + M),
                   uc = __float_as_uint(__builtin_amdgcn_fmed3f(c, -127.0f, 127.0f) + M), ud = __float_as_uint(__builtin_amdgcn_fmed3f(d, -127.0f, 127.0f) + M);
    return (ua & 0xffu) | ((ub & 0xffu) << 8) | ((uc & 0xffu) << 16) | (ud << 24); }
constexpr size_t CTL_WMAX = 12288;
constexpr float F8_SW = 1024.0f, F8_SH = 16.0f, F8_SHID = 8.0f;
DI unsigned pk4_f8(float a, float b, float c, float d) {
    a = __builtin_amdgcn_fmed3f(a, -448.0f, 448.0f); b = __builtin_amdgcn_fmed3f(b, -448.0f, 448.0f); c = __builtin_amdgcn_fmed3f(c, -448.0f, 448.0f); d = __builtin_amdgcn_fmed3f(d, -448.0f, 448.0f);
    int w = __builtin_amdgcn_cvt_pk_fp8_f32(a, b, 0, false); w = __builtin_amdgcn_cvt_pk_fp8_f32(c, d, w, true); return (unsigned)w; }

struct Ptrs {
    const float* in[16];
    float* out;
    unsigned char* ws;
};
template <class TT> DI TT* wsp(const Ptrs& P, size_t off) { return (TT*)(P.ws + off); }

DI void phase_rope_tables(const Ptrs& P) {
    float* c128 = wsp<float>(P, WS_COS128); float* s128 = wsp<float>(P, WS_SIN128); float* c64 = wsp<float>(P, WS_COS64); float* s64 = wsp<float>(P, WS_SIN64);
    const int gt = blockIdx.x * blockDim.x + otid(), ng = gridDim.x * blockDim.x;
    for (int i = gt; i < S * 64; i += ng) { const int t = i >> 6, k = i & 63; const float inv = exp2f(-(float)k * (13.287712379549449f / 64.0f));
        const double a = (double)t * (double)inv * 0.15915494309189535; const float fr = (float)(a - floor(a));
        c128[i] = __builtin_amdgcn_cosf(fr); s128[i] = __builtin_amdgcn_sinf(fr); }
    for (int i = gt; i < S * 32; i += ng) { const int t = i >> 5, k = i & 31; const float inv = exp2f(-(float)k * (13.287712379549449f / 32.0f));
        const double a = (double)t * (double)inv * 0.15915494309189535; const float fr = (float)(a - floor(a));
        c64[i] = __builtin_amdgcn_cosf(fr); s64[i] = __builtin_amdgcn_sinf(fr); }
}

DI int incol(int pc) {
    const int tile = pc >> 8, q = pc & 255, bj = q >> 7, r = q & 127, wc = r >> 5, p = r & 31;
    if (tile == 23) { if (wc == 0) return 1792 + 32 * bj + p; if (wc == 1) { if (bj == 0) return p < 16 ? 1856 + p : -1; return p < 24 ? 5968 + p : -1; } return -1; }
    const int seg = 2 * tile + (wc >> 1), base = (seg < 14) ? seg * 128 : seg * 128 + 80;
    if (seg >= 6 && seg < 14) return base + 64 * (wc & 1) + 32 * bj + p;
    return base + 64 * bj + 32 * (wc & 1) + p;
}
DI int q_next(unsigned* ctr, unsigned char* lds, int tid) {
    volatile int* slot = (volatile int*)(lds + LDS_BAR_OFF + 64);
    __syncthreads();
    if (tid == 0) *slot = (int)__hip_atomic_fetch_add(ctr, 1u, __ATOMIC_RELAXED, __HIP_MEMORY_SCOPE_AGENT);
    __syncthreads();
    return __builtin_amdgcn_readfirstlane(*slot);
}
struct ConvIt { const float* src; bf16_t* dst; int srcN, K, n0, k0, sc, f8; float wmax; };
DI ConvIt conv_decode(const Ptrs& P, int layer, int it, int tid) {
    const float* w_in = P.in[1] + (size_t)layer * DM * INW; const float* w_out = P.in[2] + (size_t)layer * DM * DM;
    const float* w1k = P.in[4] + (size_t)layer * 4096 * 256; const float* w2k = P.in[5] + (size_t)layer * 256 * 128;
    const float* w1v = P.in[7] + (size_t)layer * 4096 * 256; const float* w2v = P.in[8] + (size_t)layer * 256 * 128;
    const float* wg = P.in[9] + (size_t)layer * DM * FF; const float* wu = P.in[10] + (size_t)layer * DM * FF; const float* wd = P.in[11] + (size_t)layer * FF * DM;
    constexpr int I0 = (NPAD / 64) * (DM / 128), I1 = (DM / 64) * (DM / 128), I2 = (NGU / 64) * (DM / 128), I3 = (DM / 64) * (FF / 128), I4 = 4 * 32, I6 = 2 * 2;
    const int nq = (tid & 15) * 4;
    ConvIt c; c.f8 = 0; c.wmax = 0.f; int r = it;
    if (r < I0) { const int nt = r / (DM / 128), kt = r % (DM / 128); c.src = w_in; c.dst = wsp<bf16_t>(P, WS_WIN); c.srcN = INW; c.K = DM; c.n0 = nt * 64; c.k0 = kt * 128; c.sc = incol(c.n0 + nq); c.f8 = 2;
        c.wmax = __uint_as_float(__builtin_amdgcn_readfirstlane(__hip_atomic_load((unsigned*)(P.ws + WS_CTL) + CTL_WMAX + layer * 64 + 1, __ATOMIC_RELAXED, __HIP_MEMORY_SCOPE_AGENT))); return c; } r -= I0;
    if (r < I4) { const int nt = r / 32, kt = r % 32; c.src = w1k; c.dst = wsp<bf16_t>(P, WS_CW1K); c.srcN = 256; c.K = 4096; c.n0 = nt * 64; c.k0 = kt * 128; c.sc = c.n0 + nq; return c; } r -= I4;
    if (r < I4) { const int nt = r / 32, kt = r % 32; c.src = w1v; c.dst = wsp<bf16_t>(P, WS_CW1V); c.srcN = 256; c.K = 4096; c.n0 = nt * 64; c.k0 = kt * 128; c.sc = c.n0 + nq; return c; } r -= I4;
    if (r < I6) { const int nt = r / 2, kt = r % 2; c.src = w2k; c.dst = wsp<bf16_t>(P, WS_CW2K); c.srcN = 128; c.K = 256; c.n0 = nt * 64; c.k0 = kt * 128; c.sc = c.n0 + nq; return c; } r -= I6;
    if (r < I6) { const int nt = r / 2, kt = r % 2; c.src = w2v; c.dst = wsp<bf16_t>(P, WS_CW2V); c.srcN = 128; c.K = 256; c.n0 = nt * 64; c.k0 = kt * 128; c.sc = c.n0 + nq; return c; } r -= I6;
    if (r < I1) { const int nt = r / (DM / 128), kt = r % (DM / 128); c.src = w_out; c.dst = wsp<bf16_t>(P, WS_WOUT); c.srcN = DM; c.K = DM; c.n0 = nt * 64; c.k0 = kt * 128; c.sc = c.n0 + nq; return c; } r -= I1;
    constexpr int DA = (I1 + I2 + I3) / 4 - I1; static_assert(DA >= 0 && DA <= I3, "late-set split");
    if (r >= DA && r < DA + I2) { r -= DA; const int nt = r / (DM / 128), kt = r % (DM / 128); const int n0 = nt * 64, tl = n0 >> 8, o = n0 & 255;
        c.src = (o < 128) ? wg : wu; c.dst = wsp<bf16_t>(P, WS_WGU); c.srcN = FF; c.K = DM; c.n0 = n0; c.k0 = kt * 128; c.sc = tl * 128 + (o & 127) + nq; c.f8 = 2; c.wmax = __uint_as_float(__builtin_amdgcn_readfirstlane(__hip_atomic_load((unsigned*)(P.ws + WS_CTL) + CTL_WMAX + layer * 64, __ATOMIC_RELAXED, __HIP_MEMORY_SCOPE_AGENT))); return c; }
    if (r >= DA) r -= I2;
    { const int nt = r / (FF / 128), kt = r % (FF / 128); c.src = wd; c.dst = wsp<bf16_t>(P, WS_WDN); c.srcN = DM; c.K = FF; c.n0 = nt * 64; c.k0 = kt * 128; c.sc = c.n0 + nq; c.f8 = 1; return c; }
}
constexpr int CONV_EARLY = (NPAD / 64) * (DM / 128) + 2 * 4 * 32 + 2 * 2 * 2;
constexpr int CONV_NIT = (NPAD / 64) * (DM / 128) + (DM / 64) * (DM / 128) + (NGU / 64) * (DM / 128) + (DM / 64) * (FF / 128) + 2 * 4 * 32 + 2 * 2 * 2;
DI void conv_load(const ConvIt& c, int tid, f32x4 (&v)[4]) {
    const int kr = tid >> 4;
#pragma unroll
    for (int i = 0; i < 4; ++i) v[i] = (c.sc >= 0) ? __builtin_nontemporal_load((const f32x4*)(c.src + (size_t)(c.k0 + kr + 32 * i) * c.srcN + c.sc)) : (f32x4){0.f, 0.f, 0.f, 0.f};
}
DI void conv_store(const ConvIt& c, int tid, const f32x4 (&v)[4], float* tile  ) {
    const int nq = (tid & 15) * 4, kr = tid >> 4;
#pragma unroll
    for (int i = 0; i < 4; ++i)
#pragma unroll
        for (int e = 0; e < 4; ++e) tile[(nq + e) * 129 + kr + 32 * i] = v[i][e];
    __syncthreads();
    const int n2 = tid >> 3, c8 = tid & 7;
#pragma unroll
    for (int j = 0; j < 2; ++j) { float x[8];
#pragma unroll
        for (int e = 0; e < 8; ++e) x[e] = tile[n2 * 129 + 8 * c8 + 64 * j + e];
        if (c.f8 == 2) { const float sw = 127.0f / fmaxf(c.wmax, 1e-30f); u32x2 w; w.x = pk4_i8(x[0] * sw, x[1] * sw, x[2] * sw, x[3] * sw); w.y = pk4_i8(x[4] * sw, x[5] * sw, x[6] * sw, x[7] * sw);
            *(u32x2*)((unsigned char*)c.dst + (size_t)(c.n0 + n2) * c.K + c.k0 + 8 * c8 + 64 * j) = w; }
        else if (c.f8) { u32x2 w; w.x = pk4_f8(x[0] * F8_SW, x[1] * F8_SW, x[2] * F8_SW, x[3] * F8_SW); w.y = pk4_f8(x[4] * F8_SW, x[5] * F8_SW, x[6] * F8_SW, x[7] * F8_SW);
            *(u32x2*)((unsigned char*)c.dst + (size_t)(c.n0 + n2) * c.K + c.k0 + 8 * c8 + 64 * j) = w; }
        else *(u32x4*)(c.dst + (size_t)(c.n0 + n2) * c.K + c.k0 + 8 * c8 + 64 * j) = pack8(x); }
}
DI void conv_range(const Ptrs& P, int layer, unsigned char* lds, int first, int end, int step) {
    const int tid = otid();
    float* tileA = (float*)lds; float* tileB = (float*)lds + 64 * 129;
    int it = first;
    if (it < end) {
        ConvIt ca = conv_decode(P, layer, it, tid), cb = ca; f32x4 va[4], vb[4];
        conv_load(ca, tid, va);
        for (;;) {
            const bool nb = it + step < end; if (nb) { cb = conv_decode(P, layer, it + step, tid); conv_load(cb, tid, vb); }
            conv_store(ca, tid, va, tileA);
            if (!nb) break;
            it += step;
            const bool na = it + step < end; if (na) { ca = conv_decode(P, layer, it + step, tid); conv_load(ca, tid, va); }
            conv_store(cb, tid, vb, tileB);
            if (!na) break;
            it += step;
        }
    }
    __syncthreads();
}
constexpr int CONV_FILL_TILES = 4, CONV_FILL_ITEMS = (CONV_NIT - CONV_EARLY) / CONV_FILL_TILES, CONV_FILL_PER_PHASE = CONV_FILL_ITEMS / 4;
static_assert((CONV_NIT - CONV_EARLY) % (CONV_FILL_TILES * 4) == 0, "filler items must split evenly over the four attention phases");
constexpr int WMAX_ITEMS = 512;
DI void wmax_item(const Ptrs& P, int layer, int it, unsigned char* lds) {
    constexpr int N4 = DM * FF / 4, PER = N4 / WMAX_ITEMS; static_assert(N4 % WMAX_ITEMS == 0 && PER % (512 * 11) == 0, "slice shape");
    const int tid = otid();
    const f32x4* wg = (const f32x4*)(P.in[9] + (size_t)layer * DM * FF) + (size_t)it * PER + tid; const f32x4* wu = (const f32x4*)(P.in[10] + (size_t)layer * DM * FF) + (size_t)it * PER + tid;
    float m = 0.f;
#pragma unroll 1
    for (int h = 0; h < PER / 512; h += 11) { f32x4 a[11], b[11];
#pragma unroll
        for (int j = 0; j < 11; ++j) { a[j] = wg[(h + j) * 512]; b[j] = wu[(h + j) * 512]; }
#pragma unroll
        for (int j = 0; j < 11; ++j) { m = fmaxf(m, fmaxf(fmaxf(fabsf(a[j][0]), fabsf(a[j][1])), fmaxf(fabsf(a[j][2]), fabsf(a[j][3])))); m = fmaxf(m, fmaxf(fmaxf(fabsf(b[j][0]), fabsf(b[j][1])), fmaxf(fabsf(b[j][2]), fabsf(b[j][3])))); } }
    unsigned* slot = (unsigned*)(lds + LDS_BAR_OFF + 128);
    if (tid == 0) *slot = 0u;
    __syncthreads();
    __hip_atomic_fetch_max(slot, __float_as_uint(m), __ATOMIC_RELAXED, __HIP_MEMORY_SCOPE_WORKGROUP);
    __syncthreads();
    if (tid == 0) __hip_atomic_fetch_max((unsigned*)(P.ws + WS_CTL) + CTL_WMAX + layer * 64, *slot, __ATOMIC_RELAXED, __HIP_MEMORY_SCOPE_AGENT);
}
DI void wmax_in_item(const Ptrs& P, int layer, int it, unsigned char* lds) {
    constexpr int N4 = DM * INW / 4, PER = N4 / WMAX_ITEMS; static_assert(N4 % WMAX_ITEMS == 0 && PER <= 12 * 512, "slice shape");
    const int tid = otid();
    const f32x4* w = (const f32x4*)(P.in[1] + (size_t)layer * DM * INW) + (size_t)it * PER;
    float m = 0.f; f32x4 a[12];
#pragma unroll
    for (int j = 0; j < 12; ++j) { int i = tid + 512 * j; i = i < PER ? i : PER - 1; a[j] = w[i]; }
#pragma unroll
    for (int j = 0; j < 12; ++j) m = fmaxf(m, fmaxf(fmaxf(fabsf(a[j][0]), fabsf(a[j][1])), fmaxf(fabsf(a[j][2]), fabsf(a[j][3]))));
    unsigned* slot = (unsigned*)(lds + LDS_BAR_OFF + 128);
    if (tid == 0) *slot = 0u;
    __syncthreads();
    __hip_atomic_fetch_max(slot, __float_as_uint(m), __ATOMIC_RELAXED, __HIP_MEMORY_SCOPE_WORKGROUP);
    __syncthreads();
    if (tid == 0) __hip_atomic_fetch_max((unsigned*)(P.ws + WS_CTL) + CTL_WMAX + layer * 64 + 1, *slot, __ATOMIC_RELAXED, __HIP_MEMORY_SCOPE_AGENT);
    __syncthreads();
}
DI void bias1_item(const Ptrs& P, int layer, int j) {
    const int tid = otid(), wid = tid >> 6, lane = tid & 63, o = j * 8 + wid, kv = o >> 8, n = o & 255;
    const float* pe = P.in[kv ? 6 : 3] + (size_t)layer * 4096; const float* w1 = P.in[kv ? 7 : 4] + (size_t)layer * 4096 * 256;
    float sacc = 0.f;
    for (int k = lane; k < 4096; k += 64) sacc += pe[k] * w1[(size_t)k * 256 + n];
    sacc = wave_sum(sacc);
    if (lane == 0) wsp<float>(P, WS_CB1)[o] = sacc;
}
constexpr int EARLY_ITEMS = CONV_EARLY / CONV_FILL_TILES; static_assert(CONV_EARLY % CONV_FILL_TILES == 0, "early set in filler items");
DI void conv_filler(const Ptrs& P, int layer, unsigned char* lds, unsigned* ctr, int part) {
    const bool nxt = layer + 1 < DEPTH;
    int extra = 0;
    if (part == 0) extra = WMAX_ITEMS; else if (nxt) extra = (part == 1) ? WMAX_ITEMS : (part == 2 ? EARLY_ITEMS / 2 : EARLY_ITEMS - EARLY_ITEMS / 2 + 64);
    for (int it = q_next(ctr, lds, otid()); it < CONV_FILL_PER_PHASE + extra; it = q_next(ctr, lds, otid())) {
        const int j = it - CONV_FILL_PER_PHASE;
        if (j >= 0 && part == 0) { wmax_item(P, layer, j, lds); continue; }
        if (j >= 0 && part == 1) { wmax_in_item(P, layer + 1, j, lds); continue; }
        int lyr = layer, t0 = CONV_EARLY + (part * CONV_FILL_PER_PHASE + it) * CONV_FILL_TILES;
        if (j >= 0) { const int e = (part == 2) ? j : j + EARLY_ITEMS / 2; if (e >= EARLY_ITEMS) { bias1_item(P, layer + 1, e - EARLY_ITEMS); continue; } lyr = layer + 1; t0 = e * CONV_FILL_TILES; }
        conv_range(P, lyr, lds, t0, t0 + CONV_FILL_TILES, 1); }
}
DI void phase_wconv(const Ptrs& P, int layer, unsigned char* lds) {
    const int tid = otid();
    conv_range(P, layer, lds, blockIdx.x, CONV_EARLY, gridDim.x);
    __syncthreads();
    if (blockIdx.x < 64) {
        const int wid = tid >> 6, lane = tid & 63, o = blockIdx.x * 8 + wid, kv = o >> 8, n = o & 255;
        const float* pe = P.in[kv ? 6 : 3] + (size_t)layer * 4096; const float* w1 = P.in[kv ? 7 : 4] + (size_t)layer * 4096 * 256;
        float sacc = 0.f;
        for (int k = lane; k < 4096; k += 64) sacc += pe[k] * w1[(size_t)k * 256 + n];
        sacc = wave_sum(sacc);
        if (lane == 0) wsp<float>(P, WS_CB1)[o] = sacc;
    }
}

template <bool XI, bool XO, int H8 = 0  > DI void phase_norm(const void* xin_, void* xout_, const bf16_t* Y, const float* g_post, const float* g_pre, bf16_t* H) {
    const float* xin = (const float*)xin_; float* xout = (float*)xout_; const bf16_t* xinb = (const bf16_t*)xin_; bf16_t* xoutb = (bf16_t*)xout_;
    const int lane = otid() & 63, gw = blockIdx.x * 8 + (otid() >> 6), ngw = gridDim.x * 8;
    for (int row = gw; row < T; row += ngw) {
        float xv[4][8];
#pragma unroll
        for (int j = 0; j < 4; ++j) { const int col = 8 * (lane + 64 * j);
            if (XI) { unpack8(*(const u32x4*)(xinb + (size_t)row * DM + col), xv[j]); }
            else { const f32x4 a = *(const f32x4*)(xin + (size_t)row * DM + col), b = *(const f32x4*)(xin + (size_t)row * DM + col + 4);
                xv[j][0] = a[0]; xv[j][1] = a[1]; xv[j][2] = a[2]; xv[j][3] = a[3]; xv[j][4] = b[0]; xv[j][5] = b[1]; xv[j][6] = b[2]; xv[j][7] = b[3]; } }
        if (Y) {
            float yv[4][8]; float ss = 0.f;
#pragma unroll
            for (int j = 0; j < 4; ++j) { const int col = 8 * (lane + 64 * j); const u32x4 w = *(const u32x4*)(Y + (size_t)row * DM + col); unpack8(w, yv[j]);
#pragma unroll
                for (int e = 0; e < 8; ++e) ss += yv[j][e] * yv[j][e]; }
            const float rstd = rsqrtf(wave_sum(ss) * (1.0f / DM) + RMS_EPS);
#pragma unroll
            for (int j = 0; j < 4; ++j) { const int col = 8 * (lane + 64 * j); const f32x4 ga = *(const f32x4*)(g_post + col), gb = *(const f32x4*)(g_post + col + 4);
#pragma unroll
                for (int e = 0; e < 4; ++e) { xv[j][e] += yv[j][e] * rstd * ga[e]; xv[j][4 + e] += yv[j][4 + e] * rstd * gb[e]; }
                if (XO) { *(u32x4*)(xoutb + (size_t)row * DM + col) = pack8(xv[j]); unpack8(pack8(xv[j]), xv[j]); }
                else { *(f32x4*)(xout + (size_t)row * DM + col) = (f32x4){xv[j][0], xv[j][1], xv[j][2], xv[j][3]};
                    *(f32x4*)(xout + (size_t)row * DM + col + 4) = (f32x4){xv[j][4], xv[j][5], xv[j][6], xv[j][7]}; } }
        }
        if (H) {
            float ss = 0.f;
#pragma unroll
            for (int j = 0; j < 4; ++j)
#pragma unroll
                for (int e = 0; e < 8; ++e) ss += xv[j][e] * xv[j][e];
            const float rstd = rsqrtf(wave_sum(ss) * (1.0f / DM) + RMS_EPS);
            if (H8 == 2) { float am = 0.f;
#pragma unroll
                for (int j = 0; j < 4; ++j) { const int col = 8 * (lane + 64 * j); const f32x4 ga = *(const f32x4*)(g_pre + col), gb = *(const f32x4*)(g_pre + col + 4);
#pragma unroll
                    for (int e = 0; e < 4; ++e) { xv[j][e] *= rstd * ga[e]; xv[j][4 + e] *= rstd * gb[e]; am = fmaxf(am, fmaxf(fabsf(xv[j][e]), fabsf(xv[j][4 + e]))); } }
#pragma unroll
                for (int o = 1; o < 64; o <<= 1) am = fmaxf(am, __shfl_xor(am, o));
                am = fmaxf(am, 1e-30f); const float sa = 127.0f / am;
                if (lane == 0) ((float*)((unsigned char*)H + (size_t)T * DM))[row] = am * (1.0f / 127.0f);
#pragma unroll
                for (int j = 0; j < 4; ++j) { const int col = 8 * (lane + 64 * j); u32x2 w; w.x = pk4_i8(xv[j][0] * sa, xv[j][1] * sa, xv[j][2] * sa, xv[j][3] * sa); w.y = pk4_i8(xv[j][4] * sa, xv[j][5] * sa, xv[j][6] * sa, xv[j][7] * sa);
                    *(u32x2*)((unsigned char*)H + (size_t)row * DM + col) = w; }
            } else
#pragma unroll
            for (int j = 0; j < 4; ++j) { const int col = 8 * (lane + 64 * j); const f32x4 ga = *(const f32x4*)(g_pre + col), gb = *(const f32x4*)(g_pre + col + 4); float hv[8];
#pragma unroll
                for (int e = 0; e < 4; ++e) { hv[e] = xv[j][e] * rstd * ga[e]; hv[4 + e] = xv[j][4 + e] * rstd * gb[e]; }
                if (H8) { u32x2 w; w.x = pk4_f8(hv[0] * F8_SH, hv[1] * F8_SH, hv[2] * F8_SH, hv[3] * F8_SH); w.y = pk4_f8(hv[4] * F8_SH, hv[5] * F8_SH, hv[6] * F8_SH, hv[7] * F8_SH);
                    *(u32x2*)((unsigned char*)H + (size_t)row * DM + col) = w; }
                else *(u32x4*)(H + (size_t)row * DM + col) = pack8(hv); }
        }
    }
}

struct EpiSwiglu {
    static constexpr bool PERM = true, AFTER_DRAIN = false;
    bf16_t* O; int ldc;
    __device__ __forceinline__ void operator()(const pg8::f32x4 (&acc)[2][2][4][2], const pg8::Unit& u, int wr, int wc, int fr, int fq) const {
        const int row0 = u.pm * 256 + wr * 64 + fr, col0 = u.pn * 128 + wc * 32 + 8 * fq;
#pragma unroll
        for (int ai = 0; ai < 2; ++ai)
#pragma unroll
            for (int m = 0; m < 4; ++m) { bf16_t* rowp = O + (size_t)(row0 + ai * 128 + m * 16) * ldc + col0; float h[8];
#pragma unroll
                for (int n = 0; n < 2; ++n)
#pragma unroll
                    for (int i = 0; i < 4; ++i) { const float g = acc[ai][0][m][n][i], up = acc[ai][1][m][n][i]; h[4 * n + i] = g * frcp(1.0f + fexp2(-1.4426950408889634f * g)) * up; }
                *(u32x4*)rowp = pack8(h); }
    }
};

struct EpiSwiglu8 {
    static constexpr bool PERM = true, AFTER_DRAIN = false;
    unsigned char* O; int ldc;
    __device__ __forceinline__ void operator()(const pg8::f32x4 (&acc)[2][2][4][2], const pg8::Unit& u, int wr, int wc, int fr, int fq) const {
        const int row0 = u.pm * 256 + wr * 64 + fr, col0 = u.pn * 128 + wc * 32 + 8 * fq;
        constexpr float US = 1.0f / (F8_SH * F8_SW);
#pragma unroll
        for (int ai = 0; ai < 2; ++ai)
#pragma unroll
            for (int m = 0; m < 4; ++m) { unsigned char* rowp = O + (size_t)(row0 + ai * 128 + m * 16) * ldc + col0; float h[8];
#pragma unroll
                for (int n = 0; n < 2; ++n)
#pragma unroll
                    for (int i = 0; i < 4; ++i) { const float g = acc[ai][0][m][n][i] * US, up = acc[ai][1][m][n][i] * (US * F8_SHID); h[4 * n + i] = g * frcp(1.0f + fexp2(-1.4426950408889634f * g)) * up; }
                u32x2 w; w.x = pk4_f8(h[0], h[1], h[2], h[3]); w.y = pk4_f8(h[4], h[5], h[6], h[7]);
                *(u32x2*)rowp = w; }
    }
};
struct EpiSwigluI8 {
    static constexpr bool PERM = true, AFTER_DRAIN = false, STAGED = true;
    static constexpr int PITCH = 144;
    unsigned char* O; int ldc; const float* rs; float ws;
    __device__ __forceinline__ void staged(const pg8::f32x4 (&acc)[2][2][4][2], const pg8::Unit& u, int wr, int wc, int fr, int fq, PG8_LAS unsigned char* ep, int wid, int lane) const {
        const int row0 = u.pm * 256 + wr * 64 + fr;
        float scv[8];
#pragma unroll
        for (int i = 0; i < 8; ++i) scv[i] = rs[row0 + (i >> 2) * 128 + (i & 3) * 16] * ws;
#pragma unroll
        for (int ai = 0; ai < 2; ++ai) {
#pragma unroll
            for (int m = 0; m < 4; ++m) { float h[8]; const float sc = scv[ai * 4 + m];
#pragma unroll
                for (int n = 0; n < 2; ++n)
#pragma unroll
                    for (int i = 0; i < 4; ++i) { const float g = (float)__float_as_int(acc[ai][0][m][n][i]) * sc, up = (float)__float_as_int(acc[ai][1][m][n][i]) * (sc * F8_SHID); h[4 * n + i] = g * frcp(1.0f + fexp2(-1.4426950408889634f * g)) * up; }
                u32x2 w; w.x = pk4_f8(h[0], h[1], h[2], h[3]); w.y = pk4_f8(h[4], h[5], h[6], h[7]);
                *(PG8_LAS u32x2*)(ep + (wr * 64 + m * 16 + fr) * PITCH + wc * 32 + 8 * fq) = w; }
            asm volatile("s_waitcnt lgkmcnt(0)" ::: "memory"); __builtin_amdgcn_s_barrier(); asm volatile("" ::: "memory");
            u32x4 v[2];
#pragma unroll
            for (int h2 = 0; h2 < 2; ++h2) v[h2] = *(const PG8_LAS u32x4*)(ep + (wid * 16 + h2 * 8 + (lane >> 3)) * PITCH + (lane & 7) * 16);
            asm volatile("s_waitcnt lgkmcnt(0)" ::: "memory"); __builtin_amdgcn_s_barrier(); asm volatile("" ::: "memory");
#pragma unroll
            for (int h2 = 0; h2 < 2; ++h2) *(u32x4*)(O + (size_t)(u.pm * 256 + ai * 128 + wid * 16 + h2 * 8 + (lane >> 3)) * ldc + u.pn * 128 + (lane & 7) * 16) = v[h2];
        }
    }
    __device__ __forceinline__ void operator()(const pg8::f32x4 (&acc)[2][2][4][2], const pg8::Unit& u, int wr, int wc, int fr, int fq) const {
        const int row0 = u.pm * 256 + wr * 64 + fr, col0 = u.pn * 128 + wc * 32 + 8 * fq;
#pragma unroll
        for (int ai = 0; ai < 2; ++ai)
#pragma unroll
            for (int m = 0; m < 4; ++m) { const int row = row0 + ai * 128 + m * 16; unsigned char* rowp = O + (size_t)row * ldc + col0; float h[8]; const float sc = rs[row] * ws;
#pragma unroll
                for (int n = 0; n < 2; ++n)
#pragma unroll
                    for (int i = 0; i < 4; ++i) { const float g = (float)__float_as_int(acc[ai][0][m][n][i]) * sc, up = (float)__float_as_int(acc[ai][1][m][n][i]) * (sc * F8_SHID); h[4 * n + i] = g * frcp(1.0f + fexp2(-1.4426950408889634f * g)) * up; }
                u32x2 w; w.x = pk4_f8(h[0], h[1], h[2], h[3]); w.y = pk4_f8(h[4], h[5], h[6], h[7]);
                *(u32x2*)rowp = w; }
    }
};
struct EpiRowsBf16 {
    static constexpr bool PERM = true, AFTER_DRAIN = false, STAGED = true;
    static constexpr int RPITCH = 528;
    bf16_t* O; int ldc; float US;
    __device__ __forceinline__ void staged(const pg8::f32x4 (&acc)[2][2][4][2], const pg8::Unit& u, int wr, int wc, int fr_in, int fq_in, PG8_LAS unsigned char* ep, int wid, int lane_in) const {
        int fr = fr_in, fq = fq_in, lane = lane_in; asm volatile("" : "+v"(fr), "+v"(fq), "+v"(lane));
        PG8_LAS unsigned char* wt = ep + (wr * 16 + fr) * RPITCH + (wc * 32 + 8 * fq) * 2;
        const int rrow = wid * 4 + (lane >> 5);
        const PG8_LAS unsigned char* rt = ep + rrow * RPITCH + (lane & 31) * 16;
        bf16_t* obase = O + (size_t)(u.pm * 256 + (rrow >> 4) * 64 + (rrow & 15)) * ldc + u.pn * 256 + (lane & 31) * 8;
#pragma unroll
        for (int idx = 0; idx < 8; ++idx) { const int ai = idx >> 2, m = idx & 3;
#pragma unroll
            for (int bj = 0; bj < 2; ++bj) { const pg8::f32x4 v0 = acc[ai][bj][m][0] * US, v1 = acc[ai][bj][m][1] * US;
                u32x4 w; w.x = pg8::cvt_pk_bf16(v0[0], v0[1]); w.y = pg8::cvt_pk_bf16(v0[2], v0[3]); w.z = pg8::cvt_pk_bf16(v1[0], v1[1]); w.w = pg8::cvt_pk_bf16(v1[2], v1[3]);
                *(PG8_LAS u32x4*)(wt + bj * 256) = w; }
            asm volatile("s_waitcnt lgkmcnt(0)" ::: "memory"); __builtin_amdgcn_s_barrier(); asm volatile("" ::: "memory");
            const u32x4 r0 = *(const PG8_LAS u32x4*)rt, r1 = *(const PG8_LAS u32x4*)(rt + 2 * RPITCH);
            asm volatile("s_waitcnt lgkmcnt(0)" ::: "memory"); __builtin_amdgcn_s_barrier(); asm volatile("" ::: "memory");
            bf16_t* d = obase + (size_t)(ai * 128 + m * 16) * ldc;
            *(u32x4*)d = r0; *(u32x4*)(d + (size_t)2 * ldc) = r1; }
    }
};
struct EpiDown8 {
    static constexpr bool PERM = true, AFTER_DRAIN = false;
    bf16_t* O; int ldc;
    __device__ __forceinline__ void operator()(const pg8::f32x4 (&acc)[2][2][4][2], const pg8::Unit& u, int wr, int wc, int fr, int fq) const {
        const int row0 = u.pm * 256 + wr * 64 + fr, col0 = u.pn * 256 + wc * 32 + 8 * fq;
        constexpr float US = 1.0f / (F8_SHID * F8_SW);
#pragma unroll
        for (int ai = 0; ai < 2; ++ai)
#pragma unroll
            for (int m = 0; m < 4; ++m) { bf16_t* rowp = O + (size_t)(row0 + ai * 128 + m * 16) * ldc + col0;
#pragma unroll
                for (int bj = 0; bj < 2; ++bj) { const pg8::f32x4 v0 = acc[ai][bj][m][0] * US, v1 = acc[ai][bj][m][1] * US;
                    u32x4 w; w.x = pg8::cvt_pk_bf16(v0[0], v0[1]); w.y = pg8::cvt_pk_bf16(v0[2], v0[3]); w.z = pg8::cvt_pk_bf16(v1[0], v1[1]); w.w = pg8::cvt_pk_bf16(v1[2], v1[3]);
                    *(u32x4*)(rowp + bj * 128) = w; } }
    }
};

DI float gelu_tanh(float x) { const float u2 = 2.0f * 0.7978845608028654f * (x + 0.044715f * x * x * x); const float e = fexp2(u2 * 1.4426950408889634f); return x - x * frcp(e + 1.0f); }
struct EpiGelu {
    static constexpr bool PERM = true, AFTER_DRAIN = false;
    bf16_t* O; int ldc; const float* bias;
    __device__ __forceinline__ void operator()(const pg8::f32x4 (&acc)[2][2][4][2], const pg8::Unit& u, int wr, int wc, int fr, int fq) const {
        const int row0 = u.pm * 256 + wr * 64 + fr, col0 = u.pn * 256 + wc * 32 + 8 * fq;
#pragma unroll
        for (int bj = 0; bj < 2; ++bj) { const f32x4 b0 = *(const f32x4*)(bias + col0 + bj * 128), b1 = *(const f32x4*)(bias + col0 + bj * 128 + 4);
#pragma unroll
            for (int ai = 0; ai < 2; ++ai)
#pragma unroll
                for (int m = 0; m < 4; ++m) { float h[8];
#pragma unroll
                    for (int i = 0; i < 4; ++i) { h[i] = gelu_tanh(acc[ai][bj][m][0][i] + b0[i]); h[4 + i] = gelu_tanh(acc[ai][bj][m][1][i] + b1[i]); }
                    *(u32x4*)(O + (size_t)(row0 + ai * 128 + m * 16) * ldc + col0 + bj * 128) = pack8(h); } }
    }
};


struct EpiPrep {
    static constexpr bool PERM = true, AFTER_DRAIN = false, STAGED = true;
    static constexpr int TPITCH = 272, HTILE = 32 * 272;
    unsigned char* ws_; const float* rs; float ws;
    template <class TT> __device__ __forceinline__ TT* wp(size_t off) const { return (TT*)(ws_ + off); }
    __device__ __forceinline__ static void st8(bf16_t* p, const f32x4 a, const f32x4 b) { u32x4 w; w.x = pk2(a[0], a[1]); w.y = pk2(a[2], a[3]); w.z = pk2(b[0], b[1]); w.w = pk2(b[2], b[3]); *(u32x4*)p = w; }
    __device__ __forceinline__ static f32x4 cv(const pg8::f32x4 v, float sc) { f32x4 r; r[0] = (float)__float_as_int(v[0]) * sc; r[1] = (float)__float_as_int(v[1]) * sc; r[2] = (float)__float_as_int(v[2]) * sc; r[3] = (float)__float_as_int(v[3]) * sc; return r; }
    __device__ __forceinline__ static int kind_of(int seg) {
        return (seg >= 6 && seg < 14) ? 2 : ((seg == 5 || (seg >= 22 && seg < 26) || (seg >= 34 && seg < 38) || seg == 40 || seg == 41 || seg == 44 || seg == 45) ? 1 : 0); }
    __device__ __forceinline__ void operator()(const pg8::f32x4 (&acc)[2][2][4][2], const pg8::Unit& u, int wr, int wc, int fr_in, int fq_in) const {
        int fr = fr_in, fq = fq_in; asm volatile("" : "+v"(fr), "+v"(fq));
        const int b = u.pm >> 3, tb = (u.pm & 7) * 256 + wr * 64 + fr;
        const float* rsp = rs + (size_t)b * S + tb; float nsc = rsp[0] * ws;
        if (u.pn == 23) {
            if (wc >= 2) return;
            const int dd = 8 * fq;
#pragma unroll
            for (int idx = 0; idx < 8; ++idx) { const int ai = idx >> 2, m = idx & 3, t = tb + ai * 128 + m * 16, row = b * S + t;
                const float sc = nsc; if (idx < 7) nsc = rsp[((idx + 1) >> 2) * 128 + ((idx + 1) & 3) * 16] * ws;
                const f32x4 a0 = cv(acc[ai][0][m][0], sc), a1 = cv(acc[ai][0][m][1], sc), c0 = cv(acc[ai][1][m][0], sc), c1 = cv(acc[ai][1][m][1], sc);
                if (wc == 0) { const float* cp = wp<float>(WS_COS64) + (size_t)t * 32 + dd; const float* sp = wp<float>(WS_SIN64) + (size_t)t * 32 + dd;
                    const f32x4 cs0 = *(const f32x4*)cp, cs1 = *(const f32x4*)(cp + 4), sn0 = *(const f32x4*)sp, sn1 = *(const f32x4*)(sp + 4);
                    bf16_t* d = wp<bf16_t>(WS_IK) + (size_t)row * 64 + dd; st8(d, a0 * cs0 - c0 * sn0, a1 * cs1 - c1 * sn1); st8(d + 32, c0 * cs0 + a0 * sn0, c1 * cs1 + a1 * sn1); }
                else { if (fq < 2) { float* d = wp<float>(WS_IW) + (size_t)row * 16 + dd; *(f32x4*)d = a0 * 0.03125f; *(f32x4*)(d + 4) = a1 * 0.03125f; }
                    if (fq < 3) { float* d = wp<float>(WS_GATE) + (size_t)row * 24 + dd; f32x4 g0, g1;
#pragma unroll
                        for (int i = 0; i < 4; ++i) { g0[i] = frcp(1.0f + fexp2(-1.4426950408889634f * c0[i])); g1[i] = frcp(1.0f + fexp2(-1.4426950408889634f * c1[i])); }
                        *(f32x4*)d = g0; *(f32x4*)(d + 4) = g1; } }
                __builtin_amdgcn_sched_barrier(0); }
            return;
        }
        const int seg = 2 * u.pn + (wc >> 1), kind = kind_of(seg);
        if (kind == 2) {
            const int head = 4 * (u.pn - 3) + wc, dd = 8 * fq;
#pragma unroll
            for (int idx = 0; idx < 8; ++idx) { const int ai = idx >> 2, m = idx & 3, t = tb + ai * 128 + m * 16;
                const float sc = nsc; if (idx < 7) nsc = rsp[((idx + 1) >> 2) * 128 + ((idx + 1) & 3) * 16] * ws;
                const f32x4 a0 = cv(acc[ai][0][m][0], sc), a1 = cv(acc[ai][0][m][1], sc), c0 = cv(acc[ai][1][m][0], sc), c1 = cv(acc[ai][1][m][1], sc);
                const float* cp = wp<float>(WS_COS64) + (size_t)t * 32 + dd; const float* sp = wp<float>(WS_SIN64) + (size_t)t * 32 + dd;
                const f32x4 cs0 = *(const f32x4*)cp, cs1 = *(const f32x4*)(cp + 4), sn0 = *(const f32x4*)sp, sn1 = *(const f32x4*)(sp + 4);
                bf16_t* d = wp<bf16_t>(WS_IQ) + (((size_t)b * 16 + head) * S + t) * 64 + dd; st8(d, a0 * cs0 - c0 * sn0, a1 * cs1 - c1 * sn1); st8(d + 32, c0 * cs0 + a0 * sn0, c1 * cs1 + a1 * sn1);
                __builtin_amdgcn_sched_barrier(0); }
            return;
        }
        const int d0 = 32 * (wc & 1) + 8 * fq;
        size_t dst = 0; int nh = 1, hd = 0;
        if (seg < 4) { dst = WS_AQ; nh = 4; hd = seg; } else if (seg == 4) { dst = WS_AK; } else if (seg == 5) { dst = WS_AVT; }
        else if (seg < 18) { dst = WS_BQ; nh = 4; hd = seg - 14; } else if (seg < 22) { dst = WS_BK1; nh = 4; hd = seg - 18; } else if (seg < 26) { dst = WS_BVT1; nh = 4; hd = seg - 22; }
        else if (seg < 34) { dst = WS_CQR; nh = 8; hd = seg - 26; } else if (seg < 36) { dst = WS_KC; nh = 2; hd = seg - 34; } else if (seg < 38) { dst = WS_VC; nh = 2; hd = seg - 36; }
        else if (seg < 40) { dst = WS_CKS; nh = 2; hd = seg - 38; } else if (seg < 42) { dst = WS_CVST; nh = 2; hd = seg - 40; } else if (seg < 44) { dst = WS_CKW; nh = 2; hd = seg - 42; } else { dst = WS_CVWT; nh = 2; hd = seg - 44; }
        bf16_t* dbase = wp<bf16_t>(dst) + ((size_t)(b * nh + hd) * S) * 128 + d0;
        const bool cq = (seg >= 26 && seg < 34);
        bf16_t* qbase = wp<bf16_t>(WS_CQ) + ((size_t)(b * 8 + (seg - 26)) * S) * 128 + d0;
        const float* cb = wp<float>(WS_COS128) + d0; const float* sb = wp<float>(WS_SIN128) + d0;
        f32x4 ncs0 = *(const f32x4*)(cb + (size_t)tb * 64), ncs1 = *(const f32x4*)(cb + (size_t)tb * 64 + 4), nsn0 = *(const f32x4*)(sb + (size_t)tb * 64), nsn1 = *(const f32x4*)(sb + (size_t)tb * 64 + 4);
#pragma unroll
        for (int idx = 0; idx < 8; ++idx) { const int ai = idx >> 2, m = idx & 3, t = tb + ai * 128 + m * 16;
            const float sc = nsc; if (idx < 7) nsc = rsp[((idx + 1) >> 2) * 128 + ((idx + 1) & 3) * 16] * ws;
            const f32x4 a0 = cv(acc[ai][0][m][0], sc), a1 = cv(acc[ai][0][m][1], sc), c0 = cv(acc[ai][1][m][0], sc), c1 = cv(acc[ai][1][m][1], sc);
            bf16_t* d = dbase + (size_t)t * 128;
            const f32x4 cs0 = ncs0, cs1 = ncs1, sn0 = nsn0, sn1 = nsn1;
            if (idx < 7) { const size_t tn = (size_t)(tb + ((idx + 1) >> 2) * 128 + ((idx + 1) & 3) * 16) * 64;
                ncs0 = *(const f32x4*)(cb + tn); ncs1 = *(const f32x4*)(cb + tn + 4); nsn0 = *(const f32x4*)(sb + tn); nsn1 = *(const f32x4*)(sb + tn + 4); }
            if (kind == 0) {
                st8(d, a0 * cs0 - c0 * sn0, a1 * cs1 - c1 * sn1); st8(d + 64, c0 * cs0 + a0 * sn0, c1 * cs1 + a1 * sn1);
                if (cq) { bf16_t* q = qbase + (size_t)t * 128; st8(q, a0 * QSCALE, a1 * QSCALE); st8(q + 64, c0 * QSCALE, c1 * QSCALE); } }
            else { st8(d, a0, a1); st8(d + 64, c0, c1); }
            __builtin_amdgcn_sched_barrier(0); }
    }
    __device__ __forceinline__ static void seg_dst(int seg, size_t& dst, int& nh, int& hd) {
        dst = 0; nh = 1; hd = 0;
        if (seg < 4) { dst = WS_AQ; nh = 4; hd = seg; } else if (seg == 4) { dst = WS_AK; } else if (seg == 5) { dst = WS_AVT; }
        else if (seg < 18) { dst = WS_BQ; nh = 4; hd = seg - 14; } else if (seg < 22) { dst = WS_BK1; nh = 4; hd = seg - 18; } else if (seg < 26) { dst = WS_BVT1; nh = 4; hd = seg - 22; }
        else if (seg < 34) { dst = WS_CQR; nh = 8; hd = seg - 26; } else if (seg < 36) { dst = WS_KC; nh = 2; hd = seg - 34; } else if (seg < 38) { dst = WS_VC; nh = 2; hd = seg - 36; }
        else if (seg < 40) { dst = WS_CKS; nh = 2; hd = seg - 38; } else if (seg < 42) { dst = WS_CVST; nh = 2; hd = seg - 40; } else if (seg < 44) { dst = WS_CKW; nh = 2; hd = seg - 42; } else { dst = WS_CVWT; nh = 2; hd = seg - 44; }
    }
    __device__ __forceinline__ void staged(const pg8::f32x4 (&acc)[2][2][4][2], const pg8::Unit& u, int wr, int wc, int fr_in, int fq_in, PG8_LAS unsigned char* ep, int wid, int lane_in) const {
        if (u.pn == 23 || (u.pn >= 3 && u.pn <= 6)) { (*this)(acc, u, wr, wc, fr_in, fq_in); return; }
        int fr = fr_in, fq = fq_in, lane = lane_in; asm volatile("" : "+v"(fr), "+v"(fq), "+v"(lane));
        const int b = u.pm >> 3, tb = (u.pm & 7) * 256 + wr * 64 + fr;
        const float* rsp = rs + (size_t)b * S + tb; float nsc = rsp[0] * ws;
        const int seg = 2 * u.pn + (wc >> 1), kind = kind_of(seg), d0 = 32 * (wc & 1) + 8 * fq;
        size_t dstR; int nhR, hdR; seg_dst(2 * u.pn + (wid >> 2), dstR, nhR, hdR);
        bf16_t* dbaseR = wp<bf16_t>(dstR) + ((size_t)(b * nhR + hdR) * S) * 128 + (lane & 15) * 8;
        const bool cq = (seg >= 26 && seg < 34);
        bf16_t* qbase = wp<bf16_t>(WS_CQ) + ((size_t)(b * 8 + (seg - 26)) * S) * 128 + d0;
        const float* cb = wp<float>(WS_COS128) + d0; const float* sb = wp<float>(WS_SIN128) + d0;
        f32x4 ncs0 = *(const f32x4*)(cb + (size_t)tb * 64), ncs1 = *(const f32x4*)(cb + (size_t)tb * 64 + 4), nsn0 = *(const f32x4*)(sb + (size_t)tb * 64), nsn1 = *(const f32x4*)(sb + (size_t)tb * 64 + 4);
        PG8_LAS unsigned char* wt = ep + (wc >> 1) * HTILE + (wr * 16 + fr) * TPITCH + d0 * 2;
        const PG8_LAS unsigned char* rt = ep + (wid >> 2) * HTILE + ((wid & 3) * 8 + (lane >> 4)) * TPITCH + (lane & 15) * 16;
        const int rrow = (wid & 3) * 8 + (lane >> 4), tR0 = (u.pm & 7) * 256 + (rrow >> 4) * 64 + (rrow & 15);
#pragma unroll
        for (int idx = 0; idx < 8; ++idx) { const int ai = idx >> 2, m = idx & 3, t = tb + ai * 128 + m * 16;
            const float sc = nsc; if (idx < 7) nsc = rsp[((idx + 1) >> 2) * 128 + ((idx + 1) & 3) * 16] * ws;
            const f32x4 a0 = cv(acc[ai][0][m][0], sc), a1 = cv(acc[ai][0][m][1], sc), c0 = cv(acc[ai][1][m][0], sc), c1 = cv(acc[ai][1][m][1], sc);
            const f32x4 cs0 = ncs0, cs1 = ncs1, sn0 = nsn0, sn1 = nsn1;
            if (idx < 7) { const size_t tn = (size_t)(tb + ((idx + 1) >> 2) * 128 + ((idx + 1) & 3) * 16) * 64;
                ncs0 = *(const f32x4*)(cb + tn); ncs1 = *(const f32x4*)(cb + tn + 4); nsn0 = *(const f32x4*)(sb + tn); nsn1 = *(const f32x4*)(sb + tn + 4); }
            f32x4 x0, x1, y0, y1;
            if (kind == 0) { x0 = a0 * cs0 - c0 * sn0; x1 = a1 * cs1 - c1 * sn1; y0 = c0 * cs0 + a0 * sn0; y1 = c1 * cs1 + a1 * sn1;
                if (cq) { bf16_t* q = qbase + (size_t)t * 128; st8(q, a0 * QSCALE, a1 * QSCALE); st8(q + 64, c0 * QSCALE, c1 * QSCALE); } }
            else { x0 = a0; x1 = a1; y0 = c0; y1 = c1; }
            u32x4 w1, w2; w1.x = pk2(x0[0], x0[1]); w1.y = pk2(x0[2], x0[3]); w1.z = pk2(x1[0], x1[1]); w1.w = pk2(x1[2], x1[3]); w2.x = pk2(y0[0], y0[1]); w2.y = pk2(y0[2], y0[3]); w2.z = pk2(y1[0], y1[1]); w2.w = pk2(y1[2], y1[3]);
            *(PG8_LAS u32x4*)wt = w1; *(PG8_LAS u32x4*)(wt + 128) = w2;
            asm volatile("s_waitcnt lgkmcnt(0)" ::: "memory"); __builtin_amdgcn_s_barrier(); asm volatile("" ::: "memory");
            const u32x4 v0 = *(const PG8_LAS u32x4*)rt, v1 = *(const PG8_LAS u32x4*)(rt + 4 * TPITCH);
            asm volatile("s_waitcnt lgkmcnt(0)" ::: "memory"); __builtin_amdgcn_s_barrier(); asm volatile("" ::: "memory");
            bf16_t* dR = dbaseR + (size_t)(tR0 + ai * 128 + m * 16) * 128;
            *(u32x4*)dR = v0; *(u32x4*)(dR + 4 * 128) = v1; }
    }
};

constexpr int TP = 136;
DI void lds_row8(const bf16_t* tile, int tok, int ch, float (&x)[8]) { const u32x4 w = *(const u32x4*)(tile + tok * TP + ch * 8); unpack8(w, x); }
template <int HD> DI void rope_chunk(const bf16_t* tile, int tok, int ch, int hc0, const float* cs, const float* sn, int t, float scale, float (&o)[8]) {
    constexpr int NCH = HD / 8, HALF_CH = NCH / 2;
    const int cc = ch - hc0; float own[8], par[8];
    lds_row8(tile, tok, ch, own); lds_row8(tile, tok, hc0 + (cc ^ HALF_CH), par);
    const int ci = (cc & (HALF_CH - 1)) * 8; const float* cp = cs + (size_t)t * (HD / 2) + ci; const float* sp = sn + (size_t)t * (HD / 2) + ci;
    const f32x4 c0 = *(const f32x4*)cp, c1 = *(const f32x4*)(cp + 4), s0 = *(const f32x4*)sp, s1 = *(const f32x4*)(sp + 4);
    const float sg = (cc < HALF_CH) ? -1.0f : 1.0f;
#pragma unroll
    for (int e = 0; e < 4; ++e) { o[e] = (own[e] * c0[e] + sg * par[e] * s0[e]) * scale; o[4 + e] = (own[4 + e] * c1[e] + sg * par[4 + e] * s1[e]) * scale; }
}
DI void phase_prep(const Ptrs& P, unsigned char* lds) {
    bf16_t* tile = (bf16_t*)lds;
    const bf16_t* Pm = wsp<bf16_t>(P, WS_P);
    const float* c128 = wsp<float>(P, WS_COS128); const float* s128 = wsp<float>(P, WS_SIN128); const float* c64 = wsp<float>(P, WS_COS64); const float* s64 = wsp<float>(P, WS_SIN64);
    const int tid = otid(), tok = tid >> 4, ch = tid & 15;
    for (int it = blockIdx.x; it < (T / 32) * NSEG; it += gridDim.x) {
        const int tl = it / NSEG, seg = it % NSEG, b = tl >> 6, s0 = (tl & 63) * 32, t = s0 + tok; const size_t row = (size_t)b * S + t;
        *(u32x4*)(tile + tok * TP + ch * 8) = *(const u32x4*)(Pm + row * NPAD + seg * 128 + ch * 8);
        __syncthreads();
        float o[8];
        if (seg < 4) { rope_chunk<128>(tile, tok, ch, 0, c128, s128, t, 1.0f, o); *(u32x4*)(wsp<bf16_t>(P, WS_AQ) + (((size_t)b * 4 + seg) * S + t) * 128 + ch * 8) = pack8(o); }
        else if (seg == 4) { rope_chunk<128>(tile, tok, ch, 0, c128, s128, t, 1.0f, o); *(u32x4*)(wsp<bf16_t>(P, WS_AK) + row * 128 + ch * 8) = pack8(o); }
        else if (seg == 5) { *(u32x4*)(wsp<bf16_t>(P, WS_AVT) + row * 128 + ch * 8) = *(const u32x4*)(tile + tok * TP + ch * 8); }
        else if (seg < 14) { const int hc0 = ch & 8, head = 2 * (seg - 6) + (ch >> 3); rope_chunk<64>(tile, tok, ch, hc0, c64, s64, t, 1.0f, o);
            *(u32x4*)(wsp<bf16_t>(P, WS_IQ) + (((size_t)b * 16 + head) * S + t) * 64 + (ch & 7) * 8) = pack8(o); }
        else if (seg < 18) { rope_chunk<128>(tile, tok, ch, 0, c128, s128, t, 1.0f, o); *(u32x4*)(wsp<bf16_t>(P, WS_BQ) + (((size_t)b * 4 + (seg - 14)) * S + t) * 128 + ch * 8) = pack8(o); }
        else if (seg < 22) { rope_chunk<128>(tile, tok, ch, 0, c128, s128, t, 1.0f, o); const u32x4 w = pack8(o); const size_t hb = ((size_t)b * 4 + (seg - 18)) * S;
            *(u32x4*)(wsp<bf16_t>(P, WS_BK1) + (hb + t) * 128 + ch * 8) = w;
            *(u32x4*)(wsp<bf16_t>(P, WS_BK4) + (hb + (t & 3) * 512 + (t >> 2)) * 128 + ch * 8) = w;
            *(u32x4*)(wsp<bf16_t>(P, WS_BK16) + (hb + (t & 15) * 128 + (t >> 4)) * 128 + ch * 8) = w; }
        else if (seg < 26) { const u32x4 w = *(const u32x4*)(tile + tok * TP + ch * 8); const size_t hb = ((size_t)b * 4 + (seg - 22)) * S;
            *(u32x4*)(wsp<bf16_t>(P, WS_BVT1) + (hb + t) * 128 + ch * 8) = w;
            *(u32x4*)(wsp<bf16_t>(P, WS_BVT4) + (hb + (t & 3) * 512 + (t >> 2)) * 128 + ch * 8) = w;
            *(u32x4*)(wsp<bf16_t>(P, WS_BVT16) + (hb + (t & 15) * 128 + (t >> 4)) * 128 + ch * 8) = w; }
        else if (seg < 34) { const size_t hb = (((size_t)b * 8 + (seg - 26)) * S + t) * 128 + ch * 8; float x[8]; lds_row8(tile, tok, ch, x);
#pragma unroll
            for (int e = 0; e < 8; ++e) x[e] *= QSCALE;
            *(u32x4*)(wsp<bf16_t>(P, WS_CQ) + hb) = pack8(x);
            rope_chunk<128>(tile, tok, ch, 0, c128, s128, t, 1.0f, o); *(u32x4*)(wsp<bf16_t>(P, WS_CQR) + hb) = pack8(o); }
        else if (seg < 36) { *(u32x4*)(wsp<bf16_t>(P, WS_KC) + (((size_t)b * 2 + (seg - 34)) * S + t) * 128 + ch * 8) = *(const u32x4*)(tile + tok * TP + ch * 8); }
        else if (seg < 38) { *(u32x4*)(wsp<bf16_t>(P, WS_VC) + (((size_t)b * 2 + (seg - 36)) * S + t) * 128 + ch * 8) = *(const u32x4*)(tile + tok * TP + ch * 8); }
        else if (seg < 40) { rope_chunk<128>(tile, tok, ch, 0, c128, s128, t, 1.0f, o); *(u32x4*)(wsp<bf16_t>(P, WS_CKS) + (((size_t)b * 2 + (seg - 38)) * S + t) * 128 + ch * 8) = pack8(o); }
        else if (seg < 42) { *(u32x4*)(wsp<bf16_t>(P, WS_CVST) + (((size_t)b * 2 + (seg - 40)) * S + t) * 128 + ch * 8) = *(const u32x4*)(tile + tok * TP + ch * 8); }
        else if (seg < 44) { rope_chunk<128>(tile, tok, ch, 0, c128, s128, t, 1.0f, o); *(u32x4*)(wsp<bf16_t>(P, WS_CKW) + (((size_t)b * 2 + (seg - 42)) * S + t) * 128 + ch * 8) = pack8(o); }
        else if (seg < 46) { *(u32x4*)(wsp<bf16_t>(P, WS_CVWT) + (((size_t)b * 2 + (seg - 44)) * S + t) * 128 + ch * 8) = *(const u32x4*)(tile + tok * TP + ch * 8); }
        else {
            if (ch < 8) { rope_chunk<64>(tile, tok, ch, 0, c64, s64, t, 1.0f, o); *(u32x4*)(wsp<bf16_t>(P, WS_IK) + row * 64 + ch * 8) = pack8(o); }
            else if (ch < 10) { float x[8]; lds_row8(tile, tok, ch, x); float* d = wsp<float>(P, WS_IW) + row * 16 + (ch - 8) * 8;
                *(f32x4*)d = (f32x4){x[0], x[1], x[2], x[3]} * 0.03125f; *(f32x4*)(d + 4) = (f32x4){x[4], x[5], x[6], x[7]} * 0.03125f; }
            else if (ch < 13) { float x[8]; lds_row8(tile, tok, ch, x); float* d = wsp<float>(P, WS_GATE) + row * 24 + (ch - 10) * 8;
#pragma unroll
                for (int e = 0; e < 8; ++e) x[e] = frcp(1.0f + fexp2(-1.4426950408889634f * x[e]));
                *(f32x4*)d = (f32x4){x[0], x[1], x[2], x[3]}; *(f32x4*)(d + 4) = (f32x4){x[4], x[5], x[6], x[7]}; }
        }
        __syncthreads();
    }
}

DI void a1_item(const Ptrs& P, int it) {
    const int wid = otid() >> 6, lane = otid() & 63, c = lane & 15, q4 = lane >> 4;
    const int b = it & 7; int rem = it >> 3, qblk = 15, np = 2;
    for (;; --qblk) { np = ((((qblk + 2) >> 1) + 1) >> 1); if (rem < np) break; rem -= np; }
    const int nk = (qblk + 2) >> 1, kb_lo = rem * nk / np, kb_hi = (rem + 1) * nk / np - 1, t0 = qblk * 128 + wid * 16, t = t0 + c;
    const bf16_t* IQ = wsp<bf16_t>(P, WS_IQ); const bf16_t* IK = wsp<bf16_t>(P, WS_IK); const float* IW = wsp<float>(P, WS_IW); float* SC = wsp<float>(P, WS_SC);
    bf16x8 iq[16][2]; float w[16];
#pragma unroll
    for (int h = 0; h < 16; ++h) { const bf16_t* p = IQ + (((size_t)b * 16 + h) * S + t) * 64 + 8 * q4; iq[h][0] = *(const bf16x8*)p; iq[h][1] = *(const bf16x8*)(p + 32); }
#pragma unroll
    for (int h4 = 0; h4 < 4; ++h4) { const f32x4 v = *(const f32x4*)(IW + ((size_t)b * S + t) * 16 + 4 * h4); w[4 * h4] = v[0]; w[4 * h4 + 1] = v[1]; w[4 * h4 + 2] = v[2]; w[4 * h4 + 3] = v[3]; }
    const int k16_lo = kb_lo * 16; int k16_hi = kb_hi * 16 + 15; const int lim = (t0 + 15) >> 4; if (k16_hi > lim) k16_hi = lim;
    const bf16_t* kp = IK + ((size_t)b * S + k16_lo * 16 + c) * 64 + 8 * q4;
    bf16x8 nk0 = *(const bf16x8*)kp, nk1 = *(const bf16x8*)(kp + 32);
    for (int k16 = k16_lo; k16 <= k16_hi; ++k16) {
        const bf16x8 k0 = nk0, k1 = nk1;
        if (k16 < k16_hi) { kp += 16 * 64; nk0 = *(const bf16x8*)kp; nk1 = *(const bf16x8*)(kp + 32); }
        f32x4 acc = (f32x4){0.f, 0.f, 0.f, 0.f};
#pragma unroll
        for (int h = 0; h < 16; ++h) { f32x4 s = (f32x4){0.f, 0.f, 0.f, 0.f}; s = MFMA16(k0, iq[h][0], s); s = MFMA16(k1, iq[h][1], s);
#pragma unroll
            for (int j = 0; j < 4; ++j) acc[j] += w[h] * fmaxf(s[j], 0.f); }
        *(f32x4*)(SC + ((size_t)b * S + t) * S + k16 * 16 + 4 * q4) = acc;
    }
}

DI void a2_load(const Ptrs& P, int row, int lane, unsigned (&raw)[32]) {
    const int t = row & (S - 1); const float* sc = wsp<float>(P, WS_SC) + (size_t)row * S;
#pragma unroll
    for (int i = 0; i < 32; ++i) { const int key = 64 * i + lane; raw[i] = __float_as_uint(sc[(key <= t) ? key : lane]); }
}
DI void a2_select(const Ptrs& P, int row  , int lane, const unsigned (&raw)[32]) {
    const int t = row & (S - 1);
    unsigned long long* bits = wsp<unsigned long long>(P, WS_BITS) + (size_t)row * 32;
    unsigned long long mine = 0ull;
    if (t < 256) {
#pragma unroll
        for (int i = 0; i < 32; ++i) { const unsigned long long m = __ballot(64 * i + lane <= t); if (lane == i) mine = m; }
    } else {
        unsigned u[32];
#pragma unroll
        for (int i = 0; i < 32; ++i) { const int key = 64 * i + lane; const unsigned bts = raw[i]; const unsigned x = (bts & 0x80000000u) ? ~bts : (bts | 0x80000000u); u[i] = (key <= t) ? x : 0u; }
        unsigned prefix = 0u; bool exact = false;
        for (int bit = 31; bit >= 0; --bit) { const unsigned cand = prefix | (1u << bit); int cnt = 0;
#pragma unroll
            for (int i = 0; i < 32; ++i) cnt += __builtin_popcountll(__ballot(u[i] >= cand));
            if (cnt >= 256) prefix = cand;
            if (cnt == 256) { exact = true; break; } }
        int cgt = 0;
        if (exact) prefix -= 1u;
#pragma unroll
        for (int i = 0; i < 32; ++i) cgt += __builtin_popcountll(__ballot(u[i] > prefix));
        const int need = 256 - cgt; int carried = 0; const unsigned long long lt = (lane == 0) ? 0ull : (~0ull >> (64 - lane));
#pragma unroll
        for (int i = 0; i < 32; ++i) { const bool eq = (u[i] == prefix); const unsigned long long meq = __ballot(eq);
            const int rk = carried + __builtin_popcountll(meq & lt); carried += __builtin_popcountll(meq);
            const bool sel = ((u[i] > prefix) || (eq && rk < need)) && (64 * i + lane <= t);
            const unsigned long long m = __ballot(sel); if (lane == i) mine = m; }
    }
    if (lane < 32) bits[lane] = mine;
}
DI void a2_item(const Ptrs& P, int j) {
    const int lane = otid() & 63, wid = otid() >> 6, base = (T - 1) - 32 * j - wid;
    unsigned ra[32], rb[32];
    a2_load(P, base, lane, ra);
    a2_load(P, base - 8, lane, rb);  a2_select(P, base, lane, ra);
    a2_load(P, base - 16, lane, ra); a2_select(P, base - 8, lane, rb);
    a2_load(P, base - 24, lane, rb); a2_select(P, base - 16, lane, ra);
    a2_select(P, base - 24, lane, rb);
}
DI void c1b_item(const Ptrs& P, int it) {
    const int wid = otid() >> 6, lane = otid() & 63, c = lane & 15, q4 = lane >> 4;
    const int kv = it >> 4, rt = (it & 15) * 8 + wid, row = 16 * rt + c, bg = row >> 7, cc = row & 127;
    const bf16_t* A = wsp<bf16_t>(P, kv ? WS_G1V : WS_G1K) + (size_t)row * 256 + 8 * q4;
    const bf16_t* Bt = wsp<bf16_t>(P, kv ? WS_CW2V : WS_CW2K) + (size_t)c * 256 + 8 * q4;
    f32x4 acc[8];
#pragma unroll
    for (int n = 0; n < 8; ++n) acc[n] = (f32x4){0.f, 0.f, 0.f, 0.f};
#pragma unroll
    for (int ks = 0; ks < 8; ++ks) { const bf16x8 a = *(const bf16x8*)(A + 32 * ks);
#pragma unroll
        for (int n = 0; n < 8; ++n) { const bf16x8 bt = *(const bf16x8*)(Bt + (size_t)(16 * n) * 256 + 32 * ks); acc[n] = MFMA16(bt, a, acc[n]); } }
    const bool zr = (cc == 127);
    if (!kv) { bf16_t* dst = wsp<bf16_t>(P, WS_KCC) + ((size_t)bg * 128 + cc) * 128;
#pragma unroll
        for (int n = 0; n < 8; ++n) { u32x2 w; w.x = zr ? 0u : pk2(acc[n][0], acc[n][1]); w.y = zr ? 0u : pk2(acc[n][2], acc[n][3]); *(u32x2*)(dst + 16 * n + 4 * q4) = w; }
    } else { bf16_t* dst = wsp<bf16_t>(P, WS_VCT) + ((size_t)bg * 4 + (cc >> 5)) * 4096 + (cc & 31);
#pragma unroll
        for (int n = 0; n < 8; ++n)
#pragma unroll
            for (int j = 0; j < 4; ++j) dst[(16 * n + 4 * q4 + j) * 32] = zr ? (bf16_t)0 : (bf16_t)(pk2(acc[n][j], 0.f) & 0xffffu);
    }
}

DI void load_q(bf16x8 (&qf)[4], const bf16_t* qrow, int q4) {
#pragma unroll
    for (int ks = 0; ks < 4; ++ks) qf[ks] = *(const bf16x8*)(qrow + 32 * ks + 8 * q4);
}
DI void c2_item(const Ptrs& P, int it, unsigned char* lds) {
    const int wid = otid() >> 6, lane = otid() & 63, c = lane & 15, q4 = lane >> 4, r16 = lane & 15;
    const int bg = it >> 4, b = bg >> 1, g = bg & 1, t0 = (it & 15) * 128 + wid * 16, t = t0 + c, kr0 = 8 * (r16 >> 2) + (r16 & 3);
    constexpr int KP = 136;
    bf16_t* Kl = (bf16_t*)(lds + 32768); bf16_t* Vl = (bf16_t*)(lds + 32768 + 128 * KP * 2);
    { const int tid = otid(); const bf16_t* Kg = wsp<bf16_t>(P, WS_KCC) + (size_t)bg * 128 * 128; const bf16_t* Vg = wsp<bf16_t>(P, WS_VCT) + (size_t)bg * 4 * 4096;
      __syncthreads();
#pragma unroll
      for (int i = 0; i < 4; ++i) { const int e = (tid + 512 * i) * 8, row = e >> 7, col = e & 127; *(u32x4*)(Kl + row * KP + col) = *(const u32x4*)(Kg + e); *(u32x4*)(Vl + e) = *(const u32x4*)(Vg + e); }
      __syncthreads(); }
    const LAS bf16_t* KCC = (const LAS bf16_t*)Kl + kr0 * KP + 8 * q4; const LAS bf16_t* VCT = (const LAS bf16_t*)Vl + r16 * 32 + 8 * q4;
    const float* gates = wsp<float>(P, WS_GATE) + ((size_t)b * S + t) * 24;
    const int cmax = (t >= 31) ? ((t - 31) >> 4) : -1;
    f32x4 ia[4][2];
#pragma unroll
    for (int kt = 0; kt < 4; ++kt) { ia[kt][0] = (f32x4){0.f, 0.f, 0.f, 0.f}; ia[kt][1] = (f32x4){0.f, 0.f, 0.f, 0.f}; }
    bf16x8 qfa[4][4]; float g0a[4];
#pragma unroll
    for (int rr = 0; rr < 4; ++rr) { load_q(qfa[rr], wsp<bf16_t>(P, WS_CQ) + (((size_t)b * 8 + g * 4 + rr) * S + t) * 128, q4); g0a[rr] = gates[(g * 4 + rr) * 3 + 0]; }
#pragma unroll
    for (int rr = 0; rr < 4; ++rr) {
        const int hh = g * 4 + rr;
        asm volatile("" : "+v"(KCC), "+v"(VCT));
        bf16x8 qf[4];
#pragma unroll
        for (int ks = 0; ks < 4; ++ks) qf[ks] = qfa[rr][ks];
        f32x4 s[4][2]; float mx = NEG;
#pragma unroll
        for (int kt = 0; kt < 4; ++kt)
#pragma unroll
            for (int sub = 0; sub < 2; ++sub) { f32x4 a = (f32x4){0.f, 0.f, 0.f, 0.f};
#pragma unroll
                for (int ks = 0; ks < 4; ++ks) { const bf16x8 kf = *(const LAS bf16x8*)(KCC + (32 * kt + 4 * sub) * KP + 32 * ks); a = MFMA16(kf, qf[ks], a); }
#pragma unroll
                for (int j = 0; j < 4; ++j) { const int cc = 32 * kt + 8 * q4 + 4 * sub + j; const bool ok = (cc <= cmax) && (cc < 127); a[j] = ok ? a[j] : NEG; mx = fmaxf(mx, a[j]); }
                s[kt][sub] = a; __builtin_amdgcn_sched_barrier(0); }
        mx = fmaxf(mx, __shfl_xor(mx, 16)); mx = fmaxf(mx, __shfl_xor(mx, 32));
        float den = 0.f;
#pragma unroll
        for (int kt = 0; kt < 4; ++kt)
#pragma unroll
            for (int sub = 0; sub < 2; ++sub)
#pragma unroll
                for (int j = 0; j < 4; ++j) { const float e = (s[kt][sub][j] > -5.0e29f) ? fexp2(s[kt][sub][j] - mx) : 0.f; s[kt][sub][j] = e; den += e; }
        den += __shfl_xor(den, 16); den += __shfl_xor(den, 32);
        const float inv = den > 0.f ? 1.0f / den : 0.f;
        f32x4 o[8];
#pragma unroll
        for (int db = 0; db < 8; ++db) o[db] = (f32x4){0.f, 0.f, 0.f, 0.f};
#pragma unroll
        for (int kt = 0; kt < 4; ++kt) { float p[8];
#pragma unroll
            for (int sub = 0; sub < 2; ++sub) { s[kt][sub] = s[kt][sub] * inv; ia[kt][sub] += s[kt][sub];
#pragma unroll
                for (int j = 0; j < 4; ++j) p[4 * sub + j] = s[kt][sub][j]; }
            const u32x4 pw = pack8(p); const bf16x8 pb = __builtin_bit_cast(bf16x8, pw);
#pragma unroll
            for (int db = 0; db < 8; ++db) { const bf16x8 vf = *(const LAS bf16x8*)(VCT + kt * 4096 + (16 * db) * 32); o[db] = MFMA16(vf, pb, o[db]); }
            __builtin_amdgcn_sched_barrier(0); }
        const float g0 = g0a[rr]; bf16_t* dst = wsp<bf16_t>(P, WS_OC) + ((size_t)b * S + t) * 1024 + hh * 128;
#pragma unroll
        for (int db = 0; db < 8; ++db) { u32x2 w; w.x = pk2(o[db][0] * g0, o[db][1] * g0); w.y = pk2(o[db][2] * g0, o[db][3] * g0); *(u32x2*)(dst + 16 * db + 4 * q4) = w; }
    }
    float* impw = (float*)lds + wid * (16 * 33);
#pragma unroll
    for (int kt = 0; kt < 4; ++kt) {
        const float own = __shfl(ia[kt][1][3], (lane + 48) & 63);
        const float wrp = (kt > 0) ? __shfl(ia[kt > 0 ? kt - 1 : 0][1][3], (lane + 48) & 63) : 0.f;
        const float prev0 = (q4 == 0) ? wrp : own;
        const float v0 = (ia[kt][0][0] + ia[kt][0][1]) + (ia[kt][0][2] + ia[kt][0][3]) + prev0;
        const float v1 = (ia[kt][1][0] + ia[kt][1][1]) + (ia[kt][1][2] + ia[kt][1][3]) + ia[kt][0][3];
        impw[c * 33 + 8 * kt + 2 * q4] = v0; impw[c * 33 + 8 * kt + 2 * q4 + 1] = v1;
    }
    asm volatile("s_waitcnt lgkmcnt(0)" ::: "memory");
    __builtin_amdgcn_wave_barrier();
    const int cur = t >> 6; unsigned key[32];
#pragma unroll
    for (int n = 0; n < 32; ++n) { const float x = impw[c * 33 + n]; const float v = (n > cur) ? -__builtin_inff() : ((n == 0 || n == cur || n + 1 == cur) ? __builtin_inff() : x);
        const unsigned bts = __float_as_uint(v); const unsigned o = (bts & 0x80000000u) ? ~bts : (bts | 0x80000000u); key[n] = (o & ~31u) | (unsigned)(31 - n); }
    unsigned selbits = 0u;
#pragma unroll
    for (int e = 0; e < 8; ++e) { const int myn = 8 * q4 + e; const float x = impw[c * 33 + myn];
        const float v = (myn > cur) ? -__builtin_inff() : ((myn == 0 || myn == cur || myn + 1 == cur) ? __builtin_inff() : x);
        const unsigned bts = __float_as_uint(v); const unsigned o = (bts & 0x80000000u) ? ~bts : (bts | 0x80000000u); const unsigned km = (o & ~31u) | (unsigned)(31 - myn);
        int rank = 0;
#pragma unroll
        for (int n = 0; n < 32; ++n) rank += (key[n] > km) ? 1 : 0;
        if (rank < 16) selbits |= 1u << myn; }
    selbits |= __shfl_xor(selbits, 16); selbits |= __shfl_xor(selbits, 32);
    if (q4 == 0) wsp<unsigned>(P, WS_SEL)[(size_t)bg * S + t] = selbits;
    __builtin_amdgcn_wave_barrier();
}


enum { FK_B1 = 0, FK_B4 = 1, FK_B16 = 2, FK_C5 = 3, FK_C4 = 4, FK_A3 = 5 };
DI fa::BlockRef fa_ref(const Ptrs& P, int kind, int idx) {
    fa::BlockRef r; r.LSE = nullptr; r.aux = nullptr; r.lstr = 0; r.m = S; r.ecode = 0;
    if (kind <= FK_B16) {
        const int bh = idx & 31, pb = idx >> 5, b = bh >> 2, h = bh & 3; const size_t hb = (size_t)bh * S * 128, tb = (size_t)b * S;
        r.Q = wsp<bf16_t>(P, WS_BQ) + hb;
        r.K = wsp<bf16_t>(P, WS_BK1) + hb; r.V = wsp<bf16_t>(P, WS_BVT1) + hb;
        r.O = wsp<bf16_t>(P, kind == FK_B1 ? WS_OB1 : (kind == FK_B4 ? WS_OB4 : WS_OB16)) + tb * 512 + h * 128; r.ldo = 512;
        r.LSE = wsp<float>(P, kind == FK_B1 ? WS_LSE1 : (kind == FK_B4 ? WS_LSE4 : WS_LSE16)) + tb * 4 + h; r.lstr = 4;
        r.P0 = pb * 256; r.mode = fa::M_WIN; r.Wu = 129; r.m = (kind == FK_B1) ? S : (kind == FK_B4 ? S / 4 : S / 16);
        if (kind == FK_B1) { r.O = wsp<bf16_t>(P, WS_MIX) + tb * DM + 512 + h * 128; r.ldo = DM; r.LSE = nullptr; r.ecode = 3 | (h << 4) | (b << 8); }
    } else if (kind == FK_C5 || kind == FK_C4) {
        const int bhh = idx & 63, qb = 7 - (idx >> 6), b = bhh >> 3, hh = bhh & 7, g = hh >> 2; const size_t gb = ((size_t)b * 2 + g) * S * 128, tb = (size_t)b * S;
        r.Q = wsp<bf16_t>(P, WS_CQR) + (size_t)bhh * S * 128;
        r.K = wsp<bf16_t>(P, kind == FK_C5 ? WS_CKW : WS_CKS) + gb; r.V = wsp<bf16_t>(P, kind == FK_C5 ? WS_CVWT : WS_CVST) + gb;
        r.O = wsp<bf16_t>(P, kind == FK_C5 ? WS_OWIN : WS_OSLC) + tb * 1024 + hh * 128; r.ldo = 1024;
        r.P0 = qb * 256; r.mode = (kind == FK_C5) ? fa::M_WIN : fa::M_SEL; r.Wu = (kind == FK_C5) ? 512 : 0x40000000;
        r.aux = wsp<unsigned>(P, WS_SEL) + ((size_t)b * 2 + g) * S;
        if (kind == FK_C4) { r.O = wsp<bf16_t>(P, WS_MIX) + tb * DM + 1024 + hh * 128; r.ldo = DM; r.ecode = 2 | (hh << 4) | (b << 8); }
    } else {
        const int bh = idx & 31, qb = 7 - (idx >> 5), b = bh >> 2, h = bh & 3; const size_t tb = (size_t)b * S;
        r.Q = wsp<bf16_t>(P, WS_AQ) + (size_t)bh * S * 128; r.K = wsp<bf16_t>(P, WS_AK) + tb * 128; r.V = wsp<bf16_t>(P, WS_AVT) + tb * 128;
        r.O = wsp<bf16_t>(P, WS_MIX) + tb * DM + h * 128; r.ldo = DM;
        r.P0 = qb * 256; r.mode = fa::M_BITS; r.Wu = 0x40000000; r.aux = wsp<unsigned>(P, WS_BITS) + tb * 64;
    }
    return r;
}
struct FaList { int kind[4]; int n[4]; int ng; };
DI fa::BlockRef fa_list_ref(const Ptrs& P, const FaList& L, int i) {
    int g = 0;
#pragma unroll
    for (int k = 0; k < 3; ++k) if (g == k && k + 1 < L.ng && i >= L.n[k]) { i -= L.n[k]; g = k + 1; }
    const int kind = (g == 0) ? L.kind[0] : (g == 1 ? L.kind[1] : (g == 2 ? L.kind[2] : L.kind[3]));
    return fa_ref(P, kind, i);
}
struct FaNext {
    const Ptrs* P; const FaList* L; unsigned* ctr; unsigned char* lds; int total, tid; bool last;
    DI fa::BlockRef operator()(const fa::BlockRef& cur) { const int ni = q_next(ctr, lds, tid); last = ni >= total; return last ? cur : fa_list_ref(*P, *L, ni); }
};
DI void fa_stream(const Ptrs& P, const FaList& L, unsigned* ctr, unsigned char* lds) {
    const int tid = otid();
    int total = 0;
#pragma unroll
    for (int k = 0; k < 4; ++k) if (k < L.ng) total += L.n[k];
    const int i = q_next(ctr, lds, tid);
    if (i >= total) return;
    fa::BlockRef cur = fa_list_ref(P, L, i), nxt = cur;
    fa::Seam Sm;
    fa::prime(cur, (char*)lds, Sm, tid);
    fa::EpiPtrs ep; ep.oc = wsp<bf16_t>(P, WS_OC); ep.owin = wsp<bf16_t>(P, WS_OWIN); ep.gate = wsp<float>(P, WS_GATE); ep.ob4 = wsp<bf16_t>(P, WS_OB4); ep.ob16 = wsp<bf16_t>(P, WS_OB16); ep.lse4 = wsp<float>(P, WS_LSE4); ep.lse16 = wsp<float>(P, WS_LSE16);
    FaNext nf; nf.P = &P; nf.L = &L; nf.ctr = ctr; nf.lds = lds; nf.total = total; nf.tid = tid; nf.last = false;
    for (;;) {
        fa::block(cur, nxt, nf, ep, (char*)lds, Sm, tid);
        if (nf.last) break;
        cur = nxt;
    }
}

DI void phase_merge(const Ptrs& P) {
    const int tid = otid(), lane = tid & 63, gw = blockIdx.x * 8 + (tid >> 6), ngw = gridDim.x * 8;
    for (int row = gw; row < T; row += ngw) {
        bf16_t* dst = wsp<bf16_t>(P, WS_MIX) + (size_t)row * DM;
        {
            const int h = lane >> 4, col = 8 * lane;
            const float l1 = wsp<float>(P, WS_LSE1)[(size_t)row * 4 + h], l4 = wsp<float>(P, WS_LSE4)[(size_t)row * 4 + h], l16 = wsp<float>(P, WS_LSE16)[(size_t)row * 4 + h];
            const float mm = fmaxf(l1, fmaxf(l4, l16)), w1 = fexp2(l1 - mm), w4 = fexp2(l4 - mm), w16 = fexp2(l16 - mm), wi = 1.0f / (w1 + w4 + w16);
            float a[8], b4[8], c16[8], o[8];
            unpack8(*(const u32x4*)(wsp<bf16_t>(P, WS_OB1) + (size_t)row * 512 + col), a); unpack8(*(const u32x4*)(wsp<bf16_t>(P, WS_OB4) + (size_t)row * 512 + col), b4);
            unpack8(*(const u32x4*)(wsp<bf16_t>(P, WS_OB16) + (size_t)row * 512 + col), c16);
#pragma unroll
            for (int e = 0; e < 8; ++e) o[e] = (a[e] * w1 + b4[e] * w4 + c16[e] * w16) * wi;
            *(u32x4*)(dst + 512 + col) = pack8(o);
        }
#pragma unroll
        for (int j = 0; j < 2; ++j) {
            const int col = 8 * (lane + 64 * j), hh = col >> 7;
            const float* gt = wsp<float>(P, WS_GATE) + (size_t)row * 24 + hh * 3; const float g1 = gt[1], g2 = gt[2];
            float a[8], b[8], c[8], o[8];
            unpack8(*(const u32x4*)(wsp<bf16_t>(P, WS_OC) + (size_t)row * 1024 + col), a); unpack8(*(const u32x4*)(wsp<bf16_t>(P, WS_OSLC) + (size_t)row * 1024 + col), b);
            unpack8(*(const u32x4*)(wsp<bf16_t>(P, WS_OWIN) + (size_t)row * 1024 + col), c);
#pragma unroll
            for (int e = 0; e < 8; ++e) o[e] = a[e] + g1 * b[e] + g2 * c[e];
            *(u32x4*)(dst + 1024 + col) = pack8(o);
        }
    }
}

constexpr int NPH = 13;
constexpr int NPHASES = 1 + DEPTH * NPH;
struct Args { const float* in[16]; float* out; unsigned char* ws; int ph_lo, ph_hi; };

__global__ void __launch_bounds__(512, 2) fwd(Args a) {
    extern __shared__ __attribute__((aligned(16))) unsigned char lds[];
    Ptrs P;
#pragma unroll
    for (int i = 0; i < 16; ++i) P.in[i] = a.in[i];
    P.out = a.out; P.ws = a.ws;
    const int lo = a.ph_lo, hi = a.ph_hi;
    volatile LAS unsigned* bst = (volatile LAS unsigned*)((LAS unsigned char*)lds + LDS_BAR_OFF);
    if (otid() < 4) bst[otid()] = 0u;
    __syncthreads();
    XcdBarrier bar; bar.bar = (unsigned*)(P.ws + WS_CTL); bar.x = 0; bar.st = bst;
    if (hi - lo > 1) bar = xcd_barrier_post((unsigned*)(P.ws + WS_CTL), bst);
#define IN(k) (lo <= (k) && (k) < hi)
#define SEAM(k) do { if (IN(k) && IN((k) + 1)) xcd_barrier(bar); } while (0)
    if (IN(0)) { phase_rope_tables(P); for (int it = blockIdx.x; it < WMAX_ITEMS; it += gridDim.x) wmax_in_item(P, 0, it, lds); }
    SEAM(0);
    for (int layer = 0; layer < DEPTH; ++layer) {
        const int pb = 1 + layer * NPH;
        const float* xcur = (layer == 0) ? P.in[0] : P.out;
        if (layer == 0) { if (IN(pb + 0)) { phase_wconv(P, layer, lds); phase_norm<false, false, 2>(P.in[0], nullptr, nullptr, nullptr, P.in[12], wsp<bf16_t>(P, WS_H)); }
            SEAM(pb + 0); }
#if MK_DUP_PH == 100
        phase_wconv(P, layer, lds); xcd_barrier(bar);
#endif
        if (IN(pb + 1)) { pg8::Gemm g{wsp<bf16_t>(P, WS_H), wsp<bf16_t>(P, WS_WIN), T, NPAD, DM / 2}; pg8::StaticOrder So; So.init(T, NPAD, gridDim.x, blockIdx.x);
            const float wmx = __uint_as_float(__builtin_amdgcn_readfirstlane(__hip_atomic_load((unsigned*)(P.ws + WS_CTL) + CTL_WMAX + layer * 64 + 1, __ATOMIC_RELAXED, __HIP_MEMORY_SCOPE_AGENT)));
            EpiPrep E{P.ws, (const float*)(P.ws + WS_H + (size_t)T * DM), fmaxf(wmx, 1e-30f) * (1.0f / 127.0f)}; pg8::gemm_phase<EpiPrep, pg8::StaticOrder, false, 2>((LAS unsigned char*)lds, g, So, E, nullptr); }
        SEAM(pb + 1);
#if MK_DUP_PH == 101
        { pg8::Gemm g{wsp<bf16_t>(P, WS_H), wsp<bf16_t>(P, WS_WIN), T, NPAD, DM}; pg8::StaticOrder So; So.init(T, NPAD, gridDim.x, blockIdx.x);
            EpiPrep E{P.ws}; pg8::gemm_phase<EpiPrep, pg8::StaticOrder, false>((LAS unsigned char*)lds, g, So, E, nullptr); } xcd_barrier(bar);
#endif
#define ATT_BODY \
          \
        if (ATT_IN(3)) { unsigned* ctr = (unsigned*)(P.ws + WS_CTL) + 4096 + (layer * 16 + ATT_CB + 0) * 64; \
            if (ATT_PART(1) && blockIdx.x < 16) { const int kv = blockIdx.x >> 3; pg8::Gemm g{wsp<bf16_t>(P, kv ? WS_VC : WS_KC), wsp<bf16_t>(P, kv ? WS_CW1V : WS_CW1K), 2048, 256, 4096, 2048}; \
                pg8::StaticOrder So; So.init(2048, 256, 8, blockIdx.x & 7); EpiGelu E{wsp<bf16_t>(P, kv ? WS_G1V : WS_G1K), 256, wsp<float>(P, WS_CB1) + kv * 256}; \
                pg8::gemm_phase<EpiGelu, pg8::StaticOrder, false>((LAS unsigned char*)lds, g, So, E, nullptr); } \
            FaList L; L.ng = 2; L.kind[0] = FK_B4; L.n[0] = 256; L.kind[1] = FK_B16; L.n[1] = 256; L.kind[2] = 0; L.n[2] = 0; L.kind[3] = 0; L.n[3] = 0; \
            if (ATT_PART(2)) fa_stream(P, L, ctr, lds); \
            if (ATT_PART(3)) for (int it = q_next(ctr + 64, lds, otid()); it < NB * 40; it = q_next(ctr + 64, lds, otid())) a1_item(P, it); \
            conv_filler(P, layer, lds, (unsigned*)(P.ws + WS_CTL) + 8192 + (layer * 4 + 0) * 64, 0); } \
        ATT_SEAM(3); \
          \
        if (ATT_IN(4)) { unsigned* ctr = (unsigned*)(P.ws + WS_CTL) + 4096 + (layer * 16 + ATT_CB + 2) * 64; \
            FaList L; L.ng = 1; L.kind[0] = FK_B1; L.n[0] = 256; L.kind[1] = 0; L.n[1] = 0; L.kind[2] = 0; L.n[2] = 0; L.kind[3] = 0; L.n[3] = 0; \
            if (ATT_PART(2)) fa_stream(P, L, ctr, lds); \
            if (ATT_PART(3)) for (int it = q_next(ctr + 64, lds, otid()); it < T / 32 + 32; it = q_next(ctr + 64, lds, otid())) { if (it < 32) c1b_item(P, it); else a2_item(P, it - 32); } \
            conv_filler(P, layer, lds, (unsigned*)(P.ws + WS_CTL) + 8192 + (layer * 4 + 1) * 64, 1); } \
        ATT_SEAM(4); \
          \
        if (ATT_IN(5)) { unsigned* ctr = (unsigned*)(P.ws + WS_CTL) + 4096 + (layer * 16 + ATT_CB + 4) * 64; \
            FaList L; L.ng = 2; L.kind[0] = FK_A3; L.n[0] = 256; L.kind[1] = FK_C5; L.n[1] = 512; L.kind[2] = 0; L.n[2] = 0; L.kind[3] = 0; L.n[3] = 0; \
            if (ATT_PART(3)) for (int it = q_next(ctr + 64, lds, otid()); it < 256; it = q_next(ctr + 64, lds, otid())) c2_item(P, it, lds);     \
            if (ATT_PART(2)) fa_stream(P, L, ctr, lds); \
            conv_filler(P, layer, lds, (unsigned*)(P.ws + WS_CTL) + 8192 + (layer * 4 + 2) * 64, 2); } \
        ATT_SEAM(5); \
          \
        if (ATT_IN(6)) { unsigned* ctr = (unsigned*)(P.ws + WS_CTL) + 4096 + (layer * 16 + ATT_CB + 6) * 64; \
            FaList L; L.ng = 1; L.kind[0] = FK_C4; L.n[0] = 512; L.kind[1] = 0; L.n[1] = 0; L.kind[2] = 0; L.n[2] = 0; L.kind[3] = 0; L.n[3] = 0; \
            if (ATT_PART(2)) fa_stream(P, L, ctr, lds); \
            conv_filler(P, layer, lds, (unsigned*)(P.ws + WS_CTL) + 8192 + (layer * 4 + 3) * 64, 3); } \
        ATT_SEAM(6); \
          \

#define ATT_IN(k) IN(pb + (k))
#define ATT_SEAM(k) SEAM(pb + (k))
#define ATT_CB 0
#define ATT_PART(p) true
        ATT_BODY
#undef ATT_IN
#undef ATT_SEAM
#undef ATT_CB
#undef ATT_PART
#if MK_DUP_PH >= 30 && MK_DUP_PH <= 79
#define ATT_IN(k) ((k) == MK_DUP_PH / 10)
#define ATT_SEAM(k) do { if ((k) == MK_DUP_PH / 10) xcd_barrier(bar); } while (0)
#define ATT_CB 8
#define ATT_PART(p) ((p) == MK_DUP_PH % 10)
        ATT_BODY
#undef ATT_IN
#undef ATT_SEAM
#undef ATT_CB
#undef ATT_PART
#endif
#if MK_DUP_PH >= 3 && MK_DUP_PH <= 7
#define ATT_IN(k) ((k) == MK_DUP_PH)
#define ATT_SEAM(k) do { if ((k) == MK_DUP_PH) xcd_barrier(bar); } while (0)
#define ATT_CB 8
#define ATT_PART(p) true
        ATT_BODY
#undef ATT_IN
#undef ATT_SEAM
#undef ATT_CB
#undef ATT_PART
#endif
        if (IN(pb + 8)) { pg8::Gemm g{wsp<bf16_t>(P, WS_MIX), wsp<bf16_t>(P, WS_WOUT), T, DM, DM}; pg8::StaticOrder So; So.init(T, DM, gridDim.x, blockIdx.x);
            EpiRowsBf16 E{wsp<bf16_t>(P, WS_Y), DM, 1.0f}; pg8::gemm_phase<EpiRowsBf16, pg8::StaticOrder, false>((LAS unsigned char*)lds, g, So, E, nullptr); }
        SEAM(pb + 8);
#if MK_DUP_PH == 108
        { pg8::Gemm g{wsp<bf16_t>(P, WS_MIX), wsp<bf16_t>(P, WS_WOUT), T, DM, DM}; pg8::StaticOrder So; So.init(T, DM, gridDim.x, blockIdx.x);
            pg8::EpiBf16<0> E{wsp<bf16_t>(P, WS_Y), DM, nullptr, 0, 0}; pg8::gemm_phase<pg8::EpiBf16<0>, pg8::StaticOrder, false>((LAS unsigned char*)lds, g, So, E, nullptr); } xcd_barrier(bar);
#endif
        if (IN(pb + 9)) { if (layer == 0) phase_norm<false, true, 2>(P.in[0], wsp<bf16_t>(P, WS_XB), wsp<bf16_t>(P, WS_Y), P.in[13] + (size_t)layer * DM, P.in[14] + (size_t)layer * DM, wsp<bf16_t>(P, WS_H));
            else phase_norm<true, true, 2>(wsp<bf16_t>(P, WS_XB), wsp<bf16_t>(P, WS_XB), wsp<bf16_t>(P, WS_Y), P.in[13] + (size_t)layer * DM, P.in[14] + (size_t)layer * DM, wsp<bf16_t>(P, WS_H)); }
        SEAM(pb + 9);
#if MK_DUP_PH == 109
        phase_norm<true, true>(wsp<bf16_t>(P, WS_XB), wsp<bf16_t>(P, WS_BIG), wsp<bf16_t>(P, WS_Y), P.in[13] + (size_t)layer * DM, P.in[14] + (size_t)layer * DM, wsp<bf16_t>(P, WS_MIX)); xcd_barrier(bar);
#endif
        if (IN(pb + 10)) { pg8::Gemm g{wsp<bf16_t>(P, WS_H), wsp<bf16_t>(P, WS_WGU), T, NGU, DM / 2}; pg8::StaticOrder So; So.init(T, NGU, gridDim.x, blockIdx.x);
            const float wmx = __uint_as_float(__builtin_amdgcn_readfirstlane(__hip_atomic_load((unsigned*)(P.ws + WS_CTL) + CTL_WMAX + layer * 64, __ATOMIC_RELAXED, __HIP_MEMORY_SCOPE_AGENT)));
            EpiSwigluI8 E{wsp<unsigned char>(P, WS_HID), FF, (const float*)(P.ws + WS_H + (size_t)T * DM), fmaxf(wmx, 1e-30f) * (1.0f / 127.0f)}; pg8::gemm_phase<EpiSwigluI8, pg8::StaticOrder, false, 2>((LAS unsigned char*)lds, g, So, E, nullptr); }
        SEAM(pb + 10);
#if MK_DUP_PH == 110
        { pg8::Gemm g{wsp<bf16_t>(P, WS_H), wsp<bf16_t>(P, WS_WGU), T, NGU, DM}; pg8::StaticOrder So; So.init(T, NGU, gridDim.x, blockIdx.x);
            EpiSwiglu E{wsp<bf16_t>(P, WS_HID), FF}; pg8::gemm_phase<EpiSwiglu, pg8::StaticOrder, false>((LAS unsigned char*)lds, g, So, E, nullptr); } xcd_barrier(bar);
#endif
        if (IN(pb + 11)) { pg8::Gemm g{wsp<bf16_t>(P, WS_HID), wsp<bf16_t>(P, WS_WDN), T, DM, FF / 2}; pg8::StaticOrder So; So.init(T, DM, gridDim.x, blockIdx.x);
            EpiRowsBf16 E{wsp<bf16_t>(P, WS_Y), DM, 1.0f / (F8_SHID * F8_SW)}; pg8::gemm_phase<EpiRowsBf16, pg8::StaticOrder, false, 1>((LAS unsigned char*)lds, g, So, E, nullptr); }
        SEAM(pb + 11);
#if MK_DUP_PH == 111
        { pg8::Gemm g{wsp<bf16_t>(P, WS_HID), wsp<bf16_t>(P, WS_WDN), T, DM, FF}; pg8::StaticOrder So; So.init(T, DM, gridDim.x, blockIdx.x);
            pg8::EpiBf16<0> E{wsp<bf16_t>(P, WS_Y), DM, nullptr, 0, 0}; pg8::gemm_phase<pg8::EpiBf16<0>, pg8::StaticOrder, false>((LAS unsigned char*)lds, g, So, E, nullptr); } xcd_barrier(bar);
#endif
        if (IN(pb + 12)) { if (layer + 1 < DEPTH) phase_norm<true, true, 2>(wsp<bf16_t>(P, WS_XB), wsp<bf16_t>(P, WS_XB), wsp<bf16_t>(P, WS_Y), P.in[15] + (size_t)layer * DM, P.in[12] + (size_t)(layer + 1) * DM, wsp<bf16_t>(P, WS_H));
            else phase_norm<true, false>(wsp<bf16_t>(P, WS_XB), P.out, wsp<bf16_t>(P, WS_Y), P.in[15] + (size_t)layer * DM, nullptr, nullptr); }
        SEAM(pb + 12);
#if MK_DUP_PH == 120
        for (int i = 0; i < 10; ++i) xcd_barrier(bar);
#endif
    }
#undef IN
#undef SEAM
}
}

#ifndef MK_ONE_LAUNCH
#define MK_ONE_LAUNCH 1
#endif
extern "C" void kernel_launch(void* const* d_in, const int* in_sizes, int n_in, void* d_out, int out_size, void* d_ws, size_t ws_size, hipStream_t stream) {
    static int grid = 0;
    if (grid == 0) {
        if (n_in != 16 || out_size != mk::T * mk::DM || ws_size < mk::WS_END) { fprintf(stderr, "kernel_launch: unexpected shapes (n_in %d, out %d, ws %zu < %zu)\n", n_in, out_size, ws_size, (size_t)mk::WS_END); grid = -1; return; }
        int dev = 0, cus = 0, per_cu = 0;
        if (hipGetDevice(&dev) != hipSuccess || hipDeviceGetAttribute(&cus, hipDeviceAttributeMultiprocessorCount, dev) != hipSuccess) { grid = -1; return; }
        if (hipFuncSetAttribute((const void*)mk::fwd, hipFuncAttributeMaxDynamicSharedMemorySize, mk::LDS_BYTES) != hipSuccess) { fprintf(stderr, "kernel_launch: hipFuncSetAttribute failed\n"); grid = -1; return; }
        if (hipOccupancyMaxActiveBlocksPerMultiprocessor(&per_cu, (const void*)mk::fwd, 512, mk::LDS_BYTES) != hipSuccess || per_cu < 1) { fprintf(stderr, "kernel_launch: occupancy query says %d blocks per CU\n", per_cu); }
        (void)hipGetLastError();
        grid = cus;
    }
    if (grid < 0) return;
    (void)in_sizes;
    hipMemsetAsync((char*)d_ws + mk::WS_CTL, 0, mk::CTL_BYTES, stream);
    mk::Args a{};
    for (int i = 0; i < 16; ++i) a.in[i] = (const float*)d_in[i];
    a.out = (float*)d_out; a.ws = (unsigned char*)d_ws;
#if MK_ONE_LAUNCH
    a.ph_lo = 0; a.ph_hi = mk::NPHASES;
    hipLaunchKernelGGL(mk::fwd, dim3(grid), dim3(512), mk::LDS_BYTES, stream, a);
#else
    for (int ph = 0; ph < mk::NPHASES; ++ph) { a.ph_lo = ph; a.ph_hi = ph + 1; hipLaunchKernelGGL(mk::fwd, dim3(grid), dim3(512), mk::LDS_BYTES, stream, a); }
#endif
}
```

```cpp
#include <hip/hip_runtime.h>
#include <cstdio>
#include <cstdint>
namespace pg8 {
#define PG8_LAS __attribute__((address_space(3)))
typedef unsigned short bf16_t;
typedef short bf16x8 __attribute__((ext_vector_type(8)));
typedef float f32x4 __attribute__((ext_vector_type(4)));
typedef unsigned u32x4 __attribute__((ext_vector_type(4)));
typedef int i32x4 __attribute__((ext_vector_type(4)));
typedef int i32x8 __attribute__((ext_vector_type(8)));
constexpr int BM = 256, BK = 64, HALF = 128, HTB = HALF * BK * 2  , STAGE_BYTES = 8 * HTB, NXCD = 8, WGM = 8;

__host__ __device__ __forceinline__ int lds_byte(int r, int c) { const int st = (r >> 4) * 2 + (c >> 5), rr = r & 15, cc = c & 31, ob = rr * 64 + cc * 2; return st * 1024 + (ob ^ (((ob >> 9) & 1) << 5)); }
__host__ __device__ __forceinline__ void stage_rc(int b, int& R, int& C) { const int st = b / 1024, sb = b % 1024, swz = sb ^ (((sb >> 9) & 1) << 5); R = (st >> 1) * 16 + swz / 64; C = (st & 1) * 32 + (swz % 64) / 2; }
__host__ __device__ __forceinline__ int perm32(int rho) { const int n = rho >> 4, i = rho & 15; return 8 * (i >> 2) + 4 * n + (i & 3); }

struct Unit { int pm, pn; };
struct Gemm { const bf16_t* A; const bf16_t* Bt; int M, N, K; int lda; int ldb; };

struct StaticOrder {
    int nM, nN, nwg, G, c;
    __host__ __device__ void init(int M, int N, int G_, int c_) { nM = M / BM; nN = N / BM; nwg = nM * nN; G = G_; c = c_; }
    __host__ __device__ bool next(int i, Unit& u) const {
        const long L = (long)i * G + c; if (L >= nwg) return false;
        int wgid = (int)L; { const int q = nwg / NXCD, r = nwg % NXCD, xcd = wgid % NXCD, off = wgid / NXCD; wgid = (xcd < r ? xcd * (q + 1) : r * (q + 1) + (xcd - r) * q) + off; }
        const int nig = WGM * nN, gid = wgid / nig, fm = gid * WGM, gsz = (nM - fm) < WGM ? (nM - fm) : WGM;
        u.pm = fm + ((wgid % nig) % gsz); u.pn = (wgid % nig) / gsz; return true;
    }
    __device__ __forceinline__ void a_ready(const Unit&) const {}
    __device__ __forceinline__ void done(const Unit&) const {}
};
struct CountedOrder : StaticOrder {
    const unsigned* ready; unsigned need; unsigned* tmo;
    __device__ __forceinline__ void a_ready(const Unit& u) const {
        if (threadIdx.x < 64) {
            const unsigned long long t0 = __builtin_amdgcn_s_memrealtime(); unsigned polls = 0;
            while ((unsigned)__builtin_amdgcn_readfirstlane(__hip_atomic_load(ready + 64 * u.pm, __ATOMIC_RELAXED, __HIP_MEMORY_SCOPE_AGENT)) < need) {
                if ((++polls & 255u) == 0u && __builtin_amdgcn_readfirstlane(__hip_atomic_load(tmo, __ATOMIC_RELAXED, __HIP_MEMORY_SCOPE_AGENT)) != 0u) break;
                if (__builtin_amdgcn_s_memrealtime() - t0 > 2000000ull) {
                    if (threadIdx.x == 0) { unsigned expect = 0u; __hip_atomic_compare_exchange_strong(tmo + 1, &expect, 0x600u | (unsigned)(u.pm & 0xff), __ATOMIC_RELAXED, __ATOMIC_RELAXED, __HIP_MEMORY_SCOPE_AGENT); __hip_atomic_store(tmo, 1u, __ATOMIC_RELAXED, __HIP_MEMORY_SCOPE_AGENT); }
                    break; }
                __builtin_amdgcn_s_sleep(2); }
            __builtin_amdgcn_fence(__ATOMIC_ACQUIRE, "agent");
            asm volatile("s_waitcnt vmcnt(0)" ::: "memory");
        }
#if !defined(BROKEN_HOOK_NO_BARRIER)
        asm volatile("" ::: "memory"); __builtin_amdgcn_s_barrier(); asm volatile("" ::: "memory");
#endif
    }
};

__device__ __forceinline__ unsigned cvt_pk_bf16(float lo, float hi) { unsigned r; asm volatile("v_cvt_pk_bf16_f32 %0, %1, %2" : "=v"(r) : "v"(lo), "v"(hi)); return r; }
typedef float f32x2 __attribute__((ext_vector_type(2)));
__device__ __forceinline__ f32x2 gelu_pk(f32x2 v) {
    const f32x2 av = __builtin_elementwise_abs(v), d = av * 0.2316418882f + 1.0f;
    f32x2 t; t.x = __builtin_amdgcn_rcpf(d.x); t.y = __builtin_amdgcn_rcpf(d.y);
    f32x2 q = t * 0.5307027145f + (-0.7265760135f); q = q * t + 0.7107068705f; q = q * t + (-0.142248368f); q = q * t + 0.127414796f; q = q * t;
    const f32x2 s = (v * v) * (-0.72134752044f);
    f32x2 e; e.x = __builtin_amdgcn_exp2f(s.x); e.y = __builtin_amdgcn_exp2f(s.y);
    const f32x2 m = v * (q * e), r = v - m;
    f32x2 o; o.x = v.x < 0.f ? m.x : r.x; o.y = v.y < 0.f ? m.y : r.y; return o;
}

struct EpiF32 {
    static constexpr bool PERM = false, AFTER_DRAIN = false;
    float* C; int ldc; const float* bias;
    __device__ __forceinline__ void operator()(const f32x4 (&acc)[2][2][4][2], const Unit& u, int wr, int wc, int fr, int fq) const {
        const int row0 = u.pm * BM + wr * 64 + fr, col0 = u.pn * BM + wc * 32 + 4 * fq;
        f32x4 bv[2][2];
#pragma unroll
        for (int bj = 0; bj < 2; ++bj)
#pragma unroll
            for (int n = 0; n < 2; ++n) bv[bj][n] = bias ? *(const f32x4*)(bias + col0 + bj * HALF + n * 16) : (f32x4){0.f, 0.f, 0.f, 0.f};
#pragma unroll
        for (int ai = 0; ai < 2; ++ai)
#pragma unroll
            for (int m = 0; m < 4; ++m) { float* rowp = C + (size_t)(row0 + ai * HALF + m * 16) * ldc + col0;
#pragma unroll
                for (int bj = 0; bj < 2; ++bj)
#pragma unroll
                    for (int n = 0; n < 2; ++n) *(f32x4*)(rowp + bj * HALF + n * 16) = acc[ai][bj][m][n] + bv[bj][n]; }
    }
};
template <int ACT  > struct EpiBf16 {
    static constexpr bool PERM = true, AFTER_DRAIN = false;
    bf16_t* O; int ldc; const float* bias; int split_cols; size_t split_stride;
    __device__ __forceinline__ void operator()(const f32x4 (&acc)[2][2][4][2], const Unit& u, int wr, int wc, int fr, int fq) const {
        const int row0 = u.pm * BM + wr * 64 + fr; int colt = u.pn * BM; bf16_t* base = O;
        if (split_cols) { const int t = colt / split_cols; base += (size_t)t * split_stride; colt -= t * split_cols; }
        const int col0 = colt + wc * 32 + 8 * fq, bcol0 = u.pn * BM + wc * 32 + 8 * fq;
        f32x4 bv[2][2];
#pragma unroll
        for (int bj = 0; bj < 2; ++bj)
#pragma unroll
            for (int n = 0; n < 2; ++n) bv[bj][n] = bias ? *(const f32x4*)(bias + bcol0 + bj * HALF + 4 * n) : (f32x4){0.f, 0.f, 0.f, 0.f};
#pragma unroll
        for (int ai = 0; ai < 2; ++ai)
#pragma unroll
            for (int m = 0; m < 4; ++m) { bf16_t* rowp = base + (size_t)(row0 + ai * HALF + m * 16) * ldc + col0;
#pragma unroll
                for (int bj = 0; bj < 2; ++bj) { f32x4 v0 = acc[ai][bj][m][0] + bv[bj][0], v1 = acc[ai][bj][m][1] + bv[bj][1];
                    if (ACT == 1) { f32x2 a = gelu_pk((f32x2){v0[0], v0[1]}), b = gelu_pk((f32x2){v0[2], v0[3]}), c = gelu_pk((f32x2){v1[0], v1[1]}), d = gelu_pk((f32x2){v1[2], v1[3]});
                        v0 = (f32x4){a.x, a.y, b.x, b.y}; v1 = (f32x4){c.x, c.y, d.x, d.y}; }
                    if (ACT == 2) {
#pragma unroll
                        for (int j = 0; j < 4; ++j) { v0[j] = 0.5f * v0[j] * (1.0f + erff(v0[j] * 0.70710678f)); v1[j] = 0.5f * v1[j] * (1.0f + erff(v1[j] * 0.70710678f)); } }
                    u32x4 w; w.x = cvt_pk_bf16(v0[0], v0[1]); w.y = cvt_pk_bf16(v0[2], v0[3]); w.z = cvt_pk_bf16(v1[0], v1[1]); w.w = cvt_pk_bf16(v1[2], v1[3]);
                    *(u32x4*)(rowp + bj * HALF) = w; } }
    }
};

struct PanelStats {
    unsigned* xbuf;
    unsigned* cnt;
    unsigned* tmo;
    int ntn; float eps;
    unsigned code;
    __device__ __forceinline__ bool run(const f32x4 (&v)[2][2][4][2], const Unit& u, int wr, int wc, int fr, int fq, PG8_LAS unsigned char* lds, int wid, int lane) const {
        typedef float f32x2v __attribute__((ext_vector_type(2)));
        PG8_LAS f32x2v* P = (PG8_LAS f32x2v*)lds;
        PG8_LAS f32x2v* S = (PG8_LAS f32x2v*)(lds + 8192);
        PG8_LAS unsigned* flag = (PG8_LAS unsigned*)(lds + 8192 + 2048);
#pragma unroll
        for (int ai = 0; ai < 2; ++ai)
#pragma unroll
            for (int m = 0; m < 4; ++m) {
                float s = 0.f;
#pragma unroll
                for (int bj = 0; bj < 2; ++bj)
#pragma unroll
                    for (int n = 0; n < 2; ++n) { const f32x4 x = v[ai][bj][m][n]; s += (x[0] + x[1]) + (x[2] + x[3]); }
                s += __shfl_xor(s, 16); s += __shfl_xor(s, 32);
                const float mw = s * (1.0f / 64.0f); float q = 0.f;
#pragma unroll
                for (int bj = 0; bj < 2; ++bj)
#pragma unroll
                    for (int n = 0; n < 2; ++n) { const f32x4 d = v[ai][bj][m][n] - mw; q += (d[0] * d[0] + d[1] * d[1]) + (d[2] * d[2] + d[3] * d[3]); }
                q += __shfl_xor(q, 16); q += __shfl_xor(q, 32);
                if (fq == 0) P[(ai * HALF + wr * 64 + m * 16 + fr) * 4 + wc] = (f32x2v){mw, q};
            }
        asm volatile("s_waitcnt lgkmcnt(0)" ::: "memory"); __builtin_amdgcn_s_barrier(); asm volatile("" ::: "memory");
#if defined(BROKEN_NO_WAIT)
        if (blockIdx.x >= 64) { const long long t0 = clock64(); while (clock64() - t0 < 60000) __builtin_amdgcn_s_sleep(8); }
#endif
        const int row = wid * 32 + (lane & 31);
        if (lane < 32) {
            const f32x2v a = P[row * 4 + 0], b = P[row * 4 + 1], c = P[row * 4 + 2], d = P[row * 4 + 3];
            const float mt = (a.x + b.x + c.x + d.x) * 0.25f;
            const float da = a.x - mt, db = b.x - mt, dc = c.x - mt, dd = d.x - mt;
            const float m2 = (a.y + b.y) + (c.y + d.y) + 64.0f * ((da * da + db * db) + (dc * dc + dd * dd));
            unsigned long long* slot = (unsigned long long*)xbuf + ((size_t)(u.pm * BM + row) * 4 + u.pn);
            __hip_atomic_store(slot, ((unsigned long long)__float_as_uint(m2) << 32) | __float_as_uint(mt), __ATOMIC_RELAXED, __HIP_MEMORY_SCOPE_AGENT);
        }
        asm volatile("s_waitcnt vmcnt(0)" ::: "memory");
        if (lane == 0) __hip_atomic_fetch_add(cnt + 64 * u.pm, 1u, __ATOMIC_RELAXED, __HIP_MEMORY_SCOPE_AGENT);
        if (wid == 0) {
            bool dead = false; const unsigned long long t0 = __builtin_amdgcn_s_memrealtime(); const unsigned want = 8u * (unsigned)ntn;
            for (;;) {
#if defined(BROKEN_NO_WAIT)
                break;
#endif
                if ((unsigned)__builtin_amdgcn_readfirstlane(__hip_atomic_load(cnt + 64 * u.pm, __ATOMIC_RELAXED, __HIP_MEMORY_SCOPE_AGENT)) >= want) break;
                if (__builtin_amdgcn_s_memrealtime() - t0 > 2000000ull) {
                    if (lane == 0) { unsigned expect = 0u; __hip_atomic_compare_exchange_strong(tmo + 1, &expect, code | (unsigned)(u.pm & 0xff), __ATOMIC_RELAXED, __ATOMIC_RELAXED, __HIP_MEMORY_SCOPE_AGENT);
                                     __hip_atomic_store(tmo, 1u, __ATOMIC_RELAXED, __HIP_MEMORY_SCOPE_AGENT); }
                    dead = true; break; }
                __builtin_amdgcn_s_sleep(2);
            }
            __builtin_amdgcn_fence(__ATOMIC_ACQUIRE, "agent");
            if (lane == 0) flag[0] = dead ? 1u : 0u;
        }
        asm volatile("s_waitcnt vmcnt(0) lgkmcnt(0)" ::: "memory"); __builtin_amdgcn_s_barrier(); asm volatile("" ::: "memory");
        const bool bad = flag[0] != 0u;
        if (lane < 32) {
            const unsigned long long* slot = (const unsigned long long*)xbuf + (size_t)(u.pm * BM + row) * 4; float mt[4], m2[4]; float ms = 0.f;
#pragma unroll
            for (int t = 0; t < 4; ++t) { if (t < ntn) { const unsigned long long w = __hip_atomic_load(slot + t, __ATOMIC_RELAXED, __HIP_MEMORY_SCOPE_AGENT); mt[t] = __uint_as_float((unsigned)w); m2[t] = __uint_as_float((unsigned)(w >> 32)); } else { mt[t] = 0.f; m2[t] = 0.f; } ms += mt[t]; }
            const float mean = ms / (float)ntn; float q = 0.f;
#pragma unroll
            for (int t = 0; t < 4; ++t) if (t < ntn) { const float dm = mt[t] - mean; q += m2[t] + 256.0f * dm * dm; }
            S[row] = (f32x2v){mean, 1.0f / sqrtf(q / (256.0f * (float)ntn) + eps)};
        }
        asm volatile("s_waitcnt lgkmcnt(0)" ::: "memory"); __builtin_amdgcn_s_barrier(); asm volatile("" ::: "memory");
        return bad;
    }
};
struct EpiLnRes {
    static constexpr bool PERM = false, AFTER_DRAIN = true;
    const float* base; float* out; int ldc; const float* bias; PanelStats st; unsigned poison;
    __device__ __forceinline__ void refuse(size_t i0, size_t stride, int M, int N) const { const float q = __builtin_nanf(""); for (size_t i = i0; i < (size_t)M * N; i += stride) out[(i / N) * ldc + i % N] = q;
        if (i0 == 0) { unsigned expect = 0u; __hip_atomic_compare_exchange_strong(st.tmo + 1, &expect, 0x7f0u, __ATOMIC_RELAXED, __ATOMIC_RELAXED, __HIP_MEMORY_SCOPE_AGENT); __hip_atomic_store(st.tmo, 1u, __ATOMIC_RELAXED, __HIP_MEMORY_SCOPE_AGENT); } }
    __device__ __forceinline__ void fused(f32x4 (&acc)[2][2][4][2], const Unit& u, int wr, int wc, int fr, int fq, PG8_LAS unsigned char* lds, int wid, int lane) const {
        typedef float f32x2v __attribute__((ext_vector_type(2)));
        const PG8_LAS f32x2v* S = (const PG8_LAS f32x2v*)(lds + 8192);
        const int col0 = u.pn * BM + wc * 32 + 4 * fq;
#pragma unroll
        for (int bj = 0; bj < 2; ++bj)
#pragma unroll
            for (int n = 0; n < 2; ++n) { const f32x4 bv = bias ? *(const f32x4*)(bias + col0 + bj * HALF + n * 16) : (f32x4){0.f, 0.f, 0.f, 0.f};
#pragma unroll
                for (int ai = 0; ai < 2; ++ai)
#pragma unroll
                    for (int m = 0; m < 4; ++m) acc[ai][bj][m][n] += bv; }
        const bool bad = st.run(acc, u, wr, wc, fr, fq, lds, wid, lane) || poison != 0u;
        const float qnan = __builtin_nanf("");
#pragma unroll
        for (int ai = 0; ai < 2; ++ai)
#pragma unroll
            for (int m = 0; m < 4; ++m) { const int r = ai * HALF + wr * 64 + m * 16 + fr; const f32x2v sr = S[r]; const size_t off = (size_t)(u.pm * BM + r) * ldc + col0;
#pragma unroll
                for (int bj = 0; bj < 2; ++bj)
#pragma unroll
                    for (int n = 0; n < 2; ++n) { const f32x4 bs = *(const f32x4*)(base + off + bj * HALF + n * 16); f32x4 o = bs + (acc[ai][bj][m][n] - sr.x) * sr.y;
                        if (bad) o = (f32x4){qnan, qnan, qnan, qnan}; *(f32x4*)(out + off + bj * HALF + n * 16) = o; }
                asm volatile("" ::: "memory"); }
    }
};
struct EpiLnResLn {
    static constexpr bool PERM = false, AFTER_DRAIN = true;
    const float* base; float* out; bf16_t* xn; int ldc; const float* bias; PanelStats st1, st2; unsigned poison;
    __device__ __forceinline__ void refuse(size_t i0, size_t stride, int M, int N) const { const float q = __builtin_nanf(""); for (size_t i = i0; i < (size_t)M * N; i += stride) { const size_t o = (i / N) * ldc + i % N; out[o] = q; xn[o] = (bf16_t)0x7fc0u; }
        if (i0 == 0) { unsigned expect = 0u; __hip_atomic_compare_exchange_strong(st1.tmo + 1, &expect, 0x7f0u, __ATOMIC_RELAXED, __ATOMIC_RELAXED, __HIP_MEMORY_SCOPE_AGENT); __hip_atomic_store(st1.tmo, 1u, __ATOMIC_RELAXED, __HIP_MEMORY_SCOPE_AGENT); } }
    __device__ __forceinline__ void fused(f32x4 (&acc)[2][2][4][2], const Unit& u, int wr, int wc, int fr, int fq, PG8_LAS unsigned char* lds, int wid, int lane) const {
        typedef float f32x2v __attribute__((ext_vector_type(2))); typedef unsigned u32x2v __attribute__((ext_vector_type(2)));
        const PG8_LAS f32x2v* S = (const PG8_LAS f32x2v*)(lds + 8192);
        const int col0 = u.pn * BM + wc * 32 + 4 * fq;
#pragma unroll
        for (int bj = 0; bj < 2; ++bj)
#pragma unroll
            for (int n = 0; n < 2; ++n) { const f32x4 bv = bias ? *(const f32x4*)(bias + col0 + bj * HALF + n * 16) : (f32x4){0.f, 0.f, 0.f, 0.f};
#pragma unroll
                for (int ai = 0; ai < 2; ++ai)
#pragma unroll
                    for (int m = 0; m < 4; ++m) acc[ai][bj][m][n] += bv; }
        bool bad = st1.run(acc, u, wr, wc, fr, fq, lds, wid, lane) || poison != 0u;
        const float qnan = __builtin_nanf("");
#pragma unroll
        for (int ai = 0; ai < 2; ++ai)
#pragma unroll
            for (int m = 0; m < 4; ++m) { const int r = ai * HALF + wr * 64 + m * 16 + fr; const f32x2v sr = S[r]; const size_t off = (size_t)(u.pm * BM + r) * ldc + col0;
#pragma unroll
                for (int bj = 0; bj < 2; ++bj)
#pragma unroll
                    for (int n = 0; n < 2; ++n) { const f32x4 bs = *(const f32x4*)(base + off + bj * HALF + n * 16); acc[ai][bj][m][n] = bs + (acc[ai][bj][m][n] - sr.x) * sr.y; }
                asm volatile("" : "+v"(acc[ai][0][m][0]), "+v"(acc[ai][0][m][1]), "+v"(acc[ai][1][m][0]), "+v"(acc[ai][1][m][1]));
                if (m & 1) asm volatile("" ::: "memory"); }
        const bool bad1 = bad;
        bad = st2.run(acc, u, wr, wc, fr, fq, lds, wid, lane) || bad;
#pragma unroll
        for (int ai = 0; ai < 2; ++ai)
#pragma unroll
            for (int m = 0; m < 4; ++m) { const int r = ai * HALF + wr * 64 + m * 16 + fr; const f32x2v sr = S[r]; const size_t off = (size_t)(u.pm * BM + r) * ldc + col0;
#pragma unroll
                for (int bj = 0; bj < 2; ++bj)
#pragma unroll
                    for (int n = 0; n < 2; ++n) { const f32x4 x1 = acc[ai][bj][m][n]; *(f32x4*)(out + off + bj * HALF + n * 16) = bad1 ? (f32x4){qnan, qnan, qnan, qnan} : x1;
                        const f32x4 o = (x1 - sr.x) * sr.y; u32x2v w; w.x = cvt_pk_bf16(o[0], o[1]); w.y = cvt_pk_bf16(o[2], o[3]);
                        if (bad) { w.x = 0x7fc07fc0u; w.y = 0x7fc07fc0u; } *(u32x2v*)(xn + off + bj * HALF + n * 16) = w; }
                asm volatile("" ::: "memory"); }
    }
};

template <class E, class = void> struct is_staged { static constexpr bool value = false; };
template <class E> struct is_staged<E, decltype((void)E::STAGED)> { static constexpr bool value = true; };
template <class Epi, class Sched, bool STAMP = false, int F8 = 0  >
__device__ __forceinline__ void gemm_phase(PG8_LAS unsigned char* lds, const Gemm g, const Sched& S, const Epi& E, unsigned long long* stamps) {
    int tid_o = threadIdx.x; asm volatile("" : "+v"(tid_o)); const int tid = tid_o, wid = __builtin_amdgcn_readfirstlane(tid >> 6), lane = tid & 63, wr = wid >> 2, wc = wid & 3, fr = lane & 15, fq = lane >> 4;
    const int K = g.K, nt = K / BK, LDA = g.lda ? g.lda : g.K, LDB = g.ldb ? g.ldb : g.K;
    int ts_lo = 0, ts_hi = 0, nts = 0; const unsigned long long rt_entry = STAMP ? (unsigned long long)wall_clock64() : 0ull;
#define PG8_STAMP() do { if (STAMP && wid == 0 && nts < 64) { const unsigned long long _c = (unsigned long long)clock64(); \
        ts_lo = (lane == nts) ? (int)(unsigned)_c : ts_lo; ts_hi = (lane == nts) ? (int)(unsigned)(_c >> 32) : ts_hi; ++nts; } } while (0)
    PG8_STAMP();
    unsigned voffA[2], voffB[2];
#pragma unroll
    for (int i = 0; i < 2; ++i) { int R, C; stage_rc(tid * 16 + i * 8192, R, C); const int Rb = Epi::PERM ? ((R & ~31) + perm32(R & 31)) : R;
        voffA[i] = (unsigned)(R * LDA + C) * 2u; voffB[i] = (unsigned)(Rb * LDB + C) * 2u; }
    const size_t kstep = (size_t)(BK * 2);
    const size_t hstep = (size_t)HALF * LDB * 2;
    const size_t tstep = 2 * hstep;
    const size_t hstepA = (size_t)HALF * LDA * 2, tstepA = 2 * hstepA;
    const unsigned ldsw = (unsigned)wid * 1024u;
    const int aoff = lds_byte(wr * 64 + fr, fq * 8), boff = lds_byte(wc * 32 + fr, fq * 8);
#define PG8_SA(b, h) (((b) * 2 + (h)) * HTB)
#define PG8_SB(b, h) ((4 + (b) * 2 + (h)) * HTB)
#define PG8_STAGE(bufoff, gbase, voff) do { _Pragma("unroll") for (int _i = 0; _i < 2; ++_i) \
        __builtin_amdgcn_global_load_lds((const unsigned*)((const char*)(gbase) + (voff)[_i]), (PG8_LAS unsigned*)(lds + (bufoff) + ldsw + _i * 8192), 16, 0, 0); } while (0)
#define PG8_LDA(dst, b, h) do { _Pragma("unroll") for (int m = 0; m < 4; ++m) _Pragma("unroll") for (int k = 0; k < 2; ++k) dst[m][k] = *(const PG8_LAS bf16x8*)(lds + PG8_SA(b, h) + aoff + m * 2048 + k * 1024); } while (0)
#define PG8_LDB(dst, b, h) do { _Pragma("unroll") for (int n = 0; n < 2; ++n) _Pragma("unroll") for (int k = 0; k < 2; ++k) dst[n][k] = *(const PG8_LAS bf16x8*)(lds + PG8_SB(b, h) + boff + n * 2048 + k * 1024); } while (0)
#define PG8_CAT(x, y) __builtin_shufflevector(__builtin_bit_cast(i32x4, (x)), __builtin_bit_cast(i32x4, (y)), 0, 1, 2, 3, 4, 5, 6, 7)
#define PG8_MMA(ai, bj, At, Bt) do { __builtin_amdgcn_s_setprio(1); _Pragma("unroll") for (int m = 0; m < 4; ++m) _Pragma("unroll") for (int n = 0; n < 2; ++n) { \
        if constexpr (F8 == 2) { _Pragma("unroll") for (int k = 0; k < 2; ++k) acc[ai][bj][m][n] = __builtin_bit_cast(f32x4, __builtin_amdgcn_mfma_i32_16x16x64_i8(__builtin_bit_cast(i32x4, Bt[n][k]), __builtin_bit_cast(i32x4, At[m][k]), __builtin_bit_cast(i32x4, acc[ai][bj][m][n]), 0, 0, 0)); } \
        else if constexpr (F8 == 1) { const i32x8 _a = PG8_CAT(Bt[n][0], Bt[n][1]), _b = PG8_CAT(At[m][0], At[m][1]); asm volatile("v_mfma_f32_16x16x128_f8f6f4 %0, %1, %2, %0" : "+v"(acc[ai][bj][m][n]) : "v"(_a), "v"(_b)); } \
        else { _Pragma("unroll") for (int k = 0; k < 2; ++k) acc[ai][bj][m][n] = __builtin_amdgcn_mfma_f32_16x16x32_bf16(Bt[n][k], At[m][k], acc[ai][bj][m][n], 0, 0, 0); } } \
        __builtin_amdgcn_s_setprio(0); } while (0)
#define PG8_WAIT_V(n) asm volatile("s_waitcnt vmcnt(" #n ")" ::: "memory")
#define PG8_WAIT_L(n) asm volatile("s_waitcnt lgkmcnt(" #n ")" ::: "memory")
#define PG8_BAR __builtin_amdgcn_s_barrier()
#define PG8_SCHED __builtin_amdgcn_sched_barrier(0)
    Unit cur, nxt; int ui = 0;
    if (!S.next(0, cur)) return;
    f32x4 acc[2][2][4][2];
#pragma unroll
    for (int a = 0; a < 2; ++a)
#pragma unroll
        for (int b = 0; b < 2; ++b)
#pragma unroll
            for (int m = 0; m < 4; ++m)
#pragma unroll
                for (int n = 0; n < 2; ++n) acc[a][b][m][n] = (f32x4){0.f, 0.f, 0.f, 0.f};
    bf16x8 At[4][2], B0[2][2], B1[2][2];
    const char* cA = (const char*)g.A + (size_t)cur.pm * tstepA; const char* cB = (const char*)g.Bt + (size_t)cur.pn * tstep;
    S.a_ready(cur);
    PG8_STAGE(PG8_SB(0, 0), cB, voffB); PG8_STAGE(PG8_SA(0, 0), cA, voffA); PG8_STAGE(PG8_SB(0, 1), cB + hstep, voffB); PG8_STAGE(PG8_SA(0, 1), cA + hstepA, voffA);
    if (wr == 1) PG8_BAR;
    PG8_WAIT_V(4); PG8_BAR;
    PG8_STAGE(PG8_SB(1, 0), cB + kstep, voffB); PG8_STAGE(PG8_SA(1, 0), cA + kstep, voffA); PG8_STAGE(PG8_SB(1, 1), cB + hstep + kstep, voffB);
    PG8_WAIT_V(6); PG8_BAR;
    PG8_STAMP();
    for (;;) {
        const bool has_next = S.next(ui + 1, nxt);
        const char* nA = has_next ? (const char*)g.A + (size_t)nxt.pm * tstepA : cA; const char* nB = has_next ? (const char*)g.Bt + (size_t)nxt.pn * tstep : cB;
        for (int t = 0; t < nt; t += 2) {
            const bool last = (t == nt - 2);
            const char* a1 = cA + (size_t)(t + 1) * kstep;
            const char* a2 = last ? nA : cA + (size_t)(t + 2) * kstep; const char* b2 = last ? nB : cB + (size_t)(t + 2) * kstep;
            const char* a3 = a2 + kstep; const char* b3 = b2 + kstep;
            if (last && has_next) S.a_ready(nxt);
            PG8_LDB(B0, 0, 0); PG8_SCHED; PG8_LDA(At, 0, 0); PG8_STAGE(PG8_SA(1, 1), a1 + hstepA, voffA);
            PG8_WAIT_L(8); PG8_BAR; PG8_WAIT_L(0); PG8_MMA(0, 0, At, B0); PG8_BAR; PG8_SCHED;
            PG8_LDB(B1, 0, 1); PG8_STAGE(PG8_SB(0, 0), b2, voffB);
            PG8_BAR; PG8_WAIT_L(0); PG8_MMA(0, 1, At, B1); PG8_BAR;
            PG8_LDA(At, 0, 1); PG8_STAGE(PG8_SA(0, 0), a2, voffA);
            PG8_BAR; PG8_WAIT_L(0); PG8_MMA(1, 0, At, B0); PG8_BAR; PG8_SCHED;
            PG8_STAGE(PG8_SB(0, 1), b2 + hstep, voffB);
            PG8_WAIT_V(6); PG8_BAR; PG8_MMA(1, 1, At, B1); PG8_BAR;
            PG8_LDB(B0, 1, 0); PG8_SCHED; PG8_LDA(At, 1, 0); PG8_STAGE(PG8_SA(0, 1), a2 + hstepA, voffA);
            PG8_WAIT_L(8); PG8_BAR; PG8_WAIT_L(0); PG8_MMA(0, 0, At, B0); PG8_BAR; PG8_SCHED;
            PG8_LDB(B1, 1, 1); PG8_STAGE(PG8_SB(1, 0), b3, voffB);
            PG8_BAR; PG8_WAIT_L(0); PG8_MMA(0, 1, At, B1); PG8_BAR;
            PG8_LDA(At, 1, 1); PG8_STAGE(PG8_SA(1, 0), a3, voffA);
            PG8_BAR; PG8_WAIT_L(0); PG8_MMA(1, 0, At, B0); PG8_BAR; PG8_SCHED;
            PG8_STAGE(PG8_SB(1, 1), b3 + hstep, voffB);
            PG8_WAIT_V(6); PG8_BAR; PG8_MMA(1, 1, At, B1); PG8_BAR;
        }
        PG8_STAMP();
        if constexpr (F8 == 1) asm volatile("s_nop 15\n\ts_nop 15" ::: "memory");
        if constexpr (Epi::AFTER_DRAIN) {}
        else if constexpr (is_staged<Epi>::value) {
            if (wr == 0) PG8_BAR;
            E.staged(acc, cur, wr, wc, fr, fq, lds + STAGE_BYTES + 256, wid, lane);
            if (wr == 1) PG8_BAR;
            S.done(cur); }
        else if constexpr (!Epi::AFTER_DRAIN) { E(acc, cur, wr, wc, fr, fq); S.done(cur); }
        PG8_STAMP();
        if (!has_next) break;
#pragma unroll
        for (int a = 0; a < 2; ++a)
#pragma unroll
            for (int b = 0; b < 2; ++b)
#pragma unroll
                for (int m = 0; m < 4; ++m)
#pragma unroll
                    for (int n = 0; n < 2; ++n) acc[a][b][m][n] = (f32x4){0.f, 0.f, 0.f, 0.f};
        cur = nxt; cA = nA; cB = nB; ++ui;
    }
    PG8_WAIT_V(0);
    if (wr == 0) PG8_BAR;
    PG8_BAR;
    if constexpr (Epi::AFTER_DRAIN) { E.fused(acc, cur, wr, wc, fr, fq, lds, wid, lane); S.done(cur); }
    PG8_STAMP();
    if (STAMP && wid == 0) { stamps[lane] = lane < nts ? (((unsigned long long)(unsigned)ts_hi << 32) | (unsigned)ts_lo) : 0ull;
        if (lane == 62) stamps[62] = rt_entry; if (lane == 63) stamps[63] = (unsigned long long)wall_clock64(); }
#undef PG8_STAMP
#undef PG8_SA
#undef PG8_SB
#undef PG8_STAGE
#undef PG8_LDA
#undef PG8_LDB
#undef PG8_MMA
#undef PG8_CAT
#undef PG8_WAIT_V
#undef PG8_WAIT_L
#undef PG8_BAR
#undef PG8_SCHED
}
}
#define XB_TMO      128
#define XB_XCNT(j)  (256  + 64 * (j))
#define XB_XSUB(j)  (1280 + 64 * (j))
#define XB_XGEN(j)  (2304 + 64 * (j))
#define XB_TOP      3328
#define XB_TOPGEN   3392
#define XCD_BAR_WORDS 3456
#define XB_SPIN_CAP (1u << 23)
#define LAS __attribute__((address_space(3)))

__device__ __forceinline__ unsigned xb_ld(unsigned* p)              { return __hip_atomic_load(p, __ATOMIC_RELAXED, __HIP_MEMORY_SCOPE_AGENT); }
__device__ __forceinline__ unsigned xb_add(unsigned* p, unsigned v) { return __hip_atomic_fetch_add(p, v, __ATOMIC_RELAXED, __HIP_MEMORY_SCOPE_AGENT); }
__device__ __forceinline__ unsigned xb_xcc_id() { return (unsigned)__builtin_amdgcn_s_getreg((3 << 11) | 20) & 0xFu; }
#define XB_SPIN(cond, bar) do { unsigned _sp = 0; while (cond) { __builtin_amdgcn_s_sleep(1); \
    if ((++_sp & 255u) == 0u) { if (xb_ld(&(bar)[XB_TMO])) break; if (_sp > XB_SPIN_CAP) { atomicAdd(&(bar)[XB_TMO], 1u); break; } } } } while (0)

struct XcdBarrier {
    unsigned* bar; unsigned x;
    volatile LAS unsigned* st;
};

__device__ __forceinline__ XcdBarrier xcd_barrier_post(unsigned* bar, volatile LAS unsigned* st) {
    XcdBarrier b; b.bar = bar; b.x = xb_xcc_id(); b.st = st;
    if (threadIdx.x == 0) (void)xb_add(&bar[XB_XCNT(b.x)], 1u);
    return b;
}
__device__ __forceinline__ void xcd_barrier_complete(unsigned* bar, unsigned x, unsigned& nloc, unsigned& nx) {
    const unsigned G = gridDim.x * gridDim.y * gridDim.z;
    unsigned sum, cnt, mine, sp = 0u;
    for (;;) {
        sum = 0u; cnt = 0u; mine = 0u;
#pragma unroll
        for (unsigned j = 0; j < 16; ++j) { const unsigned c = xb_ld(&bar[XB_XCNT(j)]); sum += c; cnt += (c > 0u) ? 1u : 0u; mine = (j == x) ? c : mine; }
        if (sum == G) break;
        __builtin_amdgcn_s_sleep(1);
        if ((++sp & 255u) == 0u) { if (xb_ld(&bar[XB_TMO])) break; if (sp > XB_SPIN_CAP) { atomicAdd(&bar[XB_TMO], 1u); break; } }
    }
    nloc = mine > 0u ? mine : 1u; nx = cnt > 0u ? cnt : 1u;
}

__device__ __forceinline__ void xcd_barrier(const XcdBarrier& b) {
    asm volatile("s_waitcnt vmcnt(0)" ::: "memory");
    __syncthreads();
    if (threadIdx.x == 0) {
        unsigned* bar = b.bar;
        __builtin_amdgcn_s_waitcnt(0);
        unsigned nloc = b.st[0], nx = b.st[1];
        if (nloc == 0u) { xcd_barrier_complete(bar, b.x, nloc, nx); b.st[0] = nloc; b.st[1] = nx; }
        const unsigned old = xb_add(&bar[XB_XSUB(b.x)], 1u);
        const unsigned gen = old / nloc;
        if (old + 1u == (gen + 1u) * nloc) {
            __builtin_amdgcn_fence(__ATOMIC_RELEASE, "agent");
            asm volatile("s_waitcnt vmcnt(0)" ::: "memory");
            const unsigned og = xb_add(&bar[XB_TOP], 1u);
            const unsigned tg = og / nx;
            if (og + 1u == (tg + 1u) * nx) xb_add(&bar[XB_TOPGEN], 1u);
            else XB_SPIN(xb_ld(&bar[XB_TOPGEN]) == tg, bar);
            __builtin_amdgcn_fence(__ATOMIC_ACQUIRE, "agent");
            xb_add(&bar[XB_XGEN(b.x)], 1u);
            asm volatile("s_waitcnt vmcnt(0)" ::: "memory");
        } else {
            XB_SPIN(xb_ld(&bar[XB_XGEN(b.x)]) == gen, bar);
            __builtin_amdgcn_fence(__ATOMIC_ACQUIRE, "agent");
            asm volatile("s_waitcnt vmcnt(0)" ::: "memory");
        }
    }
    __syncthreads();
}

namespace fa {
typedef unsigned short bf16;
typedef short bf16x8 __attribute__((ext_vector_type(8)));
typedef short s16x4 __attribute__((ext_vector_type(4)));
typedef float f32x16 __attribute__((ext_vector_type(16)));
typedef float f32x4 __attribute__((ext_vector_type(4)));
typedef unsigned u32x4 __attribute__((ext_vector_type(4)));
typedef unsigned u32x2 __attribute__((ext_vector_type(2)));
constexpr int D = 128, SEQ = 2048;
constexpr float SCALE = 0.08838834764831845f, THR = 8.f;
constexpr int NW = 8, QBLK = 32, KVBLK = 64, QB = NW * QBLK;
constexpr int SHM_V = KVBLK * D * 2, SHM_K = KVBLK * D * 2;
constexpr int LDS_BYTES = 2 * SHM_V + 2 * SHM_K + NW * 64 * 4;
enum { M_WIN = 0, M_SEL = 1, M_BITS = 2 };

#define KSWZ(row, colB) ((row) * 256 + ((colB) ^ (((row) & 7) << 4)))
#define SBAR() __builtin_amdgcn_sched_barrier(0)
__device__ __forceinline__ int v_st(int k, int c) { const int kk = (k & ~0xC) | ((k & 4) << 1) | ((k & 8) >> 1); return ((kk >> 3) * 4 + (c >> 5)) * 512 + ((kk & 7) * 32 + (c & 31)) * 2; }
__device__ __forceinline__ int v_rd_base(int lane) { return ((lane & 3) << 3) | (((lane >> 2) & 3) << 6) | (((lane >> 4) & 1) << 5) | (((lane >> 5) & 1) << 8); }
constexpr int v_rd_off(int d0, int ks, int half) { return d0 * 512 + ks * 4096 + half * 2048; }
__device__ __forceinline__ int crow(int r, int hi) { return (r & 3) + 8 * (r >> 2) + 4 * hi; }
__device__ __forceinline__ unsigned cvtpk(float lo, float hi) { unsigned r; asm volatile("v_cvt_pk_bf16_f32 %0, %1, %2" : "=v"(r) : "v"(lo), "v"(hi)); return r; }
__device__ __forceinline__ int opq(int x) { asm volatile("" : "+v"(x)); return x; }
__device__ __forceinline__ bf16x8 load8(const bf16* p) { return *reinterpret_cast<const bf16x8*>(p); }

__device__ __forceinline__ void mask_tile(f32x16& p0, f32x16& p1, int dq, unsigned W) {
    const float NEG = -__builtin_inff();
#pragma unroll
    for (int r = 0; r < 16; ++r) {
        const int c = (r & 3) + 8 * (r >> 2);
        if ((unsigned)(dq - c) >= W) p0[r] = NEG;
        if ((unsigned)(dq - c - 32) >= W) p1[r] = NEG;
    }
}
__device__ __forceinline__ void mask_all(f32x16& p0, f32x16& p1) {
    const float NEG = -__builtin_inff();
#pragma unroll
    for (int r = 0; r < 16; ++r) { p0[r] = NEG; p1[r] = NEG; }
}
__device__ __forceinline__ void mask_bits(f32x16& p0, f32x16& p1, unsigned wlo, unsigned whi, int hi) {
    const float NEG = -__builtin_inff();
    const unsigned a = wlo >> (4 * hi), b = whi >> (4 * hi);
#pragma unroll
    for (int r = 0; r < 16; ++r) {
        const int c = (r & 3) + 8 * (r >> 2);
        if (!((a >> c) & 1u)) p0[r] = NEG;
        if (!((b >> c) & 1u)) p1[r] = NEG;
    }
}
__device__ __forceinline__ void partialSM(f32x16& p0, f32x16& p1, float& m_reg, float& mn, float& alpha) {
    float pmax = p0[0]; for (int r = 1; r < 16; ++r) pmax = fmaxf(pmax, p0[r]); for (int r = 0; r < 16; ++r) pmax = fmaxf(pmax, p1[r]);
    { auto rr = __builtin_amdgcn_permlane32_swap(__float_as_uint(pmax), __float_as_uint(pmax), false, false);
      pmax = fmaxf(__uint_as_float(rr[0]), __uint_as_float(rr[1])); }
    constexpr float C2 = 1.4426950408889634f * SCALE;
    if (__builtin_expect(__all((pmax - m_reg) * SCALE <= THR), 1)) { mn = m_reg; alpha = 1.f; }
    else { mn = fmaxf(m_reg, pmax); alpha = __builtin_amdgcn_exp2f((m_reg - mn) * C2); m_reg = mn; }
    const float mnL = -mn * C2;
    for (int r = 0; r < 16; ++r) p0[r] = fmaf(p0[r], C2, mnL); for (int r = 0; r < 16; ++r) p1[r] = fmaf(p1[r], C2, mnL);
    for (int r = 0; r < 16; ++r) p0[r] = __builtin_amdgcn_exp2f(p0[r]);
}
__device__ __forceinline__ void finishSM(f32x16& p0, f32x16& p1, float alpha, float& l_reg, bf16x8& pa0, bf16x8& pa1, bf16x8& pa2, bf16x8& pa3) {
    for (int r = 0; r < 16; ++r) p1[r] = __builtin_amdgcn_exp2f(p1[r]);
    float ps = 0; for (int r = 0; r < 16; ++r) ps += p0[r]; for (int r = 0; r < 16; ++r) ps += p1[r];
    { auto rr = __builtin_amdgcn_permlane32_swap(__float_as_uint(ps), __float_as_uint(ps), false, false);
      ps = __uint_as_float(rr[0]) + __uint_as_float(rr[1]); }
    l_reg = l_reg * alpha + ps;
#define PK4(P, B_, OUT) do { unsigned a0 = cvtpk(P[B_+0], P[B_+1]), a1 = cvtpk(P[B_+2], P[B_+3]);                          \
        unsigned b0 = cvtpk(P[B_+4], P[B_+5]), b1 = cvtpk(P[B_+6], P[B_+7]);                                             \
        auto r0 = __builtin_amdgcn_permlane32_swap(a0, b0, false, false); auto r1 = __builtin_amdgcn_permlane32_swap(a1, b1, false, false); \
        u32x4 w = {r0[0], r1[0], r0[1], r1[1]}; OUT = *reinterpret_cast<bf16x8*>(&w); } while (0)
    PK4(p0, 0, pa0); PK4(p0, 8, pa1); PK4(p1, 0, pa2); PK4(p1, 8, pa3);
#undef PK4
}
template <int KB>
__device__ __forceinline__ void qkt(f32x16& p0, f32x16& p1, const char* K_lds, int r32, int hi, const bf16x8* qr, bool act) {
    if (!act) { mask_all(p0, p1); return; }
    p0 = f32x16{}; p1 = f32x16{};
    const char* kb[4];
#pragma unroll
    for (int dd = 0; dd < 4; ++dd) kb[dd] = K_lds + KB * SHM_K + KSWZ(r32, (dd * 16 + hi * 8) * 2);
#pragma unroll
    for (int d0 = 0; d0 < 8; ++d0) { const char* a = kb[d0 & 3] + (d0 >> 2) * 128;
        bf16x8 b0 = *reinterpret_cast<const bf16x8*>(a);
        bf16x8 b1 = *reinterpret_cast<const bf16x8*>(a + 32 * 256);
        p0 = __builtin_amdgcn_mfma_f32_32x32x16_bf16(b0, qr[d0], p0, 0, 0, 0);
        p1 = __builtin_amdgcn_mfma_f32_32x32x16_bf16(b1, qr[d0], p1, 0, 0, 0); }
}
template <int VB>
__device__ __forceinline__ void pv_tile(f32x16* o, int vb0, bf16x8 pa0, bf16x8 pa1, bf16x8 pa2, bf16x8 pa3, bool act) {
    if (!act) return;
#define TRRD(dst, off) asm volatile("ds_read_b64_tr_b16 %0, %1 offset:%2" : "=&v"(dst) : "v"(vb0), "i"(off) : "memory")
#define PV_D0(d0) do { s16x4 l0, l1, l2, l3, h0, h1, h2, h3; constexpr int b_ = VB * SHM_V + v_rd_off(d0, 0, 0); \
        TRRD(l0, b_); TRRD(h0, b_ + 2048); TRRD(l1, b_ + 4096); TRRD(h1, b_ + 6144); TRRD(l2, b_ + 8192); TRRD(h2, b_ + 10240); TRRD(l3, b_ + 12288); TRRD(h3, b_ + 14336); \
        asm volatile("s_waitcnt lgkmcnt(0)" ::: "memory"); SBAR();   \
        o[d0] = __builtin_amdgcn_mfma_f32_32x32x16_bf16(pa0, (bf16x8){l0[0], l0[1], l0[2], l0[3], h0[0], h0[1], h0[2], h0[3]}, o[d0], 0, 0, 0);   \
        o[d0] = __builtin_amdgcn_mfma_f32_32x32x16_bf16(pa1, (bf16x8){l1[0], l1[1], l1[2], l1[3], h1[0], h1[1], h1[2], h1[3]}, o[d0], 0, 0, 0);   \
        o[d0] = __builtin_amdgcn_mfma_f32_32x32x16_bf16(pa2, (bf16x8){l2[0], l2[1], l2[2], l2[3], h2[0], h2[1], h2[2], h2[3]}, o[d0], 0, 0, 0);   \
        o[d0] = __builtin_amdgcn_mfma_f32_32x32x16_bf16(pa3, (bf16x8){l3[0], l3[1], l3[2], l3[3], h3[0], h3[1], h3[2], h3[3]}, o[d0], 0, 0, 0); } while (0)
    PV_D0(0); PV_D0(1); PV_D0(2); PV_D0(3);
#undef PV_D0
#undef TRRD
}

struct BlockRef { const bf16* Q; const bf16* K; const bf16* V; bf16* O; float* LSE; const unsigned* aux; int P0, ldo, lstr, mode, Wu, m, ecode; };
struct EpiPtrs { const bf16* oc; const bf16* owin; const float* gate; const bf16* ob4; const bf16* ob16; const float* lse4; const float* lse16; };
struct Seam { bf16x8 qr[8]; bf16x8 st_v0, st_v1, st_k0, st_k1; };
__device__ __forceinline__ int jlo_of(const BlockRef& r) { if (r.mode != M_WIN) return 0; int lowk = r.P0 - r.Wu + 1; const int cls = r.P0 & ~(r.m - 1); if (lowk < cls) lowk = cls;
    return lowk > 0 ? lowk / KVBLK : 0; }
__device__ __forceinline__ int tok_of(const BlockRef& r, int p) { return (p & (r.m - 1)) * (SEQ / r.m) + p / r.m; }
#define LDG(base, off) (*reinterpret_cast<const bf16x8*>(reinterpret_cast<const char*>(base) + (off)))
#define VMW() asm volatile("s_waitcnt vmcnt(0)" ::: "memory")
#define VMWN(n) asm volatile("s_waitcnt vmcnt(%0)" :: "i"(n) : "memory")
#define SLOAD_H(R, k0) do { const int t_ = opq(tid); const int p0_ = (k0) + (t_ >> 4), p1_ = p0_ + 32, lm_ = 31 - __builtin_clz((R).m), ld_ = 11 - lm_;                                 \
                         const unsigned c_ = (unsigned)((t_ & 15) * 16);                                                                                                                 \
                         const unsigned o0_ = (unsigned)((((p0_ & ((R).m - 1)) << ld_) + (p0_ >> lm_)) * (D * 2)) + c_, o1_ = (unsigned)((((p1_ & ((R).m - 1)) << ld_) + (p1_ >> lm_)) * (D * 2)) + c_; \
                         S.st_v0 = LDG((R).V, o0_); S.st_v1 = LDG((R).V, o1_); S.st_k0 = LDG((R).K, o0_); S.st_k1 = LDG((R).K, o1_); } while (0)
#define SWRITE_HK(bf) do { const int t_ = opq(tid); const int kws_ = KSWZ(t_ >> 4, (t_ & 15) * 16); *(bf16x8*)(K_lds + (bf) * SHM_K + kws_) = S.st_k0; *(bf16x8*)(K_lds + (bf) * SHM_K + kws_ + 32 * 256) = S.st_k1; } while (0)
#define SWRITE_HV(bf) do { const int t_ = opq(tid); *(bf16x8*)(V_lds + (bf) * SHM_V + v_st(t_ >> 4, (t_ & 15) * 8)) = S.st_v0; *(bf16x8*)(V_lds + (bf) * SHM_V + v_st(32 + (t_ >> 4), (t_ & 15) * 8)) = S.st_v1; } while (0)
#define SWRITE_H(bf) do { SWRITE_HV(bf); SWRITE_HK(bf); } while (0)
__device__ __forceinline__ void prime(const BlockRef& cur, char* lds, Seam& S, int tid) {
    const int wid = __builtin_amdgcn_readfirstlane(tid >> 6), lane = tid & 63, r32 = lane & 31, hi = lane >> 5;
    char* K_lds = lds + 2 * SHM_V;
    const int kb0 = jlo_of(cur) * KVBLK;
    const bf16* qrow = cur.Q + (size_t)tok_of(cur, cur.P0 + wid * QBLK + r32) * D + hi * 8;
    for (int d0 = 0; d0 < 8; ++d0) S.qr[d0] = load8(qrow + d0 * 16);
    SLOAD_H(cur, kb0); VMW(); SWRITE_HK(0);
    __syncthreads();
}
template <class NF> __device__ __forceinline__ void block(const BlockRef& cur, BlockRef& nxt, NF& nf, const EpiPtrs& ep, char* lds, Seam& S, int tid) {
    const int wid = __builtin_amdgcn_readfirstlane(tid >> 6), lane = tid & 63, r32 = lane & 31, hi = lane >> 5;
    const int mode = cur.mode, W = cur.Wu;
    const int j_lo = jlo_of(cur);
    int j_hi = (cur.P0 + QB - 1) / KVBLK + 1; if (j_hi > SEQ / KVBLK) j_hi = SEQ / KVBLK;
    const int NT = j_hi - j_lo;
    const int qlo = cur.P0 + wid * QBLK;
    const int cbase = qlo & (cur.m - 1);
    const bool force = cbase < W - 1;
    unsigned mrow = 0u;
    if (mode == M_SEL) mrow = cur.aux[qlo + r32]; else if (mode == M_BITS) mrow = (unsigned)(qlo + r32) * 256u;
    char* V_lds = lds; char* K_lds = lds + 2 * SHM_V;
    float* ws = (float*)(lds + 2 * SHM_V + 2 * SHM_K) + wid * 64; float* li_l = ws, * al_l = ws + 32;
    float m_reg = -1e30f, l_reg = 0; f32x16 o[4] = {};
#define VB0 ((int)(uintptr_t)V_lds + v_rd_base(opq(lane)))
#define RESC(a) do { if (__any((a) < 1.f)) { if (hi == 0) al_l[r32] = (a); asm volatile("s_waitcnt lgkmcnt(0)" ::: "memory");              \
                     for (int d_ = 0; d_ < 4; ++d_) for (int r = 0; r < 16; ++r) o[d_][r] *= al_l[crow(r, hi)]; } } while (0)
#define KBASE(t) ((j_lo + (t)) * KVBLK)
#define ACT(t) ((mode == M_WIN) ? (KBASE(t) <= qlo + QBLK - 1 && KBASE(t) + KVBLK - 1 >= qlo - W + 1) : ((mode == M_SEL) ? (__any((mrow >> (j_lo + (t))) & 1u) && KBASE(t) <= qlo + QBLK - 1) : (KBASE(t) <= qlo + QBLK - 1)))
#define MASKT(P0_, P1_, t) do { const int kb_ = KBASE(t); if (ACT(t)) { const int l_ = opq(lane); const int qm = qlo + (l_ & 31) - 4 * (l_ >> 5);                                                                                        \
        if (mode == M_WIN) { if (force || kb_ + KVBLK - 1 > qlo || kb_ <= qlo + QBLK - 1 - W) { int rx_ = r32; asm volatile("" : "+v"(rx_));                   \
                const unsigned cp_ = (unsigned)(cbase + rx_ + 1); mask_tile(P0_, P1_, qm - kb_, cp_ < (unsigned)W ? cp_ : (unsigned)W); } }                     \
        else if (mode == M_SEL) { if (kb_ + KVBLK - 1 > qlo) mask_tile(P0_, P1_, qm - kb_, 0x7fffffffu); if (!((mrow >> (j_lo + (t))) & 1u)) mask_all(P0_, P1_); } \
        else { const u32x2 w_ = *(const u32x2*)((const char*)cur.aux + mrow + 8u * (unsigned)(j_lo + (t))); mask_bits(P0_, P1_, w_.x, w_.y, hi); } } } while (0)
    constexpr int NQL = 8;
#define SEAM_K0() do { VMWN(NQL); SWRITE_HK(0); SBAR(); } while (0)
    f32x16 pA0, pA1, pB0, pB1; float mnA, mnB, alA, alB; bf16x8 pa0, pa1, pa2, pa3;
    SWRITE_HV(0); SBAR();
    if (NT > 1) { SLOAD_H(cur, KBASE(1)); }
    SBAR(); qkt<0>(pA0, pA1, K_lds, opq(r32), hi, S.qr, ACT(0));
    MASKT(pA0, pA1, 0); partialSM(pA0, pA1, m_reg, mnA, alA);
    if (NT > 1) { VMW(); SWRITE_H(1); }
    __syncthreads();
#define HALF_STEP(PX0, PX1, mnX, alX, PY0, PY1, alY, t, KB, VB, SB) do {                                                      \
        SBAR(); qkt<KB>(PX0, PX1, K_lds, opq(r32), hi, S.qr, ACT(t));                                                 \
        finishSM(PY0, PY1, alY, l_reg, pa0, pa1, pa2, pa3); SBAR();                                                           \
        if ((t) + 1 < NT) { SLOAD_H(cur, KBASE((t) + 1)); SBAR(); }                                                        \
        pv_tile<VB>(o, VB0, pa0, pa1, pa2, pa3, ACT((t) - 1)); MASKT(PX0, PX1, (t)); partialSM(PX0, PX1, m_reg, mnX, alX);    \
        __syncthreads();                                                                                                      \
        if ((t) + 1 < NT) { VMW(); SWRITE_H(SB); }                                                                            \
        RESC(alX); __syncthreads(); } while (0)
    for (int t = 1; t + 1 < NT; t += 2) {
        HALF_STEP(pB0, pB1, mnB, alB, pA0, pA1, alA, t, 1, 0, 0);
        HALF_STEP(pA0, pA1, mnA, alA, pB0, pB1, alB, t + 1, 0, 1, 1);
    }
    const bool even = (NT & 1) == 0;
    if (even) { SBAR(); qkt<1>(pB0, pB1, K_lds, opq(r32), hi, S.qr, ACT(NT - 1)); SBAR(); }
    nxt = nf(cur); const int kbn = jlo_of(nxt) * KVBLK;
    SLOAD_H(nxt, kbn); SBAR();
    { const bf16* qrow = nxt.Q + (size_t)tok_of(nxt, nxt.P0 + wid * QBLK + r32) * D + hi * 8;
#pragma unroll
      for (int d0 = 0; d0 < 8; ++d0) S.qr[d0] = load8(qrow + d0 * 16); }
    SBAR();
    finishSM(pA0, pA1, alA, l_reg, pa0, pa1, pa2, pa3); SBAR();
    pv_tile<0>(o, VB0, pa0, pa1, pa2, pa3, ACT(even ? NT - 2 : NT - 1));
    if (even) { MASKT(pB0, pB1, NT - 1); partialSM(pB0, pB1, m_reg, mnB, alB); __syncthreads(); RESC(alB);
        finishSM(pB0, pB1, alB, l_reg, pa0, pa1, pa2, pa3); SBAR(); pv_tile<1>(o, VB0, pa0, pa1, pa2, pa3, ACT(NT - 1)); }
    SBAR(); SEAM_K0();
    if (hi == 0) li_l[r32] = l_reg; asm volatile("s_waitcnt lgkmcnt(0)" ::: "memory");
    if (cur.LSE && hi == 0) cur.LSE[(size_t)tok_of(cur, qlo + r32) * cur.lstr] = m_reg * (1.4426950408889634f * SCALE) + __builtin_amdgcn_logf(l_reg);
    float rli[16];
#pragma unroll
    for (int r = 0; r < 16; ++r) rli[r] = __builtin_amdgcn_rcpf(li_l[crow(r, hi)]);
    const int emode = cur.ecode & 15;
    if (emode == 0) {
        char* stg = lds + (wid < 7 ? LDS_BYTES + wid * (32 * 272) : 131072 + 256);
        { const int l_ = opq(lane); char* wp_ = stg + (4 * (l_ >> 5)) * 272 + (l_ & 31) * 2;
#pragma unroll
          for (int r = 0; r < 16; ++r)
#pragma unroll
            for (int d0 = 0; d0 < 4; ++d0) *(unsigned short*)(wp_ + ((r & 3) + 8 * (r >> 2)) * 272 + d0 * 64) = (unsigned short)cvtpk(o[d0][r] * rli[r], 0.f); }
        asm volatile("s_waitcnt lgkmcnt(0)" ::: "memory");
        { const int l_ = opq(lane); const char* rp_ = stg + (l_ >> 4) * 272 + (l_ & 15) * 16;
#pragma unroll
          for (int i = 0; i < 8; ++i) { const u32x4 v = *(const u32x4*)(rp_ + i * 4 * 272);
              *(u32x4*)(cur.O + (size_t)tok_of(cur, qlo + i * 4 + (l_ >> 4)) * cur.ldo + (l_ & 15) * 8) = v; } }
    } else {
        const int ehead = (cur.ecode >> 4) & 15, etb = (cur.ecode >> 8) * SEQ;
        if (emode == 3) { if (hi == 0) al_l[r32] = m_reg * (1.4426950408889634f * SCALE) + __builtin_amdgcn_logf(l_reg); }
        char* stg = lds + (wid < 7 ? LDS_BYTES + wid * (32 * 272) : 131072 + 256);
        { const int l_ = opq(lane); char* wp_ = stg + (4 * (l_ >> 5)) * 272 + (l_ & 31) * 2;
#pragma unroll
          for (int r = 0; r < 16; ++r)
#pragma unroll
            for (int d0 = 0; d0 < 4; ++d0) *(unsigned short*)(wp_ + ((r & 3) + 8 * (r >> 2)) * 272 + d0 * 64) = (unsigned short)cvtpk(o[d0][r] * rli[r], 0.f); }
        asm volatile("s_waitcnt lgkmcnt(0)" ::: "memory");
        const int l_ = opq(lane), rq = l_ >> 4, c8 = (l_ & 15) * 8;
        const char* rp_ = stg + rq * 272 + (l_ & 15) * 16;
#pragma unroll
        for (int ib = 0; ib < 8; ib += 4) {
            u32x4 wo[4], wa[4], wb[4]; float s0[4], s1[4], l1[4];
#pragma unroll
            for (int k = 0; k < 4; ++k) { const int row = (ib + k) * 4 + rq; const size_t tg = (size_t)(etb + qlo + row);
                wo[k] = *(const u32x4*)(rp_ + (ib + k) * 4 * 272);
                if (emode == 2) { const float* gp = ep.gate + tg * 24 + ehead * 3; s0[k] = gp[1]; s1[k] = gp[2]; l1[k] = 0.f;
                    const size_t e = tg * 1024 + ehead * 128 + c8; wa[k] = *(const u32x4*)(ep.oc + e); wb[k] = *(const u32x4*)(ep.owin + e); }
                else { s0[k] = ep.lse4[tg * 4 + ehead]; s1[k] = ep.lse16[tg * 4 + ehead]; l1[k] = al_l[row];
                    const size_t e = tg * 512 + ehead * 128 + c8; wa[k] = *(const u32x4*)(ep.ob4 + e); wb[k] = *(const u32x4*)(ep.ob16 + e); } }
#pragma unroll
            for (int k = 0; k < 4; ++k) { const int row = (ib + k) * 4 + rq;
                float c0, ca, cb;
                if (emode == 2) { c0 = s0[k]; ca = 1.0f; cb = s1[k]; }
                else { const float mm = fmaxf(l1[k], fmaxf(s0[k], s1[k])), w1 = __builtin_amdgcn_exp2f(l1[k] - mm), w4 = __builtin_amdgcn_exp2f(s0[k] - mm), w16 = __builtin_amdgcn_exp2f(s1[k] - mm);
                    const float wi = __builtin_amdgcn_rcpf(w1 + w4 + w16); c0 = w1 * wi; ca = w4 * wi; cb = w16 * wi; }
                u32x4 w;
#pragma unroll
                for (int j = 0; j < 4; ++j) { const unsigned uo = wo[k][j], ua = wa[k][j], ub = wb[k][j];
                    const float x0 = c0 * __uint_as_float(uo << 16) + ca * __uint_as_float(ua << 16) + cb * __uint_as_float(ub << 16);
                    const float x1 = c0 * __uint_as_float(uo & 0xffff0000u) + ca * __uint_as_float(ua & 0xffff0000u) + cb * __uint_as_float(ub & 0xffff0000u);
                    w[j] = cvtpk(x0, x1); }
                *(u32x4*)(cur.O + (size_t)(qlo + row) * cur.ldo + c8) = w; }
        }
    }
    __syncthreads();
#undef RESC
#undef KBASE
#undef ACT
#undef MASKT
#undef SEAM_K0
#undef HALF_STEP
#undef VB0
}
#undef LDG
#undef VMW
#undef VMWN
#undef SLOAD_H
#undef SWRITE_HK
#undef SWRITE_HV
#undef SWRITE_H
#undef KSWZ
}
#ifndef MK_DUP_PH
#define MK_DUP_PH 0
#endif
namespace mk {
typedef unsigned short bf16_t;
typedef short bf16x8 __attribute__((ext_vector_type(8)));
typedef float f32x4 __attribute__((ext_vector_type(4)));
typedef float f32x2 __attribute__((ext_vector_type(2)));
typedef unsigned u32x4 __attribute__((ext_vector_type(4)));
typedef unsigned u32x2 __attribute__((ext_vector_type(2)));
typedef __bf16 bf16x2n __attribute__((ext_vector_type(2)));
#define DI __device__ __forceinline__
DI int otid() { int t = threadIdx.x; asm volatile("" : "+v"(t)); return t; }

constexpr int NB = 8, S = 2048, DM = 2048, T = NB * S, DEPTH = 4;
constexpr int NPAD = 6144, INW = 5992, FF = 5632, NGU = 2 * FF;
constexpr int NSEG = 47;
constexpr float QSCALE = 0.08838834764831845f * 1.4426950408889634f;
constexpr float NEG = -1.0e30f;
constexpr float RMS_EPS = 1e-6f;

constexpr size_t AL(size_t x) { return (x + 255) & ~(size_t)255; }
constexpr size_t WS_CTL   = 0;
constexpr size_t CTL_BYTES = 65536;
constexpr size_t WS_COS128 = WS_CTL + CTL_BYTES;
constexpr size_t WS_SIN128 = WS_COS128 + (size_t)S * 64 * 4;
constexpr size_t WS_COS64  = WS_SIN128 + (size_t)S * 64 * 4;
constexpr size_t WS_SIN64  = WS_COS64 + (size_t)S * 32 * 4;
constexpr size_t WS_WIN   = WS_SIN64 + (size_t)S * 32 * 4;
constexpr size_t WS_WOUT  = WS_WIN + (size_t)NPAD * DM * 2;
constexpr size_t WS_WGU   = WS_WOUT + (size_t)DM * DM * 2;
constexpr size_t WS_WDN   = WS_WGU + (size_t)NGU * DM * 2;
constexpr size_t WS_CW1K  = WS_WDN + (size_t)DM * FF * 2;
constexpr size_t WS_CW1V  = WS_CW1K + (size_t)256 * 4096 * 2;
constexpr size_t WS_CW2K  = WS_CW1V + (size_t)256 * 4096 * 2;
constexpr size_t WS_CW2V  = WS_CW2K + (size_t)128 * 256 * 2;
constexpr size_t WS_CB1   = WS_CW2V + (size_t)128 * 256 * 2;
constexpr size_t WS_H     = AL(WS_CB1 + 2 * 256 * 4);
constexpr size_t WS_MIX   = WS_H + (size_t)T * DM * 2;
constexpr size_t WS_BIG   = WS_MIX + (size_t)T * DM * 2;
constexpr size_t WS_P     = WS_BIG;
constexpr size_t WS_SC    = WS_BIG;
constexpr size_t WS_PART  = WS_BIG + ((size_t)144 << 20);
constexpr size_t WS_HID   = WS_BIG;
constexpr size_t WS_PREP  = WS_BIG + (size_t)T * NPAD * 2;
constexpr size_t WS_Y     = WS_PREP;
constexpr size_t SZ_H4 = (size_t)T * 512 * 2, SZ_H1 = (size_t)T * 128 * 2, SZ_H8 = (size_t)T * 1024 * 2, SZ_H2 = (size_t)T * 256 * 2;
constexpr size_t WS_AQ   = WS_PREP;
constexpr size_t WS_AK   = WS_AQ + SZ_H4;
constexpr size_t WS_AVT  = WS_AK + SZ_H1;
constexpr size_t WS_IQ   = WS_AVT + SZ_H1;
constexpr size_t WS_IK   = WS_IQ + SZ_H8;
constexpr size_t WS_IW   = WS_IK + (size_t)T * 64 * 2;
constexpr size_t WS_GATE = WS_IW + (size_t)T * 16 * 4;
constexpr size_t WS_BQ   = WS_GATE + (size_t)T * 24 * 4;
constexpr size_t WS_BK1  = WS_BQ + SZ_H4;
constexpr size_t WS_BVT1 = WS_BK1 + SZ_H4;
constexpr size_t WS_BK4  = WS_BK1, WS_BK16 = WS_BK1, WS_BVT4 = WS_BVT1, WS_BVT16 = WS_BVT1;
constexpr size_t WS_CQ   = WS_BVT1 + SZ_H4;
constexpr size_t WS_CQR  = WS_CQ + SZ_H8;
constexpr size_t WS_KC   = WS_CQR + SZ_H8;
constexpr size_t WS_VC   = WS_KC + SZ_H2 + 65536;
constexpr size_t WS_CKS  = WS_VC + SZ_H2 + 65536;
constexpr size_t WS_CVST = WS_CKS + SZ_H2;
constexpr size_t WS_CKW  = WS_CVST + SZ_H2;
constexpr size_t WS_CVWT = WS_CKW + SZ_H2;
constexpr size_t WS_PREP_END = WS_CVWT + SZ_H2;
constexpr size_t WS_BITS = WS_PREP_END;
constexpr size_t WS_OB4  = WS_BITS + (size_t)T * 64 * 4;
constexpr size_t WS_OB16 = WS_OB4 + SZ_H4;
constexpr size_t WS_LSE4 = WS_OB16 + SZ_H4;
constexpr size_t WS_LSE16 = WS_LSE4 + (size_t)T * 4 * 4;
constexpr size_t WS_LSE1 = WS_LSE16 + (size_t)T * 4 * 4;
constexpr size_t WS_OB1  = WS_LSE1 + (size_t)T * 4 * 4;
constexpr size_t WS_OSLC = WS_OB1 + SZ_H4;
constexpr size_t WS_OWIN = WS_OSLC + SZ_H8;
constexpr size_t WS_OC   = WS_OWIN + SZ_H8;
constexpr size_t WS_G1K  = WS_OC + SZ_H8;
constexpr size_t WS_G1V  = WS_G1K + (size_t)2048 * 256 * 2;
constexpr size_t WS_KCC  = WS_G1V + (size_t)2048 * 256 * 2;
constexpr size_t WS_VCT  = WS_KCC + (size_t)16 * 128 * 128 * 2;
constexpr size_t WS_SEL  = WS_VCT + (size_t)16 * 128 * 128 * 2;
constexpr size_t WS_XB   = AL(WS_SEL + (size_t)16 * S * 4);
constexpr size_t WS_END  = AL(WS_XB + (size_t)T * DM * 2);
static_assert(WS_HID + (size_t)T * FF * 2 <= WS_PREP, "hidden must fit inside P");
static_assert(WS_SC + (size_t)T * S * 4 <= WS_PART && WS_PART + (size_t)4 * 2048 * 256 * 4 <= WS_PREP, "split-K partials sit between SC and the prep region");
static_assert(WS_Y + (size_t)T * DM * 2 <= WS_PREP_END, "Y must fit inside the prep region");

constexpr int LDS_BAR_OFF = 131072;
constexpr int LDS_BYTES = 131072 + 256 + 128 * 144;   static_assert(2 * 32 * 272 <= 128 * 144 && 32 * 528 <= 128 * 144, "the in-projection's staging tile shares the region");

DI unsigned pk2(float a, float b) { f32x2 v = {a, b}; bf16x2n r = __builtin_convertvector(v, bf16x2n); return __builtin_bit_cast(unsigned, r); }
DI float bflo(unsigned w) { return __uint_as_float(w << 16); }
DI float bfhi(unsigned w) { return __uint_as_float(w & 0xffff0000u); }
DI float bf2f(bf16_t v) { return __uint_as_float(((unsigned)v) << 16); }
DI float wave_sum(float v) {
#pragma unroll
    for (int o = 1; o < 64; o <<= 1) v += __shfl_xor(v, o);
    return v;
}
DI float fexp2(float x) { return __builtin_amdgcn_exp2f(x); }
DI float frcp(float x) { return __builtin_amdgcn_rcpf(x); }
DI void unpack8(const u32x4 w, float (&x)[8]) { x[0] = bflo(w.x); x[1] = bfhi(w.x); x[2] = bflo(w.y); x[3] = bfhi(w.y); x[4] = bflo(w.z); x[5] = bfhi(w.z); x[6] = bflo(w.w); x[7] = bfhi(w.w); }
DI u32x4 pack8(const float (&x)[8]) { u32x4 w; w.x = pk2(x[0], x[1]); w.y = pk2(x[2], x[3]); w.z = pk2(x[4], x[5]); w.w = pk2(x[6], x[7]); return w; }
#define MFMA16(a, b, c) __builtin_amdgcn_mfma_f32_16x16x32_bf16((a), (b), (c), 0, 0, 0)
DI unsigned pk4_i8(float a, float b, float c, float d) {
    const float M = 12582912.0f;
    const unsigned ua = __float_as_uint(__builtin_amdgcn_fmed3f(a, -127.0f, 127.0f) + M), ub = __float_as_uint(__builtin_amdgcn_fmed3f(b, -127.0f, 127.0f) + M),
                   uc = __float_as_uint(__builtin_amdgcn_fmed3f(c, -127.0f, 127.0f) + M), ud = __float_as_uint(__builtin_amdgcn_fmed3f(d, -127.0f, 127.0f) + M);
    return (ua & 0xffu) | ((ub & 0xffu) << 8) | ((uc & 0xffu) << 16) | (ud << 24); }
constexpr size_t CTL_WMAX = 12288;
constexpr float F8_SW = 1024.0f, F8_SH = 16.0f, F8_SHID = 8.0f;
DI unsigned pk4_f8(float a, float b, float c, float d) {
    a = __builtin_amdgcn_fmed3f(a, -448.0f, 448.0f); b = __builtin_amdgcn_fmed3f(b, -448.0f, 448.0f); c = __builtin_amdgcn_fmed3f(c, -448.0f, 448.0f); d = __builtin_amdgcn_fmed3f(d, -448.0f, 448.0f);
    int w = __builtin_amdgcn_cvt_pk_fp8_f32(a, b, 0, false); w = __builtin_amdgcn_cvt_pk_fp8_f32(c, d, w, true); return (unsigned)w; }

struct Ptrs {
    const float* in[16];
    float* out;
    unsigned char* ws;
};
template <class TT> DI TT* wsp(const Ptrs& P, size_t off) { return (TT*)(P.ws + off); }

DI void phase_rope_tables(const Ptrs& P) {
    float* c128 = wsp<float>(P, WS_COS128); float* s128 = wsp<float>(P, WS_SIN128); float* c64 = wsp<float>(P, WS_COS64); float* s64 = wsp<float>(P, WS_SIN64);
    const int gt = blockIdx.x * blockDim.x + otid(), ng = gridDim.x * blockDim.x;
    for (int i = gt; i < S * 64; i += ng) { const int t = i >> 6, k = i & 63; const float inv = exp2f(-(float)k * (13.287712379549449f / 64.0f));
        const double a = (double)t * (double)inv * 0.15915494309189535; const float fr = (float)(a - floor(a));
        c128[i] = __builtin_amdgcn_cosf(fr); s128[i] = __builtin_amdgcn_sinf(fr); }
    for (int i = gt; i < S * 32; i += ng) { const int t = i >> 5, k = i & 31; const float inv = exp2f(-(float)k * (13.287712379549449f / 32.0f));
        const double a = (double)t * (double)inv * 0.15915494309189535; const float fr = (float)(a - floor(a));
        c64[i] = __builtin_amdgcn_cosf(fr); s64[i] = __builtin_amdgcn_sinf(fr); }
}

DI int incol(int pc) {
    const int tile = pc >> 8, q = pc & 255, bj = q >> 7, r = q & 127, wc = r >> 5, p = r & 31;
    if (tile == 23) { if (wc == 0) return 1792 + 32 * bj + p; if (wc == 1) { if (bj == 0) return p < 16 ? 1856 + p : -1; return p < 24 ? 5968 + p : -1; } return -1; }
    const int seg = 2 * tile + (wc >> 1), base = (seg < 14) ? seg * 128 : seg * 128 + 80;
    if (seg >= 6 && seg < 14) return base + 64 * (wc & 1) + 32 * bj + p;
    return base + 64 * bj + 32 * (wc & 1) + p;
}
DI int q_next(unsigned* ctr, unsigned char* lds, int tid) {
    volatile int* slot = (volatile int*)(lds + LDS_BAR_OFF + 64);
    __syncthreads();
    if (tid == 0) *slot = (int)__hip_atomic_fetch_add(ctr, 1u, __ATOMIC_RELAXED, __HIP_MEMORY_SCOPE_AGENT);
    __syncthreads();
    return __builtin_amdgcn_readfirstlane(*slot);
}
struct ConvIt { const float* src; bf16_t* dst; int srcN, K, n0, k0, sc, f8; float wmax; };
DI ConvIt conv_decode(const Ptrs& P, int layer, int it, int tid) {
    const float* w_in = P.in[1] + (size_t)layer * DM * INW; const float* w_out = P.in[2] + (size_t)layer * DM * DM;
    const float* w1k = P.in[4] + (size_t)layer * 4096 * 256; const float* w2k = P.in[5] + (size_t)layer * 256 * 128;
    const float* w1v = P.in[7] + (size_t)layer * 4096 * 256; const float* w2v = P.in[8] + (size_t)layer * 256 * 128;
    const float* wg = P.in[9] + (size_t)layer * DM * FF; const float* wu = P.in[10] + (size_t)layer * DM * FF; const float* wd = P.in[11] + (size_t)layer * FF * DM;
    constexpr int I0 = (NPAD / 64) * (DM / 128), I1 = (DM / 64) * (DM / 128), I2 = (NGU / 64) * (DM / 128), I3 = (DM / 64) * (FF / 128), I4 = 4 * 32, I6 = 2 * 2;
    const int nq = (tid & 15) * 4;
    ConvIt c; c.f8 = 0; c.wmax = 0.f; int r = it;
    if (r < I0) { const int nt = r / (DM / 128), kt = r % (DM / 128); c.src = w_in; c.dst = wsp<bf16_t>(P, WS_WIN); c.srcN = INW; c.K = DM; c.n0 = nt * 64; c.k0 = kt * 128; c.sc = incol(c.n0 + nq); c.f8 = 2;
        c.wmax = __uint_as_float(__builtin_amdgcn_readfirstlane(__hip_atomic_load((unsigned*)(P.ws + WS_CTL) + CTL_WMAX + layer * 64 + 1, __ATOMIC_RELAXED, __HIP_MEMORY_SCOPE_AGENT))); return c; } r -= I0;
    if (r < I4) { const int nt = r / 32, kt = r % 32; c.src = w1k; c.dst = wsp<bf16_t>(P, WS_CW1K); c.srcN = 256; c.K = 4096; c.n0 = nt * 64; c.k0 = kt * 128; c.sc = c.n0 + nq; return c; } r -= I4;
    if (r < I4) { const int nt = r / 32, kt = r % 32; c.src = w1v; c.dst = wsp<bf16_t>(P, WS_CW1V); c.srcN = 256; c.K = 4096; c.n0 = nt * 64; c.k0 = kt * 128; c.sc = c.n0 + nq; return c; } r -= I4;
    if (r < I6) { const int nt = r / 2, kt = r % 2; c.src = w2k; c.dst = wsp<bf16_t>(P, WS_CW2K); c.srcN = 128; c.K = 256; c.n0 = nt * 64; c.k0 = kt * 128; c.sc = c.n0 + nq; return c; } r -= I6;
    if (r < I6) { const int nt = r / 2, kt = r % 2; c.src = w2v; c.dst = wsp<bf16_t>(P, WS_CW2V); c.srcN = 128; c.K = 256; c.n0 = nt * 64; c.k0 = kt * 128; c.sc = c.n0 + nq; return c; } r -= I6;
    if (r < I1) { const int nt = r / (DM / 128), kt = r % (DM / 128); c.src = w_out; c.dst = wsp<bf16_t>(P, WS_WOUT); c.srcN = DM; c.K = DM; c.n0 = nt * 64; c.k0 = kt * 128; c.sc = c.n0 + nq; return c; } r -= I1;
    constexpr int DA = (I1 + I2 + I3) / 4 - I1; static_assert(DA >= 0 && DA <= I3, "late-set split");
    if (r >= DA && r < DA + I2) { r -= DA; const int nt = r / (DM / 128), kt = r % (DM / 128); const int n0 = nt * 64, tl = n0 >> 8, o = n0 & 255;
        c.src = (o < 128) ? wg : wu; c.dst = wsp<bf16_t>(P, WS_WGU); c.srcN = FF; c.K = DM; c.n0 = n0; c.k0 = kt * 128; c.sc = tl * 128 + (o & 127) + nq; c.f8 = 2; c.wmax = __uint_as_float(__builtin_amdgcn_readfirstlane(__hip_atomic_load((unsigned*)(P.ws + WS_CTL) + CTL_WMAX + layer * 64, __ATOMIC_RELAXED, __HIP_MEMORY_SCOPE_AGENT))); return c; }
    if (r >= DA) r -= I2;
    { const int nt = r / (FF / 128), kt = r % (FF / 128); c.src = wd; c.dst = wsp<bf16_t>(P, WS_WDN); c.srcN = DM; c.K = FF; c.n0 = nt * 64; c.k0 = kt * 128; c.sc = c.n0 + nq; c.f8 = 1; return c; }
}
constexpr int CONV_EARLY = (NPAD / 64) * (DM / 128) + 2 * 4 * 32 + 2 * 2 * 2;
constexpr int CONV_NIT = (NPAD / 64) * (DM / 128) + (DM / 64) * (DM / 128) + (NGU / 64) * (DM / 128) + (DM / 64) * (FF / 128) + 2 * 4 * 32 + 2 * 2 * 2;
DI void conv_load(const ConvIt& c, int tid, f32x4 (&v)[4]) {
    const int kr = tid >> 4;
#pragma unroll
    for (int i = 0; i < 4; ++i) v[i] = (c.sc >= 0) ? __builtin_nontemporal_load((const f32x4*)(c.src + (size_t)(c.k0 + kr + 32 * i) * c.srcN + c.sc)) : (f32x4){0.f, 0.f, 0.f, 0.f};
}
DI void conv_store(const ConvIt& c, int tid, const f32x4 (&v)[4], float* tile  ) {
    const int nq = (tid & 15) * 4, kr = tid >> 4;
#pragma unroll
    for (int i = 0; i < 4; ++i)
#pragma unroll
        for (int e = 0; e < 4; ++e) tile[(nq + e) * 129 + kr + 32 * i] = v[i][e];
    __syncthreads();
    const int n2 = tid >> 3, c8 = tid & 7;
#pragma unroll
    for (int j = 0; j < 2; ++j) { float x[8];
#pragma unroll
        for (int e = 0; e < 8; ++e) x[e] = tile[n2 * 129 + 8 * c8 + 64 * j + e];
        if (c.f8 == 2) { const float sw = 127.0f / fmaxf(c.wmax, 1e-30f); u32x2 w; w.x = pk4_i8(x[0] * sw, x[1] * sw, x[2] * sw, x[3] * sw); w.y = pk4_i8(x[4] * sw, x[5] * sw, x[6] * sw, x[7] * sw);
            *(u32x2*)((unsigned char*)c.dst + (size_t)(c.n0 + n2) * c.K + c.k0 + 8 * c8 + 64 * j) = w; }
        else if (c.f8) { u32x2 w; w.x = pk4_f8(x[0] * F8_SW, x[1] * F8_SW, x[2] * F8_SW, x[3] * F8_SW); w.y = pk4_f8(x[4] * F8_SW, x[5] * F8_SW, x[6] * F8_SW, x[7] * F8_SW);
            *(u32x2*)((unsigned char*)c.dst + (size_t)(c.n0 + n2) * c.K + c.k0 + 8 * c8 + 64 * j) = w; }
        else *(u32x4*)(c.dst + (size_t)(c.n0 + n2) * c.K + c.k0 + 8 * c8 + 64 * j) = pack8(x); }
}
DI void conv_range(const Ptrs& P, int layer, unsigned char* lds, int first, int end, int step) {
    const int tid = otid();
    float* tileA = (float*)lds; float* tileB = (float*)lds + 64 * 129;
    int it = first;
    if (it < end) {
        ConvIt ca = conv_decode(P, layer, it, tid), cb = ca; f32x4 va[4], vb[4];
        conv_load(ca, tid, va);
        for (;;) {
            const bool nb = it + step < end; if (nb) { cb = conv_decode(P, layer, it + step, tid); conv_load(cb, tid, vb); }
            conv_store(ca, tid, va, tileA);
            if (!nb) break;
            it += step;
            const bool na = it + step < end; if (na) { ca = conv_decode(P, layer, it + step, tid); conv_load(ca, tid, va); }
            conv_store(cb, tid, vb, tileB);
            if (!na) break;
            it += step;
        }
    }
    __syncthreads();
}
constexpr int CONV_FILL_TILES = 4, CONV_FILL_ITEMS = (CONV_NIT - CONV_EARLY) / CONV_FILL_TILES, CONV_FILL_PER_PHASE = CONV_FILL_ITEMS / 4;
static_assert((CONV_NIT - CONV_EARLY) % (CONV_FILL_TILES * 4) == 0, "filler items must split evenly over the four attention phases");
constexpr int WMAX_ITEMS = 512;
DI void wmax_item(const Ptrs& P, int layer, int it, unsigned char* lds) {
    constexpr int N4 = DM * FF / 4, PER = N4 / WMAX_ITEMS; static_assert(N4 % WMAX_ITEMS == 0 && PER % (512 * 11) == 0, "slice shape");
    const int tid = otid();
    const f32x4* wg = (const f32x4*)(P.in[9] + (size_t)layer * DM * FF) + (size_t)it * PER + tid; const f32x4* wu = (const f32x4*)(P.in[10] + (size_t)layer * DM * FF) + (size_t)it * PER + tid;
    float m = 0.f;
#pragma unroll 1
    for (int h = 0; h < PER / 512; h += 11) { f32x4 a[11], b[11];
#pragma unroll
        for (int j = 0; j < 11; ++j) { a[j] = wg[(h + j) * 512]; b[j] = wu[(h + j) * 512]; }
#pragma unroll
        for (int j = 0; j < 11; ++j) { m = fmaxf(m, fmaxf(fmaxf(fabsf(a[j][0]), fabsf(a[j][1])), fmaxf(fabsf(a[j][2]), fabsf(a[j][3])))); m = fmaxf(m, fmaxf(fmaxf(fabsf(b[j][0]), fabsf(b[j][1])), fmaxf(fabsf(b[j][2]), fabsf(b[j][3])))); } }
    unsigned* slot = (unsigned*)(lds + LDS_BAR_OFF + 128);
    if (tid == 0) *slot = 0u;
    __syncthreads();
    __hip_atomic_fetch_max(slot, __float_as_uint(m), __ATOMIC_RELAXED, __HIP_MEMORY_SCOPE_WORKGROUP);
    __syncthreads();
    if (tid == 0) __hip_atomic_fetch_max((unsigned*)(P.ws + WS_CTL) + CTL_WMAX + layer * 64, *slot, __ATOMIC_RELAXED, __HIP_MEMORY_SCOPE_AGENT);
}
DI void wmax_in_item(const Ptrs& P, int layer, int it, unsigned char* lds) {
    constexpr int N4 = DM * INW / 4, PER = N4 / WMAX_ITEMS; static_assert(N4 % WMAX_ITEMS == 0 && PER <= 12 * 512, "slice shape");
    const int tid = otid();
    const f32x4* w = (const f32x4*)(P.in[1] + (size_t)layer * DM * INW) + (size_t)it * PER;
    float m = 0.f; f32x4 a[12];
#pragma unroll
    for (int j = 0; j < 12; ++j) { int i = tid + 512 * j; i = i < PER ? i : PER - 1; a[j] = w[i]; }
#pragma unroll
    for (int j = 0; j < 12; ++j) m = fmaxf(m, fmaxf(fmaxf(fabsf(a[j][0]), fabsf(a[j][1])), fmaxf(fabsf(a[j][2]), fabsf(a[j][3]))));
    unsigned* slot = (unsigned*)(lds + LDS_BAR_OFF + 128);
    if (tid == 0) *slot = 0u;
    __syncthreads();
    __hip_atomic_fetch_max(slot, __float_as_uint(m), __ATOMIC_RELAXED, __HIP_MEMORY_SCOPE_WORKGROUP);
    __syncthreads();
    if (tid == 0) __hip_atomic_fetch_max((unsigned*)(P.ws + WS_CTL) + CTL_WMAX + layer * 64 + 1, *slot, __ATOMIC_RELAXED, __HIP_MEMORY_SCOPE_AGENT);
    __syncthreads();
}
DI void bias1_item(const Ptrs& P, int layer, int j) {
    const int tid = otid(), wid = tid >> 6, lane = tid & 63, o = j * 8 + wid, kv = o >> 8, n = o & 255;
    const float* pe = P.in[kv ? 6 : 3] + (size_t)layer * 4096; const float* w1 = P.in[kv ? 7 : 4] + (size_t)layer * 4096 * 256;
    float sacc = 0.f;
    for (int k = lane; k < 4096; k += 64) sacc += pe[k] * w1[(size_t)k * 256 + n];
    sacc = wave_sum(sacc);
    if (lane == 0) wsp<float>(P, WS_CB1)[o] = sacc;
}
constexpr int EARLY_ITEMS = CONV_EARLY / CONV_FILL_TILES; static_assert(CONV_EARLY % CONV_FILL_TILES == 0, "early set in filler items");
DI void conv_filler(const Ptrs& P, int layer, unsigned char* lds, unsigned* ctr, int part) {
    const bool nxt = layer + 1 < DEPTH;
    int extra = 0;
    if (part == 0) extra = WMAX_ITEMS; else if (nxt) extra = (part == 1) ? WMAX_ITEMS : (part == 2 ? EARLY_ITEMS / 2 : EARLY_ITEMS - EARLY_ITEMS / 2 + 64);
    for (int it = q_next(ctr, lds, otid()); it < CONV_FILL_PER_PHASE + extra; it = q_next(ctr, lds, otid())) {
        const int j = it - CONV_FILL_PER_PHASE;
        if (j >= 0 && part == 0) { wmax_item(P, layer, j, lds); continue; }
        if (j >= 0 && part == 1) { wmax_in_item(P, layer + 1, j, lds); continue; }
        int lyr = layer, t0 = CONV_EARLY + (part * CONV_FILL_PER_PHASE + it) * CONV_FILL_TILES;
        if (j >= 0) { const int e = (part == 2) ? j : j + EARLY_ITEMS / 2; if (e >= EARLY_ITEMS) { bias1_item(P, layer + 1, e - EARLY_ITEMS); continue; } lyr = layer + 1; t0 = e * CONV_FILL_TILES; }
        conv_range(P, lyr, lds, t0, t0 + CONV_FILL_TILES, 1); }
}
DI void phase_wconv(const Ptrs& P, int layer, unsigned char* lds) {
    const int tid = otid();
    conv_range(P, layer, lds, blockIdx.x, CONV_EARLY, gridDim.x);
    __syncthreads();
    if (blockIdx.x < 64) {
        const int wid = tid >> 6, lane = tid & 63, o = blockIdx.x * 8 + wid, kv = o >> 8, n = o & 255;
        const float* pe = P.in[kv ? 6 : 3] + (size_t)layer * 4096; const float* w1 = P.in[kv ? 7 : 4] + (size_t)layer * 4096 * 256;
        float sacc = 0.f;
        for (int k = lane; k < 4096; k += 64) sacc += pe[k] * w1[(size_t)k * 256 + n];
        sacc = wave_sum(sacc);
        if (lane == 0) wsp<float>(P, WS_CB1)[o] = sacc;
    }
}

template <bool XI, bool XO, int H8 = 0  > DI void phase_norm(const void* xin_, void* xout_, const bf16_t* Y, const float* g_post, const float* g_pre, bf16_t* H) {
    const float* xin = (const float*)xin_; float* xout = (float*)xout_; const bf16_t* xinb = (const bf16_t*)xin_; bf16_t* xoutb = (bf16_t*)xout_;
    const int lane = otid() & 63, gw = blockIdx.x * 8 + (otid() >> 6), ngw = gridDim.x * 8;
    for (int row = gw; row < T; row += ngw) {
        float xv[4][8];
#pragma unroll
        for (int j = 0; j < 4; ++j) { const int col = 8 * (lane + 64 * j);
            if (XI) { unpack8(*(const u32x4*)(xinb + (size_t)row * DM + col), xv[j]); }
            else { const f32x4 a = *(const f32x4*)(xin + (size_t)row * DM + col), b = *(const f32x4*)(xin + (size_t)row * DM + col + 4);
                xv[j][0] = a[0]; xv[j][1] = a[1]; xv[j][2] = a[2]; xv[j][3] = a[3]; xv[j][4] = b[0]; xv[j][5] = b[1]; xv[j][6] = b[2]; xv[j][7] = b[3]; } }
        if (Y) {
            float yv[4][8]; float ss = 0.f;
#pragma unroll
            for (int j = 0; j < 4; ++j) { const int col = 8 * (lane + 64 * j); const u32x4 w = *(const u32x4*)(Y + (size_t)row * DM + col); unpack8(w, yv[j]);
#pragma unroll
                for (int e = 0; e < 8; ++e) ss += yv[j][e] * yv[j][e]; }
            const float rstd = rsqrtf(wave_sum(ss) * (1.0f / DM) + RMS_EPS);
#pragma unroll
            for (int j = 0; j < 4; ++j) { const int col = 8 * (lane + 64 * j); const f32x4 ga = *(const f32x4*)(g_post + col), gb = *(const f32x4*)(g_post + col + 4);
#pragma unroll
                for (int e = 0; e < 4; ++e) { xv[j][e] += yv[j][e] * rstd * ga[e]; xv[j][4 + e] += yv[j][4 + e] * rstd * gb[e]; }
                if (XO) { *(u32x4*)(xoutb + (size_t)row * DM + col) = pack8(xv[j]); unpack8(pack8(xv[j]), xv[j]); }
                else { *(f32x4*)(xout + (size_t)row * DM + col) = (f32x4){xv[j][0], xv[j][1], xv[j][2], xv[j][3]};
                    *(f32x4*)(xout + (size_t)row * DM + col + 4) = (f32x4){xv[j][4], xv[j][5], xv[j][6], xv[j][7]}; } }
        }
        if (H) {
            float ss = 0.f;
#pragma unroll
            for (int j = 0; j < 4; ++j)
#pragma unroll
                for (int e = 0; e < 8; ++e) ss += xv[j][e] * xv[j][e];
            const float rstd = rsqrtf(wave_sum(ss) * (1.0f / DM) + RMS_EPS);
            if (H8 == 2) { float am = 0.f;
#pragma unroll
                for (int j = 0; j < 4; ++j) { const int col = 8 * (lane + 64 * j); const f32x4 ga = *(const f32x4*)(g_pre + col), gb = *(const f32x4*)(g_pre + col + 4);
#pragma unroll
                    for (int e = 0; e < 4; ++e) { xv[j][e] *= rstd * ga[e]; xv[j][4 + e] *= rstd * gb[e]; am = fmaxf(am, fmaxf(fabsf(xv[j][e]), fabsf(xv[j][4 + e]))); } }
#pragma unroll
                for (int o = 1; o < 64; o <<= 1) am = fmaxf(am, __shfl_xor(am, o));
                am = fmaxf(am, 1e-30f); const float sa = 127.0f / am;
                if (lane == 0) ((float*)((unsigned char*)H + (size_t)T * DM))[row] = am * (1.0f / 127.0f);
#pragma unroll
                for (int j = 0; j < 4; ++j) { const int col = 8 * (lane + 64 * j); u32x2 w; w.x = pk4_i8(xv[j][0] * sa, xv[j][1] * sa, xv[j][2] * sa, xv[j][3] * sa); w.y = pk4_i8(xv[j][4] * sa, xv[j][5] * sa, xv[j][6] * sa, xv[j][7] * sa);
                    *(u32x2*)((unsigned char*)H + (size_t)row * DM + col) = w; }
            } else
#pragma unroll
            for (int j = 0; j < 4; ++j) { const int col = 8 * (lane + 64 * j); const f32x4 ga = *(const f32x4*)(g_pre + col), gb = *(const f32x4*)(g_pre + col + 4); float hv[8];
#pragma unroll
                for (int e = 0; e < 4; ++e) { hv[e] = xv[j][e] * rstd * ga[e]; hv[4 + e] = xv[j][4 + e] * rstd * gb[e]; }
                if (H8) { u32x2 w; w.x = pk4_f8(hv[0] * F8_SH, hv[1] * F8_SH, hv[2] * F8_SH, hv[3] * F8_SH); w.y = pk4_f8(hv[4] * F8_SH, hv[5] * F8_SH, hv[6] * F8_SH, hv[7] * F8_SH);
                    *(u32x2*)((unsigned char*)H + (size_t)row * DM + col) = w; }
                else *(u32x4*)(H + (size_t)row * DM + col) = pack8(hv); }
        }
    }
}

struct EpiSwiglu {
    static constexpr bool PERM = true, AFTER_DRAIN = false;
    bf16_t* O; int ldc;
    __device__ __forceinline__ void operator()(const pg8::f32x4 (&acc)[2][2][4][2], const pg8::Unit& u, int wr, int wc, int fr, int fq) const {
        const int row0 = u.pm * 256 + wr * 64 + fr, col0 = u.pn * 128 + wc * 32 + 8 * fq;
#pragma unroll
        for (int ai = 0; ai < 2; ++ai)
#pragma unroll
            for (int m = 0; m < 4; ++m) { bf16_t* rowp = O + (size_t)(row0 + ai * 128 + m * 16) * ldc + col0; float h[8];
#pragma unroll
                for (int n = 0; n < 2; ++n)
#pragma unroll
                    for (int i = 0; i < 4; ++i) { const float g = acc[ai][0][m][n][i], up = acc[ai][1][m][n][i]; h[4 * n + i] = g * frcp(1.0f + fexp2(-1.4426950408889634f * g)) * up; }
                *(u32x4*)rowp = pack8(h); }
    }
};

struct EpiSwiglu8 {
    static constexpr bool PERM = true, AFTER_DRAIN = false;
    unsigned char* O; int ldc;
    __device__ __forceinline__ void operator()(const pg8::f32x4 (&acc)[2][2][4][2], const pg8::Unit& u, int wr, int wc, int fr, int fq) const {
        const int row0 = u.pm * 256 + wr * 64 + fr, col0 = u.pn * 128 + wc * 32 + 8 * fq;
        constexpr float US = 1.0f / (F8_SH * F8_SW);
#pragma unroll
        for (int ai = 0; ai < 2; ++ai)
#pragma unroll
            for (int m = 0; m < 4; ++m) { unsigned char* rowp = O + (size_t)(row0 + ai * 128 + m * 16) * ldc + col0; float h[8];
#pragma unroll
                for (int n = 0; n < 2; ++n)
#pragma unroll
                    for (int i = 0; i < 4; ++i) { const float g = acc[ai][0][m][n][i] * US, up = acc[ai][1][m][n][i] * (US * F8_SHID); h[4 * n + i] = g * frcp(1.0f + fexp2(-1.4426950408889634f * g)) * up; }
                u32x2 w; w.x = pk4_f8(h[0], h[1], h[2], h[3]); w.y = pk4_f8(h[4], h[5], h[6], h[7]);
                *(u32x2*)rowp = w; }
    }
};
struct EpiSwigluI8 {
    static constexpr bool PERM = true, AFTER_DRAIN = false, STAGED = true;
    static constexpr int PITCH = 144;
    unsigned char* O; int ldc; const float* rs; float ws;
    __device__ __forceinline__ void staged(const pg8::f32x4 (&acc)[2][2][4][2], const pg8::Unit& u, int wr, int wc, int fr, int fq, PG8_LAS unsigned char* ep, int wid, int lane) const {
        const int row0 = u.pm * 256 + wr * 64 + fr;
        float scv[8];
#pragma unroll
        for (int i = 0; i < 8; ++i) scv[i] = rs[row0 + (i >> 2) * 128 + (i & 3) * 16] * ws;
#pragma unroll
        for (int ai = 0; ai < 2; ++ai) {
#pragma unroll
            for (int m = 0; m < 4; ++m) { float h[8]; const float sc = scv[ai * 4 + m];
#pragma unroll
                for (int n = 0; n < 2; ++n)
#pragma unroll
                    for (int i = 0; i < 4; ++i) { const float g = (float)__float_as_int(acc[ai][0][m][n][i]) * sc, up = (float)__float_as_int(acc[ai][1][m][n][i]) * (sc * F8_SHID); h[4 * n + i] = g * frcp(1.0f + fexp2(-1.4426950408889634f * g)) * up; }
                u32x2 w; w.x = pk4_f8(h[0], h[1], h[2], h[3]); w.y = pk4_f8(h[4], h[5], h[6], h[7]);
                *(PG8_LAS u32x2*)(ep + (wr * 64 + m * 16 + fr) * PITCH + wc * 32 + 8 * fq) = w; }
            asm volatile("s_waitcnt lgkmcnt(0)" ::: "memory"); __builtin_amdgcn_s_barrier(); asm volatile("" ::: "memory");
            u32x4 v[2];
#pragma unroll
            for (int h2 = 0; h2 < 2; ++h2) v[h2] = *(const PG8_LAS u32x4*)(ep + (wid * 16 + h2 * 8 + (lane >> 3)) * PITCH + (lane & 7) * 16);
            asm volatile("s_waitcnt lgkmcnt(0)" ::: "memory"); __builtin_amdgcn_s_barrier(); asm volatile("" ::: "memory");
#pragma unroll
            for (int h2 = 0; h2 < 2; ++h2) *(u32x4*)(O + (size_t)(u.pm * 256 + ai * 128 + wid * 16 + h2 * 8 + (lane >> 3)) * ldc + u.pn * 128 + (lane & 7) * 16) = v[h2];
        }
    }
    __device__ __forceinline__ void operator()(const pg8::f32x4 (&acc)[2][2][4][2], const pg8::Unit& u, int wr, int wc, int fr, int fq) const {
        const int row0 = u.pm * 256 + wr * 64 + fr, col0 = u.pn * 128 + wc * 32 + 8 * fq;
#pragma unroll
        for (int ai = 0; ai < 2; ++ai)
#pragma unroll
            for (int m = 0; m < 4; ++m) { const int row = row0 + ai * 128 + m * 16; unsigned char* rowp = O + (size_t)row * ldc + col0; float h[8]; const float sc = rs[row] * ws;
#pragma unroll
                for (int n = 0; n < 2; ++n)
#pragma unroll
                    for (int i = 0; i < 4; ++i) { const float g = (float)__float_as_int(acc[ai][0][m][n][i]) * sc, up = (float)__float_as_int(acc[ai][1][m][n][i]) * (sc * F8_SHID); h[4 * n + i] = g * frcp(1.0f + fexp2(-1.4426950408889634f * g)) * up; }
                u32x2 w; w.x = pk4_f8(h[0], h[1], h[2], h[3]); w.y = pk4_f8(h[4], h[5], h[6], h[7]);
                *(u32x2*)rowp = w; }
    }
};
struct EpiRowsBf16 {
    static constexpr bool PERM = true, AFTER_DRAIN = false, STAGED = true;
    static constexpr int RPITCH = 528;
    bf16_t* O; int ldc; float US;
    __device__ __forceinline__ void staged(const pg8::f32x4 (&acc)[2][2][4][2], const pg8::Unit& u, int wr, int wc, int fr_in, int fq_in, PG8_LAS unsigned char* ep, int wid, int lane_in) const {
        int fr = fr_in, fq = fq_in, lane = lane_in; asm volatile("" : "+v"(fr), "+v"(fq), "+v"(lane));
        PG8_LAS unsigned char* wt = ep + (wr * 16 + fr) * RPITCH + (wc * 32 + 8 * fq) * 2;
        const int rrow = wid * 4 + (lane >> 5);
        const PG8_LAS unsigned char* rt = ep + rrow * RPITCH + (lane & 31) * 16;
        bf16_t* obase = O + (size_t)(u.pm * 256 + (rrow >> 4) * 64 + (rrow & 15)) * ldc + u.pn * 256 + (lane & 31) * 8;
#pragma unroll
        for (int idx = 0; idx < 8; ++idx) { const int ai = idx >> 2, m = idx & 3;
#pragma unroll
            for (int bj = 0; bj < 2; ++bj) { const pg8::f32x4 v0 = acc[ai][bj][m][0] * US, v1 = acc[ai][bj][m][1] * US;
                u32x4 w; w.x = pg8::cvt_pk_bf16(v0[0], v0[1]); w.y = pg8::cvt_pk_bf16(v0[2], v0[3]); w.z = pg8::cvt_pk_bf16(v1[0], v1[1]); w.w = pg8::cvt_pk_bf16(v1[2], v1[3]);
                *(PG8_LAS u32x4*)(wt + bj * 256) = w; }
            asm volatile("s_waitcnt lgkmcnt(0)" ::: "memory"); __builtin_amdgcn_s_barrier(); asm volatile("" ::: "memory");
            const u32x4 r0 = *(const PG8_LAS u32x4*)rt, r1 = *(const PG8_LAS u32x4*)(rt + 2 * RPITCH);
            asm volatile("s_waitcnt lgkmcnt(0)" ::: "memory"); __builtin_amdgcn_s_barrier(); asm volatile("" ::: "memory");
            bf16_t* d = obase + (size_t)(ai * 128 + m * 16) * ldc;
            *(u32x4*)d = r0; *(u32x4*)(d + (size_t)2 * ldc) = r1; }
    }
};
struct EpiDown8 {
    static constexpr bool PERM = true, AFTER_DRAIN = false;
    bf16_t* O; int ldc;
    __device__ __forceinline__ void operator()(const pg8::f32x4 (&acc)[2][2][4][2], const pg8::Unit& u, int wr, int wc, int fr, int fq) const {
        const int row0 = u.pm * 256 + wr * 64 + fr, col0 = u.pn * 256 + wc * 32 + 8 * fq;
        constexpr float US = 1.0f / (F8_SHID * F8_SW);
#pragma unroll
        for (int ai = 0; ai < 2; ++ai)
#pragma unroll
            for (int m = 0; m < 4; ++m) { bf16_t* rowp = O + (size_t)(row0 + ai * 128 + m * 16) * ldc + col0;
#pragma unroll
                for (int bj = 0; bj < 2; ++bj) { const pg8::f32x4 v0 = acc[ai][bj][m][0] * US, v1 = acc[ai][bj][m][1] * US;
                    u32x4 w; w.x = pg8::cvt_pk_bf16(v0[0], v0[1]); w.y = pg8::cvt_pk_bf16(v0[2], v0[3]); w.z = pg8::cvt_pk_bf16(v1[0], v1[1]); w.w = pg8::cvt_pk_bf16(v1[2], v1[3]);
                    *(u32x4*)(rowp + bj * 128) = w; } }
    }
};

struct EpiPart {
    static constexpr bool PERM = true, AFTER_DRAIN = false;
    float* C;
    __device__ __forceinline__ void operator()(const pg8::f32x4 (&acc)[2][2][4][2], const pg8::Unit& u, int wr, int wc, int fr, int fq) const {
        const int row0 = u.pm * 256 + wr * 64 + fr, col0 = wc * 32 + 8 * fq;
#pragma unroll
        for (int ai = 0; ai < 2; ++ai)
#pragma unroll
            for (int m = 0; m < 4; ++m)
#pragma unroll
                for (int bj = 0; bj < 2; ++bj) { float* d = C + (size_t)(row0 + ai * 128 + m * 16) * 256 + col0 + bj * 128; *(f32x4*)d = acc[ai][bj][m][0]; *(f32x4*)(d + 4) = acc[ai][bj][m][1]; }
    }
};
DI float gelu_tanh(float x) { const float u2 = 2.0f * 0.7978845608028654f * (x + 0.044715f * x * x * x); const float e = fexp2(u2 * 1.4426950408889634f); return x - x * frcp(e + 1.0f); }
struct EpiGelu {
    static constexpr bool PERM = true, AFTER_DRAIN = false;
    bf16_t* O; int ldc; const float* bias;
    __device__ __forceinline__ void operator()(const pg8::f32x4 (&acc)[2][2][4][2], const pg8::Unit& u, int wr, int wc, int fr, int fq) const {
        const int row0 = u.pm * 256 + wr * 64 + fr, col0 = u.pn * 256 + wc * 32 + 8 * fq;
#pragma unroll
        for (int bj = 0; bj < 2; ++bj) { const f32x4 b0 = *(const f32x4*)(bias + col0 + bj * 128), b1 = *(const f32x4*)(bias + col0 + bj * 128 + 4);
#pragma unroll
            for (int ai = 0; ai < 2; ++ai)
#pragma unroll
                for (int m = 0; m < 4; ++m) { float h[8];
#pragma unroll
                    for (int i = 0; i < 4; ++i) { h[i] = gelu_tanh(acc[ai][bj][m][0][i] + b0[i]); h[4 + i] = gelu_tanh(acc[ai][bj][m][1][i] + b1[i]); }
                    *(u32x4*)(O + (size_t)(row0 + ai * 128 + m * 16) * ldc + col0 + bj * 128) = pack8(h); } }
    }
};


struct EpiPrep {
    static constexpr bool PERM = true, AFTER_DRAIN = false, STAGED = true;
    static constexpr int TPITCH = 272, HTILE = 32 * 272;
    unsigned char* ws_; const float* rs; float ws;
    template <class TT> __device__ __forceinline__ TT* wp(size_t off) const { return (TT*)(ws_ + off); }
    __device__ __forceinline__ static void st8(bf16_t* p, const f32x4 a, const f32x4 b) { u32x4 w; w.x = pk2(a[0], a[1]); w.y = pk2(a[2], a[3]); w.z = pk2(b[0], b[1]); w.w = pk2(b[2], b[3]); *(u32x4*)p = w; }
    __device__ __forceinline__ static f32x4 cv(const pg8::f32x4 v, float sc) { f32x4 r; r[0] = (float)__float_as_int(v[0]) * sc; r[1] = (float)__float_as_int(v[1]) * sc; r[2] = (float)__float_as_int(v[2]) * sc; r[3] = (float)__float_as_int(v[3]) * sc; return r; }
    __device__ __forceinline__ static int kind_of(int seg) {
        return (seg >= 6 && seg < 14) ? 2 : ((seg == 5 || (seg >= 22 && seg < 26) || (seg >= 34 && seg < 38) || seg == 40 || seg == 41 || seg == 44 || seg == 45) ? 1 : 0); }
    __device__ __forceinline__ void operator()(const pg8::f32x4 (&acc)[2][2][4][2], const pg8::Unit& u, int wr, int wc, int fr_in, int fq_in) const {
        int fr = fr_in, fq = fq_in; asm volatile("" : "+v"(fr), "+v"(fq));
        const int b = u.pm >> 3, tb = (u.pm & 7) * 256 + wr * 64 + fr;
        const float* rsp = rs + (size_t)b * S + tb; float nsc = rsp[0] * ws;
        if (u.pn == 23) {
            if (wc >= 2) return;
            const int dd = 8 * fq;
#pragma unroll
            for (int idx = 0; idx < 8; ++idx) { const int ai = idx >> 2, m = idx & 3, t = tb + ai * 128 + m * 16, row = b * S + t;
                const float sc = nsc; if (idx < 7) nsc = rsp[((idx + 1) >> 2) * 128 + ((idx + 1) & 3) * 16] * ws;
                const f32x4 a0 = cv(acc[ai][0][m][0], sc), a1 = cv(acc[ai][0][m][1], sc), c0 = cv(acc[ai][1][m][0], sc), c1 = cv(acc[ai][1][m][1], sc);
                if (wc == 0) { const float* cp = wp<float>(WS_COS64) + (size_t)t * 32 + dd; const float* sp = wp<float>(WS_SIN64) + (size_t)t * 32 + dd;
                    const f32x4 cs0 = *(const f32x4*)cp, cs1 = *(const f32x4*)(cp + 4), sn0 = *(const f32x4*)sp, sn1 = *(const f32x4*)(sp + 4);
                    bf16_t* d = wp<bf16_t>(WS_IK) + (size_t)row * 64 + dd; st8(d, a0 * cs0 - c0 * sn0, a1 * cs1 - c1 * sn1); st8(d + 32, c0 * cs0 + a0 * sn0, c1 * cs1 + a1 * sn1); }
                else { if (fq < 2) { float* d = wp<float>(WS_IW) + (size_t)row * 16 + dd; *(f32x4*)d = a0 * 0.03125f; *(f32x4*)(d + 4) = a1 * 0.03125f; }
                    if (fq < 3) { float* d = wp<float>(WS_GATE) + (size_t)row * 24 + dd; f32x4 g0, g1;
#pragma unroll
                        for (int i = 0; i < 4; ++i) { g0[i] = frcp(1.0f + fexp2(-1.4426950408889634f * c0[i])); g1[i] = frcp(1.0f + fexp2(-1.4426950408889634f * c1[i])); }
                        *(f32x4*)d = g0; *(f32x4*)(d + 4) = g1; } }
                __builtin_amdgcn_sched_barrier(0); }
            return;
        }
        const int seg = 2 * u.pn + (wc >> 1), kind = kind_of(seg);
        if (kind == 2) {
            const int head = 4 * (u.pn - 3) + wc, dd = 8 * fq;
#pragma unroll
            for (int idx = 0; idx < 8; ++idx) { const int ai = idx >> 2, m = idx & 3, t = tb + ai * 128 + m * 16;
                const float sc = nsc; if (idx < 7) nsc = rsp[((idx + 1) >> 2) * 128 + ((idx + 1) & 3) * 16] * ws;
                const f32x4 a0 = cv(acc[ai][0][m][0], sc), a1 = cv(acc[ai][0][m][1], sc), c0 = cv(acc[ai][1][m][0], sc), c1 = cv(acc[ai][1][m][1], sc);
                const float* cp = wp<float>(WS_COS64) + (size_t)t * 32 + dd; const float* sp = wp<float>(WS_SIN64) + (size_t)t * 32 + dd;
                const f32x4 cs0 = *(const f32x4*)cp, cs1 = *(const f32x4*)(cp + 4), sn0 = *(const f32x4*)sp, sn1 = *(const f32x4*)(sp + 4);
                bf16_t* d = wp<bf16_t>(WS_IQ) + (((size_t)b * 16 + head) * S + t) * 64 + dd; st8(d, a0 * cs0 - c0 * sn0, a1 * cs1 - c1 * sn1); st8(d + 32, c0 * cs0 + a0 * sn0, c1 * cs1 + a1 * sn1);
                __builtin_amdgcn_sched_barrier(0); }
            return;
        }
        const int d0 = 32 * (wc & 1) + 8 * fq;
        size_t dst = 0; int nh = 1, hd = 0;
        if (seg < 4) { dst = WS_AQ; nh = 4; hd = seg; } else if (seg == 4) { dst = WS_AK; } else if (seg == 5) { dst = WS_AVT; }
        else if (seg < 18) { dst = WS_BQ; nh = 4; hd = seg - 14; } else if (seg < 22) { dst = WS_BK1; nh = 4; hd = seg - 18; } else if (seg < 26) { dst = WS_BVT1; nh = 4; hd = seg - 22; }
        else if (seg < 34) { dst = WS_CQR; nh = 8; hd = seg - 26; } else if (seg < 36) { dst = WS_KC; nh = 2; hd = seg - 34; } else if (seg < 38) { dst = WS_VC; nh = 2; hd = seg - 36; }
        else if (seg < 40) { dst = WS_CKS; nh = 2; hd = seg - 38; } else if (seg < 42) { dst = WS_CVST; nh = 2; hd = seg - 40; } else if (seg < 44) { dst = WS_CKW; nh = 2; hd = seg - 42; } else { dst = WS_CVWT; nh = 2; hd = seg - 44; }
        bf16_t* dbase = wp<bf16_t>(dst) + ((size_t)(b * nh + hd) * S) * 128 + d0;
        const bool cq = (seg >= 26 && seg < 34);
        bf16_t* qbase = wp<bf16_t>(WS_CQ) + ((size_t)(b * 8 + (seg - 26)) * S) * 128 + d0;
        const float* cb = wp<float>(WS_COS128) + d0; const float* sb = wp<float>(WS_SIN128) + d0;
        f32x4 ncs0 = *(const f32x4*)(cb + (size_t)tb * 64), ncs1 = *(const f32x4*)(cb + (size_t)tb * 64 + 4), nsn0 = *(const f32x4*)(sb + (size_t)tb * 64), nsn1 = *(const f32x4*)(sb + (size_t)tb * 64 + 4);
#pragma unroll
        for (int idx = 0; idx < 8; ++idx) { const int ai = idx >> 2, m = idx & 3, t = tb + ai * 128 + m * 16;
            const float sc = nsc; if (idx < 7) nsc = rsp[((idx + 1) >> 2) * 128 + ((idx + 1) & 3) * 16] * ws;
            const f32x4 a0 = cv(acc[ai][0][m][0], sc), a1 = cv(acc[ai][0][m][1], sc), c0 = cv(acc[ai][1][m][0], sc), c1 = cv(acc[ai][1][m][1], sc);
            bf16_t* d = dbase + (size_t)t * 128;
            const f32x4 cs0 = ncs0, cs1 = ncs1, sn0 = nsn0, sn1 = nsn1;
            if (idx < 7) { const size_t tn = (size_t)(tb + ((idx + 1) >> 2) * 128 + ((idx + 1) & 3) * 16) * 64;
                ncs0 = *(const f32x4*)(cb + tn); ncs1 = *(const f32x4*)(cb + tn + 4); nsn0 = *(const f32x4*)(sb + tn); nsn1 = *(const f32x4*)(sb + tn + 4); }
            if (kind == 0) {
                st8(d, a0 * cs0 - c0 * sn0, a1 * cs1 - c1 * sn1); st8(d + 64, c0 * cs0 + a0 * sn0, c1 * cs1 + a1 * sn1);
                if (cq) { bf16_t* q = qbase + (size_t)t * 128; st8(q, a0 * QSCALE, a1 * QSCALE); st8(q + 64, c0 * QSCALE, c1 * QSCALE); } }
            else { st8(d, a0, a1); st8(d + 64, c0, c1); }
            __builtin_amdgcn_sched_barrier(0); }
    }
    __device__ __forceinline__ static void seg_dst(int seg, size_t& dst, int& nh, int& hd) {
        dst = 0; nh = 1; hd = 0;
        if (seg < 4) { dst = WS_AQ; nh = 4; hd = seg; } else if (seg == 4) { dst = WS_AK; } else if (seg == 5) { dst = WS_AVT; }
        else if (seg < 18) { dst = WS_BQ; nh = 4; hd = seg - 14; } else if (seg < 22) { dst = WS_BK1; nh = 4; hd = seg - 18; } else if (seg < 26) { dst = WS_BVT1; nh = 4; hd = seg - 22; }
        else if (seg < 34) { dst = WS_CQR; nh = 8; hd = seg - 26; } else if (seg < 36) { dst = WS_KC; nh = 2; hd = seg - 34; } else if (seg < 38) { dst = WS_VC; nh = 2; hd = seg - 36; }
        else if (seg < 40) { dst = WS_CKS; nh = 2; hd = seg - 38; } else if (seg < 42) { dst = WS_CVST; nh = 2; hd = seg - 40; } else if (seg < 44) { dst = WS_CKW; nh = 2; hd = seg - 42; } else { dst = WS_CVWT; nh = 2; hd = seg - 44; }
    }
    __device__ __forceinline__ void staged(const pg8::f32x4 (&acc)[2][2][4][2], const pg8::Unit& u, int wr, int wc, int fr_in, int fq_in, PG8_LAS unsigned char* ep, int wid, int lane_in) const {
        if (u.pn == 23 || (u.pn >= 3 && u.pn <= 6)) { (*this)(acc, u, wr, wc, fr_in, fq_in); return; }
        int fr = fr_in, fq = fq_in, lane = lane_in; asm volatile("" : "+v"(fr), "+v"(fq), "+v"(lane));
        const int b = u.pm >> 3, tb = (u.pm & 7) * 256 + wr * 64 + fr;
        const float* rsp = rs + (size_t)b * S + tb; float nsc = rsp[0] * ws;
        const int seg = 2 * u.pn + (wc >> 1), kind = kind_of(seg), d0 = 32 * (wc & 1) + 8 * fq;
        size_t dstR; int nhR, hdR; seg_dst(2 * u.pn + (wid >> 2), dstR, nhR, hdR);
        bf16_t* dbaseR = wp<bf16_t>(dstR) + ((size_t)(b * nhR + hdR) * S) * 128 + (lane & 15) * 8;
        const bool cq = (seg >= 26 && seg < 34);
        bf16_t* qbase = wp<bf16_t>(WS_CQ) + ((size_t)(b * 8 + (seg - 26)) * S) * 128 + d0;
        const float* cb = wp<float>(WS_COS128) + d0; const float* sb = wp<float>(WS_SIN128) + d0;
        f32x4 ncs0 = *(const f32x4*)(cb + (size_t)tb * 64), ncs1 = *(const f32x4*)(cb + (size_t)tb * 64 + 4), nsn0 = *(const f32x4*)(sb + (size_t)tb * 64), nsn1 = *(const f32x4*)(sb + (size_t)tb * 64 + 4);
        PG8_LAS unsigned char* wt = ep + (wc >> 1) * HTILE + (wr * 16 + fr) * TPITCH + d0 * 2;
        const PG8_LAS unsigned char* rt = ep + (wid >> 2) * HTILE + ((wid & 3) * 8 + (lane >> 4)) * TPITCH + (lane & 15) * 16;
        const int rrow = (wid & 3) * 8 + (lane >> 4), tR0 = (u.pm & 7) * 256 + (rrow >> 4) * 64 + (rrow & 15);
#pragma unroll
        for (int idx = 0; idx < 8; ++idx) { const int ai = idx >> 2, m = idx & 3, t = tb + ai * 128 + m * 16;
            const float sc = nsc; if (idx < 7) nsc = rsp[((idx + 1) >> 2) * 128 + ((idx + 1) & 3) * 16] * ws;
            const f32x4 a0 = cv(acc[ai][0][m][0], sc), a1 = cv(acc[ai][0][m][1], sc), c0 = cv(acc[ai][1][m][0], sc), c1 = cv(acc[ai][1][m][1], sc);
            const f32x4 cs0 = ncs0, cs1 = ncs1, sn0 = nsn0, sn1 = nsn1;
            if (idx < 7) { const size_t tn = (size_t)(tb + ((idx + 1) >> 2) * 128 + ((idx + 1) & 3) * 16) * 64;
                ncs0 = *(const f32x4*)(cb + tn); ncs1 = *(const f32x4*)(cb + tn + 4); nsn0 = *(const f32x4*)(sb + tn); nsn1 = *(const f32x4*)(sb + tn + 4); }
            f32x4 x0, x1, y0, y1;
            if (kind == 0) { x0 = a0 * cs0 - c0 * sn0; x1 = a1 * cs1 - c1 * sn1; y0 = c0 * cs0 + a0 * sn0; y1 = c1 * cs1 + a1 * sn1;
                if (cq) { bf16_t* q = qbase + (size_t)t * 128; st8(q, a0 * QSCALE, a1 * QSCALE); st8(q + 64, c0 * QSCALE, c1 * QSCALE); } }
            else { x0 = a0; x1 = a1; y0 = c0; y1 = c1; }
            u32x4 w1, w2; w1.x = pk2(x0[0], x0[1]); w1.y = pk2(x0[2], x0[3]); w1.z = pk2(x1[0], x1[1]); w1.w = pk2(x1[2], x1[3]); w2.x = pk2(y0[0], y0[1]); w2.y = pk2(y0[2], y0[3]); w2.z = pk2(y1[0], y1[1]); w2.w = pk2(y1[2], y1[3]);
            *(PG8_LAS u32x4*)wt = w1; *(PG8_LAS u32x4*)(wt + 128) = w2;
            asm volatile("s_waitcnt lgkmcnt(0)" ::: "memory"); __builtin_amdgcn_s_barrier(); asm volatile("" ::: "memory");
            const u32x4 v0 = *(const PG8_LAS u32x4*)rt, v1 = *(const PG8_LAS u32x4*)(rt + 4 * TPITCH);
            asm volatile("s_waitcnt lgkmcnt(0)" ::: "memory"); __builtin_amdgcn_s_barrier(); asm volatile("" ::: "memory");
            bf16_t* dR = dbaseR + (size_t)(tR0 + ai * 128 + m * 16) * 128;
            *(u32x4*)dR = v0; *(u32x4*)(dR + 4 * 128) = v1; }
    }
};

constexpr int TP = 136;
DI void lds_row8(const bf16_t* tile, int tok, int ch, float (&x)[8]) { const u32x4 w = *(const u32x4*)(tile + tok * TP + ch * 8); unpack8(w, x); }
template <int HD> DI void rope_chunk(const bf16_t* tile, int tok, int ch, int hc0, const float* cs, const float* sn, int t, float scale, float (&o)[8]) {
    constexpr int NCH = HD / 8, HALF_CH = NCH / 2;
    const int cc = ch - hc0; float own[8], par[8];
    lds_row8(tile, tok, ch, own); lds_row8(tile, tok, hc0 + (cc ^ HALF_CH), par);
    const int ci = (cc & (HALF_CH - 1)) * 8; const float* cp = cs + (size_t)t * (HD / 2) + ci; const float* sp = sn + (size_t)t * (HD / 2) + ci;
    const f32x4 c0 = *(const f32x4*)cp, c1 = *(const f32x4*)(cp + 4), s0 = *(const f32x4*)sp, s1 = *(const f32x4*)(sp + 4);
    const float sg = (cc < HALF_CH) ? -1.0f : 1.0f;
#pragma unroll
    for (int e = 0; e < 4; ++e) { o[e] = (own[e] * c0[e] + sg * par[e] * s0[e]) * scale; o[4 + e] = (own[4 + e] * c1[e] + sg * par[4 + e] * s1[e]) * scale; }
}
DI void phase_prep(const Ptrs& P, unsigned char* lds) {
    bf16_t* tile = (bf16_t*)lds;
    const bf16_t* Pm = wsp<bf16_t>(P, WS_P);
    const float* c128 = wsp<float>(P, WS_COS128); const float* s128 = wsp<float>(P, WS_SIN128); const float* c64 = wsp<float>(P, WS_COS64); const float* s64 = wsp<float>(P, WS_SIN64);
    const int tid = otid(), tok = tid >> 4, ch = tid & 15;
    for (int it = blockIdx.x; it < (T / 32) * NSEG; it += gridDim.x) {
        const int tl = it / NSEG, seg = it % NSEG, b = tl >> 6, s0 = (tl & 63) * 32, t = s0 + tok; const size_t row = (size_t)b * S + t;
        *(u32x4*)(tile + tok * TP + ch * 8) = *(const u32x4*)(Pm + row * NPAD + seg * 128 + ch * 8);
        __syncthreads();
        float o[8];
        if (seg < 4) { rope_chunk<128>(tile, tok, ch, 0, c128, s128, t, 1.0f, o); *(u32x4*)(wsp<bf16_t>(P, WS_AQ) + (((size_t)b * 4 + seg) * S + t) * 128 + ch * 8) = pack8(o); }
        else if (seg == 4) { rope_chunk<128>(tile, tok, ch, 0, c128, s128, t, 1.0f, o); *(u32x4*)(wsp<bf16_t>(P, WS_AK) + row * 128 + ch * 8) = pack8(o); }
        else if (seg == 5) { *(u32x4*)(wsp<bf16_t>(P, WS_AVT) + row * 128 + ch * 8) = *(const u32x4*)(tile + tok * TP + ch * 8); }
        else if (seg < 14) { const int hc0 = ch & 8, head = 2 * (seg - 6) + (ch >> 3); rope_chunk<64>(tile, tok, ch, hc0, c64, s64, t, 1.0f, o);
            *(u32x4*)(wsp<bf16_t>(P, WS_IQ) + (((size_t)b * 16 + head) * S + t) * 64 + (ch & 7) * 8) = pack8(o); }
        else if (seg < 18) { rope_chunk<128>(tile, tok, ch, 0, c128, s128, t, 1.0f, o); *(u32x4*)(wsp<bf16_t>(P, WS_BQ) + (((size_t)b * 4 + (seg - 14)) * S + t) * 128 + ch * 8) = pack8(o); }
        else if (seg < 22) { rope_chunk<128>(tile, tok, ch, 0, c128, s128, t, 1.0f, o); const u32x4 w = pack8(o); const size_t hb = ((size_t)b * 4 + (seg - 18)) * S;
            *(u32x4*)(wsp<bf16_t>(P, WS_BK1) + (hb + t) * 128 + ch * 8) = w;
            *(u32x4*)(wsp<bf16_t>(P, WS_BK4) + (hb + (t & 3) * 512 + (t >> 2)) * 128 + ch * 8) = w;
            *(u32x4*)(wsp<bf16_t>(P, WS_BK16) + (hb + (t & 15) * 128 + (t >> 4)) * 128 + ch * 8) = w; }
        else if (seg < 26) { const u32x4 w = *(const u32x4*)(tile + tok * TP + ch * 8); const size_t hb = ((size_t)b * 4 + (seg - 22)) * S;
            *(u32x4*)(wsp<bf16_t>(P, WS_BVT1) + (hb + t) * 128 + ch * 8) = w;
            *(u32x4*)(wsp<bf16_t>(P, WS_BVT4) + (hb + (t & 3) * 512 + (t >> 2)) * 128 + ch * 8) = w;
            *(u32x4*)(wsp<bf16_t>(P, WS_BVT16) + (hb + (t & 15) * 128 + (t >> 4)) * 128 + ch * 8) = w; }
        else if (seg < 34) { const size_t hb = (((size_t)b * 8 + (seg - 26)) * S + t) * 128 + ch * 8; float x[8]; lds_row8(tile, tok, ch, x);
#pragma unroll
            for (int e = 0; e < 8; ++e) x[e] *= QSCALE;
            *(u32x4*)(wsp<bf16_t>(P, WS_CQ) + hb) = pack8(x);
            rope_chunk<128>(tile, tok, ch, 0, c128, s128, t, 1.0f, o); *(u32x4*)(wsp<bf16_t>(P, WS_CQR) + hb) = pack8(o); }
        else if (seg < 36) { *(u32x4*)(wsp<bf16_t>(P, WS_KC) + (((size_t)b * 2 + (seg - 34)) * S + t) * 128 + ch * 8) = *(const u32x4*)(tile + tok * TP + ch * 8); }
        else if (seg < 38) { *(u32x4*)(wsp<bf16_t>(P, WS_VC) + (((size_t)b * 2 + (seg - 36)) * S + t) * 128 + ch * 8) = *(const u32x4*)(tile + tok * TP + ch * 8); }
        else if (seg < 40) { rope_chunk<128>(tile, tok, ch, 0, c128, s128, t, 1.0f, o); *(u32x4*)(wsp<bf16_t>(P, WS_CKS) + (((size_t)b * 2 + (seg - 38)) * S + t) * 128 + ch * 8) = pack8(o); }
        else if (seg < 42) { *(u32x4*)(wsp<bf16_t>(P, WS_CVST) + (((size_t)b * 2 + (seg - 40)) * S + t) * 128 + ch * 8) = *(const u32x4*)(tile + tok * TP + ch * 8); }
        else if (seg < 44) { rope_chunk<128>(tile, tok, ch, 0, c128, s128, t, 1.0f, o); *(u32x4*)(wsp<bf16_t>(P, WS_CKW) + (((size_t)b * 2 + (seg - 42)) * S + t) * 128 + ch * 8) = pack8(o); }
        else if (seg < 46) { *(u32x4*)(wsp<bf16_t>(P, WS_CVWT) + (((size_t)b * 2 + (seg - 44)) * S + t) * 128 + ch * 8) = *(const u32x4*)(tile + tok * TP + ch * 8); }
        else {
            if (ch < 8) { rope_chunk<64>(tile, tok, ch, 0, c64, s64, t, 1.0f, o); *(u32x4*)(wsp<bf16_t>(P, WS_IK) + row * 64 + ch * 8) = pack8(o); }
            else if (ch < 10) { float x[8]; lds_row8(tile, tok, ch, x); float* d = wsp<float>(P, WS_IW) + row * 16 + (ch - 8) * 8;
                *(f32x4*)d = (f32x4){x[0], x[1], x[2], x[3]} * 0.03125f; *(f32x4*)(d + 4) = (f32x4){x[4], x[5], x[6], x[7]} * 0.03125f; }
            else if (ch < 13) { float x[8]; lds_row8(tile, tok, ch, x); float* d = wsp<float>(P, WS_GATE) + row * 24 + (ch - 10) * 8;
#pragma unroll
                for (int e = 0; e < 8; ++e) x[e] = frcp(1.0f + fexp2(-1.4426950408889634f * x[e]));
                *(f32x4*)d = (f32x4){x[0], x[1], x[2], x[3]}; *(f32x4*)(d + 4) = (f32x4){x[4], x[5], x[6], x[7]}; }
        }
        __syncthreads();
    }
}

DI void a1_item(const Ptrs& P, int it) {
    const int wid = otid() >> 6, lane = otid() & 63, c = lane & 15, q4 = lane >> 4;
    const int b = it & 7; int rem = it >> 3, qblk = 15, np = 2;
    for (;; --qblk) { np = ((((qblk + 2) >> 1) + 1) >> 1); if (rem < np) break; rem -= np; }
    const int nk = (qblk + 2) >> 1, kb_lo = rem * nk / np, kb_hi = (rem + 1) * nk / np - 1, t0 = qblk * 128 + wid * 16, t = t0 + c;
    const bf16_t* IQ = wsp<bf16_t>(P, WS_IQ); const bf16_t* IK = wsp<bf16_t>(P, WS_IK); const float* IW = wsp<float>(P, WS_IW); float* SC = wsp<float>(P, WS_SC);
    bf16x8 iq[16][2]; float w[16];
#pragma unroll
    for (int h = 0; h < 16; ++h) { const bf16_t* p = IQ + (((size_t)b * 16 + h) * S + t) * 64 + 8 * q4; iq[h][0] = *(const bf16x8*)p; iq[h][1] = *(const bf16x8*)(p + 32); }
#pragma unroll
    for (int h4 = 0; h4 < 4; ++h4) { const f32x4 v = *(const f32x4*)(IW + ((size_t)b * S + t) * 16 + 4 * h4); w[4 * h4] = v[0]; w[4 * h4 + 1] = v[1]; w[4 * h4 + 2] = v[2]; w[4 * h4 + 3] = v[3]; }
    const int k16_lo = kb_lo * 16; int k16_hi = kb_hi * 16 + 15; const int lim = (t0 + 15) >> 4; if (k16_hi > lim) k16_hi = lim;
    const bf16_t* kp = IK + ((size_t)b * S + k16_lo * 16 + c) * 64 + 8 * q4;
    bf16x8 nk0 = *(const bf16x8*)kp, nk1 = *(const bf16x8*)(kp + 32);
    for (int k16 = k16_lo; k16 <= k16_hi; ++k16) {
        const bf16x8 k0 = nk0, k1 = nk1;
        if (k16 < k16_hi) { kp += 16 * 64; nk0 = *(const bf16x8*)kp; nk1 = *(const bf16x8*)(kp + 32); }
        f32x4 acc = (f32x4){0.f, 0.f, 0.f, 0.f};
#pragma unroll
        for (int h = 0; h < 16; ++h) { f32x4 s = (f32x4){0.f, 0.f, 0.f, 0.f}; s = MFMA16(k0, iq[h][0], s); s = MFMA16(k1, iq[h][1], s);
#pragma unroll
            for (int j = 0; j < 4; ++j) acc[j] += w[h] * fmaxf(s[j], 0.f); }
        *(f32x4*)(SC + ((size_t)b * S + t) * S + k16 * 16 + 4 * q4) = acc;
    }
}

DI void a2_load(const Ptrs& P, int row, int lane, unsigned (&raw)[32]) {
    const int t = row & (S - 1); const float* sc = wsp<float>(P, WS_SC) + (size_t)row * S;
#pragma unroll
    for (int i = 0; i < 32; ++i) { const int key = 64 * i + lane; raw[i] = __float_as_uint(sc[(key <= t) ? key : lane]); }
}
DI void a2_select(const Ptrs& P, int row  , int lane, const unsigned (&raw)[32]) {
    const int t = row & (S - 1);
    unsigned long long* bits = wsp<unsigned long long>(P, WS_BITS) + (size_t)row * 32;
    unsigned long long mine = 0ull;
    if (t < 256) {
#pragma unroll
        for (int i = 0; i < 32; ++i) { const unsigned long long m = __ballot(64 * i + lane <= t); if (lane == i) mine = m; }
    } else {
        unsigned u[32];
#pragma unroll
        for (int i = 0; i < 32; ++i) { const int key = 64 * i + lane; const unsigned bts = raw[i]; const unsigned x = (bts & 0x80000000u) ? ~bts : (bts | 0x80000000u); u[i] = (key <= t) ? x : 0u; }
        unsigned prefix = 0u; bool exact = false;
        for (int bit = 31; bit >= 0; --bit) { const unsigned cand = prefix | (1u << bit); int cnt = 0;
#pragma unroll
            for (int i = 0; i < 32; ++i) cnt += __builtin_popcountll(__ballot(u[i] >= cand));
            if (cnt >= 256) prefix = cand;
            if (cnt == 256) { exact = true; break; } }
        int cgt = 0;
        if (exact) prefix -= 1u;
#pragma unroll
        for (int i = 0; i < 32; ++i) cgt += __builtin_popcountll(__ballot(u[i] > prefix));
        const int need = 256 - cgt; int carried = 0; const unsigned long long lt = (lane == 0) ? 0ull : (~0ull >> (64 - lane));
#pragma unroll
        for (int i = 0; i < 32; ++i) { const bool eq = (u[i] == prefix); const unsigned long long meq = __ballot(eq);
            const int rk = carried + __builtin_popcountll(meq & lt); carried += __builtin_popcountll(meq);
            const bool sel = ((u[i] > prefix) || (eq && rk < need)) && (64 * i + lane <= t);
            const unsigned long long m = __ballot(sel); if (lane == i) mine = m; }
    }
    if (lane < 32) bits[lane] = mine;
}
DI void a2_item(const Ptrs& P, int j) {
    const int lane = otid() & 63, wid = otid() >> 6, base = (T - 1) - 32 * j - wid;
    unsigned ra[32], rb[32];
    a2_load(P, base, lane, ra);
    a2_load(P, base - 8, lane, rb);  a2_select(P, base, lane, ra);
    a2_load(P, base - 16, lane, ra); a2_select(P, base - 8, lane, rb);
    a2_load(P, base - 24, lane, rb); a2_select(P, base - 16, lane, ra);
    a2_select(P, base - 24, lane, rb);
}
DI void c1b_item(const Ptrs& P, int it) {
    const int wid = otid() >> 6, lane = otid() & 63, c = lane & 15, q4 = lane >> 4;
    const int kv = it >> 4, rt = (it & 15) * 8 + wid, row = 16 * rt + c, bg = row >> 7, cc = row & 127;
    const float* P0 = wsp<float>(P, WS_PART) + ((size_t)(kv * 2) * 2048 + row) * 256 + 8 * q4; const float* P1 = P0 + (size_t)2048 * 256;
    const float* B1 = wsp<float>(P, WS_CB1) + kv * 256 + 8 * q4;
    const bf16_t* Bt = wsp<bf16_t>(P, kv ? WS_CW2V : WS_CW2K) + (size_t)c * 256 + 8 * q4;
    f32x4 acc[8];
#pragma unroll
    for (int n = 0; n < 8; ++n) acc[n] = (f32x4){0.f, 0.f, 0.f, 0.f};
#pragma unroll
    for (int ks = 0; ks < 8; ++ks) { float h[8];
        { const f32x4 p0 = *(const f32x4*)(P0 + 32 * ks), p1 = *(const f32x4*)(P0 + 32 * ks + 4), q0 = *(const f32x4*)(P1 + 32 * ks), q1 = *(const f32x4*)(P1 + 32 * ks + 4), b0 = *(const f32x4*)(B1 + 32 * ks), b1 = *(const f32x4*)(B1 + 32 * ks + 4);
#pragma unroll
          for (int i = 0; i < 4; ++i) { h[i] = gelu_tanh(p0[i] + q0[i] + b0[i]); h[4 + i] = gelu_tanh(p1[i] + q1[i] + b1[i]); } }
        const bf16x8 a = __builtin_bit_cast(bf16x8, pack8(h));
#pragma unroll
        for (int n = 0; n < 8; ++n) { const bf16x8 bt = *(const bf16x8*)(Bt + (size_t)(16 * n) * 256 + 32 * ks); acc[n] = MFMA16(bt, a, acc[n]); } }
    const bool zr = (cc == 127);
    if (!kv) { bf16_t* dst = wsp<bf16_t>(P, WS_KCC) + ((size_t)bg * 128 + cc) * 128;
#pragma unroll
        for (int n = 0; n < 8; ++n) { u32x2 w; w.x = zr ? 0u : pk2(acc[n][0], acc[n][1]); w.y = zr ? 0u : pk2(acc[n][2], acc[n][3]); *(u32x2*)(dst + 16 * n + 4 * q4) = w; }
    } else { bf16_t* dst = wsp<bf16_t>(P, WS_VCT) + ((size_t)bg * 4 + (cc >> 5)) * 4096 + (cc & 31);
#pragma unroll
        for (int n = 0; n < 8; ++n)
#pragma unroll
            for (int j = 0; j < 4; ++j) dst[(16 * n + 4 * q4 + j) * 32] = zr ? (bf16_t)0 : (bf16_t)(pk2(acc[n][j], 0.f) & 0xffffu);
    }
}

DI void load_q(bf16x8 (&qf)[4], const bf16_t* qrow, int q4) {
#pragma unroll
    for (int ks = 0; ks < 4; ++ks) qf[ks] = *(const bf16x8*)(qrow + 32 * ks + 8 * q4);
}
DI void c2_item(const Ptrs& P, int it, unsigned char* lds) {
    const int wid = otid() >> 6, lane = otid() & 63, c = lane & 15, q4 = lane >> 4, r16 = lane & 15;
    const int bg = it >> 4, b = bg >> 1, g = bg & 1, t0 = (it & 15) * 128 + wid * 16, t = t0 + c, kr0 = 8 * (r16 >> 2) + (r16 & 3);
    constexpr int KP = 136;
    bf16_t* Kl = (bf16_t*)(lds + 32768); bf16_t* Vl = (bf16_t*)(lds + 32768 + 128 * KP * 2);
    { const int tid = otid(); const bf16_t* Kg = wsp<bf16_t>(P, WS_KCC) + (size_t)bg * 128 * 128; const bf16_t* Vg = wsp<bf16_t>(P, WS_VCT) + (size_t)bg * 4 * 4096;
      __syncthreads();
#pragma unroll
      for (int i = 0; i < 4; ++i) { const int e = (tid + 512 * i) * 8, row = e >> 7, col = e & 127; *(u32x4*)(Kl + row * KP + col) = *(const u32x4*)(Kg + e); *(u32x4*)(Vl + e) = *(const u32x4*)(Vg + e); }
      __syncthreads(); }
    const LAS bf16_t* KCC = (const LAS bf16_t*)Kl + kr0 * KP + 8 * q4; const LAS bf16_t* VCT = (const LAS bf16_t*)Vl + r16 * 32 + 8 * q4;
    const float* gates = wsp<float>(P, WS_GATE) + ((size_t)b * S + t) * 24;
    const int cmax = (t >= 31) ? ((t - 31) >> 4) : -1;
    f32x4 ia[4][2];
#pragma unroll
    for (int kt = 0; kt < 4; ++kt) { ia[kt][0] = (f32x4){0.f, 0.f, 0.f, 0.f}; ia[kt][1] = (f32x4){0.f, 0.f, 0.f, 0.f}; }
    bf16x8 qfa[4][4]; float g0a[4];
#pragma unroll
    for (int rr = 0; rr < 4; ++rr) { load_q(qfa[rr], wsp<bf16_t>(P, WS_CQ) + (((size_t)b * 8 + g * 4 + rr) * S + t) * 128, q4); g0a[rr] = gates[(g * 4 + rr) * 3 + 0]; }
#pragma unroll
    for (int rr = 0; rr < 4; ++rr) {
        const int hh = g * 4 + rr;
        asm volatile("" : "+v"(KCC), "+v"(VCT));
        bf16x8 qf[4];
#pragma unroll
        for (int ks = 0; ks < 4; ++ks) qf[ks] = qfa[rr][ks];
        f32x4 s[4][2]; float mx = NEG;
#pragma unroll
        for (int kt = 0; kt < 4; ++kt)
#pragma unroll
            for (int sub = 0; sub < 2; ++sub) { f32x4 a = (f32x4){0.f, 0.f, 0.f, 0.f};
#pragma unroll
                for (int ks = 0; ks < 4; ++ks) { const bf16x8 kf = *(const LAS bf16x8*)(KCC + (32 * kt + 4 * sub) * KP + 32 * ks); a = MFMA16(kf, qf[ks], a); }
#pragma unroll
                for (int j = 0; j < 4; ++j) { const int cc = 32 * kt + 8 * q4 + 4 * sub + j; const bool ok = (cc <= cmax) && (cc < 127); a[j] = ok ? a[j] : NEG; mx = fmaxf(mx, a[j]); }
                s[kt][sub] = a; __builtin_amdgcn_sched_barrier(0); }
        mx = fmaxf(mx, __shfl_xor(mx, 16)); mx = fmaxf(mx, __shfl_xor(mx, 32));
        float den = 0.f;
#pragma unroll
        for (int kt = 0; kt < 4; ++kt)
#pragma unroll
            for (int sub = 0; sub < 2; ++sub)
#pragma unroll
                for (int j = 0; j < 4; ++j) { const float e = (s[kt][sub][j] > -5.0e29f) ? fexp2(s[kt][sub][j] - mx) : 0.f; s[kt][sub][j] = e; den += e; }
        den += __shfl_xor(den, 16); den += __shfl_xor(den, 32);
        const float inv = den > 0.f ? 1.0f / den : 0.f;
        f32x4 o[8];
#pragma unroll
        for (int db = 0; db < 8; ++db) o[db] = (f32x4){0.f, 0.f, 0.f, 0.f};
#pragma unroll
        for (int kt = 0; kt < 4; ++kt) { float p[8];
#pragma unroll
            for (int sub = 0; sub < 2; ++sub) { s[kt][sub] = s[kt][sub] * inv; ia[kt][sub] += s[kt][sub];
#pragma unroll
                for (int j = 0; j < 4; ++j) p[4 * sub + j] = s[kt][sub][j]; }
            const u32x4 pw = pack8(p); const bf16x8 pb = __builtin_bit_cast(bf16x8, pw);
#pragma unroll
            for (int db = 0; db < 8; ++db) { const bf16x8 vf = *(const LAS bf16x8*)(VCT + kt * 4096 + (16 * db) * 32); o[db] = MFMA16(vf, pb, o[db]); }
            __builtin_amdgcn_sched_barrier(0); }
        const float g0 = g0a[rr]; bf16_t* dst = wsp<bf16_t>(P, WS_OC) + ((size_t)b * S + t) * 1024 + hh * 128;
#pragma unroll
        for (int db = 0; db < 8; ++db) { u32x2 w; w.x = pk2(o[db][0] * g0, o[db][1] * g0); w.y = pk2(o[db][2] * g0, o[db][3] * g0); *(u32x2*)(dst + 16 * db + 4 * q4) = w; }
    }
    float* impw = (float*)lds + wid * (16 * 33);
#pragma unroll
    for (int kt = 0; kt < 4; ++kt) {
        const float own = __shfl(ia[kt][1][3], (lane + 48) & 63);
        const float wrp = (kt > 0) ? __shfl(ia[kt > 0 ? kt - 1 : 0][1][3], (lane + 48) & 63) : 0.f;
        const float prev0 = (q4 == 0) ? wrp : own;
        const float v0 = (ia[kt][0][0] + ia[kt][0][1]) + (ia[kt][0][2] + ia[kt][0][3]) + prev0;
        const float v1 = (ia[kt][1][0] + ia[kt][1][1]) + (ia[kt][1][2] + ia[kt][1][3]) + ia[kt][0][3];
        impw[c * 33 + 8 * kt + 2 * q4] = v0; impw[c * 33 + 8 * kt + 2 * q4 + 1] = v1;
    }
    asm volatile("s_waitcnt lgkmcnt(0)" ::: "memory");
    __builtin_amdgcn_wave_barrier();
    const int cur = t >> 6; unsigned key[32];
#pragma unroll
    for (int n = 0; n < 32; ++n) { const float x = impw[c * 33 + n]; const float v = (n > cur) ? -__builtin_inff() : ((n == 0 || n == cur || n + 1 == cur) ? __builtin_inff() : x);
        const unsigned bts = __float_as_uint(v); const unsigned o = (bts & 0x80000000u) ? ~bts : (bts | 0x80000000u); key[n] = (o & ~31u) | (unsigned)(31 - n); }
    unsigned selbits = 0u;
#pragma unroll
    for (int e = 0; e < 8; ++e) { const int myn = 8 * q4 + e; const float x = impw[c * 33 + myn];
        const float v = (myn > cur) ? -__builtin_inff() : ((myn == 0 || myn == cur || myn + 1 == cur) ? __builtin_inff() : x);
        const unsigned bts = __float_as_uint(v); const unsigned o = (bts & 0x80000000u) ? ~bts : (bts | 0x80000000u); const unsigned km = (o & ~31u) | (unsigned)(31 - myn);
        int rank = 0;
#pragma unroll
        for (int n = 0; n < 32; ++n) rank += (key[n] > km) ? 1 : 0;
        if (rank < 16) selbits |= 1u << myn; }
    selbits |= __shfl_xor(selbits, 16); selbits |= __shfl_xor(selbits, 32);
    if (q4 == 0) wsp<unsigned>(P, WS_SEL)[(size_t)bg * S + t] = selbits;
    __builtin_amdgcn_wave_barrier();
}


enum { FK_B1 = 0, FK_B4 = 1, FK_B16 = 2, FK_C5 = 3, FK_C4 = 4, FK_A3 = 5 };
DI fa::BlockRef fa_ref(const Ptrs& P, int kind, int idx) {
    fa::BlockRef r; r.LSE = nullptr; r.aux = nullptr; r.lstr = 0; r.m = S; r.ecode = 0;
    if (kind <= FK_B16) {
        const int bh = idx & 31, pb = idx >> 5, b = bh >> 2, h = bh & 3; const size_t hb = (size_t)bh * S * 128, tb = (size_t)b * S;
        r.Q = wsp<bf16_t>(P, WS_BQ) + hb;
        r.K = wsp<bf16_t>(P, WS_BK1) + hb; r.V = wsp<bf16_t>(P, WS_BVT1) + hb;
        r.O = wsp<bf16_t>(P, kind == FK_B1 ? WS_OB1 : (kind == FK_B4 ? WS_OB4 : WS_OB16)) + tb * 512 + h * 128; r.ldo = 512;
        r.LSE = wsp<float>(P, kind == FK_B1 ? WS_LSE1 : (kind == FK_B4 ? WS_LSE4 : WS_LSE16)) + tb * 4 + h; r.lstr = 4;
        r.P0 = pb * 256; r.mode = fa::M_WIN; r.Wu = 129; r.m = (kind == FK_B1) ? S : (kind == FK_B4 ? S / 4 : S / 16);
        if (kind == FK_B1) { r.O = wsp<bf16_t>(P, WS_MIX) + tb * DM + 512 + h * 128; r.ldo = DM; r.LSE = nullptr; r.ecode = 3 | (h << 4) | (b << 8); }
    } else if (kind == FK_C5 || kind == FK_C4) {
        const int bhh = idx & 63, qb = 7 - (idx >> 6), b = bhh >> 3, hh = bhh & 7, g = hh >> 2; const size_t gb = ((size_t)b * 2 + g) * S * 128, tb = (size_t)b * S;
        r.Q = wsp<bf16_t>(P, WS_CQR) + (size_t)bhh * S * 128;
        r.K = wsp<bf16_t>(P, kind == FK_C5 ? WS_CKW : WS_CKS) + gb; r.V = wsp<bf16_t>(P, kind == FK_C5 ? WS_CVWT : WS_CVST) + gb;
        r.O = wsp<bf16_t>(P, kind == FK_C5 ? WS_OWIN : WS_OSLC) + tb * 1024 + hh * 128; r.ldo = 1024;
        r.P0 = qb * 256; r.mode = (kind == FK_C5) ? fa::M_WIN : fa::M_SEL; r.Wu = (kind == FK_C5) ? 512 : 0x40000000;
        r.aux = wsp<unsigned>(P, WS_SEL) + ((size_t)b * 2 + g) * S;
        if (kind == FK_C4) { r.O = wsp<bf16_t>(P, WS_MIX) + tb * DM + 1024 + hh * 128; r.ldo = DM; r.ecode = 2 | (hh << 4) | (b << 8); }
    } else {
        const int bh = idx & 31, qb = 7 - (idx >> 5), b = bh >> 2, h = bh & 3; const size_t tb = (size_t)b * S;
        r.Q = wsp<bf16_t>(P, WS_AQ) + (size_t)bh * S * 128; r.K = wsp<bf16_t>(P, WS_AK) + tb * 128; r.V = wsp<bf16_t>(P, WS_AVT) + tb * 128;
        r.O = wsp<bf16_t>(P, WS_MIX) + tb * DM + h * 128; r.ldo = DM;
        r.P0 = qb * 256; r.mode = fa::M_BITS; r.Wu = 0x40000000; r.aux = wsp<unsigned>(P, WS_BITS) + tb * 64;
    }
    return r;
}
struct FaList { int kind[4]; int n[4]; int ng; };
DI fa::BlockRef fa_list_ref(const Ptrs& P, const FaList& L, int i) {
    int g = 0;
#pragma unroll
    for (int k = 0; k < 3; ++k) if (g == k && k + 1 < L.ng && i >= L.n[k]) { i -= L.n[k]; g = k + 1; }
    const int kind = (g == 0) ? L.kind[0] : (g == 1 ? L.kind[1] : (g == 2 ? L.kind[2] : L.kind[3]));
    return fa_ref(P, kind, i);
}
struct FaNext {
    const Ptrs* P; const FaList* L; unsigned* ctr; unsigned char* lds; int total, tid; bool last;
    DI fa::BlockRef operator()(const fa::BlockRef& cur) { const int ni = q_next(ctr, lds, tid); last = ni >= total; return last ? cur : fa_list_ref(*P, *L, ni); }
};
DI void fa_stream(const Ptrs& P, const FaList& L, unsigned* ctr, unsigned char* lds) {
    const int tid = otid();
    int total = 0;
#pragma unroll
    for (int k = 0; k < 4; ++k) if (k < L.ng) total += L.n[k];
    const int i = q_next(ctr, lds, tid);
    if (i >= total) return;
    fa::BlockRef cur = fa_list_ref(P, L, i), nxt = cur;
    fa::Seam Sm;
    fa::prime(cur, (char*)lds, Sm, tid);
    fa::EpiPtrs ep; ep.oc = wsp<bf16_t>(P, WS_OC); ep.owin = wsp<bf16_t>(P, WS_OWIN); ep.gate = wsp<float>(P, WS_GATE); ep.ob4 = wsp<bf16_t>(P, WS_OB4); ep.ob16 = wsp<bf16_t>(P, WS_OB16); ep.lse4 = wsp<float>(P, WS_LSE4); ep.lse16 = wsp<float>(P, WS_LSE16);
    FaNext nf; nf.P = &P; nf.L = &L; nf.ctr = ctr; nf.lds = lds; nf.total = total; nf.tid = tid; nf.last = false;
    for (;;) {
        fa::block(cur, nxt, nf, ep, (char*)lds, Sm, tid);
        if (nf.last) break;
        cur = nxt;
    }
}

DI void phase_merge(const Ptrs& P) {
    const int tid = otid(), lane = tid & 63, gw = blockIdx.x * 8 + (tid >> 6), ngw = gridDim.x * 8;
    for (int row = gw; row < T; row += ngw) {
        bf16_t* dst = wsp<bf16_t>(P, WS_MIX) + (size_t)row * DM;
        {
            const int h = lane >> 4, col = 8 * lane;
            const float l1 = wsp<float>(P, WS_LSE1)[(size_t)row * 4 + h], l4 = wsp<float>(P, WS_LSE4)[(size_t)row * 4 + h], l16 = wsp<float>(P, WS_LSE16)[(size_t)row * 4 + h];
            const float mm = fmaxf(l1, fmaxf(l4, l16)), w1 = fexp2(l1 - mm), w4 = fexp2(l4 - mm), w16 = fexp2(l16 - mm), wi = 1.0f / (w1 + w4 + w16);
            float a[8], b4[8], c16[8], o[8];
            unpack8(*(const u32x4*)(wsp<bf16_t>(P, WS_OB1) + (size_t)row * 512 + col), a); unpack8(*(const u32x4*)(wsp<bf16_t>(P, WS_OB4) + (size_t)row * 512 + col), b4);
            unpack8(*(const u32x4*)(wsp<bf16_t>(P, WS_OB16) + (size_t)row * 512 + col), c16);
#pragma unroll
            for (int e = 0; e < 8; ++e) o[e] = (a[e] * w1 + b4[e] * w4 + c16[e] * w16) * wi;
            *(u32x4*)(dst + 512 + col) = pack8(o);
        }
#pragma unroll
        for (int j = 0; j < 2; ++j) {
            const int col = 8 * (lane + 64 * j), hh = col >> 7;
            const float* gt = wsp<float>(P, WS_GATE) + (size_t)row * 24 + hh * 3; const float g1 = gt[1], g2 = gt[2];
            float a[8], b[8], c[8], o[8];
            unpack8(*(const u32x4*)(wsp<bf16_t>(P, WS_OC) + (size_t)row * 1024 + col), a); unpack8(*(const u32x4*)(wsp<bf16_t>(P, WS_OSLC) + (size_t)row * 1024 + col), b);
            unpack8(*(const u32x4*)(wsp<bf16_t>(P, WS_OWIN) + (size_t)row * 1024 + col), c);
#pragma unroll
            for (int e = 0; e < 8; ++e) o[e] = a[e] + g1 * b[e] + g2 * c[e];
            *(u32x4*)(dst + 1024 + col) = pack8(o);
        }
    }
}

constexpr int NPH = 13;
constexpr int NPHASES = 1 + DEPTH * NPH;
struct Args { const float* in[16]; float* out; unsigned char* ws; int ph_lo, ph_hi; };

__global__ void __launch_bounds__(512, 2) fwd(Args a) {
    extern __shared__ __attribute__((aligned(16))) unsigned char lds[];
    Ptrs P;
#pragma unroll
    for (int i = 0; i < 16; ++i) P.in[i] = a.in[i];
    P.out = a.out; P.ws = a.ws;
    const int lo = a.ph_lo, hi = a.ph_hi;
    volatile LAS unsigned* bst = (volatile LAS unsigned*)((LAS unsigned char*)lds + LDS_BAR_OFF);
    if (otid() < 4) bst[otid()] = 0u;
    __syncthreads();
    XcdBarrier bar; bar.bar = (unsigned*)(P.ws + WS_CTL); bar.x = 0; bar.st = bst;
    if (hi - lo > 1) bar = xcd_barrier_post((unsigned*)(P.ws + WS_CTL), bst);
#define IN(k) (lo <= (k) && (k) < hi)
#define SEAM(k) do { if (IN(k) && IN((k) + 1)) xcd_barrier(bar); } while (0)
    if (IN(0)) { phase_rope_tables(P); for (int it = blockIdx.x; it < WMAX_ITEMS; it += gridDim.x) wmax_in_item(P, 0, it, lds); }
    SEAM(0);
    for (int layer = 0; layer < DEPTH; ++layer) {
        const int pb = 1 + layer * NPH;
        const float* xcur = (layer == 0) ? P.in[0] : P.out;
        if (layer == 0) { if (IN(pb + 0)) { phase_wconv(P, layer, lds); phase_norm<false, false, 2>(P.in[0], nullptr, nullptr, nullptr, P.in[12], wsp<bf16_t>(P, WS_H)); }
            SEAM(pb + 0); }
#if MK_DUP_PH == 100
        phase_wconv(P, layer, lds); xcd_barrier(bar);
#endif
        if (IN(pb + 1)) { pg8::Gemm g{wsp<bf16_t>(P, WS_H), wsp<bf16_t>(P, WS_WIN), T, NPAD, DM / 2}; pg8::StaticOrder So; So.init(T, NPAD, gridDim.x, blockIdx.x);
            const float wmx = __uint_as_float(__builtin_amdgcn_readfirstlane(__hip_atomic_load((unsigned*)(P.ws + WS_CTL) + CTL_WMAX + layer * 64 + 1, __ATOMIC_RELAXED, __HIP_MEMORY_SCOPE_AGENT)));
            EpiPrep E{P.ws, (const float*)(P.ws + WS_H + (size_t)T * DM), fmaxf(wmx, 1e-30f) * (1.0f / 127.0f)}; pg8::gemm_phase<EpiPrep, pg8::StaticOrder, false, 2>((LAS unsigned char*)lds, g, So, E, nullptr); }
        SEAM(pb + 1);
#if MK_DUP_PH == 101
        { pg8::Gemm g{wsp<bf16_t>(P, WS_H), wsp<bf16_t>(P, WS_WIN), T, NPAD, DM}; pg8::StaticOrder So; So.init(T, NPAD, gridDim.x, blockIdx.x);
            EpiPrep E{P.ws}; pg8::gemm_phase<EpiPrep, pg8::StaticOrder, false>((LAS unsigned char*)lds, g, So, E, nullptr); } xcd_barrier(bar);
#endif
#define ATT_BODY \
          \
        if (ATT_IN(3)) { unsigned* ctr = (unsigned*)(P.ws + WS_CTL) + 4096 + (layer * 16 + ATT_CB + 0) * 64; \
            if (ATT_PART(1) && blockIdx.x < 32) { const int kv = blockIdx.x >> 4, kh = (blockIdx.x >> 3) & 1;     \
                pg8::Gemm g{wsp<bf16_t>(P, kv ? WS_VC : WS_KC) + kh * 2048, wsp<bf16_t>(P, kv ? WS_CW1V : WS_CW1K) + kh * 2048, 2048, 256, 2048, 2048, 4096}; \
                pg8::StaticOrder So; So.init(2048, 256, 8, blockIdx.x & 7); EpiPart E{wsp<float>(P, WS_PART) + (size_t)(kv * 2 + kh) * 2048 * 256}; \
                pg8::gemm_phase<EpiPart, pg8::StaticOrder, false>((LAS unsigned char*)lds, g, So, E, nullptr); } \
            FaList L; L.ng = 2; L.kind[0] = FK_B4; L.n[0] = 256; L.kind[1] = FK_B16; L.n[1] = 256; L.kind[2] = 0; L.n[2] = 0; L.kind[3] = 0; L.n[3] = 0; \
            if (ATT_PART(2)) fa_stream(P, L, ctr, lds); \
            if (ATT_PART(3)) for (int it = q_next(ctr + 64, lds, otid()); it < NB * 40; it = q_next(ctr + 64, lds, otid())) a1_item(P, it); \
            conv_filler(P, layer, lds, (unsigned*)(P.ws + WS_CTL) + 8192 + (layer * 4 + 0) * 64, 0); } \
        ATT_SEAM(3); \
          \
        if (ATT_IN(4)) { unsigned* ctr = (unsigned*)(P.ws + WS_CTL) + 4096 + (layer * 16 + ATT_CB + 2) * 64; \
            FaList L; L.ng = 1; L.kind[0] = FK_B1; L.n[0] = 256; L.kind[1] = 0; L.n[1] = 0; L.kind[2] = 0; L.n[2] = 0; L.kind[3] = 0; L.n[3] = 0; \
            if (ATT_PART(2)) fa_stream(P, L, ctr, lds); \
            if (ATT_PART(3)) for (int it = q_next(ctr + 64, lds, otid()); it < T / 32 + 32; it = q_next(ctr + 64, lds, otid())) { if (it < 32) c1b_item(P, it); else a2_item(P, it - 32); } \
            conv_filler(P, layer, lds, (unsigned*)(P.ws + WS_CTL) + 8192 + (layer * 4 + 1) * 64, 1); } \
        ATT_SEAM(4); \
          \
        if (ATT_IN(5)) { unsigned* ctr = (unsigned*)(P.ws + WS_CTL) + 4096 + (layer * 16 + ATT_CB + 4) * 64; \
            FaList L; L.ng = 2; L.kind[0] = FK_A3; L.n[0] = 256; L.kind[1] = FK_C5; L.n[1] = 512; L.kind[2] = 0; L.n[2] = 0; L.kind[3] = 0; L.n[3] = 0; \
            if (ATT_PART(3)) for (int it = q_next(ctr + 64, lds, otid()); it < 256; it = q_next(ctr + 64, lds, otid())) c2_item(P, it, lds);     \
            if (ATT_PART(2)) fa_stream(P, L, ctr, lds); \
            conv_filler(P, layer, lds, (unsigned*)(P.ws + WS_CTL) + 8192 + (layer * 4 + 2) * 64, 2); } \
        ATT_SEAM(5); \
          \
        if (ATT_IN(6)) { unsigned* ctr = (unsigned*)(P.ws + WS_CTL) + 4096 + (layer * 16 + ATT_CB + 6) * 64; \
            FaList L; L.ng = 1; L.kind[0] = FK_C4; L.n[0] = 512; L.kind[1] = 0; L.n[1] = 0; L.kind[2] = 0; L.n[2] = 0; L.kind[3] = 0; L.n[3] = 0; \
            if (ATT_PART(2)) fa_stream(P, L, ctr, lds); \
            conv_filler(P, layer, lds, (unsigned*)(P.ws + WS_CTL) + 8192 + (layer * 4 + 3) * 64, 3); } \
        ATT_SEAM(6); \
          \

#define ATT_IN(k) IN(pb + (k))
#define ATT_SEAM(k) SEAM(pb + (k))
#define ATT_CB 0
#define ATT_PART(p) true
        ATT_BODY
#undef ATT_IN
#undef ATT_SEAM
#undef ATT_CB
#undef ATT_PART
#if MK_DUP_PH >= 30 && MK_DUP_PH <= 79
#define ATT_IN(k) ((k) == MK_DUP_PH / 10)
#define ATT_SEAM(k) do { if ((k) == MK_DUP_PH / 10) xcd_barrier(bar); } while (0)
#define ATT_CB 8
#define ATT_PART(p) ((p) == MK_DUP_PH % 10)
        ATT_BODY
#undef ATT_IN
#undef ATT_SEAM
#undef ATT_CB
#undef ATT_PART
#endif
#if MK_DUP_PH >= 3 && MK_DUP_PH <= 7
#define ATT_IN(k) ((k) == MK_DUP_PH)
#define ATT_SEAM(k) do { if ((k) == MK_DUP_PH) xcd_barrier(bar); } while (0)
#define ATT_CB 8
#define ATT_PART(p) true
        ATT_BODY
#undef ATT_IN
#undef ATT_SEAM
#undef ATT_CB
#undef ATT_PART
#endif
        if (IN(pb + 8)) { pg8::Gemm g{wsp<bf16_t>(P, WS_MIX), wsp<bf16_t>(P, WS_WOUT), T, DM, DM}; pg8::StaticOrder So; So.init(T, DM, gridDim.x, blockIdx.x);
            EpiRowsBf16 E{wsp<bf16_t>(P, WS_Y), DM, 1.0f}; pg8::gemm_phase<EpiRowsBf16, pg8::StaticOrder, false>((LAS unsigned char*)lds, g, So, E, nullptr); }
        SEAM(pb + 8);
#if MK_DUP_PH == 108
        { pg8::Gemm g{wsp<bf16_t>(P, WS_MIX), wsp<bf16_t>(P, WS_WOUT), T, DM, DM}; pg8::StaticOrder So; So.init(T, DM, gridDim.x, blockIdx.x);
            pg8::EpiBf16<0> E{wsp<bf16_t>(P, WS_Y), DM, nullptr, 0, 0}; pg8::gemm_phase<pg8::EpiBf16<0>, pg8::StaticOrder, false>((LAS unsigned char*)lds, g, So, E, nullptr); } xcd_barrier(bar);
#endif
        if (IN(pb + 9)) { if (layer == 0) phase_norm<false, true, 2>(P.in[0], wsp<bf16_t>(P, WS_XB), wsp<bf16_t>(P, WS_Y), P.in[13] + (size_t)layer * DM, P.in[14] + (size_t)layer * DM, wsp<bf16_t>(P, WS_H));
            else phase_norm<true, true, 2>(wsp<bf16_t>(P, WS_XB), wsp<bf16_t>(P, WS_XB), wsp<bf16_t>(P, WS_Y), P.in[13] + (size_t)layer * DM, P.in[14] + (size_t)layer * DM, wsp<bf16_t>(P, WS_H)); }
        SEAM(pb + 9);
#if MK_DUP_PH == 109
        phase_norm<true, true>(wsp<bf16_t>(P, WS_XB), wsp<bf16_t>(P, WS_BIG), wsp<bf16_t>(P, WS_Y), P.in[13] + (size_t)layer * DM, P.in[14] + (size_t)layer * DM, wsp<bf16_t>(P, WS_MIX)); xcd_barrier(bar);
#endif
        if (IN(pb + 10)) { pg8::Gemm g{wsp<bf16_t>(P, WS_H), wsp<bf16_t>(P, WS_WGU), T, NGU, DM / 2}; pg8::StaticOrder So; So.init(T, NGU, gridDim.x, blockIdx.x);
            const float wmx = __uint_as_float(__builtin_amdgcn_readfirstlane(__hip_atomic_load((unsigned*)(P.ws + WS_CTL) + CTL_WMAX + layer * 64, __ATOMIC_RELAXED, __HIP_MEMORY_SCOPE_AGENT)));
            EpiSwigluI8 E{wsp<unsigned char>(P, WS_HID), FF, (const float*)(P.ws + WS_H + (size_t)T * DM), fmaxf(wmx, 1e-30f) * (1.0f / 127.0f)}; pg8::gemm_phase<EpiSwigluI8, pg8::StaticOrder, false, 2>((LAS unsigned char*)lds, g, So, E, nullptr); }
        SEAM(pb + 10);
#if MK_DUP_PH == 110
        { pg8::Gemm g{wsp<bf16_t>(P, WS_H), wsp<bf16_t>(P, WS_WGU), T, NGU, DM}; pg8::StaticOrder So; So.init(T, NGU, gridDim.x, blockIdx.x);
            EpiSwiglu E{wsp<bf16_t>(P, WS_HID), FF}; pg8::gemm_phase<EpiSwiglu, pg8::StaticOrder, false>((LAS unsigned char*)lds, g, So, E, nullptr); } xcd_barrier(bar);
#endif
        if (IN(pb + 11)) { pg8::Gemm g{wsp<bf16_t>(P, WS_HID), wsp<bf16_t>(P, WS_WDN), T, DM, FF / 2}; pg8::StaticOrder So; So.init(T, DM, gridDim.x, blockIdx.x);
            EpiRowsBf16 E{wsp<bf16_t>(P, WS_Y), DM, 1.0f / (F8_SHID * F8_SW)}; pg8::gemm_phase<EpiRowsBf16, pg8::StaticOrder, false, 1>((LAS unsigned char*)lds, g, So, E, nullptr); }
        SEAM(pb + 11);
#if MK_DUP_PH == 111
        { pg8::Gemm g{wsp<bf16_t>(P, WS_HID), wsp<bf16_t>(P, WS_WDN), T, DM, FF}; pg8::StaticOrder So; So.init(T, DM, gridDim.x, blockIdx.x);
            pg8::EpiBf16<0> E{wsp<bf16_t>(P, WS_Y), DM, nullptr, 0, 0}; pg8::gemm_phase<pg8::EpiBf16<0>, pg8::StaticOrder, false>((LAS unsigned char*)lds, g, So, E, nullptr); } xcd_barrier(bar);
#endif
        if (IN(pb + 12)) { if (layer + 1 < DEPTH) phase_norm<true, true, 2>(wsp<bf16_t>(P, WS_XB), wsp<bf16_t>(P, WS_XB), wsp<bf16_t>(P, WS_Y), P.in[15] + (size_t)layer * DM, P.in[12] + (size_t)(layer + 1) * DM, wsp<bf16_t>(P, WS_H));
            else phase_norm<true, false>(wsp<bf16_t>(P, WS_XB), P.out, wsp<bf16_t>(P, WS_Y), P.in[15] + (size_t)layer * DM, nullptr, nullptr); }
        SEAM(pb + 12);
#if MK_DUP_PH == 120
        for (int i = 0; i < 10; ++i) xcd_barrier(bar);
#endif
    }
#undef IN
#undef SEAM
}
}

#ifndef MK_ONE_LAUNCH
#define MK_ONE_LAUNCH 1
#endif
extern "C" void kernel_launch(void* const* d_in, const int* in_sizes, int n_in, void* d_out, int out_size, void* d_ws, size_t ws_size, hipStream_t stream) {
    static int grid = 0;
    if (grid == 0) {
        if (n_in != 16 || out_size != mk::T * mk::DM || ws_size < mk::WS_END) { fprintf(stderr, "kernel_launch: unexpected shapes (n_in %d, out %d, ws %zu < %zu)\n", n_in, out_size, ws_size, (size_t)mk::WS_END); grid = -1; return; }
        int dev = 0, cus = 0, per_cu = 0;
        if (hipGetDevice(&dev) != hipSuccess || hipDeviceGetAttribute(&cus, hipDeviceAttributeMultiprocessorCount, dev) != hipSuccess) { grid = -1; return; }
        if (hipFuncSetAttribute((const void*)mk::fwd, hipFuncAttributeMaxDynamicSharedMemorySize, mk::LDS_BYTES) != hipSuccess) { fprintf(stderr, "kernel_launch: hipFuncSetAttribute failed\n"); grid = -1; return; }
        if (hipOccupancyMaxActiveBlocksPerMultiprocessor(&per_cu, (const void*)mk::fwd, 512, mk::LDS_BYTES) != hipSuccess || per_cu < 1) { fprintf(stderr, "kernel_launch: occupancy query says %d blocks per CU\n", per_cu); }
        (void)hipGetLastError();
        grid = cus;
    }
    if (grid < 0) return;
    (void)in_sizes;
    hipMemsetAsync((char*)d_ws + mk::WS_CTL, 0, mk::CTL_BYTES, stream);
    mk::Args a{};
    for (int i = 0; i < 16; ++i) a.in[i] = (const float*)d_in[i];
    a.out = (float*)d_out; a.ws = (unsigned char*)d_ws;
#if MK_ONE_LAUNCH
    a.ph_lo = 0; a.ph_hi = mk::NPHASES;
    hipLaunchKernelGGL(mk::fwd, dim3(grid), dim3(512), mk::LDS_BYTES, stream, a);
#else
    for (int ph = 0; ph < mk::NPHASES; ++ph) { a.ph_lo = ph; a.ph_hi = ph + 1; hipLaunchKernelGGL(mk::fwd, dim3(grid), dim3(512), mk::LDS_BYTES, stream, a); }
#endif
}
```

```cpp
#include <hip/hip_runtime.h>
#include <cstdio>
#include <cstdint>
namespace pg8 {
#define PG8_LAS __attribute__((address_space(3)))
typedef unsigned short bf16_t;
typedef short bf16x8 __attribute__((ext_vector_type(8)));
typedef float f32x4 __attribute__((ext_vector_type(4)));
typedef unsigned u32x4 __attribute__((ext_vector_type(4)));
typedef int i32x4 __attribute__((ext_vector_type(4)));
typedef int i32x8 __attribute__((ext_vector_type(8)));
constexpr int BM = 256, BK = 64, HALF = 128, HTB = HALF * BK * 2  , STAGE_BYTES = 8 * HTB, NXCD = 8, WGM = 8;

__host__ __device__ __forceinline__ int lds_byte(int r, int c) { const int st = (r >> 4) * 2 + (c >> 5), rr = r & 15, cc = c & 31, ob = rr * 64 + cc * 2; return st * 1024 + (ob ^ (((ob >> 9) & 1) << 5)); }
__host__ __device__ __forceinline__ void stage_rc(int b, int& R, int& C) { const int st = b / 1024, sb = b % 1024, swz = sb ^ (((sb >> 9) & 1) << 5); R = (st >> 1) * 16 + swz / 64; C = (st & 1) * 32 + (swz % 64) / 2; }
__host__ __device__ __forceinline__ int perm32(int rho) { const int n = rho >> 4, i = rho & 15; return 8 * (i >> 2) + 4 * n + (i & 3); }

struct Unit { int pm, pn; };
struct Gemm { const bf16_t* A; const bf16_t* Bt; int M, N, K; int lda; };

struct StaticOrder {
    int nM, nN, nwg, G, c;
    __host__ __device__ void init(int M, int N, int G_, int c_) { nM = M / BM; nN = N / BM; nwg = nM * nN; G = G_; c = c_; }
    __host__ __device__ bool next(int i, Unit& u) const {
        const long L = (long)i * G + c; if (L >= nwg) return false;
        int wgid = (int)L; { const int q = nwg / NXCD, r = nwg % NXCD, xcd = wgid % NXCD, off = wgid / NXCD; wgid = (xcd < r ? xcd * (q + 1) : r * (q + 1) + (xcd - r) * q) + off; }
        const int nig = WGM * nN, gid = wgid / nig, fm = gid * WGM, gsz = (nM - fm) < WGM ? (nM - fm) : WGM;
        u.pm = fm + ((wgid % nig) % gsz); u.pn = (wgid % nig) / gsz; return true;
    }
    __device__ __forceinline__ void a_ready(const Unit&) const {}
    __device__ __forceinline__ void done(const Unit&) const {}
};
struct CountedOrder : StaticOrder {
    const unsigned* ready; unsigned need; unsigned* tmo;
    __device__ __forceinline__ void a_ready(const Unit& u) const {
        if (threadIdx.x < 64) {
            const unsigned long long t0 = __builtin_amdgcn_s_memrealtime(); unsigned polls = 0;
            while ((unsigned)__builtin_amdgcn_readfirstlane(__hip_atomic_load(ready + 64 * u.pm, __ATOMIC_RELAXED, __HIP_MEMORY_SCOPE_AGENT)) < need) {
                if ((++polls & 255u) == 0u && __builtin_amdgcn_readfirstlane(__hip_atomic_load(tmo, __ATOMIC_RELAXED, __HIP_MEMORY_SCOPE_AGENT)) != 0u) break;
                if (__builtin_amdgcn_s_memrealtime() - t0 > 2000000ull) {
                    if (threadIdx.x == 0) { unsigned expect = 0u; __hip_atomic_compare_exchange_strong(tmo + 1, &expect, 0x600u | (unsigned)(u.pm & 0xff), __ATOMIC_RELAXED, __ATOMIC_RELAXED, __HIP_MEMORY_SCOPE_AGENT); __hip_atomic_store(tmo, 1u, __ATOMIC_RELAXED, __HIP_MEMORY_SCOPE_AGENT); }
                    break; }
                __builtin_amdgcn_s_sleep(2); }
            __builtin_amdgcn_fence(__ATOMIC_ACQUIRE, "agent");
            asm volatile("s_waitcnt vmcnt(0)" ::: "memory");
        }
#if !defined(BROKEN_HOOK_NO_BARRIER)
        asm volatile("" ::: "memory"); __builtin_amdgcn_s_barrier(); asm volatile("" ::: "memory");
#endif
    }
};

__device__ __forceinline__ unsigned cvt_pk_bf16(float lo, float hi) { unsigned r; asm volatile("v_cvt_pk_bf16_f32 %0, %1, %2" : "=v"(r) : "v"(lo), "v"(hi)); return r; }
typedef float f32x2 __attribute__((ext_vector_type(2)));
__device__ __forceinline__ f32x2 gelu_pk(f32x2 v) {
    const f32x2 av = __builtin_elementwise_abs(v), d = av * 0.2316418882f + 1.0f;
    f32x2 t; t.x = __builtin_amdgcn_rcpf(d.x); t.y = __builtin_amdgcn_rcpf(d.y);
    f32x2 q = t * 0.5307027145f + (-0.7265760135f); q = q * t + 0.7107068705f; q = q * t + (-0.142248368f); q = q * t + 0.127414796f; q = q * t;
    const f32x2 s = (v * v) * (-0.72134752044f);
    f32x2 e; e.x = __builtin_amdgcn_exp2f(s.x); e.y = __builtin_amdgcn_exp2f(s.y);
    const f32x2 m = v * (q * e), r = v - m;
    f32x2 o; o.x = v.x < 0.f ? m.x : r.x; o.y = v.y < 0.f ? m.y : r.y; return o;
}

struct EpiF32 {
    static constexpr bool PERM = false, AFTER_DRAIN = false;
    float* C; int ldc; const float* bias;
    __device__ __forceinline__ void operator()(const f32x4 (&acc)[2][2][4][2], const Unit& u, int wr, int wc, int fr, int fq) const {
        const int row0 = u.pm * BM + wr * 64 + fr, col0 = u.pn * BM + wc * 32 + 4 * fq;
        f32x4 bv[2][2];
#pragma unroll
        for (int bj = 0; bj < 2; ++bj)
#pragma unroll
            for (int n = 0; n < 2; ++n) bv[bj][n] = bias ? *(const f32x4*)(bias + col0 + bj * HALF + n * 16) : (f32x4){0.f, 0.f, 0.f, 0.f};
#pragma unroll
        for (int ai = 0; ai < 2; ++ai)
#pragma unroll
            for (int m = 0; m < 4; ++m) { float* rowp = C + (size_t)(row0 + ai * HALF + m * 16) * ldc + col0;
#pragma unroll
                for (int bj = 0; bj < 2; ++bj)
#pragma unroll
                    for (int n = 0; n < 2; ++n) *(f32x4*)(rowp + bj * HALF + n * 16) = acc[ai][bj][m][n] + bv[bj][n]; }
    }
};
template <int ACT  > struct EpiBf16 {
    static constexpr bool PERM = true, AFTER_DRAIN = false;
    bf16_t* O; int ldc; const float* bias; int split_cols; size_t split_stride;
    __device__ __forceinline__ void operator()(const f32x4 (&acc)[2][2][4][2], const Unit& u, int wr, int wc, int fr, int fq) const {
        const int row0 = u.pm * BM + wr * 64 + fr; int colt = u.pn * BM; bf16_t* base = O;
        if (split_cols) { const int t = colt / split_cols; base += (size_t)t * split_stride; colt -= t * split_cols; }
        const int col0 = colt + wc * 32 + 8 * fq, bcol0 = u.pn * BM + wc * 32 + 8 * fq;
        f32x4 bv[2][2];
#pragma unroll
        for (int bj = 0; bj < 2; ++bj)
#pragma unroll
            for (int n = 0; n < 2; ++n) bv[bj][n] = bias ? *(const f32x4*)(bias + bcol0 + bj * HALF + 4 * n) : (f32x4){0.f, 0.f, 0.f, 0.f};
#pragma unroll
        for (int ai = 0; ai < 2; ++ai)
#pragma unroll
            for (int m = 0; m < 4; ++m) { bf16_t* rowp = base + (size_t)(row0 + ai * HALF + m * 16) * ldc + col0;
#pragma unroll
                for (int bj = 0; bj < 2; ++bj) { f32x4 v0 = acc[ai][bj][m][0] + bv[bj][0], v1 = acc[ai][bj][m][1] + bv[bj][1];
                    if (ACT == 1) { f32x2 a = gelu_pk((f32x2){v0[0], v0[1]}), b = gelu_pk((f32x2){v0[2], v0[3]}), c = gelu_pk((f32x2){v1[0], v1[1]}), d = gelu_pk((f32x2){v1[2], v1[3]});
                        v0 = (f32x4){a.x, a.y, b.x, b.y}; v1 = (f32x4){c.x, c.y, d.x, d.y}; }
                    if (ACT == 2) {
#pragma unroll
                        for (int j = 0; j < 4; ++j) { v0[j] = 0.5f * v0[j] * (1.0f + erff(v0[j] * 0.70710678f)); v1[j] = 0.5f * v1[j] * (1.0f + erff(v1[j] * 0.70710678f)); } }
                    u32x4 w; w.x = cvt_pk_bf16(v0[0], v0[1]); w.y = cvt_pk_bf16(v0[2], v0[3]); w.z = cvt_pk_bf16(v1[0], v1[1]); w.w = cvt_pk_bf16(v1[2], v1[3]);
                    *(u32x4*)(rowp + bj * HALF) = w; } }
    }
};

struct PanelStats {
    unsigned* xbuf;
    unsigned* cnt;
    unsigned* tmo;
    int ntn; float eps;
    unsigned code;
    __device__ __forceinline__ bool run(const f32x4 (&v)[2][2][4][2], const Unit& u, int wr, int wc, int fr, int fq, PG8_LAS unsigned char* lds, int wid, int lane) const {
        typedef float f32x2v __attribute__((ext_vector_type(2)));
        PG8_LAS f32x2v* P = (PG8_LAS f32x2v*)lds;
        PG8_LAS f32x2v* S = (PG8_LAS f32x2v*)(lds + 8192);
        PG8_LAS unsigned* flag = (PG8_LAS unsigned*)(lds + 8192 + 2048);
#pragma unroll
        for (int ai = 0; ai < 2; ++ai)
#pragma unroll
            for (int m = 0; m < 4; ++m) {
                float s = 0.f;
#pragma unroll
                for (int bj = 0; bj < 2; ++bj)
#pragma unroll
                    for (int n = 0; n < 2; ++n) { const f32x4 x = v[ai][bj][m][n]; s += (x[0] + x[1]) + (x[2] + x[3]); }
                s += __shfl_xor(s, 16); s += __shfl_xor(s, 32);
                const float mw = s * (1.0f / 64.0f); float q = 0.f;
#pragma unroll
                for (int bj = 0; bj < 2; ++bj)
#pragma unroll
                    for (int n = 0; n < 2; ++n) { const f32x4 d = v[ai][bj][m][n] - mw; q += (d[0] * d[0] + d[1] * d[1]) + (d[2] * d[2] + d[3] * d[3]); }
                q += __shfl_xor(q, 16); q += __shfl_xor(q, 32);
                if (fq == 0) P[(ai * HALF + wr * 64 + m * 16 + fr) * 4 + wc] = (f32x2v){mw, q};
            }
        asm volatile("s_waitcnt lgkmcnt(0)" ::: "memory"); __builtin_amdgcn_s_barrier(); asm volatile("" ::: "memory");
#if defined(BROKEN_NO_WAIT)
        if (blockIdx.x >= 64) { const long long t0 = clock64(); while (clock64() - t0 < 60000) __builtin_amdgcn_s_sleep(8); }
#endif
        const int row = wid * 32 + (lane & 31);
        if (lane < 32) {
            const f32x2v a = P[row * 4 + 0], b = P[row * 4 + 1], c = P[row * 4 + 2], d = P[row * 4 + 3];
            const float mt = (a.x + b.x + c.x + d.x) * 0.25f;
            const float da = a.x - mt, db = b.x - mt, dc = c.x - mt, dd = d.x - mt;
            const float m2 = (a.y + b.y) + (c.y + d.y) + 64.0f * ((da * da + db * db) + (dc * dc + dd * dd));
            unsigned long long* slot = (unsigned long long*)xbuf + ((size_t)(u.pm * BM + row) * 4 + u.pn);
            __hip_atomic_store(slot, ((unsigned long long)__float_as_uint(m2) << 32) | __float_as_uint(mt), __ATOMIC_RELAXED, __HIP_MEMORY_SCOPE_AGENT);
        }
        asm volatile("s_waitcnt vmcnt(0)" ::: "memory");
        if (lane == 0) __hip_atomic_fetch_add(cnt + 64 * u.pm, 1u, __ATOMIC_RELAXED, __HIP_MEMORY_SCOPE_AGENT);
        if (wid == 0) {
            bool dead = false; const unsigned long long t0 = __builtin_amdgcn_s_memrealtime(); const unsigned want = 8u * (unsigned)ntn;
            for (;;) {
#if defined(BROKEN_NO_WAIT)
                break;
#endif
                if ((unsigned)__builtin_amdgcn_readfirstlane(__hip_atomic_load(cnt + 64 * u.pm, __ATOMIC_RELAXED, __HIP_MEMORY_SCOPE_AGENT)) >= want) break;
                if (__builtin_amdgcn_s_memrealtime() - t0 > 2000000ull) {
                    if (lane == 0) { unsigned expect = 0u; __hip_atomic_compare_exchange_strong(tmo + 1, &expect, code | (unsigned)(u.pm & 0xff), __ATOMIC_RELAXED, __ATOMIC_RELAXED, __HIP_MEMORY_SCOPE_AGENT);
                                     __hip_atomic_store(tmo, 1u, __ATOMIC_RELAXED, __HIP_MEMORY_SCOPE_AGENT); }
                    dead = true; break; }
                __builtin_amdgcn_s_sleep(2);
            }
            __builtin_amdgcn_fence(__ATOMIC_ACQUIRE, "agent");
            if (lane == 0) flag[0] = dead ? 1u : 0u;
        }
        asm volatile("s_waitcnt vmcnt(0) lgkmcnt(0)" ::: "memory"); __builtin_amdgcn_s_barrier(); asm volatile("" ::: "memory");
        const bool bad = flag[0] != 0u;
        if (lane < 32) {
            const unsigned long long* slot = (const unsigned long long*)xbuf + (size_t)(u.pm * BM + row) * 4; float mt[4], m2[4]; float ms = 0.f;
#pragma unroll
            for (int t = 0; t < 4; ++t) { if (t < ntn) { const unsigned long long w = __hip_atomic_load(slot + t, __ATOMIC_RELAXED, __HIP_MEMORY_SCOPE_AGENT); mt[t] = __uint_as_float((unsigned)w); m2[t] = __uint_as_float((unsigned)(w >> 32)); } else { mt[t] = 0.f; m2[t] = 0.f; } ms += mt[t]; }
            const float mean = ms / (float)ntn; float q = 0.f;
#pragma unroll
            for (int t = 0; t < 4; ++t) if (t < ntn) { const float dm = mt[t] - mean; q += m2[t] + 256.0f * dm * dm; }
            S[row] = (f32x2v){mean, 1.0f / sqrtf(q / (256.0f * (float)ntn) + eps)};
        }
        asm volatile("s_waitcnt lgkmcnt(0)" ::: "memory"); __builtin_amdgcn_s_barrier(); asm volatile("" ::: "memory");
        return bad;
    }
};
struct EpiLnRes {
    static constexpr bool PERM = false, AFTER_DRAIN = true;
    const float* base; float* out; int ldc; const float* bias; PanelStats st; unsigned poison;
    __device__ __forceinline__ void refuse(size_t i0, size_t stride, int M, int N) const { const float q = __builtin_nanf(""); for (size_t i = i0; i < (size_t)M * N; i += stride) out[(i / N) * ldc + i % N] = q;
        if (i0 == 0) { unsigned expect = 0u; __hip_atomic_compare_exchange_strong(st.tmo + 1, &expect, 0x7f0u, __ATOMIC_RELAXED, __ATOMIC_RELAXED, __HIP_MEMORY_SCOPE_AGENT); __hip_atomic_store(st.tmo, 1u, __ATOMIC_RELAXED, __HIP_MEMORY_SCOPE_AGENT); } }
    __device__ __forceinline__ void fused(f32x4 (&acc)[2][2][4][2], const Unit& u, int wr, int wc, int fr, int fq, PG8_LAS unsigned char* lds, int wid, int lane) const {
        typedef float f32x2v __attribute__((ext_vector_type(2)));
        const PG8_LAS f32x2v* S = (const PG8_LAS f32x2v*)(lds + 8192);
        const int col0 = u.pn * BM + wc * 32 + 4 * fq;
#pragma unroll
        for (int bj = 0; bj < 2; ++bj)
#pragma unroll
            for (int n = 0; n < 2; ++n) { const f32x4 bv = bias ? *(const f32x4*)(bias + col0 + bj * HALF + n * 16) : (f32x4){0.f, 0.f, 0.f, 0.f};
#pragma unroll
                for (int ai = 0; ai < 2; ++ai)
#pragma unroll
                    for (int m = 0; m < 4; ++m) acc[ai][bj][m][n] += bv; }
        const bool bad = st.run(acc, u, wr, wc, fr, fq, lds, wid, lane) || poison != 0u;
        const float qnan = __builtin_nanf("");
#pragma unroll
        for (int ai = 0; ai < 2; ++ai)
#pragma unroll
            for (int m = 0; m < 4; ++m) { const int r = ai * HALF + wr * 64 + m * 16 + fr; const f32x2v sr = S[r]; const size_t off = (size_t)(u.pm * BM + r) * ldc + col0;
#pragma unroll
                for (int bj = 0; bj < 2; ++bj)
#pragma unroll
                    for (int n = 0; n < 2; ++n) { const f32x4 bs = *(const f32x4*)(base + off + bj * HALF + n * 16); f32x4 o = bs + (acc[ai][bj][m][n] - sr.x) * sr.y;
                        if (bad) o = (f32x4){qnan, qnan, qnan, qnan}; *(f32x4*)(out + off + bj * HALF + n * 16) = o; }
                asm volatile("" ::: "memory"); }
    }
};
struct EpiLnResLn {
    static constexpr bool PERM = false, AFTER_DRAIN = true;
    const float* base; float* out; bf16_t* xn; int ldc; const float* bias; PanelStats st1, st2; unsigned poison;
    __device__ __forceinline__ void refuse(size_t i0, size_t stride, int M, int N) const { const float q = __builtin_nanf(""); for (size_t i = i0; i < (size_t)M * N; i += stride) { const size_t o = (i / N) * ldc + i % N; out[o] = q; xn[o] = (bf16_t)0x7fc0u; }
        if (i0 == 0) { unsigned expect = 0u; __hip_atomic_compare_exchange_strong(st1.tmo + 1, &expect, 0x7f0u, __ATOMIC_RELAXED, __ATOMIC_RELAXED, __HIP_MEMORY_SCOPE_AGENT); __hip_atomic_store(st1.tmo, 1u, __ATOMIC_RELAXED, __HIP_MEMORY_SCOPE_AGENT); } }
    __device__ __forceinline__ void fused(f32x4 (&acc)[2][2][4][2], const Unit& u, int wr, int wc, int fr, int fq, PG8_LAS unsigned char* lds, int wid, int lane) const {
        typedef float f32x2v __attribute__((ext_vector_type(2))); typedef unsigned u32x2v __attribute__((ext_vector_type(2)));
        const PG8_LAS f32x2v* S = (const PG8_LAS f32x2v*)(lds + 8192);
        const int col0 = u.pn * BM + wc * 32 + 4 * fq;
#pragma unroll
        for (int bj = 0; bj < 2; ++bj)
#pragma unroll
            for (int n = 0; n < 2; ++n) { const f32x4 bv = bias ? *(const f32x4*)(bias + col0 + bj * HALF + n * 16) : (f32x4){0.f, 0.f, 0.f, 0.f};
#pragma unroll
                for (int ai = 0; ai < 2; ++ai)
#pragma unroll
                    for (int m = 0; m < 4; ++m) acc[ai][bj][m][n] += bv; }
        bool bad = st1.run(acc, u, wr, wc, fr, fq, lds, wid, lane) || poison != 0u;
        const float qnan = __builtin_nanf("");
#pragma unroll
        for (int ai = 0; ai < 2; ++ai)
#pragma unroll
            for (int m = 0; m < 4; ++m) { const int r = ai * HALF + wr * 64 + m * 16 + fr; const f32x2v sr = S[r]; const size_t off = (size_t)(u.pm * BM + r) * ldc + col0;
#pragma unroll
                for (int bj = 0; bj < 2; ++bj)
#pragma unroll
                    for (int n = 0; n < 2; ++n) { const f32x4 bs = *(const f32x4*)(base + off + bj * HALF + n * 16); acc[ai][bj][m][n] = bs + (acc[ai][bj][m][n] - sr.x) * sr.y; }
                asm volatile("" : "+v"(acc[ai][0][m][0]), "+v"(acc[ai][0][m][1]), "+v"(acc[ai][1][m][0]), "+v"(acc[ai][1][m][1]));
                if (m & 1) asm volatile("" ::: "memory"); }
        const bool bad1 = bad;
        bad = st2.run(acc, u, wr, wc, fr, fq, lds, wid, lane) || bad;
#pragma unroll
        for (int ai = 0; ai < 2; ++ai)
#pragma unroll
            for (int m = 0; m < 4; ++m) { const int r = ai * HALF + wr * 64 + m * 16 + fr; const f32x2v sr = S[r]; const size_t off = (size_t)(u.pm * BM + r) * ldc + col0;
#pragma unroll
                for (int bj = 0; bj < 2; ++bj)
#pragma unroll
                    for (int n = 0; n < 2; ++n) { const f32x4 x1 = acc[ai][bj][m][n]; *(f32x4*)(out + off + bj * HALF + n * 16) = bad1 ? (f32x4){qnan, qnan, qnan, qnan} : x1;
                        const f32x4 o = (x1 - sr.x) * sr.y; u32x2v w; w.x = cvt_pk_bf16(o[0], o[1]); w.y = cvt_pk_bf16(o[2], o[3]);
                        if (bad) { w.x = 0x7fc07fc0u; w.y = 0x7fc07fc0u; } *(u32x2v*)(xn + off + bj * HALF + n * 16) = w; }
                asm volatile("" ::: "memory"); }
    }
};

template <class E, class = void> struct is_staged { static constexpr bool value = false; };
template <class E> struct is_staged<E, decltype((void)E::STAGED)> { static constexpr bool value = true; };
template <class Epi, class Sched, bool STAMP = false, int F8 = 0  >
__device__ __forceinline__ void gemm_phase(PG8_LAS unsigned char* lds, const Gemm g, const Sched& S, const Epi& E, unsigned long long* stamps) {
    int tid_o = threadIdx.x; asm volatile("" : "+v"(tid_o)); const int tid = tid_o, wid = __builtin_amdgcn_readfirstlane(tid >> 6), lane = tid & 63, wr = wid >> 2, wc = wid & 3, fr = lane & 15, fq = lane >> 4;
    const int K = g.K, nt = K / BK, LDA = g.lda ? g.lda : g.K;
    int ts_lo = 0, ts_hi = 0, nts = 0; const unsigned long long rt_entry = STAMP ? (unsigned long long)wall_clock64() : 0ull;
#define PG8_STAMP() do { if (STAMP && wid == 0 && nts < 64) { const unsigned long long _c = (unsigned long long)clock64(); \
        ts_lo = (lane == nts) ? (int)(unsigned)_c : ts_lo; ts_hi = (lane == nts) ? (int)(unsigned)(_c >> 32) : ts_hi; ++nts; } } while (0)
    PG8_STAMP();
    unsigned voffA[2], voffB[2];
#pragma unroll
    for (int i = 0; i < 2; ++i) { int R, C; stage_rc(tid * 16 + i * 8192, R, C); const int Rb = Epi::PERM ? ((R & ~31) + perm32(R & 31)) : R;
        voffA[i] = (unsigned)(R * LDA + C) * 2u; voffB[i] = (unsigned)(Rb * K + C) * 2u; }
    const size_t kstep = (size_t)(BK * 2);
    const size_t hstep = (size_t)HALF * K * 2;
    const size_t tstep = 2 * hstep;
    const size_t hstepA = (size_t)HALF * LDA * 2, tstepA = 2 * hstepA;
    const unsigned ldsw = (unsigned)wid * 1024u;
    const int aoff = lds_byte(wr * 64 + fr, fq * 8), boff = lds_byte(wc * 32 + fr, fq * 8);
#define PG8_SA(b, h) (((b) * 2 + (h)) * HTB)
#define PG8_SB(b, h) ((4 + (b) * 2 + (h)) * HTB)
#define PG8_STAGE(bufoff, gbase, voff) do { _Pragma("unroll") for (int _i = 0; _i < 2; ++_i) \
        __builtin_amdgcn_global_load_lds((const unsigned*)((const char*)(gbase) + (voff)[_i]), (PG8_LAS unsigned*)(lds + (bufoff) + ldsw + _i * 8192), 16, 0, 0); } while (0)
#define PG8_LDA(dst, b, h) do { _Pragma("unroll") for (int m = 0; m < 4; ++m) _Pragma("unroll") for (int k = 0; k < 2; ++k) dst[m][k] = *(const PG8_LAS bf16x8*)(lds + PG8_SA(b, h) + aoff + m * 2048 + k * 1024); } while (0)
#define PG8_LDB(dst, b, h) do { _Pragma("unroll") for (int n = 0; n < 2; ++n) _Pragma("unroll") for (int k = 0; k < 2; ++k) dst[n][k] = *(const PG8_LAS bf16x8*)(lds + PG8_SB(b, h) + boff + n * 2048 + k * 1024); } while (0)
#define PG8_CAT(x, y) __builtin_shufflevector(__builtin_bit_cast(i32x4, (x)), __builtin_bit_cast(i32x4, (y)), 0, 1, 2, 3, 4, 5, 6, 7)
#define PG8_MMA(ai, bj, At, Bt) do { __builtin_amdgcn_s_setprio(1); _Pragma("unroll") for (int m = 0; m < 4; ++m) _Pragma("unroll") for (int n = 0; n < 2; ++n) { \
        if constexpr (F8 == 2) { _Pragma("unroll") for (int k = 0; k < 2; ++k) acc[ai][bj][m][n] = __builtin_bit_cast(f32x4, __builtin_amdgcn_mfma_i32_16x16x64_i8(__builtin_bit_cast(i32x4, Bt[n][k]), __builtin_bit_cast(i32x4, At[m][k]), __builtin_bit_cast(i32x4, acc[ai][bj][m][n]), 0, 0, 0)); } \
        else if constexpr (F8 == 1) { const i32x8 _a = PG8_CAT(Bt[n][0], Bt[n][1]), _b = PG8_CAT(At[m][0], At[m][1]); asm volatile("v_mfma_f32_16x16x128_f8f6f4 %0, %1, %2, %0" : "+v"(acc[ai][bj][m][n]) : "v"(_a), "v"(_b)); } \
        else { _Pragma("unroll") for (int k = 0; k < 2; ++k) acc[ai][bj][m][n] = __builtin_amdgcn_mfma_f32_16x16x32_bf16(Bt[n][k], At[m][k], acc[ai][bj][m][n], 0, 0, 0); } } \
        __builtin_amdgcn_s_setprio(0); } while (0)
#define PG8_WAIT_V(n) asm volatile("s_waitcnt vmcnt(" #n ")" ::: "memory")
#define PG8_WAIT_L(n) asm volatile("s_waitcnt lgkmcnt(" #n ")" ::: "memory")
#define PG8_BAR __builtin_amdgcn_s_barrier()
#define PG8_SCHED __builtin_amdgcn_sched_barrier(0)
    Unit cur, nxt; int ui = 0;
    if (!S.next(0, cur)) return;
    f32x4 acc[2][2][4][2];
#pragma unroll
    for (int a = 0; a < 2; ++a)
#pragma unroll
        for (int b = 0; b < 2; ++b)
#pragma unroll
            for (int m = 0; m < 4; ++m)
#pragma unroll
                for (int n = 0; n < 2; ++n) acc[a][b][m][n] = (f32x4){0.f, 0.f, 0.f, 0.f};
    bf16x8 At[4][2], B0[2][2], B1[2][2];
    const char* cA = (const char*)g.A + (size_t)cur.pm * tstepA; const char* cB = (const char*)g.Bt + (size_t)cur.pn * tstep;
    S.a_ready(cur);
    PG8_STAGE(PG8_SB(0, 0), cB, voffB); PG8_STAGE(PG8_SA(0, 0), cA, voffA); PG8_STAGE(PG8_SB(0, 1), cB + hstep, voffB); PG8_STAGE(PG8_SA(0, 1), cA + hstepA, voffA);
    if (wr == 1) PG8_BAR;
    PG8_WAIT_V(4); PG8_BAR;
    PG8_STAGE(PG8_SB(1, 0), cB + kstep, voffB); PG8_STAGE(PG8_SA(1, 0), cA + kstep, voffA); PG8_STAGE(PG8_SB(1, 1), cB + hstep + kstep, voffB);
    PG8_WAIT_V(6); PG8_BAR;
    PG8_STAMP();
    for (;;) {
        const bool has_next = S.next(ui + 1, nxt);
        const char* nA = has_next ? (const char*)g.A + (size_t)nxt.pm * tstepA : cA; const char* nB = has_next ? (const char*)g.Bt + (size_t)nxt.pn * tstep : cB;
        for (int t = 0; t < nt; t += 2) {
            const bool last = (t == nt - 2);
            const char* a1 = cA + (size_t)(t + 1) * kstep;
            const char* a2 = last ? nA : cA + (size_t)(t + 2) * kstep; const char* b2 = last ? nB : cB + (size_t)(t + 2) * kstep;
            const char* a3 = a2 + kstep; const char* b3 = b2 + kstep;
            if (last && has_next) S.a_ready(nxt);
            PG8_LDB(B0, 0, 0); PG8_SCHED; PG8_LDA(At, 0, 0); PG8_STAGE(PG8_SA(1, 1), a1 + hstepA, voffA);
            PG8_WAIT_L(8); PG8_BAR; PG8_WAIT_L(0); PG8_MMA(0, 0, At, B0); PG8_BAR; PG8_SCHED;
            PG8_LDB(B1, 0, 1); PG8_STAGE(PG8_SB(0, 0), b2, voffB);
            PG8_BAR; PG8_WAIT_L(0); PG8_MMA(0, 1, At, B1); PG8_BAR;
            PG8_LDA(At, 0, 1); PG8_STAGE(PG8_SA(0, 0), a2, voffA);
            PG8_BAR; PG8_WAIT_L(0); PG8_MMA(1, 0, At, B0); PG8_BAR; PG8_SCHED;
            PG8_STAGE(PG8_SB(0, 1), b2 + hstep, voffB);
            PG8_WAIT_V(6); PG8_BAR; PG8_MMA(1, 1, At, B1); PG8_BAR;
            PG8_LDB(B0, 1, 0); PG8_SCHED; PG8_LDA(At, 1, 0); PG8_STAGE(PG8_SA(0, 1), a2 + hstepA, voffA);
            PG8_WAIT_L(8); PG8_BAR; PG8_WAIT_L(0); PG8_MMA(0, 0, At, B0); PG8_BAR; PG8_SCHED;
            PG8_LDB(B1, 1, 1); PG8_STAGE(PG8_SB(1, 0), b3, voffB);
            PG8_BAR; PG8_WAIT_L(0); PG8_MMA(0, 1, At, B1); PG8_BAR;
            PG8_LDA(At, 1, 1); PG8_STAGE(PG8_SA(1, 0), a3, voffA);
            PG8_BAR; PG8_WAIT_L(0); PG8_MMA(1, 0, At, B0); PG8_BAR; PG8_SCHED;
            PG8_STAGE(PG8_SB(1, 1), b3 + hstep, voffB);
            PG8_WAIT_V(6); PG8_BAR; PG8_MMA(1, 1, At, B1); PG8_BAR;
        }
        PG8_STAMP();
        if constexpr (F8 == 1) asm volatile("s_nop 15\n\ts_nop 15" ::: "memory");
        if constexpr (Epi::AFTER_DRAIN) {}
        else if constexpr (is_staged<Epi>::value) {
            if (wr == 0) PG8_BAR;
            E.staged(acc, cur, wr, wc, fr, fq, lds + STAGE_BYTES + 256, wid, lane);
            if (wr == 1) PG8_BAR;
            S.done(cur); }
        else if constexpr (!Epi::AFTER_DRAIN) { E(acc, cur, wr, wc, fr, fq); S.done(cur); }
        PG8_STAMP();
        if (!has_next) break;
#pragma unroll
        for (int a = 0; a < 2; ++a)
#pragma unroll
            for (int b = 0; b < 2; ++b)
#pragma unroll
                for (int m = 0; m < 4; ++m)
#pragma unroll
                    for (int n = 0; n < 2; ++n) acc[a][b][m][n] = (f32x4){0.f, 0.f, 0.f, 0.f};
        cur = nxt; cA = nA; cB = nB; ++ui;
    }
    PG8_WAIT_V(0);
    if (wr == 0) PG8_BAR;
    PG8_BAR;
    if constexpr (Epi::AFTER_DRAIN) { E.fused(acc, cur, wr, wc, fr, fq, lds, wid, lane); S.done(cur); }
    PG8_STAMP();
    if (STAMP && wid == 0) { stamps[lane] = lane < nts ? (((unsigned long long)(unsigned)ts_hi << 32) | (unsigned)ts_lo) : 0ull;
        if (lane == 62) stamps[62] = rt_entry; if (lane == 63) stamps[63] = (unsigned long long)wall_clock64(); }
#undef PG8_STAMP
#undef PG8_SA
#undef PG8_SB
#undef PG8_STAGE
#undef PG8_LDA
#undef PG8_LDB
#undef PG8_MMA
#undef PG8_CAT
#undef PG8_WAIT_V
#undef PG8_WAIT_L
#undef PG8_BAR
#undef PG8_SCHED
}
}
#define XB_TMO      128
#define XB_XCNT(j)  (256  + 64 * (j))
#define XB_XSUB(j)  (1280 + 64 * (j))
#define XB_XGEN(j)  (2304 + 64 * (j))
#define XB_TOP      3328
#define XB_TOPGEN   3392
#define XCD_BAR_WORDS 3456
#define XB_SPIN_CAP (1u << 23)
#define LAS __attribute__((address_space(3)))

__device__ __forceinline__ unsigned xb_ld(unsigned* p)              { return __hip_atomic_load(p, __ATOMIC_RELAXED, __HIP_MEMORY_SCOPE_AGENT); }
__device__ __forceinline__ unsigned xb_add(unsigned* p, unsigned v) { return __hip_atomic_fetch_add(p, v, __ATOMIC_RELAXED, __HIP_MEMORY_SCOPE_AGENT); }
__device__ __forceinline__ unsigned xb_xcc_id() { return (unsigned)__builtin_amdgcn_s_getreg((3 << 11) | 20) & 0xFu; }
#define XB_SPIN(cond, bar) do { unsigned _sp = 0; while (cond) { __builtin_amdgcn_s_sleep(1); \
    if ((++_sp & 255u) == 0u) { if (xb_ld(&(bar)[XB_TMO])) break; if (_sp > XB_SPIN_CAP) { atomicAdd(&(bar)[XB_TMO], 1u); break; } } } } while (0)

struct XcdBarrier {
    unsigned* bar; unsigned x;
    volatile LAS unsigned* st;
};

__device__ __forceinline__ XcdBarrier xcd_barrier_post(unsigned* bar, volatile LAS unsigned* st) {
    XcdBarrier b; b.bar = bar; b.x = xb_xcc_id(); b.st = st;
    if (threadIdx.x == 0) (void)xb_add(&bar[XB_XCNT(b.x)], 1u);
    return b;
}
__device__ __forceinline__ void xcd_barrier_complete(unsigned* bar, unsigned x, unsigned& nloc, unsigned& nx) {
    const unsigned G = gridDim.x * gridDim.y * gridDim.z;
    unsigned sum, cnt, mine, sp = 0u;
    for (;;) {
        sum = 0u; cnt = 0u; mine = 0u;
#pragma unroll
        for (unsigned j = 0; j < 16; ++j) { const unsigned c = xb_ld(&bar[XB_XCNT(j)]); sum += c; cnt += (c > 0u) ? 1u : 0u; mine = (j == x) ? c : mine; }
        if (sum == G) break;
        __builtin_amdgcn_s_sleep(1);
        if ((++sp & 255u) == 0u) { if (xb_ld(&bar[XB_TMO])) break; if (sp > XB_SPIN_CAP) { atomicAdd(&bar[XB_TMO], 1u); break; } }
    }
    nloc = mine > 0u ? mine : 1u; nx = cnt > 0u ? cnt : 1u;
}

__device__ __forceinline__ void xcd_barrier(const XcdBarrier& b) {
    asm volatile("s_waitcnt vmcnt(0)" ::: "memory");
    __syncthreads();
    if (threadIdx.x == 0) {
        unsigned* bar = b.bar;
        __builtin_amdgcn_s_waitcnt(0);
        unsigned nloc = b.st[0], nx = b.st[1];
        if (nloc == 0u) { xcd_barrier_complete(bar, b.x, nloc, nx); b.st[0] = nloc; b.st[1] = nx; }
        const unsigned old = xb_add(&bar[XB_XSUB(b.x)], 1u);
        const unsigned gen = old / nloc;
        if (old + 1u == (gen + 1u) * nloc) {
            __builtin_amdgcn_fence(__ATOMIC_RELEASE, "agent");
            asm volatile("s_waitcnt vmcnt(0)" ::: "memory");
            const unsigned og = xb_add(&bar[XB_TOP], 1u);
            const unsigned tg = og / nx;
            if (og + 1u == (tg + 1u) * nx) xb_add(&bar[XB_TOPGEN], 1u);
            else XB_SPIN(xb_ld(&bar[XB_TOPGEN]) == tg, bar);
            __builtin_amdgcn_fence(__ATOMIC_ACQUIRE, "agent");
            xb_add(&bar[XB_XGEN(b.x)], 1u);
            asm volatile("s_waitcnt vmcnt(0)" ::: "memory");
        } else {
            XB_SPIN(xb_ld(&bar[XB_XGEN(b.x)]) == gen, bar);
            __builtin_amdgcn_fence(__ATOMIC_ACQUIRE, "agent");
            asm volatile("s_waitcnt vmcnt(0)" ::: "memory");
        }
    }
    __syncthreads();
}

namespace fa {
typedef unsigned short bf16;
typedef short bf16x8 __attribute__((ext_vector_type(8)));
typedef short s16x4 __attribute__((ext_vector_type(4)));
typedef float f32x16 __attribute__((ext_vector_type(16)));
typedef float f32x4 __attribute__((ext_vector_type(4)));
typedef unsigned u32x4 __attribute__((ext_vector_type(4)));
typedef unsigned u32x2 __attribute__((ext_vector_type(2)));
constexpr int D = 128, SEQ = 2048;
constexpr float SCALE = 0.08838834764831845f, THR = 8.f;
constexpr int NW = 8, QBLK = 32, KVBLK = 64, QB = NW * QBLK;
constexpr int SHM_V = KVBLK * D * 2, SHM_K = KVBLK * D * 2;
constexpr int LDS_BYTES = 2 * SHM_V + 2 * SHM_K + NW * 64 * 4;
enum { M_WIN = 0, M_SEL = 1, M_BITS = 2 };

#define KSWZ(row, colB) ((row) * 256 + ((colB) ^ (((row) & 7) << 4)))
#define SBAR() __builtin_amdgcn_sched_barrier(0)
__device__ __forceinline__ int v_st(int k, int c) { const int kk = (k & ~0xC) | ((k & 4) << 1) | ((k & 8) >> 1); return ((kk >> 3) * 4 + (c >> 5)) * 512 + ((kk & 7) * 32 + (c & 31)) * 2; }
__device__ __forceinline__ int v_rd_base(int lane) { return ((lane & 3) << 3) | (((lane >> 2) & 3) << 6) | (((lane >> 4) & 1) << 5) | (((lane >> 5) & 1) << 8); }
constexpr int v_rd_off(int d0, int ks, int half) { return d0 * 512 + ks * 4096 + half * 2048; }
__device__ __forceinline__ int crow(int r, int hi) { return (r & 3) + 8 * (r >> 2) + 4 * hi; }
__device__ __forceinline__ unsigned cvtpk(float lo, float hi) { unsigned r; asm volatile("v_cvt_pk_bf16_f32 %0, %1, %2" : "=v"(r) : "v"(lo), "v"(hi)); return r; }
__device__ __forceinline__ int opq(int x) { asm volatile("" : "+v"(x)); return x; }
__device__ __forceinline__ bf16x8 load8(const bf16* p) { return *reinterpret_cast<const bf16x8*>(p); }

__device__ __forceinline__ void mask_tile(f32x16& p0, f32x16& p1, int dq, unsigned W) {
    const float NEG = -__builtin_inff();
#pragma unroll
    for (int r = 0; r < 16; ++r) {
        const int c = (r & 3) + 8 * (r >> 2);
        if ((unsigned)(dq - c) >= W) p0[r] = NEG;
        if ((unsigned)(dq - c - 32) >= W) p1[r] = NEG;
    }
}
__device__ __forceinline__ void mask_all(f32x16& p0, f32x16& p1) {
    const float NEG = -__builtin_inff();
#pragma unroll
    for (int r = 0; r < 16; ++r) { p0[r] = NEG; p1[r] = NEG; }
}
__device__ __forceinline__ void mask_bits(f32x16& p0, f32x16& p1, unsigned wlo, unsigned whi, int hi) {
    const float NEG = -__builtin_inff();
    const unsigned a = wlo >> (4 * hi), b = whi >> (4 * hi);
#pragma unroll
    for (int r = 0; r < 16; ++r) {
        const int c = (r & 3) + 8 * (r >> 2);
        if (!((a >> c) & 1u)) p0[r] = NEG;
        if (!((b >> c) & 1u)) p1[r] = NEG;
    }
}
__device__ __forceinline__ void partialSM(f32x16& p0, f32x16& p1, float& m_reg, float& mn, float& alpha) {
    float pmax = p0[0]; for (int r = 1; r < 16; ++r) pmax = fmaxf(pmax, p0[r]); for (int r = 0; r < 16; ++r) pmax = fmaxf(pmax, p1[r]);
    { auto rr = __builtin_amdgcn_permlane32_swap(__float_as_uint(pmax), __float_as_uint(pmax), false, false);
      pmax = fmaxf(__uint_as_float(rr[0]), __uint_as_float(rr[1])); }
    constexpr float C2 = 1.4426950408889634f * SCALE;
    if (__builtin_expect(__all((pmax - m_reg) * SCALE <= THR), 1)) { mn = m_reg; alpha = 1.f; }
    else { mn = fmaxf(m_reg, pmax); alpha = __builtin_amdgcn_exp2f((m_reg - mn) * C2); m_reg = mn; }
    const float mnL = -mn * C2;
    for (int r = 0; r < 16; ++r) p0[r] = fmaf(p0[r], C2, mnL); for (int r = 0; r < 16; ++r) p1[r] = fmaf(p1[r], C2, mnL);
    for (int r = 0; r < 16; ++r) p0[r] = __builtin_amdgcn_exp2f(p0[r]);
}
__device__ __forceinline__ void finishSM(f32x16& p0, f32x16& p1, float alpha, float& l_reg, bf16x8& pa0, bf16x8& pa1, bf16x8& pa2, bf16x8& pa3) {
    for (int r = 0; r < 16; ++r) p1[r] = __builtin_amdgcn_exp2f(p1[r]);
    float ps = 0; for (int r = 0; r < 16; ++r) ps += p0[r]; for (int r = 0; r < 16; ++r) ps += p1[r];
    { auto rr = __builtin_amdgcn_permlane32_swap(__float_as_uint(ps), __float_as_uint(ps), false, false);
      ps = __uint_as_float(rr[0]) + __uint_as_float(rr[1]); }
    l_reg = l_reg * alpha + ps;
#define PK4(P, B_, OUT) do { unsigned a0 = cvtpk(P[B_+0], P[B_+1]), a1 = cvtpk(P[B_+2], P[B_+3]);                          \
        unsigned b0 = cvtpk(P[B_+4], P[B_+5]), b1 = cvtpk(P[B_+6], P[B_+7]);                                             \
        auto r0 = __builtin_amdgcn_permlane32_swap(a0, b0, false, false); auto r1 = __builtin_amdgcn_permlane32_swap(a1, b1, false, false); \
        u32x4 w = {r0[0], r1[0], r0[1], r1[1]}; OUT = *reinterpret_cast<bf16x8*>(&w); } while (0)
    PK4(p0, 0, pa0); PK4(p0, 8, pa1); PK4(p1, 0, pa2); PK4(p1, 8, pa3);
#undef PK4
}
template <int KB>
__device__ __forceinline__ void qkt(f32x16& p0, f32x16& p1, const char* K_lds, int r32, int hi, const bf16x8* qr, bool act) {
    if (!act) { mask_all(p0, p1); return; }
    p0 = f32x16{}; p1 = f32x16{};
    const char* kb[4];
#pragma unroll
    for (int dd = 0; dd < 4; ++dd) kb[dd] = K_lds + KB * SHM_K + KSWZ(r32, (dd * 16 + hi * 8) * 2);
#pragma unroll
    for (int d0 = 0; d0 < 8; ++d0) { const char* a = kb[d0 & 3] + (d0 >> 2) * 128;
        bf16x8 b0 = *reinterpret_cast<const bf16x8*>(a);
        bf16x8 b1 = *reinterpret_cast<const bf16x8*>(a + 32 * 256);
        p0 = __builtin_amdgcn_mfma_f32_32x32x16_bf16(b0, qr[d0], p0, 0, 0, 0);
        p1 = __builtin_amdgcn_mfma_f32_32x32x16_bf16(b1, qr[d0], p1, 0, 0, 0); }
}
template <int VB>
__device__ __forceinline__ void pv_tile(f32x16* o, int vb0, bf16x8 pa0, bf16x8 pa1, bf16x8 pa2, bf16x8 pa3, bool act) {
    if (!act) return;
#define TRRD(dst, off) asm volatile("ds_read_b64_tr_b16 %0, %1 offset:%2" : "=&v"(dst) : "v"(vb0), "i"(off) : "memory")
#define PV_D0(d0) do { s16x4 l0, l1, l2, l3, h0, h1, h2, h3; constexpr int b_ = VB * SHM_V + v_rd_off(d0, 0, 0); \
        TRRD(l0, b_); TRRD(h0, b_ + 2048); TRRD(l1, b_ + 4096); TRRD(h1, b_ + 6144); TRRD(l2, b_ + 8192); TRRD(h2, b_ + 10240); TRRD(l3, b_ + 12288); TRRD(h3, b_ + 14336); \
        asm volatile("s_waitcnt lgkmcnt(0)" ::: "memory"); SBAR();   \
        o[d0] = __builtin_amdgcn_mfma_f32_32x32x16_bf16(pa0, (bf16x8){l0[0], l0[1], l0[2], l0[3], h0[0], h0[1], h0[2], h0[3]}, o[d0], 0, 0, 0);   \
        o[d0] = __builtin_amdgcn_mfma_f32_32x32x16_bf16(pa1, (bf16x8){l1[0], l1[1], l1[2], l1[3], h1[0], h1[1], h1[2], h1[3]}, o[d0], 0, 0, 0);   \
        o[d0] = __builtin_amdgcn_mfma_f32_32x32x16_bf16(pa2, (bf16x8){l2[0], l2[1], l2[2], l2[3], h2[0], h2[1], h2[2], h2[3]}, o[d0], 0, 0, 0);   \
        o[d0] = __builtin_amdgcn_mfma_f32_32x32x16_bf16(pa3, (bf16x8){l3[0], l3[1], l3[2], l3[3], h3[0], h3[1], h3[2], h3[3]}, o[d0], 0, 0, 0); } while (0)
    PV_D0(0); PV_D0(1); PV_D0(2); PV_D0(3);
#undef PV_D0
#undef TRRD
}

struct BlockRef { const bf16* Q; const bf16* K; const bf16* V; bf16* O; float* LSE; const unsigned* aux; int P0, ldo, lstr, mode, Wu, m, ecode; };
struct EpiPtrs { const bf16* oc; const bf16* owin; const float* gate; const bf16* ob4; const bf16* ob16; const float* lse4; const float* lse16; };
struct Seam { bf16x8 qr[8]; bf16x8 st_v0, st_v1, st_k0, st_k1; };
__device__ __forceinline__ int jlo_of(const BlockRef& r) { if (r.mode != M_WIN) return 0; int lowk = r.P0 - r.Wu + 1; const int cls = r.P0 & ~(r.m - 1); if (lowk < cls) lowk = cls;
    return lowk > 0 ? lowk / KVBLK : 0; }
__device__ __forceinline__ int tok_of(const BlockRef& r, int p) { return (p & (r.m - 1)) * (SEQ / r.m) + p / r.m; }
#define LDG(base, off) (*reinterpret_cast<const bf16x8*>(reinterpret_cast<const char*>(base) + (off)))
#define VMW() asm volatile("s_waitcnt vmcnt(0)" ::: "memory")
#define VMWN(n) asm volatile("s_waitcnt vmcnt(%0)" :: "i"(n) : "memory")
#define SLOAD_H(R, k0) do { const int t_ = opq(tid); const int p0_ = (k0) + (t_ >> 4), p1_ = p0_ + 32, lm_ = 31 - __builtin_clz((R).m), ld_ = 11 - lm_;                                 \
                         const unsigned c_ = (unsigned)((t_ & 15) * 16);                                                                                                                 \
                         const unsigned o0_ = (unsigned)((((p0_ & ((R).m - 1)) << ld_) + (p0_ >> lm_)) * (D * 2)) + c_, o1_ = (unsigned)((((p1_ & ((R).m - 1)) << ld_) + (p1_ >> lm_)) * (D * 2)) + c_; \
                         S.st_v0 = LDG((R).V, o0_); S.st_v1 = LDG((R).V, o1_); S.st_k0 = LDG((R).K, o0_); S.st_k1 = LDG((R).K, o1_); } while (0)
#define SWRITE_HK(bf) do { const int t_ = opq(tid); const int kws_ = KSWZ(t_ >> 4, (t_ & 15) * 16); *(bf16x8*)(K_lds + (bf) * SHM_K + kws_) = S.st_k0; *(bf16x8*)(K_lds + (bf) * SHM_K + kws_ + 32 * 256) = S.st_k1; } while (0)
#define SWRITE_HV(bf) do { const int t_ = opq(tid); *(bf16x8*)(V_lds + (bf) * SHM_V + v_st(t_ >> 4, (t_ & 15) * 8)) = S.st_v0; *(bf16x8*)(V_lds + (bf) * SHM_V + v_st(32 + (t_ >> 4), (t_ & 15) * 8)) = S.st_v1; } while (0)
#define SWRITE_H(bf) do { SWRITE_HV(bf); SWRITE_HK(bf); } while (0)
__device__ __forceinline__ void prime(const BlockRef& cur, char* lds, Seam& S, int tid) {
    const int wid = __builtin_amdgcn_readfirstlane(tid >> 6), lane = tid & 63, r32 = lane & 31, hi = lane >> 5;
    char* K_lds = lds + 2 * SHM_V;
    const int kb0 = jlo_of(cur) * KVBLK;
    const bf16* qrow = cur.Q + (size_t)tok_of(cur, cur.P0 + wid * QBLK + r32) * D + hi * 8;
    for (int d0 = 0; d0 < 8; ++d0) S.qr[d0] = load8(qrow + d0 * 16);
    SLOAD_H(cur, kb0); VMW(); SWRITE_HK(0);
    __syncthreads();
}
template <class NF> __device__ __forceinline__ void block(const BlockRef& cur, BlockRef& nxt, NF& nf, const EpiPtrs& ep, char* lds, Seam& S, int tid) {
    const int wid = __builtin_amdgcn_readfirstlane(tid >> 6), lane = tid & 63, r32 = lane & 31, hi = lane >> 5;
    const int mode = cur.mode, W = cur.Wu;
    const int j_lo = jlo_of(cur);
    int j_hi = (cur.P0 + QB - 1) / KVBLK + 1; if (j_hi > SEQ / KVBLK) j_hi = SEQ / KVBLK;
    const int NT = j_hi - j_lo;
    const int qlo = cur.P0 + wid * QBLK;
    const int cbase = qlo & (cur.m - 1);
    const bool force = cbase < W - 1;
    unsigned mrow = 0u;
    if (mode == M_SEL) mrow = cur.aux[qlo + r32]; else if (mode == M_BITS) mrow = (unsigned)(qlo + r32) * 256u;
    char* V_lds = lds; char* K_lds = lds + 2 * SHM_V;
    float* ws = (float*)(lds + 2 * SHM_V + 2 * SHM_K) + wid * 64; float* li_l = ws, * al_l = ws + 32;
    float m_reg = -1e30f, l_reg = 0; f32x16 o[4] = {};
#define VB0 ((int)(uintptr_t)V_lds + v_rd_base(opq(lane)))
#define RESC(a) do { if (__any((a) < 1.f)) { if (hi == 0) al_l[r32] = (a); asm volatile("s_waitcnt lgkmcnt(0)" ::: "memory");              \
                     for (int d_ = 0; d_ < 4; ++d_) for (int r = 0; r < 16; ++r) o[d_][r] *= al_l[crow(r, hi)]; } } while (0)
#define KBASE(t) ((j_lo + (t)) * KVBLK)
#define ACT(t) ((mode == M_WIN) ? (KBASE(t) <= qlo + QBLK - 1 && KBASE(t) + KVBLK - 1 >= qlo - W + 1) : ((mode == M_SEL) ? (__any((mrow >> (j_lo + (t))) & 1u) && KBASE(t) <= qlo + QBLK - 1) : (KBASE(t) <= qlo + QBLK - 1)))
#define MASKT(P0_, P1_, t) do { const int kb_ = KBASE(t); if (ACT(t)) { const int l_ = opq(lane); const int qm = qlo + (l_ & 31) - 4 * (l_ >> 5);                                                                                        \
        if (mode == M_WIN) { if (force || kb_ + KVBLK - 1 > qlo || kb_ <= qlo + QBLK - 1 - W) { int rx_ = r32; asm volatile("" : "+v"(rx_));                   \
                const unsigned cp_ = (unsigned)(cbase + rx_ + 1); mask_tile(P0_, P1_, qm - kb_, cp_ < (unsigned)W ? cp_ : (unsigned)W); } }                     \
        else if (mode == M_SEL) { if (kb_ + KVBLK - 1 > qlo) mask_tile(P0_, P1_, qm - kb_, 0x7fffffffu); if (!((mrow >> (j_lo + (t))) & 1u)) mask_all(P0_, P1_); } \
        else { const u32x2 w_ = *(const u32x2*)((const char*)cur.aux + mrow + 8u * (unsigned)(j_lo + (t))); mask_bits(P0_, P1_, w_.x, w_.y, hi); } } } while (0)
    constexpr int NQL = 8;
#define SEAM_K0() do { VMWN(NQL); SWRITE_HK(0); SBAR(); } while (0)
    f32x16 pA0, pA1, pB0, pB1; float mnA, mnB, alA, alB; bf16x8 pa0, pa1, pa2, pa3;
    SWRITE_HV(0); SBAR();
    if (NT > 1) { SLOAD_H(cur, KBASE(1)); }
    SBAR(); qkt<0>(pA0, pA1, K_lds, opq(r32), hi, S.qr, ACT(0));
    MASKT(pA0, pA1, 0); partialSM(pA0, pA1, m_reg, mnA, alA);
    if (NT > 1) { VMW(); SWRITE_H(1); }
    __syncthreads();
#define HALF_STEP(PX0, PX1, mnX, alX, PY0, PY1, alY, t, KB, VB, SB) do {                                                      \
        SBAR(); qkt<KB>(PX0, PX1, K_lds, opq(r32), hi, S.qr, ACT(t));                                                 \
        finishSM(PY0, PY1, alY, l_reg, pa0, pa1, pa2, pa3); SBAR();                                                           \
        if ((t) + 1 < NT) { SLOAD_H(cur, KBASE((t) + 1)); SBAR(); }                                                        \
        pv_tile<VB>(o, VB0, pa0, pa1, pa2, pa3, ACT((t) - 1)); MASKT(PX0, PX1, (t)); partialSM(PX0, PX1, m_reg, mnX, alX);    \
        __syncthreads();                                                                                                      \
        if ((t) + 1 < NT) { VMW(); SWRITE_H(SB); }                                                                            \
        RESC(alX); __syncthreads(); } while (0)
    for (int t = 1; t + 1 < NT; t += 2) {
        HALF_STEP(pB0, pB1, mnB, alB, pA0, pA1, alA, t, 1, 0, 0);
        HALF_STEP(pA0, pA1, mnA, alA, pB0, pB1, alB, t + 1, 0, 1, 1);
    }
    const bool even = (NT & 1) == 0;
    if (even) { SBAR(); qkt<1>(pB0, pB1, K_lds, opq(r32), hi, S.qr, ACT(NT - 1)); SBAR(); }
    nxt = nf(cur); const int kbn = jlo_of(nxt) * KVBLK;
    SLOAD_H(nxt, kbn); SBAR();
    { const bf16* qrow = nxt.Q + (size_t)tok_of(nxt, nxt.P0 + wid * QBLK + r32) * D + hi * 8;
#pragma unroll
      for (int d0 = 0; d0 < 8; ++d0) S.qr[d0] = load8(qrow + d0 * 16); }
    SBAR();
    finishSM(pA0, pA1, alA, l_reg, pa0, pa1, pa2, pa3); SBAR();
    pv_tile<0>(o, VB0, pa0, pa1, pa2, pa3, ACT(even ? NT - 2 : NT - 1));
    if (even) { MASKT(pB0, pB1, NT - 1); partialSM(pB0, pB1, m_reg, mnB, alB); __syncthreads(); RESC(alB);
        finishSM(pB0, pB1, alB, l_reg, pa0, pa1, pa2, pa3); SBAR(); pv_tile<1>(o, VB0, pa0, pa1, pa2, pa3, ACT(NT - 1)); }
    SBAR(); SEAM_K0();
    if (hi == 0) li_l[r32] = l_reg; asm volatile("s_waitcnt lgkmcnt(0)" ::: "memory");
    if (cur.LSE && hi == 0) cur.LSE[(size_t)tok_of(cur, qlo + r32) * cur.lstr] = m_reg * (1.4426950408889634f * SCALE) + __builtin_amdgcn_logf(l_reg);
    float rli[16];
#pragma unroll
    for (int r = 0; r < 16; ++r) rli[r] = __builtin_amdgcn_rcpf(li_l[crow(r, hi)]);
    const int emode = cur.ecode & 15;
    if (emode == 0) {
        char* stg = lds + (wid < 7 ? LDS_BYTES + wid * (32 * 272) : 131072 + 256);
        { const int l_ = opq(lane); char* wp_ = stg + (4 * (l_ >> 5)) * 272 + (l_ & 31) * 2;
#pragma unroll
          for (int r = 0; r < 16; ++r)
#pragma unroll
            for (int d0 = 0; d0 < 4; ++d0) *(unsigned short*)(wp_ + ((r & 3) + 8 * (r >> 2)) * 272 + d0 * 64) = (unsigned short)cvtpk(o[d0][r] * rli[r], 0.f); }
        asm volatile("s_waitcnt lgkmcnt(0)" ::: "memory");
        { const int l_ = opq(lane); const char* rp_ = stg + (l_ >> 4) * 272 + (l_ & 15) * 16;
#pragma unroll
          for (int i = 0; i < 8; ++i) { const u32x4 v = *(const u32x4*)(rp_ + i * 4 * 272);
              *(u32x4*)(cur.O + (size_t)tok_of(cur, qlo + i * 4 + (l_ >> 4)) * cur.ldo + (l_ & 15) * 8) = v; } }
    } else {
        const int ehead = (cur.ecode >> 4) & 15, etb = (cur.ecode >> 8) * SEQ;
        if (emode == 3) { if (hi == 0) al_l[r32] = m_reg * (1.4426950408889634f * SCALE) + __builtin_amdgcn_logf(l_reg); }
        char* stg = lds + (wid < 7 ? LDS_BYTES + wid * (32 * 272) : 131072 + 256);
        { const int l_ = opq(lane); char* wp_ = stg + (4 * (l_ >> 5)) * 272 + (l_ & 31) * 2;
#pragma unroll
          for (int r = 0; r < 16; ++r)
#pragma unroll
            for (int d0 = 0; d0 < 4; ++d0) *(unsigned short*)(wp_ + ((r & 3) + 8 * (r >> 2)) * 272 + d0 * 64) = (unsigned short)cvtpk(o[d0][r] * rli[r], 0.f); }
        asm volatile("s_waitcnt lgkmcnt(0)" ::: "memory");
        const int l_ = opq(lane), rq = l_ >> 4, c8 = (l_ & 15) * 8;
        const char* rp_ = stg + rq * 272 + (l_ & 15) * 16;
#pragma unroll
        for (int ib = 0; ib < 8; ib += 4) {
            u32x4 wo[4], wa[4], wb[4]; float s0[4], s1[4], l1[4];
#pragma unroll
            for (int k = 0; k < 4; ++k) { const int row = (ib + k) * 4 + rq; const size_t tg = (size_t)(etb + qlo + row);
                wo[k] = *(const u32x4*)(rp_ + (ib + k) * 4 * 272);
                if (emode == 2) { const float* gp = ep.gate + tg * 24 + ehead * 3; s0[k] = gp[1]; s1[k] = gp[2]; l1[k] = 0.f;
                    const size_t e = tg * 1024 + ehead * 128 + c8; wa[k] = *(const u32x4*)(ep.oc + e); wb[k] = *(const u32x4*)(ep.owin + e); }
                else { s0[k] = ep.lse4[tg * 4 + ehead]; s1[k] = ep.lse16[tg * 4 + ehead]; l1[k] = al_l[row];
                    const size_t e = tg * 512 + ehead * 128 + c8; wa[k] = *(const u32x4*)(ep.ob4 + e); wb[k] = *(const u32x4*)(ep.ob16 + e); } }
#pragma unroll
            for (int k = 0; k < 4; ++k) { const int row = (ib + k) * 4 + rq;
                float c0, ca, cb;
                if (emode == 2) { c0 = s0[k]; ca = 1.0f; cb = s1[k]; }
                else { const float mm = fmaxf(l1[k], fmaxf(s0[k], s1[k])), w1 = __builtin_amdgcn_exp2f(l1[k] - mm), w4 = __builtin_amdgcn_exp2f(s0[k] - mm), w16 = __builtin_amdgcn_exp2f(s1[k] - mm);
                    const float wi = __builtin_amdgcn_rcpf(w1 + w4 + w16); c0 = w1 * wi; ca = w4 * wi; cb = w16 * wi; }
                u32x4 w;
#pragma unroll
                for (int j = 0; j < 4; ++j) { const unsigned uo = wo[k][j], ua = wa[k][j], ub = wb[k][j];
                    const float x0 = c0 * __uint_as_float(uo << 16) + ca * __uint_as_float(ua << 16) + cb * __uint_as_float(ub << 16);
                    const float x1 = c0 * __uint_as_float(uo & 0xffff0000u) + ca * __uint_as_float(ua & 0xffff0000u) + cb * __uint_as_float(ub & 0xffff0000u);
                    w[j] = cvtpk(x0, x1); }
                *(u32x4*)(cur.O + (size_t)(qlo + row) * cur.ldo + c8) = w; }
        }
    }
    __syncthreads();
#undef RESC
#undef KBASE
#undef ACT
#undef MASKT
#undef SEAM_K0
#undef HALF_STEP
#undef VB0
}
#undef LDG
#undef VMW
#undef VMWN
#undef SLOAD_H
#undef SWRITE_HK
#undef SWRITE_HV
#undef SWRITE_H
#undef KSWZ
}
#ifndef MK_DUP_PH
#define MK_DUP_PH 0
#endif
namespace mk {
typedef unsigned short bf16_t;
typedef short bf16x8 __attribute__((ext_vector_type(8)));
typedef float f32x4 __attribute__((ext_vector_type(4)));
typedef float f32x2 __attribute__((ext_vector_type(2)));
typedef unsigned u32x4 __attribute__((ext_vector_type(4)));
typedef unsigned u32x2 __attribute__((ext_vector_type(2)));
typedef __bf16 bf16x2n __attribute__((ext_vector_type(2)));
#define DI __device__ __forceinline__
DI int otid() { int t = threadIdx.x; asm volatile("" : "+v"(t)); return t; }

constexpr int NB = 8, S = 2048, DM = 2048, T = NB * S, DEPTH = 4;
constexpr int NPAD = 6144, INW = 5992, FF = 5632, NGU = 2 * FF;
constexpr int NSEG = 47;
constexpr float QSCALE = 0.08838834764831845f * 1.4426950408889634f;
constexpr float NEG = -1.0e30f;
constexpr float RMS_EPS = 1e-6f;

constexpr size_t AL(size_t x) { return (x + 255) & ~(size_t)255; }
constexpr size_t WS_CTL   = 0;
constexpr size_t CTL_BYTES = 65536;
constexpr size_t WS_COS128 = WS_CTL + CTL_BYTES;
constexpr size_t WS_SIN128 = WS_COS128 + (size_t)S * 64 * 4;
constexpr size_t WS_COS64  = WS_SIN128 + (size_t)S * 64 * 4;
constexpr size_t WS_SIN64  = WS_COS64 + (size_t)S * 32 * 4;
constexpr size_t WS_WIN   = WS_SIN64 + (size_t)S * 32 * 4;
constexpr size_t WS_WOUT  = WS_WIN + (size_t)NPAD * DM * 2;
constexpr size_t WS_WGU   = WS_WOUT + (size_t)DM * DM * 2;
constexpr size_t WS_WDN   = WS_WGU + (size_t)NGU * DM * 2;
constexpr size_t WS_CW1K  = WS_WDN + (size_t)DM * FF * 2;
constexpr size_t WS_CW1V  = WS_CW1K + (size_t)256 * 4096 * 2;
constexpr size_t WS_CW2K  = WS_CW1V + (size_t)256 * 4096 * 2;
constexpr size_t WS_CW2V  = WS_CW2K + (size_t)128 * 256 * 2;
constexpr size_t WS_CB1   = WS_CW2V + (size_t)128 * 256 * 2;
constexpr size_t WS_H     = AL(WS_CB1 + 2 * 256 * 4);
constexpr size_t WS_MIX   = WS_H + (size_t)T * DM * 2;
constexpr size_t WS_BIG   = WS_MIX + (size_t)T * DM * 2;
constexpr size_t WS_P     = WS_BIG;
constexpr size_t WS_SC    = WS_BIG;
constexpr size_t WS_HID   = WS_BIG;
constexpr size_t WS_PREP  = WS_BIG + (size_t)T * NPAD * 2;
constexpr size_t WS_Y     = WS_PREP;
constexpr size_t SZ_H4 = (size_t)T * 512 * 2, SZ_H1 = (size_t)T * 128 * 2, SZ_H8 = (size_t)T * 1024 * 2, SZ_H2 = (size_t)T * 256 * 2;
constexpr size_t WS_AQ   = WS_PREP;
constexpr size_t WS_AK   = WS_AQ + SZ_H4;
constexpr size_t WS_AVT  = WS_AK + SZ_H1;
constexpr size_t WS_IQ   = WS_AVT + SZ_H1;
constexpr size_t WS_IK   = WS_IQ + SZ_H8;
constexpr size_t WS_IW   = WS_IK + (size_t)T * 64 * 2;
constexpr size_t WS_GATE = WS_IW + (size_t)T * 16 * 4;
constexpr size_t WS_BQ   = WS_GATE + (size_t)T * 24 * 4;
constexpr size_t WS_BK1  = WS_BQ + SZ_H4;
constexpr size_t WS_BVT1 = WS_BK1 + SZ_H4;
constexpr size_t WS_BK4  = WS_BK1, WS_BK16 = WS_BK1, WS_BVT4 = WS_BVT1, WS_BVT16 = WS_BVT1;
constexpr size_t WS_CQ   = WS_BVT1 + SZ_H4;
constexpr size_t WS_CQR  = WS_CQ + SZ_H8;
constexpr size_t WS_KC   = WS_CQR + SZ_H8;
constexpr size_t WS_VC   = WS_KC + SZ_H2 + 65536;
constexpr size_t WS_CKS  = WS_VC + SZ_H2 + 65536;
constexpr size_t WS_CVST = WS_CKS + SZ_H2;
constexpr size_t WS_CKW  = WS_CVST + SZ_H2;
constexpr size_t WS_CVWT = WS_CKW + SZ_H2;
constexpr size_t WS_PREP_END = WS_CVWT + SZ_H2;
constexpr size_t WS_BITS = WS_PREP_END;
constexpr size_t WS_OB4  = WS_BITS + (size_t)T * 64 * 4;
constexpr size_t WS_OB16 = WS_OB4 + SZ_H4;
constexpr size_t WS_LSE4 = WS_OB16 + SZ_H4;
constexpr size_t WS_LSE16 = WS_LSE4 + (size_t)T * 4 * 4;
constexpr size_t WS_LSE1 = WS_LSE16 + (size_t)T * 4 * 4;
constexpr size_t WS_OB1  = WS_LSE1 + (size_t)T * 4 * 4;
constexpr size_t WS_OSLC = WS_OB1 + SZ_H4;
constexpr size_t WS_OWIN = WS_OSLC + SZ_H8;
constexpr size_t WS_OC   = WS_OWIN + SZ_H8;
constexpr size_t WS_G1K  = WS_OC + SZ_H8;
constexpr size_t WS_G1V  = WS_G1K + (size_t)2048 * 256 * 2;
constexpr size_t WS_KCC  = WS_G1V + (size_t)2048 * 256 * 2;
constexpr size_t WS_VCT  = WS_KCC + (size_t)16 * 128 * 128 * 2;
constexpr size_t WS_SEL  = WS_VCT + (size_t)16 * 128 * 128 * 2;
constexpr size_t WS_XB   = AL(WS_SEL + (size_t)16 * S * 4);
constexpr size_t WS_END  = AL(WS_XB + (size_t)T * DM * 2);
static_assert(WS_HID + (size_t)T * FF * 2 <= WS_PREP, "hidden must fit inside P");
static_assert(WS_Y + (size_t)T * DM * 2 <= WS_PREP_END, "Y must fit inside the prep region");

constexpr int LDS_BAR_OFF = 131072;
constexpr int LDS_BYTES = 131072 + 256 + 128 * 144;   static_assert(2 * 32 * 272 <= 128 * 144 && 32 * 528 <= 128 * 144, "the in-projection's staging tile shares the region");

DI unsigned pk2(float a, float b) { f32x2 v = {a, b}; bf16x2n r = __builtin_convertvector(v, bf16x2n); return __builtin_bit_cast(unsigned, r); }
DI float bflo(unsigned w) { return __uint_as_float(w << 16); }
DI float bfhi(unsigned w) { return __uint_as_float(w & 0xffff0000u); }
DI float bf2f(bf16_t v) { return __uint_as_float(((unsigned)v) << 16); }
DI float wave_sum(float v) {
#pragma unroll
    for (int o = 1; o < 64; o <<= 1) v += __shfl_xor(v, o);
    return v;
}
DI float fexp2(float x) { return __builtin_amdgcn_exp2f(x); }
DI float frcp(float x) { return __builtin_amdgcn_rcpf(x); }
DI void unpack8(const u32x4 w, float (&x)[8]) { x[0] = bflo(w.x); x[1] = bfhi(w.x); x[2] = bflo(w.y); x[3] = bfhi(w.y); x[4] = bflo(w.z); x[5] = bfhi(w.z); x[6] = bflo(w.w); x[7] = bfhi(w.w); }
DI u32x4 pack8(const float (&x)[8]) { u32x4 w; w.x = pk2(x[0], x[1]); w.y = pk2(x[2], x[3]); w.z = pk2(x[4], x[5]); w.w = pk2(x[6], x[7]); return w; }
#define MFMA16(a, b, c) __builtin_amdgcn_mfma_f32_16x16x32_bf16((a), (b), (c), 0, 0, 0)
DI unsigned pk4_i8(float a, float b, float c, float d) {
    const float M = 12582912.0f;
    const unsigned ua = __float_as_uint(__builtin_amdgcn_fmed3f(a, -127.0f, 127.0f) + M), ub = __float_as_uint(__builtin_amdgcn_fmed3f(b, -127.0f, 127.0f) + M),
                   uc = __float_as_uint(__builtin_amdgcn_fmed3f(c, -127.0f, 127.0f) + M), ud = __float_as_uint(__builtin_amdgcn_fmed3f(d, -127.0f, 127.0f) + M);
    return (ua & 0xffu) | ((ub & 0xffu) << 8) | ((uc & 0xffu) << 16) | (ud << 24); }
constexpr size_t CTL_WMAX = 12288;
constexpr float F8_SW = 1024.0f, F8_SH = 16.0f, F8_SHID = 8.0f;
DI unsigned pk4_f8(float a, float b, float c, float d) {
    a = __builtin_amdgcn_fmed3f(a, -448.0f, 448.0f); b = __builtin_amdgcn_fmed3f(b, -448.0f, 448.0f); c = __builtin_amdgcn_fmed3f(c, -448.0f, 448.0f); d = __builtin_amdgcn_fmed3f(d, -448.0f, 448.0f);
    int w = __builtin_amdgcn_cvt_pk_fp8_f32(a, b, 0, false); w = __builtin_amdgcn_cvt_pk_fp8_f32(c, d, w, true); return (unsigned)w; }

struct Ptrs {
    const float* in[16];
    float* out;
    unsigned char* ws;
};
template <class TT> DI TT* wsp(const Ptrs& P, size_t off) { return (TT*)(P.ws + off); }

DI void phase_rope_tables(const Ptrs& P) {
    float* c128 = wsp<float>(P, WS_COS128); float* s128 = wsp<float>(P, WS_SIN128); float* c64 = wsp<float>(P, WS_COS64); float* s64 = wsp<float>(P, WS_SIN64);
    const int gt = blockIdx.x * blockDim.x + otid(), ng = gridDim.x * blockDim.x;
    for (int i = gt; i < S * 64; i += ng) { const int t = i >> 6, k = i & 63; const float inv = exp2f(-(float)k * (13.287712379549449f / 64.0f));
        const double a = (double)t * (double)inv * 0.15915494309189535; const float fr = (float)(a - floor(a));
        c128[i] = __builtin_amdgcn_cosf(fr); s128[i] = __builtin_amdgcn_sinf(fr); }
    for (int i = gt; i < S * 32; i += ng) { const int t = i >> 5, k = i & 31; const float inv = exp2f(-(float)k * (13.287712379549449f / 32.0f));
        const double a = (double)t * (double)inv * 0.15915494309189535; const float fr = (float)(a - floor(a));
        c64[i] = __builtin_amdgcn_cosf(fr); s64[i] = __builtin_amdgcn_sinf(fr); }
}

DI int incol(int pc) {
    const int tile = pc >> 8, q = pc & 255, bj = q >> 7, r = q & 127, wc = r >> 5, p = r & 31;
    if (tile == 23) { if (wc == 0) return 1792 + 32 * bj + p; if (wc == 1) { if (bj == 0) return p < 16 ? 1856 + p : -1; return p < 24 ? 5968 + p : -1; } return -1; }
    const int seg = 2 * tile + (wc >> 1), base = (seg < 14) ? seg * 128 : seg * 128 + 80;
    if (seg >= 6 && seg < 14) return base + 64 * (wc & 1) + 32 * bj + p;
    return base + 64 * bj + 32 * (wc & 1) + p;
}
DI int q_next(unsigned* ctr, unsigned char* lds, int tid) {
    volatile int* slot = (volatile int*)(lds + LDS_BAR_OFF + 64);
    __syncthreads();
    if (tid == 0) *slot = (int)__hip_atomic_fetch_add(ctr, 1u, __ATOMIC_RELAXED, __HIP_MEMORY_SCOPE_AGENT);
    __syncthreads();
    return __builtin_amdgcn_readfirstlane(*slot);
}
struct ConvIt { const float* src; bf16_t* dst; int srcN, K, n0, k0, sc, f8; float wmax; };
DI ConvIt conv_decode(const Ptrs& P, int layer, int it, int tid) {
    const float* w_in = P.in[1] + (size_t)layer * DM * INW; const float* w_out = P.in[2] + (size_t)layer * DM * DM;
    const float* w1k = P.in[4] + (size_t)layer * 4096 * 256; const float* w2k = P.in[5] + (size_t)layer * 256 * 128;
    const float* w1v = P.in[7] + (size_t)layer * 4096 * 256; const float* w2v = P.in[8] + (size_t)layer * 256 * 128;
    const float* wg = P.in[9] + (size_t)layer * DM * FF; const float* wu = P.in[10] + (size_t)layer * DM * FF; const float* wd = P.in[11] + (size_t)layer * FF * DM;
    constexpr int I0 = (NPAD / 64) * (DM / 128), I1 = (DM / 64) * (DM / 128), I2 = (NGU / 64) * (DM / 128), I3 = (DM / 64) * (FF / 128), I4 = 4 * 32, I6 = 2 * 2;
    const int nq = (tid & 15) * 4;
    ConvIt c; c.f8 = 0; c.wmax = 0.f; int r = it;
    if (r < I0) { const int nt = r / (DM / 128), kt = r % (DM / 128); c.src = w_in; c.dst = wsp<bf16_t>(P, WS_WIN); c.srcN = INW; c.K = DM; c.n0 = nt * 64; c.k0 = kt * 128; c.sc = incol(c.n0 + nq); c.f8 = 2;
        c.wmax = __uint_as_float(__builtin_amdgcn_readfirstlane(__hip_atomic_load((unsigned*)(P.ws + WS_CTL) + CTL_WMAX + layer * 64 + 1, __ATOMIC_RELAXED, __HIP_MEMORY_SCOPE_AGENT))); return c; } r -= I0;
    if (r < I4) { const int nt = r / 32, kt = r % 32; c.src = w1k; c.dst = wsp<bf16_t>(P, WS_CW1K); c.srcN = 256; c.K = 4096; c.n0 = nt * 64; c.k0 = kt * 128; c.sc = c.n0 + nq; return c; } r -= I4;
    if (r < I4) { const int nt = r / 32, kt = r % 32; c.src = w1v; c.dst = wsp<bf16_t>(P, WS_CW1V); c.srcN = 256; c.K = 4096; c.n0 = nt * 64; c.k0 = kt * 128; c.sc = c.n0 + nq; return c; } r -= I4;
    if (r < I6) { const int nt = r / 2, kt = r % 2; c.src = w2k; c.dst = wsp<bf16_t>(P, WS_CW2K); c.srcN = 128; c.K = 256; c.n0 = nt * 64; c.k0 = kt * 128; c.sc = c.n0 + nq; return c; } r -= I6;
    if (r < I6) { const int nt = r / 2, kt = r % 2; c.src = w2v; c.dst = wsp<bf16_t>(P, WS_CW2V); c.srcN = 128; c.K = 256; c.n0 = nt * 64; c.k0 = kt * 128; c.sc = c.n0 + nq; return c; } r -= I6;
    if (r < I1) { const int nt = r / (DM / 128), kt = r % (DM / 128); c.src = w_out; c.dst = wsp<bf16_t>(P, WS_WOUT); c.srcN = DM; c.K = DM; c.n0 = nt * 64; c.k0 = kt * 128; c.sc = c.n0 + nq; return c; } r -= I1;
    constexpr int DA = (I1 + I2 + I3) / 4 - I1; static_assert(DA >= 0 && DA <= I3, "late-set split");
    if (r >= DA && r < DA + I2) { r -= DA; const int nt = r / (DM / 128), kt = r % (DM / 128); const int n0 = nt * 64, tl = n0 >> 8, o = n0 & 255;
        c.src = (o < 128) ? wg : wu; c.dst = wsp<bf16_t>(P, WS_WGU); c.srcN = FF; c.K = DM; c.n0 = n0; c.k0 = kt * 128; c.sc = tl * 128 + (o & 127) + nq; c.f8 = 2; c.wmax = __uint_as_float(__builtin_amdgcn_readfirstlane(__hip_atomic_load((unsigned*)(P.ws + WS_CTL) + CTL_WMAX + layer * 64, __ATOMIC_RELAXED, __HIP_MEMORY_SCOPE_AGENT))); return c; }
    if (r >= DA) r -= I2;
    { const int nt = r / (FF / 128), kt = r % (FF / 128); c.src = wd; c.dst = wsp<bf16_t>(P, WS_WDN); c.srcN = DM; c.K = FF; c.n0 = nt * 64; c.k0 = kt * 128; c.sc = c.n0 + nq; c.f8 = 1; return c; }
}
constexpr int CONV_EARLY = (NPAD / 64) * (DM / 128) + 2 * 4 * 32 + 2 * 2 * 2;
constexpr int CONV_NIT = (NPAD / 64) * (DM / 128) + (DM / 64) * (DM / 128) + (NGU / 64) * (DM / 128) + (DM / 64) * (FF / 128) + 2 * 4 * 32 + 2 * 2 * 2;
DI void conv_load(const ConvIt& c, int tid, f32x4 (&v)[4]) {
    const int kr = tid >> 4;
#pragma unroll
    for (int i = 0; i < 4; ++i) v[i] = (c.sc >= 0) ? __builtin_nontemporal_load((const f32x4*)(c.src + (size_t)(c.k0 + kr + 32 * i) * c.srcN + c.sc)) : (f32x4){0.f, 0.f, 0.f, 0.f};
}
DI void conv_store(const ConvIt& c, int tid, const f32x4 (&v)[4], float* tile  ) {
    const int nq = (tid & 15) * 4, kr = tid >> 4;
#pragma unroll
    for (int i = 0; i < 4; ++i)
#pragma unroll
        for (int e = 0; e < 4; ++e) tile[(nq + e) * 129 + kr + 32 * i] = v[i][e];
    __syncthreads();
    const int n2 = tid >> 3, c8 = tid & 7;
#pragma unroll
    for (int j = 0; j < 2; ++j) { float x[8];
#pragma unroll
        for (int e = 0; e < 8; ++e) x[e] = tile[n2 * 129 + 8 * c8 + 64 * j + e];
        if (c.f8 == 2) { const float sw = 127.0f / fmaxf(c.wmax, 1e-30f); u32x2 w; w.x = pk4_i8(x[0] * sw, x[1] * sw, x[2] * sw, x[3] * sw); w.y = pk4_i8(x[4] * sw, x[5] * sw, x[6] * sw, x[7] * sw);
            *(u32x2*)((unsigned char*)c.dst + (size_t)(c.n0 + n2) * c.K + c.k0 + 8 * c8 + 64 * j) = w; }
        else if (c.f8) { u32x2 w; w.x = pk4_f8(x[0] * F8_SW, x[1] * F8_SW, x[2] * F8_SW, x[3] * F8_SW); w.y = pk4_f8(x[4] * F8_SW, x[5] * F8_SW, x[6] * F8_SW, x[7] * F8_SW);
            *(u32x2*)((unsigned char*)c.dst + (size_t)(c.n0 + n2) * c.K + c.k0 + 8 * c8 + 64 * j) = w; }
        else *(u32x4*)(c.dst + (size_t)(c.n0 + n2) * c.K + c.k0 + 8 * c8 + 64 * j) = pack8(x); }
}
DI void conv_range(const Ptrs& P, int layer, unsigned char* lds, int first, int end, int step) {
    const int tid = otid();
    float* tileA = (float*)lds; float* tileB = (float*)lds + 64 * 129;
    int it = first;
    if (it < end) {
        ConvIt ca = conv_decode(P, layer, it, tid), cb = ca; f32x4 va[4], vb[4];
        conv_load(ca, tid, va);
        for (;;) {
            const bool nb = it + step < end; if (nb) { cb = conv_decode(P, layer, it + step, tid); conv_load(cb, tid, vb); }
            conv_store(ca, tid, va, tileA);
            if (!nb) break;
            it += step;
            const bool na = it + step < end; if (na) { ca = conv_decode(P, layer, it + step, tid); conv_load(ca, tid, va); }
            conv_store(cb, tid, vb, tileB);
            if (!na) break;
            it += step;
        }
    }
    __syncthreads();
}
constexpr int CONV_FILL_TILES = 4, CONV_FILL_ITEMS = (CONV_NIT - CONV_EARLY) / CONV_FILL_TILES, CONV_FILL_PER_PHASE = CONV_FILL_ITEMS / 4;
static_assert((CONV_NIT - CONV_EARLY) % (CONV_FILL_TILES * 4) == 0, "filler items must split evenly over the four attention phases");
constexpr int WMAX_ITEMS = 512;
DI void wmax_item(const Ptrs& P, int layer, int it, unsigned char* lds) {
    constexpr int N4 = DM * FF / 4, PER = N4 / WMAX_ITEMS; static_assert(N4 % WMAX_ITEMS == 0 && PER % (512 * 11) == 0, "slice shape");
    const int tid = otid();
    const f32x4* wg = (const f32x4*)(P.in[9] + (size_t)layer * DM * FF) + (size_t)it * PER + tid; const f32x4* wu = (const f32x4*)(P.in[10] + (size_t)layer * DM * FF) + (size_t)it * PER + tid;
    float m = 0.f;
#pragma unroll 1
    for (int h = 0; h < PER / 512; h += 11) { f32x4 a[11], b[11];
#pragma unroll
        for (int j = 0; j < 11; ++j) { a[j] = wg[(h + j) * 512]; b[j] = wu[(h + j) * 512]; }
#pragma unroll
        for (int j = 0; j < 11; ++j) { m = fmaxf(m, fmaxf(fmaxf(fabsf(a[j][0]), fabsf(a[j][1])), fmaxf(fabsf(a[j][2]), fabsf(a[j][3])))); m = fmaxf(m, fmaxf(fmaxf(fabsf(b[j][0]), fabsf(b[j][1])), fmaxf(fabsf(b[j][2]), fabsf(b[j][3])))); } }
    unsigned* slot = (unsigned*)(lds + LDS_BAR_OFF + 128);
    if (tid == 0) *slot = 0u;
    __syncthreads();
    __hip_atomic_fetch_max(slot, __float_as_uint(m), __ATOMIC_RELAXED, __HIP_MEMORY_SCOPE_WORKGROUP);
    __syncthreads();
    if (tid == 0) __hip_atomic_fetch_max((unsigned*)(P.ws + WS_CTL) + CTL_WMAX + layer * 64, *slot, __ATOMIC_RELAXED, __HIP_MEMORY_SCOPE_AGENT);
}
DI void wmax_in_item(const Ptrs& P, int layer, int it, unsigned char* lds) {
    constexpr int N4 = DM * INW / 4, PER = N4 / WMAX_ITEMS; static_assert(N4 % WMAX_ITEMS == 0 && PER <= 12 * 512, "slice shape");
    const int tid = otid();
    const f32x4* w = (const f32x4*)(P.in[1] + (size_t)layer * DM * INW) + (size_t)it * PER;
    float m = 0.f; f32x4 a[12];
#pragma unroll
    for (int j = 0; j < 12; ++j) { int i = tid + 512 * j; i = i < PER ? i : PER - 1; a[j] = w[i]; }
#pragma unroll
    for (int j = 0; j < 12; ++j) m = fmaxf(m, fmaxf(fmaxf(fabsf(a[j][0]), fabsf(a[j][1])), fmaxf(fabsf(a[j][2]), fabsf(a[j][3]))));
    unsigned* slot = (unsigned*)(lds + LDS_BAR_OFF + 128);
    if (tid == 0) *slot = 0u;
    __syncthreads();
    __hip_atomic_fetch_max(slot, __float_as_uint(m), __ATOMIC_RELAXED, __HIP_MEMORY_SCOPE_WORKGROUP);
    __syncthreads();
    if (tid == 0) __hip_atomic_fetch_max((unsigned*)(P.ws + WS_CTL) + CTL_WMAX + layer * 64 + 1, *slot, __ATOMIC_RELAXED, __HIP_MEMORY_SCOPE_AGENT);
    __syncthreads();
}
constexpr int BIAS_ITEMS = 16;
DI void bias1_item(const Ptrs& P, int layer, int j, unsigned char* lds) {
    const int tid = otid(), wid = tid >> 6, lane = tid & 63, kq = lane >> 3, c4 = lane & 7, kv = j >> 3, n0 = (j & 7) * 32;
    const float* pe = P.in[kv ? 6 : 3] + (size_t)layer * 4096; const float* w1 = P.in[kv ? 7 : 4] + (size_t)layer * 4096 * 256 + n0 + 4 * c4;
    f32x4 acc = (f32x4){0.f, 0.f, 0.f, 0.f};
    const int k0 = wid * 512 + kq;
#pragma unroll 8
    for (int i = 0; i < 64; ++i) { const int k = k0 + 8 * i; const f32x4 w = *(const f32x4*)(w1 + (size_t)k * 256); const float p = pe[k]; acc[0] += w[0] * p; acc[1] += w[1] * p; acc[2] += w[2] * p; acc[3] += w[3] * p; }
#pragma unroll
    for (int e = 0; e < 4; ++e) { float v = acc[e]; v += __shfl_xor(v, 8); v += __shfl_xor(v, 16); v += __shfl_xor(v, 32); acc[e] = v; }
    float* part = (float*)lds;
    __syncthreads();
    if (kq == 0) { part[wid * 32 + 4 * c4] = acc[0]; part[wid * 32 + 4 * c4 + 1] = acc[1]; part[wid * 32 + 4 * c4 + 2] = acc[2]; part[wid * 32 + 4 * c4 + 3] = acc[3]; }
    __syncthreads();
    if (tid < 32) { float sacc = 0.f;
#pragma unroll
        for (int w = 0; w < 8; ++w) sacc += part[w * 32 + tid];
        wsp<float>(P, WS_CB1)[kv * 256 + n0 + tid] = sacc; }
    __syncthreads();
}
constexpr int EARLY_ITEMS = CONV_EARLY / CONV_FILL_TILES; static_assert(CONV_EARLY % CONV_FILL_TILES == 0, "early set in filler items");
DI void conv_filler(const Ptrs& P, int layer, unsigned char* lds, unsigned* ctr, int part) {
    const bool nxt = layer + 1 < DEPTH;
    int extra = 0;
    if (part == 0) extra = WMAX_ITEMS; else if (nxt) extra = (part == 1) ? WMAX_ITEMS : (part == 2 ? EARLY_ITEMS / 2 : EARLY_ITEMS - EARLY_ITEMS / 2 + BIAS_ITEMS);
    for (int it = q_next(ctr, lds, otid()); it < CONV_FILL_PER_PHASE + extra; it = q_next(ctr, lds, otid())) {
        const int j = it - CONV_FILL_PER_PHASE;
        if (j >= 0 && part == 0) { wmax_item(P, layer, j, lds); continue; }
        if (j >= 0 && part == 1) { wmax_in_item(P, layer + 1, j, lds); continue; }
        int lyr = layer, t0 = CONV_EARLY + (part * CONV_FILL_PER_PHASE + it) * CONV_FILL_TILES;
        if (j >= 0) { if (part == 3 && j < BIAS_ITEMS) { bias1_item(P, layer + 1, j, lds); continue; }
            const int e = (part == 2) ? j : j - BIAS_ITEMS + EARLY_ITEMS / 2; lyr = layer + 1; t0 = e * CONV_FILL_TILES; }
        conv_range(P, lyr, lds, t0, t0 + CONV_FILL_TILES, 1); }
}
DI void phase_wconv(const Ptrs& P, int layer, unsigned char* lds) {
    const int tid = otid();
    conv_range(P, layer, lds, blockIdx.x, CONV_EARLY, gridDim.x);
    __syncthreads();
    if (blockIdx.x < BIAS_ITEMS) bias1_item(P, layer, blockIdx.x, lds);
}

template <bool XI, bool XO, int H8 = 0  > DI void phase_norm(const void* xin_, void* xout_, const bf16_t* Y, const float* g_post, const float* g_pre, bf16_t* H) {
    const float* xin = (const float*)xin_; float* xout = (float*)xout_; const bf16_t* xinb = (const bf16_t*)xin_; bf16_t* xoutb = (bf16_t*)xout_;
    const int lane = otid() & 63, gw = blockIdx.x * 8 + (otid() >> 6), ngw = gridDim.x * 8;
    for (int row = gw; row < T; row += ngw) {
        float xv[4][8];
#pragma unroll
        for (int j = 0; j < 4; ++j) { const int col = 8 * (lane + 64 * j);
            if (XI) { unpack8(*(const u32x4*)(xinb + (size_t)row * DM + col), xv[j]); }
            else { const f32x4 a = *(const f32x4*)(xin + (size_t)row * DM + col), b = *(const f32x4*)(xin + (size_t)row * DM + col + 4);
                xv[j][0] = a[0]; xv[j][1] = a[1]; xv[j][2] = a[2]; xv[j][3] = a[3]; xv[j][4] = b[0]; xv[j][5] = b[1]; xv[j][6] = b[2]; xv[j][7] = b[3]; } }
        if (Y) {
            float yv[4][8]; float ss = 0.f;
#pragma unroll
            for (int j = 0; j < 4; ++j) { const int col = 8 * (lane + 64 * j); const u32x4 w = *(const u32x4*)(Y + (size_t)row * DM + col); unpack8(w, yv[j]);
#pragma unroll
                for (int e = 0; e < 8; ++e) ss += yv[j][e] * yv[j][e]; }
            const float rstd = rsqrtf(wave_sum(ss) * (1.0f / DM) + RMS_EPS);
#pragma unroll
            for (int j = 0; j < 4; ++j) { const int col = 8 * (lane + 64 * j); const f32x4 ga = *(const f32x4*)(g_post + col), gb = *(const f32x4*)(g_post + col + 4);
#pragma unroll
                for (int e = 0; e < 4; ++e) { xv[j][e] += yv[j][e] * rstd * ga[e]; xv[j][4 + e] += yv[j][4 + e] * rstd * gb[e]; }
                if (XO) { *(u32x4*)(xoutb + (size_t)row * DM + col) = pack8(xv[j]); unpack8(pack8(xv[j]), xv[j]); }
                else { *(f32x4*)(xout + (size_t)row * DM + col) = (f32x4){xv[j][0], xv[j][1], xv[j][2], xv[j][3]};
                    *(f32x4*)(xout + (size_t)row * DM + col + 4) = (f32x4){xv[j][4], xv[j][5], xv[j][6], xv[j][7]}; } }
        }
        if (H) {
            float ss = 0.f;
#pragma unroll
            for (int j = 0; j < 4; ++j)
#pragma unroll
                for (int e = 0; e < 8; ++e) ss += xv[j][e] * xv[j][e];
            const float rstd = rsqrtf(wave_sum(ss) * (1.0f / DM) + RMS_EPS);
            if (H8 == 2) { float am = 0.f;
#pragma unroll
                for (int j = 0; j < 4; ++j) { const int col = 8 * (lane + 64 * j); const f32x4 ga = *(const f32x4*)(g_pre + col), gb = *(const f32x4*)(g_pre + col + 4);
#pragma unroll
                    for (int e = 0; e < 4; ++e) { xv[j][e] *= rstd * ga[e]; xv[j][4 + e] *= rstd * gb[e]; am = fmaxf(am, fmaxf(fabsf(xv[j][e]), fabsf(xv[j][4 + e]))); } }
#pragma unroll
                for (int o = 1; o < 64; o <<= 1) am = fmaxf(am, __shfl_xor(am, o));
                am = fmaxf(am, 1e-30f); const float sa = 127.0f / am;
                if (lane == 0) ((float*)((unsigned char*)H + (size_t)T * DM))[row] = am * (1.0f / 127.0f);
#pragma unroll
                for (int j = 0; j < 4; ++j) { const int col = 8 * (lane + 64 * j); u32x2 w; w.x = pk4_i8(xv[j][0] * sa, xv[j][1] * sa, xv[j][2] * sa, xv[j][3] * sa); w.y = pk4_i8(xv[j][4] * sa, xv[j][5] * sa, xv[j][6] * sa, xv[j][7] * sa);
                    *(u32x2*)((unsigned char*)H + (size_t)row * DM + col) = w; }
            } else
#pragma unroll
            for (int j = 0; j < 4; ++j) { const int col = 8 * (lane + 64 * j); const f32x4 ga = *(const f32x4*)(g_pre + col), gb = *(const f32x4*)(g_pre + col + 4); float hv[8];
#pragma unroll
                for (int e = 0; e < 4; ++e) { hv[e] = xv[j][e] * rstd * ga[e]; hv[4 + e] = xv[j][4 + e] * rstd * gb[e]; }
                if (H8) { u32x2 w; w.x = pk4_f8(hv[0] * F8_SH, hv[1] * F8_SH, hv[2] * F8_SH, hv[3] * F8_SH); w.y = pk4_f8(hv[4] * F8_SH, hv[5] * F8_SH, hv[6] * F8_SH, hv[7] * F8_SH);
                    *(u32x2*)((unsigned char*)H + (size_t)row * DM + col) = w; }
                else *(u32x4*)(H + (size_t)row * DM + col) = pack8(hv); }
        }
    }
}

struct EpiSwiglu {
    static constexpr bool PERM = true, AFTER_DRAIN = false;
    bf16_t* O; int ldc;
    __device__ __forceinline__ void operator()(const pg8::f32x4 (&acc)[2][2][4][2], const pg8::Unit& u, int wr, int wc, int fr, int fq) const {
        const int row0 = u.pm * 256 + wr * 64 + fr, col0 = u.pn * 128 + wc * 32 + 8 * fq;
#pragma unroll
        for (int ai = 0; ai < 2; ++ai)
#pragma unroll
            for (int m = 0; m < 4; ++m) { bf16_t* rowp = O + (size_t)(row0 + ai * 128 + m * 16) * ldc + col0; float h[8];
#pragma unroll
                for (int n = 0; n < 2; ++n)
#pragma unroll
                    for (int i = 0; i < 4; ++i) { const float g = acc[ai][0][m][n][i], up = acc[ai][1][m][n][i]; h[4 * n + i] = g * frcp(1.0f + fexp2(-1.4426950408889634f * g)) * up; }
                *(u32x4*)rowp = pack8(h); }
    }
};

struct EpiSwiglu8 {
    static constexpr bool PERM = true, AFTER_DRAIN = false;
    unsigned char* O; int ldc;
    __device__ __forceinline__ void operator()(const pg8::f32x4 (&acc)[2][2][4][2], const pg8::Unit& u, int wr, int wc, int fr, int fq) const {
        const int row0 = u.pm * 256 + wr * 64 + fr, col0 = u.pn * 128 + wc * 32 + 8 * fq;
        constexpr float US = 1.0f / (F8_SH * F8_SW);
#pragma unroll
        for (int ai = 0; ai < 2; ++ai)
#pragma unroll
            for (int m = 0; m < 4; ++m) { unsigned char* rowp = O + (size_t)(row0 + ai * 128 + m * 16) * ldc + col0; float h[8];
#pragma unroll
                for (int n = 0; n < 2; ++n)
#pragma unroll
                    for (int i = 0; i < 4; ++i) { const float g = acc[ai][0][m][n][i] * US, up = acc[ai][1][m][n][i] * (US * F8_SHID); h[4 * n + i] = g * frcp(1.0f + fexp2(-1.4426950408889634f * g)) * up; }
                u32x2 w; w.x = pk4_f8(h[0], h[1], h[2], h[3]); w.y = pk4_f8(h[4], h[5], h[6], h[7]);
                *(u32x2*)rowp = w; }
    }
};
struct EpiSwigluI8 {
    static constexpr bool PERM = true, AFTER_DRAIN = false, STAGED = true;
    static constexpr int PITCH = 144;
    unsigned char* O; int ldc; const float* rs; float ws;
    __device__ __forceinline__ void staged(const pg8::f32x4 (&acc)[2][2][4][2], const pg8::Unit& u, int wr, int wc, int fr, int fq, PG8_LAS unsigned char* ep, int wid, int lane) const {
        const int row0 = u.pm * 256 + wr * 64 + fr;
        float scv[8];
#pragma unroll
        for (int i = 0; i < 8; ++i) scv[i] = rs[row0 + (i >> 2) * 128 + (i & 3) * 16] * ws;
#pragma unroll
        for (int ai = 0; ai < 2; ++ai) {
#pragma unroll
            for (int m = 0; m < 4; ++m) { float h[8]; const float sc = scv[ai * 4 + m];
#pragma unroll
                for (int n = 0; n < 2; ++n)
#pragma unroll
                    for (int i = 0; i < 4; ++i) { const float g = (float)__float_as_int(acc[ai][0][m][n][i]) * sc, up = (float)__float_as_int(acc[ai][1][m][n][i]) * (sc * F8_SHID); h[4 * n + i] = g * frcp(1.0f + fexp2(-1.4426950408889634f * g)) * up; }
                u32x2 w; w.x = pk4_f8(h[0], h[1], h[2], h[3]); w.y = pk4_f8(h[4], h[5], h[6], h[7]);
                *(PG8_LAS u32x2*)(ep + (wr * 64 + m * 16 + fr) * PITCH + wc * 32 + 8 * fq) = w; }
            asm volatile("s_waitcnt lgkmcnt(0)" ::: "memory"); __builtin_amdgcn_s_barrier(); asm volatile("" ::: "memory");
            u32x4 v[2];
#pragma unroll
            for (int h2 = 0; h2 < 2; ++h2) v[h2] = *(const PG8_LAS u32x4*)(ep + (wid * 16 + h2 * 8 + (lane >> 3)) * PITCH + (lane & 7) * 16);
            asm volatile("s_waitcnt lgkmcnt(0)" ::: "memory"); __builtin_amdgcn_s_barrier(); asm volatile("" ::: "memory");
#pragma unroll
            for (int h2 = 0; h2 < 2; ++h2) *(u32x4*)(O + (size_t)(u.pm * 256 + ai * 128 + wid * 16 + h2 * 8 + (lane >> 3)) * ldc + u.pn * 128 + (lane & 7) * 16) = v[h2];
        }
    }
    __device__ __forceinline__ void operator()(const pg8::f32x4 (&acc)[2][2][4][2], const pg8::Unit& u, int wr, int wc, int fr, int fq) const {
        const int row0 = u.pm * 256 + wr * 64 + fr, col0 = u.pn * 128 + wc * 32 + 8 * fq;
#pragma unroll
        for (int ai = 0; ai < 2; ++ai)
#pragma unroll
            for (int m = 0; m < 4; ++m) { const int row = row0 + ai * 128 + m * 16; unsigned char* rowp = O + (size_t)row * ldc + col0; float h[8]; const float sc = rs[row] * ws;
#pragma unroll
                for (int n = 0; n < 2; ++n)
#pragma unroll
                    for (int i = 0; i < 4; ++i) { const float g = (float)__float_as_int(acc[ai][0][m][n][i]) * sc, up = (float)__float_as_int(acc[ai][1][m][n][i]) * (sc * F8_SHID); h[4 * n + i] = g * frcp(1.0f + fexp2(-1.4426950408889634f * g)) * up; }
                u32x2 w; w.x = pk4_f8(h[0], h[1], h[2], h[3]); w.y = pk4_f8(h[4], h[5], h[6], h[7]);
                *(u32x2*)rowp = w; }
    }
};
struct EpiRowsBf16 {
    static constexpr bool PERM = true, AFTER_DRAIN = false, STAGED = true;
    static constexpr int RPITCH = 528;
    bf16_t* O; int ldc; float US;
    __device__ __forceinline__ void staged(const pg8::f32x4 (&acc)[2][2][4][2], const pg8::Unit& u, int wr, int wc, int fr_in, int fq_in, PG8_LAS unsigned char* ep, int wid, int lane_in) const {
        int fr = fr_in, fq = fq_in, lane = lane_in; asm volatile("" : "+v"(fr), "+v"(fq), "+v"(lane));
        PG8_LAS unsigned char* wt = ep + (wr * 16 + fr) * RPITCH + (wc * 32 + 8 * fq) * 2;
        const int rrow = wid * 4 + (lane >> 5);
        const PG8_LAS unsigned char* rt = ep + rrow * RPITCH + (lane & 31) * 16;
        bf16_t* obase = O + (size_t)(u.pm * 256 + (rrow >> 4) * 64 + (rrow & 15)) * ldc + u.pn * 256 + (lane & 31) * 8;
#pragma unroll
        for (int idx = 0; idx < 8; ++idx) { const int ai = idx >> 2, m = idx & 3;
#pragma unroll
            for (int bj = 0; bj < 2; ++bj) { const pg8::f32x4 v0 = acc[ai][bj][m][0] * US, v1 = acc[ai][bj][m][1] * US;
                u32x4 w; w.x = pg8::cvt_pk_bf16(v0[0], v0[1]); w.y = pg8::cvt_pk_bf16(v0[2], v0[3]); w.z = pg8::cvt_pk_bf16(v1[0], v1[1]); w.w = pg8::cvt_pk_bf16(v1[2], v1[3]);
                *(PG8_LAS u32x4*)(wt + bj * 256) = w; }
            asm volatile("s_waitcnt lgkmcnt(0)" ::: "memory"); __builtin_amdgcn_s_barrier(); asm volatile("" ::: "memory");
            const u32x4 r0 = *(const PG8_LAS u32x4*)rt, r1 = *(const PG8_LAS u32x4*)(rt + 2 * RPITCH);
            asm volatile("s_waitcnt lgkmcnt(0)" ::: "memory"); __builtin_amdgcn_s_barrier(); asm volatile("" ::: "memory");
            bf16_t* d = obase + (size_t)(ai * 128 + m * 16) * ldc;
            *(u32x4*)d = r0; *(u32x4*)(d + (size_t)2 * ldc) = r1; }
    }
};
struct EpiDown8 {
    static constexpr bool PERM = true, AFTER_DRAIN = false;
    bf16_t* O; int ldc;
    __device__ __forceinline__ void operator()(const pg8::f32x4 (&acc)[2][2][4][2], const pg8::Unit& u, int wr, int wc, int fr, int fq) const {
        const int row0 = u.pm * 256 + wr * 64 + fr, col0 = u.pn * 256 + wc * 32 + 8 * fq;
        constexpr float US = 1.0f / (F8_SHID * F8_SW);
#pragma unroll
        for (int ai = 0; ai < 2; ++ai)
#pragma unroll
            for (int m = 0; m < 4; ++m) { bf16_t* rowp = O + (size_t)(row0 + ai * 128 + m * 16) * ldc + col0;
#pragma unroll
                for (int bj = 0; bj < 2; ++bj) { const pg8::f32x4 v0 = acc[ai][bj][m][0] * US, v1 = acc[ai][bj][m][1] * US;
                    u32x4 w; w.x = pg8::cvt_pk_bf16(v0[0], v0[1]); w.y = pg8::cvt_pk_bf16(v0[2], v0[3]); w.z = pg8::cvt_pk_bf16(v1[0], v1[1]); w.w = pg8::cvt_pk_bf16(v1[2], v1[3]);
                    *(u32x4*)(rowp + bj * 128) = w; } }
    }
};

DI float gelu_tanh(float x) { const float u2 = 2.0f * 0.7978845608028654f * (x + 0.044715f * x * x * x); const float e = fexp2(u2 * 1.4426950408889634f); return x - x * frcp(e + 1.0f); }
struct EpiGelu {
    static constexpr bool PERM = true, AFTER_DRAIN = false;
    bf16_t* O; int ldc; const float* bias;
    __device__ __forceinline__ void operator()(const pg8::f32x4 (&acc)[2][2][4][2], const pg8::Unit& u, int wr, int wc, int fr, int fq) const {
        const int row0 = u.pm * 256 + wr * 64 + fr, col0 = u.pn * 256 + wc * 32 + 8 * fq;
#pragma unroll
        for (int bj = 0; bj < 2; ++bj) { const f32x4 b0 = *(const f32x4*)(bias + col0 + bj * 128), b1 = *(const f32x4*)(bias + col0 + bj * 128 + 4);
#pragma unroll
            for (int ai = 0; ai < 2; ++ai)
#pragma unroll
                for (int m = 0; m < 4; ++m) { float h[8];
#pragma unroll
                    for (int i = 0; i < 4; ++i) { h[i] = gelu_tanh(acc[ai][bj][m][0][i] + b0[i]); h[4 + i] = gelu_tanh(acc[ai][bj][m][1][i] + b1[i]); }
                    *(u32x4*)(O + (size_t)(row0 + ai * 128 + m * 16) * ldc + col0 + bj * 128) = pack8(h); } }
    }
};


struct EpiPrep {
    static constexpr bool PERM = true, AFTER_DRAIN = false, STAGED = true;
    static constexpr int TPITCH = 272, HTILE = 32 * 272;
    unsigned char* ws_; const float* rs; float ws;
    template <class TT> __device__ __forceinline__ TT* wp(size_t off) const { return (TT*)(ws_ + off); }
    __device__ __forceinline__ static void st8(bf16_t* p, const f32x4 a, const f32x4 b) { u32x4 w; w.x = pk2(a[0], a[1]); w.y = pk2(a[2], a[3]); w.z = pk2(b[0], b[1]); w.w = pk2(b[2], b[3]); *(u32x4*)p = w; }
    __device__ __forceinline__ static f32x4 cv(const pg8::f32x4 v, float sc) { f32x4 r; r[0] = (float)__float_as_int(v[0]) * sc; r[1] = (float)__float_as_int(v[1]) * sc; r[2] = (float)__float_as_int(v[2]) * sc; r[3] = (float)__float_as_int(v[3]) * sc; return r; }
    __device__ __forceinline__ static int kind_of(int seg) {
        return (seg >= 6 && seg < 14) ? 2 : ((seg == 5 || (seg >= 22 && seg < 26) || (seg >= 34 && seg < 38) || seg == 40 || seg == 41 || seg == 44 || seg == 45) ? 1 : 0); }
    __device__ __forceinline__ void operator()(const pg8::f32x4 (&acc)[2][2][4][2], const pg8::Unit& u, int wr, int wc, int fr_in, int fq_in) const {
        int fr = fr_in, fq = fq_in; asm volatile("" : "+v"(fr), "+v"(fq));
        const int b = u.pm >> 3, tb = (u.pm & 7) * 256 + wr * 64 + fr;
        const float* rsp = rs + (size_t)b * S + tb; float nsc = rsp[0] * ws;
        if (u.pn == 23) {
            if (wc >= 2) return;
            const int dd = 8 * fq;
#pragma unroll
            for (int idx = 0; idx < 8; ++idx) { const int ai = idx >> 2, m = idx & 3, t = tb + ai * 128 + m * 16, row = b * S + t;
                const float sc = nsc; if (idx < 7) nsc = rsp[((idx + 1) >> 2) * 128 + ((idx + 1) & 3) * 16] * ws;
                const f32x4 a0 = cv(acc[ai][0][m][0], sc), a1 = cv(acc[ai][0][m][1], sc), c0 = cv(acc[ai][1][m][0], sc), c1 = cv(acc[ai][1][m][1], sc);
                if (wc == 0) { const float* cp = wp<float>(WS_COS64) + (size_t)t * 32 + dd; const float* sp = wp<float>(WS_SIN64) + (size_t)t * 32 + dd;
                    const f32x4 cs0 = *(const f32x4*)cp, cs1 = *(const f32x4*)(cp + 4), sn0 = *(const f32x4*)sp, sn1 = *(const f32x4*)(sp + 4);
                    bf16_t* d = wp<bf16_t>(WS_IK) + (size_t)row * 64 + dd; st8(d, a0 * cs0 - c0 * sn0, a1 * cs1 - c1 * sn1); st8(d + 32, c0 * cs0 + a0 * sn0, c1 * cs1 + a1 * sn1); }
                else { if (fq < 2) { float* d = wp<float>(WS_IW) + (size_t)row * 16 + dd; *(f32x4*)d = a0 * 0.03125f; *(f32x4*)(d + 4) = a1 * 0.03125f; }
                    if (fq < 3) { float* d = wp<float>(WS_GATE) + (size_t)row * 24 + dd; f32x4 g0, g1;
#pragma unroll
                        for (int i = 0; i < 4; ++i) { g0[i] = frcp(1.0f + fexp2(-1.4426950408889634f * c0[i])); g1[i] = frcp(1.0f + fexp2(-1.4426950408889634f * c1[i])); }
                        *(f32x4*)d = g0; *(f32x4*)(d + 4) = g1; } }
                __builtin_amdgcn_sched_barrier(0); }
            return;
        }
        const int seg = 2 * u.pn + (wc >> 1), kind = kind_of(seg);
        if (kind == 2) {
            const int head = 4 * (u.pn - 3) + wc, dd = 8 * fq;
#pragma unroll
            for (int idx = 0; idx < 8; ++idx) { const int ai = idx >> 2, m = idx & 3, t = tb + ai * 128 + m * 16;
                const float sc = nsc; if (idx < 7) nsc = rsp[((idx + 1) >> 2) * 128 + ((idx + 1) & 3) * 16] * ws;
                const f32x4 a0 = cv(acc[ai][0][m][0], sc), a1 = cv(acc[ai][0][m][1], sc), c0 = cv(acc[ai][1][m][0], sc), c1 = cv(acc[ai][1][m][1], sc);
                const float* cp = wp<float>(WS_COS64) + (size_t)t * 32 + dd; const float* sp = wp<float>(WS_SIN64) + (size_t)t * 32 + dd;
                const f32x4 cs0 = *(const f32x4*)cp, cs1 = *(const f32x4*)(cp + 4), sn0 = *(const f32x4*)sp, sn1 = *(const f32x4*)(sp + 4);
                bf16_t* d = wp<bf16_t>(WS_IQ) + (((size_t)b * 16 + head) * S + t) * 64 + dd; st8(d, a0 * cs0 - c0 * sn0, a1 * cs1 - c1 * sn1); st8(d + 32, c0 * cs0 + a0 * sn0, c1 * cs1 + a1 * sn1);
                __builtin_amdgcn_sched_barrier(0); }
            return;
        }
        const int d0 = 32 * (wc & 1) + 8 * fq;
        size_t dst = 0; int nh = 1, hd = 0;
        if (seg < 4) { dst = WS_AQ; nh = 4; hd = seg; } else if (seg == 4) { dst = WS_AK; } else if (seg == 5) { dst = WS_AVT; }
        else if (seg < 18) { dst = WS_BQ; nh = 4; hd = seg - 14; } else if (seg < 22) { dst = WS_BK1; nh = 4; hd = seg - 18; } else if (seg < 26) { dst = WS_BVT1; nh = 4; hd = seg - 22; }
        else if (seg < 34) { dst = WS_CQR; nh = 8; hd = seg - 26; } else if (seg < 36) { dst = WS_KC; nh = 2; hd = seg - 34; } else if (seg < 38) { dst = WS_VC; nh = 2; hd = seg - 36; }
        else if (seg < 40) { dst = WS_CKS; nh = 2; hd = seg - 38; } else if (seg < 42) { dst = WS_CVST; nh = 2; hd = seg - 40; } else if (seg < 44) { dst = WS_CKW; nh = 2; hd = seg - 42; } else { dst = WS_CVWT; nh = 2; hd = seg - 44; }
        bf16_t* dbase = wp<bf16_t>(dst) + ((size_t)(b * nh + hd) * S) * 128 + d0;
        const bool cq = (seg >= 26 && seg < 34);
        bf16_t* qbase = wp<bf16_t>(WS_CQ) + ((size_t)(b * 8 + (seg - 26)) * S) * 128 + d0;
        const float* cb = wp<float>(WS_COS128) + d0; const float* sb = wp<float>(WS_SIN128) + d0;
        f32x4 ncs0 = *(const f32x4*)(cb + (size_t)tb * 64), ncs1 = *(const f32x4*)(cb + (size_t)tb * 64 + 4), nsn0 = *(const f32x4*)(sb + (size_t)tb * 64), nsn1 = *(const f32x4*)(sb + (size_t)tb * 64 + 4);
#pragma unroll
        for (int idx = 0; idx < 8; ++idx) { const int ai = idx >> 2, m = idx & 3, t = tb + ai * 128 + m * 16;
            const float sc = nsc; if (idx < 7) nsc = rsp[((idx + 1) >> 2) * 128 + ((idx + 1) & 3) * 16] * ws;
            const f32x4 a0 = cv(acc[ai][0][m][0], sc), a1 = cv(acc[ai][0][m][1], sc), c0 = cv(acc[ai][1][m][0], sc), c1 = cv(acc[ai][1][m][1], sc);
            bf16_t* d = dbase + (size_t)t * 128;
            const f32x4 cs0 = ncs0, cs1 = ncs1, sn0 = nsn0, sn1 = nsn1;
            if (idx < 7) { const size_t tn = (size_t)(tb + ((idx + 1) >> 2) * 128 + ((idx + 1) & 3) * 16) * 64;
                ncs0 = *(const f32x4*)(cb + tn); ncs1 = *(const f32x4*)(cb + tn + 4); nsn0 = *(const f32x4*)(sb + tn); nsn1 = *(const f32x4*)(sb + tn + 4); }
            if (kind == 0) {
                st8(d, a0 * cs0 - c0 * sn0, a1 * cs1 - c1 * sn1); st8(d + 64, c0 * cs0 + a0 * sn0, c1 * cs1 + a1 * sn1);
                if (cq) { bf16_t* q = qbase + (size_t)t * 128; st8(q, a0 * QSCALE, a1 * QSCALE); st8(q + 64, c0 * QSCALE, c1 * QSCALE); } }
            else { st8(d, a0, a1); st8(d + 64, c0, c1); }
            __builtin_amdgcn_sched_barrier(0); }
    }
    __device__ __forceinline__ static void seg_dst(int seg, size_t& dst, int& nh, int& hd) {
        dst = 0; nh = 1; hd = 0;
        if (seg < 4) { dst = WS_AQ; nh = 4; hd = seg; } else if (seg == 4) { dst = WS_AK; } else if (seg == 5) { dst = WS_AVT; }
        else if (seg < 18) { dst = WS_BQ; nh = 4; hd = seg - 14; } else if (seg < 22) { dst = WS_BK1; nh = 4; hd = seg - 18; } else if (seg < 26) { dst = WS_BVT1; nh = 4; hd = seg - 22; }
        else if (seg < 34) { dst = WS_CQR; nh = 8; hd = seg - 26; } else if (seg < 36) { dst = WS_KC; nh = 2; hd = seg - 34; } else if (seg < 38) { dst = WS_VC; nh = 2; hd = seg - 36; }
        else if (seg < 40) { dst = WS_CKS; nh = 2; hd = seg - 38; } else if (seg < 42) { dst = WS_CVST; nh = 2; hd = seg - 40; } else if (seg < 44) { dst = WS_CKW; nh = 2; hd = seg - 42; } else { dst = WS_CVWT; nh = 2; hd = seg - 44; }
    }
    __device__ __forceinline__ void staged(const pg8::f32x4 (&acc)[2][2][4][2], const pg8::Unit& u, int wr, int wc, int fr_in, int fq_in, PG8_LAS unsigned char* ep, int wid, int lane_in) const {
        if (u.pn == 23 || (u.pn >= 3 && u.pn <= 6)) { (*this)(acc, u, wr, wc, fr_in, fq_in); return; }
        int fr = fr_in, fq = fq_in, lane = lane_in; asm volatile("" : "+v"(fr), "+v"(fq), "+v"(lane));
        const int b = u.pm >> 3, tb = (u.pm & 7) * 256 + wr * 64 + fr;
        const float* rsp = rs + (size_t)b * S + tb; float nsc = rsp[0] * ws;
        const int seg = 2 * u.pn + (wc >> 1), kind = kind_of(seg), d0 = 32 * (wc & 1) + 8 * fq;
        size_t dstR; int nhR, hdR; seg_dst(2 * u.pn + (wid >> 2), dstR, nhR, hdR);
        bf16_t* dbaseR = wp<bf16_t>(dstR) + ((size_t)(b * nhR + hdR) * S) * 128 + (lane & 15) * 8;
        const bool cq = (seg >= 26 && seg < 34);
        bf16_t* qbase = wp<bf16_t>(WS_CQ) + ((size_t)(b * 8 + (seg - 26)) * S) * 128 + d0;
        const float* cb = wp<float>(WS_COS128) + d0; const float* sb = wp<float>(WS_SIN128) + d0;
        f32x4 ncs0 = *(const f32x4*)(cb + (size_t)tb * 64), ncs1 = *(const f32x4*)(cb + (size_t)tb * 64 + 4), nsn0 = *(const f32x4*)(sb + (size_t)tb * 64), nsn1 = *(const f32x4*)(sb + (size_t)tb * 64 + 4);
        PG8_LAS unsigned char* wt = ep + (wc >> 1) * HTILE + (wr * 16 + fr) * TPITCH + d0 * 2;
        const PG8_LAS unsigned char* rt = ep + (wid >> 2) * HTILE + ((wid & 3) * 8 + (lane >> 4)) * TPITCH + (lane & 15) * 16;
        const int rrow = (wid & 3) * 8 + (lane >> 4), tR0 = (u.pm & 7) * 256 + (rrow >> 4) * 64 + (rrow & 15);
#pragma unroll
        for (int idx = 0; idx < 8; ++idx) { const int ai = idx >> 2, m = idx & 3, t = tb + ai * 128 + m * 16;
            const float sc = nsc; if (idx < 7) nsc = rsp[((idx + 1) >> 2) * 128 + ((idx + 1) & 3) * 16] * ws;
            const f32x4 a0 = cv(acc[ai][0][m][0], sc), a1 = cv(acc[ai][0][m][1], sc), c0 = cv(acc[ai][1][m][0], sc), c1 = cv(acc[ai][1][m][1], sc);
            const f32x4 cs0 = ncs0, cs1 = ncs1, sn0 = nsn0, sn1 = nsn1;
            if (idx < 7) { const size_t tn = (size_t)(tb + ((idx + 1) >> 2) * 128 + ((idx + 1) & 3) * 16) * 64;
                ncs0 = *(const f32x4*)(cb + tn); ncs1 = *(const f32x4*)(cb + tn + 4); nsn0 = *(const f32x4*)(sb + tn); nsn1 = *(const f32x4*)(sb + tn + 4); }
            f32x4 x0, x1, y0, y1;
            if (kind == 0) { x0 = a0 * cs0 - c0 * sn0; x1 = a1 * cs1 - c1 * sn1; y0 = c0 * cs0 + a0 * sn0; y1 = c1 * cs1 + a1 * sn1;
                if (cq) { bf16_t* q = qbase + (size_t)t * 128; st8(q, a0 * QSCALE, a1 * QSCALE); st8(q + 64, c0 * QSCALE, c1 * QSCALE); } }
            else { x0 = a0; x1 = a1; y0 = c0; y1 = c1; }
            u32x4 w1, w2; w1.x = pk2(x0[0], x0[1]); w1.y = pk2(x0[2], x0[3]); w1.z = pk2(x1[0], x1[1]); w1.w = pk2(x1[2], x1[3]); w2.x = pk2(y0[0], y0[1]); w2.y = pk2(y0[2], y0[3]); w2.z = pk2(y1[0], y1[1]); w2.w = pk2(y1[2], y1[3]);
            *(PG8_LAS u32x4*)wt = w1; *(PG8_LAS u32x4*)(wt + 128) = w2;
            asm volatile("s_waitcnt lgkmcnt(0)" ::: "memory"); __builtin_amdgcn_s_barrier(); asm volatile("" ::: "memory");
            const u32x4 v0 = *(const PG8_LAS u32x4*)rt, v1 = *(const PG8_LAS u32x4*)(rt + 4 * TPITCH);
            asm volatile("s_waitcnt lgkmcnt(0)" ::: "memory"); __builtin_amdgcn_s_barrier(); asm volatile("" ::: "memory");
            bf16_t* dR = dbaseR + (size_t)(tR0 + ai * 128 + m * 16) * 128;
            *(u32x4*)dR = v0; *(u32x4*)(dR + 4 * 128) = v1; }
    }
};

constexpr int TP = 136;
DI void lds_row8(const bf16_t* tile, int tok, int ch, float (&x)[8]) { const u32x4 w = *(const u32x4*)(tile + tok * TP + ch * 8); unpack8(w, x); }
template <int HD> DI void rope_chunk(const bf16_t* tile, int tok, int ch, int hc0, const float* cs, const float* sn, int t, float scale, float (&o)[8]) {
    constexpr int NCH = HD / 8, HALF_CH = NCH / 2;
    const int cc = ch - hc0; float own[8], par[8];
    lds_row8(tile, tok, ch, own); lds_row8(tile, tok, hc0 + (cc ^ HALF_CH), par);
    const int ci = (cc & (HALF_CH - 1)) * 8; const float* cp = cs + (size_t)t * (HD / 2) + ci; const float* sp = sn + (size_t)t * (HD / 2) + ci;
    const f32x4 c0 = *(const f32x4*)cp, c1 = *(const f32x4*)(cp + 4), s0 = *(const f32x4*)sp, s1 = *(const f32x4*)(sp + 4);
    const float sg = (cc < HALF_CH) ? -1.0f : 1.0f;
#pragma unroll
    for (int e = 0; e < 4; ++e) { o[e] = (own[e] * c0[e] + sg * par[e] * s0[e]) * scale; o[4 + e] = (own[4 + e] * c1[e] + sg * par[4 + e] * s1[e]) * scale; }
}
DI void phase_prep(const Ptrs& P, unsigned char* lds) {
    bf16_t* tile = (bf16_t*)lds;
    const bf16_t* Pm = wsp<bf16_t>(P, WS_P);
    const float* c128 = wsp<float>(P, WS_COS128); const float* s128 = wsp<float>(P, WS_SIN128); const float* c64 = wsp<float>(P, WS_COS64); const float* s64 = wsp<float>(P, WS_SIN64);
    const int tid = otid(), tok = tid >> 4, ch = tid & 15;
    for (int it = blockIdx.x; it < (T / 32) * NSEG; it += gridDim.x) {
        const int tl = it / NSEG, seg = it % NSEG, b = tl >> 6, s0 = (tl & 63) * 32, t = s0 + tok; const size_t row = (size_t)b * S + t;
        *(u32x4*)(tile + tok * TP + ch * 8) = *(const u32x4*)(Pm + row * NPAD + seg * 128 + ch * 8);
        __syncthreads();
        float o[8];
        if (seg < 4) { rope_chunk<128>(tile, tok, ch, 0, c128, s128, t, 1.0f, o); *(u32x4*)(wsp<bf16_t>(P, WS_AQ) + (((size_t)b * 4 + seg) * S + t) * 128 + ch * 8) = pack8(o); }
        else if (seg == 4) { rope_chunk<128>(tile, tok, ch, 0, c128, s128, t, 1.0f, o); *(u32x4*)(wsp<bf16_t>(P, WS_AK) + row * 128 + ch * 8) = pack8(o); }
        else if (seg == 5) { *(u32x4*)(wsp<bf16_t>(P, WS_AVT) + row * 128 + ch * 8) = *(const u32x4*)(tile + tok * TP + ch * 8); }
        else if (seg < 14) { const int hc0 = ch & 8, head = 2 * (seg - 6) + (ch >> 3); rope_chunk<64>(tile, tok, ch, hc0, c64, s64, t, 1.0f, o);
            *(u32x4*)(wsp<bf16_t>(P, WS_IQ) + (((size_t)b * 16 + head) * S + t) * 64 + (ch & 7) * 8) = pack8(o); }
        else if (seg < 18) { rope_chunk<128>(tile, tok, ch, 0, c128, s128, t, 1.0f, o); *(u32x4*)(wsp<bf16_t>(P, WS_BQ) + (((size_t)b * 4 + (seg - 14)) * S + t) * 128 + ch * 8) = pack8(o); }
        else if (seg < 22) { rope_chunk<128>(tile, tok, ch, 0, c128, s128, t, 1.0f, o); const u32x4 w = pack8(o); const size_t hb = ((size_t)b * 4 + (seg - 18)) * S;
            *(u32x4*)(wsp<bf16_t>(P, WS_BK1) + (hb + t) * 128 + ch * 8) = w;
            *(u32x4*)(wsp<bf16_t>(P, WS_BK4) + (hb + (t & 3) * 512 + (t >> 2)) * 128 + ch * 8) = w;
            *(u32x4*)(wsp<bf16_t>(P, WS_BK16) + (hb + (t & 15) * 128 + (t >> 4)) * 128 + ch * 8) = w; }
        else if (seg < 26) { const u32x4 w = *(const u32x4*)(tile + tok * TP + ch * 8); const size_t hb = ((size_t)b * 4 + (seg - 22)) * S;
            *(u32x4*)(wsp<bf16_t>(P, WS_BVT1) + (hb + t) * 128 + ch * 8) = w;
            *(u32x4*)(wsp<bf16_t>(P, WS_BVT4) + (hb + (t & 3) * 512 + (t >> 2)) * 128 + ch * 8) = w;
            *(u32x4*)(wsp<bf16_t>(P, WS_BVT16) + (hb + (t & 15) * 128 + (t >> 4)) * 128 + ch * 8) = w; }
        else if (seg < 34) { const size_t hb = (((size_t)b * 8 + (seg - 26)) * S + t) * 128 + ch * 8; float x[8]; lds_row8(tile, tok, ch, x);
#pragma unroll
            for (int e = 0; e < 8; ++e) x[e] *= QSCALE;
            *(u32x4*)(wsp<bf16_t>(P, WS_CQ) + hb) = pack8(x);
            rope_chunk<128>(tile, tok, ch, 0, c128, s128, t, 1.0f, o); *(u32x4*)(wsp<bf16_t>(P, WS_CQR) + hb) = pack8(o); }
        else if (seg < 36) { *(u32x4*)(wsp<bf16_t>(P, WS_KC) + (((size_t)b * 2 + (seg - 34)) * S + t) * 128 + ch * 8) = *(const u32x4*)(tile + tok * TP + ch * 8); }
        else if (seg < 38) { *(u32x4*)(wsp<bf16_t>(P, WS_VC) + (((size_t)b * 2 + (seg - 36)) * S + t) * 128 + ch * 8) = *(const u32x4*)(tile + tok * TP + ch * 8); }
        else if (seg < 40) { rope_chunk<128>(tile, tok, ch, 0, c128, s128, t, 1.0f, o); *(u32x4*)(wsp<bf16_t>(P, WS_CKS) + (((size_t)b * 2 + (seg - 38)) * S + t) * 128 + ch * 8) = pack8(o); }
        else if (seg < 42) { *(u32x4*)(wsp<bf16_t>(P, WS_CVST) + (((size_t)b * 2 + (seg - 40)) * S + t) * 128 + ch * 8) = *(const u32x4*)(tile + tok * TP + ch * 8); }
        else if (seg < 44) { rope_chunk<128>(tile, tok, ch, 0, c128, s128, t, 1.0f, o); *(u32x4*)(wsp<bf16_t>(P, WS_CKW) + (((size_t)b * 2 + (seg - 42)) * S + t) * 128 + ch * 8) = pack8(o); }
        else if (seg < 46) { *(u32x4*)(wsp<bf16_t>(P, WS_CVWT) + (((size_t)b * 2 + (seg - 44)) * S + t) * 128 + ch * 8) = *(const u32x4*)(tile + tok * TP + ch * 8); }
        else {
            if (ch < 8) { rope_chunk<64>(tile, tok, ch, 0, c64, s64, t, 1.0f, o); *(u32x4*)(wsp<bf16_t>(P, WS_IK) + row * 64 + ch * 8) = pack8(o); }
            else if (ch < 10) { float x[8]; lds_row8(tile, tok, ch, x); float* d = wsp<float>(P, WS_IW) + row * 16 + (ch - 8) * 8;
                *(f32x4*)d = (f32x4){x[0], x[1], x[2], x[3]} * 0.03125f; *(f32x4*)(d + 4) = (f32x4){x[4], x[5], x[6], x[7]} * 0.03125f; }
            else if (ch < 13) { float x[8]; lds_row8(tile, tok, ch, x); float* d = wsp<float>(P, WS_GATE) + row * 24 + (ch - 10) * 8;
#pragma unroll
                for (int e = 0; e < 8; ++e) x[e] = frcp(1.0f + fexp2(-1.4426950408889634f * x[e]));
                *(f32x4*)d = (f32x4){x[0], x[1], x[2], x[3]}; *(f32x4*)(d + 4) = (f32x4){x[4], x[5], x[6], x[7]}; }
        }
        __syncthreads();
    }
}

DI void a1_item(const Ptrs& P, int it) {
    const int wid = otid() >> 6, lane = otid() & 63, c = lane & 15, q4 = lane >> 4;
    const int b = it & 7; int rem = it >> 3, qblk = 15, np = 2;
    for (;; --qblk) { np = ((((qblk + 2) >> 1) + 1) >> 1); if (rem < np) break; rem -= np; }
    const int nk = (qblk + 2) >> 1, kb_lo = rem * nk / np, kb_hi = (rem + 1) * nk / np - 1, t0 = qblk * 128 + wid * 16, t = t0 + c;
    const bf16_t* IQ = wsp<bf16_t>(P, WS_IQ); const bf16_t* IK = wsp<bf16_t>(P, WS_IK); const float* IW = wsp<float>(P, WS_IW); float* SC = wsp<float>(P, WS_SC);
    bf16x8 iq[16][2]; float w[16];
#pragma unroll
    for (int h = 0; h < 16; ++h) { const bf16_t* p = IQ + (((size_t)b * 16 + h) * S + t) * 64 + 8 * q4; iq[h][0] = *(const bf16x8*)p; iq[h][1] = *(const bf16x8*)(p + 32); }
#pragma unroll
    for (int h4 = 0; h4 < 4; ++h4) { const f32x4 v = *(const f32x4*)(IW + ((size_t)b * S + t) * 16 + 4 * h4); w[4 * h4] = v[0]; w[4 * h4 + 1] = v[1]; w[4 * h4 + 2] = v[2]; w[4 * h4 + 3] = v[3]; }
    const int k16_lo = kb_lo * 16; int k16_hi = kb_hi * 16 + 15; const int lim = (t0 + 15) >> 4; if (k16_hi > lim) k16_hi = lim;
    const bf16_t* kp = IK + ((size_t)b * S + k16_lo * 16 + c) * 64 + 8 * q4;
    bf16x8 nk0 = *(const bf16x8*)kp, nk1 = *(const bf16x8*)(kp + 32);
    for (int k16 = k16_lo; k16 <= k16_hi; ++k16) {
        const bf16x8 k0 = nk0, k1 = nk1;
        if (k16 < k16_hi) { kp += 16 * 64; nk0 = *(const bf16x8*)kp; nk1 = *(const bf16x8*)(kp + 32); }
        f32x4 acc = (f32x4){0.f, 0.f, 0.f, 0.f};
#pragma unroll
        for (int h = 0; h < 16; ++h) { f32x4 s = (f32x4){0.f, 0.f, 0.f, 0.f}; s = MFMA16(k0, iq[h][0], s); s = MFMA16(k1, iq[h][1], s);
#pragma unroll
            for (int j = 0; j < 4; ++j) acc[j] += w[h] * fmaxf(s[j], 0.f); }
        *(f32x4*)(SC + ((size_t)b * S + t) * S + k16 * 16 + 4 * q4) = acc;
    }
}

DI void a2_load(const Ptrs& P, int row, int lane, unsigned (&raw)[32]) {
    const int t = row & (S - 1); const float* sc = wsp<float>(P, WS_SC) + (size_t)row * S;
#pragma unroll
    for (int i = 0; i < 32; ++i) { const int key = 64 * i + lane; raw[i] = __float_as_uint(sc[(key <= t) ? key : lane]); }
}
DI void a2_select(const Ptrs& P, int row  , int lane, const unsigned (&raw)[32]) {
    const int t = row & (S - 1);
    unsigned long long* bits = wsp<unsigned long long>(P, WS_BITS) + (size_t)row * 32;
    unsigned long long mine = 0ull;
    if (t < 256) {
#pragma unroll
        for (int i = 0; i < 32; ++i) { const unsigned long long m = __ballot(64 * i + lane <= t); if (lane == i) mine = m; }
    } else {
        unsigned u[32];
#pragma unroll
        for (int i = 0; i < 32; ++i) { const int key = 64 * i + lane; const unsigned bts = raw[i]; const unsigned x = (bts & 0x80000000u) ? ~bts : (bts | 0x80000000u); u[i] = (key <= t) ? x : 0u; }
        unsigned prefix = 0u; bool exact = false;
        for (int bit = 31; bit >= 0; --bit) { const unsigned cand = prefix | (1u << bit); int cnt = 0;
#pragma unroll
            for (int i = 0; i < 32; ++i) cnt += __builtin_popcountll(__ballot(u[i] >= cand));
            if (cnt >= 256) prefix = cand;
            if (cnt == 256) { exact = true; break; } }
        int cgt = 0;
        if (exact) prefix -= 1u;
#pragma unroll
        for (int i = 0; i < 32; ++i) cgt += __builtin_popcountll(__ballot(u[i] > prefix));
        const int need = 256 - cgt; int carried = 0; const unsigned long long lt = (lane == 0) ? 0ull : (~0ull >> (64 - lane));
#pragma unroll
        for (int i = 0; i < 32; ++i) { const bool eq = (u[i] == prefix); const unsigned long long meq = __ballot(eq);
            const int rk = carried + __builtin_popcountll(meq & lt); carried += __builtin_popcountll(meq);
            const bool sel = ((u[i] > prefix) || (eq && rk < need)) && (64 * i + lane <= t);
            const unsigned long long m = __ballot(sel); if (lane == i) mine = m; }
    }
    if (lane < 32) bits[lane] = mine;
}
DI void a2_item(const Ptrs& P, int j) {
    const int lane = otid() & 63, wid = otid() >> 6, base = (T - 1) - 32 * j - wid;
    unsigned ra[32], rb[32];
    a2_load(P, base, lane, ra);
    a2_load(P, base - 8, lane, rb);  a2_select(P, base, lane, ra);
    a2_load(P, base - 16, lane, ra); a2_select(P, base - 8, lane, rb);
    a2_load(P, base - 24, lane, rb); a2_select(P, base - 16, lane, ra);
    a2_select(P, base - 24, lane, rb);
}
DI void c1b_item(const Ptrs& P, int it) {
    const int wid = otid() >> 6, lane = otid() & 63, c = lane & 15, q4 = lane >> 4;
    const int kv = it >> 4, rt = (it & 15) * 8 + wid, row = 16 * rt + c, bg = row >> 7, cc = row & 127;
    const bf16_t* A = wsp<bf16_t>(P, kv ? WS_G1V : WS_G1K) + (size_t)row * 256 + 8 * q4;
    const bf16_t* Bt = wsp<bf16_t>(P, kv ? WS_CW2V : WS_CW2K) + (size_t)c * 256 + 8 * q4;
    f32x4 acc[8];
#pragma unroll
    for (int n = 0; n < 8; ++n) acc[n] = (f32x4){0.f, 0.f, 0.f, 0.f};
#pragma unroll
    for (int ks = 0; ks < 8; ++ks) { const bf16x8 a = *(const bf16x8*)(A + 32 * ks);
#pragma unroll
        for (int n = 0; n < 8; ++n) { const bf16x8 bt = *(const bf16x8*)(Bt + (size_t)(16 * n) * 256 + 32 * ks); acc[n] = MFMA16(bt, a, acc[n]); } }
    const bool zr = (cc == 127);
    if (!kv) { bf16_t* dst = wsp<bf16_t>(P, WS_KCC) + ((size_t)bg * 128 + cc) * 128;
#pragma unroll
        for (int n = 0; n < 8; ++n) { u32x2 w; w.x = zr ? 0u : pk2(acc[n][0], acc[n][1]); w.y = zr ? 0u : pk2(acc[n][2], acc[n][3]); *(u32x2*)(dst + 16 * n + 4 * q4) = w; }
    } else { bf16_t* dst = wsp<bf16_t>(P, WS_VCT) + ((size_t)bg * 4 + (cc >> 5)) * 4096 + (cc & 31);
#pragma unroll
        for (int n = 0; n < 8; ++n)
#pragma unroll
            for (int j = 0; j < 4; ++j) dst[(16 * n + 4 * q4 + j) * 32] = zr ? (bf16_t)0 : (bf16_t)(pk2(acc[n][j], 0.f) & 0xffffu);
    }
}

DI void load_q(bf16x8 (&qf)[4], const bf16_t* qrow, int q4) {
#pragma unroll
    for (int ks = 0; ks < 4; ++ks) qf[ks] = *(const bf16x8*)(qrow + 32 * ks + 8 * q4);
}
DI void c2_item(const Ptrs& P, int it, unsigned char* lds) {
    const int wid = otid() >> 6, lane = otid() & 63, c = lane & 15, q4 = lane >> 4, r16 = lane & 15;
    const int bg = it >> 4, b = bg >> 1, g = bg & 1, t0 = (it & 15) * 128 + wid * 16, t = t0 + c, kr0 = 8 * (r16 >> 2) + (r16 & 3);
    constexpr int KP = 136;
    bf16_t* Kl = (bf16_t*)(lds + 32768); bf16_t* Vl = (bf16_t*)(lds + 32768 + 128 * KP * 2);
    { const int tid = otid(); const bf16_t* Kg = wsp<bf16_t>(P, WS_KCC) + (size_t)bg * 128 * 128; const bf16_t* Vg = wsp<bf16_t>(P, WS_VCT) + (size_t)bg * 4 * 4096;
      __syncthreads();
#pragma unroll
      for (int i = 0; i < 4; ++i) { const int e = (tid + 512 * i) * 8, row = e >> 7, col = e & 127; *(u32x4*)(Kl + row * KP + col) = *(const u32x4*)(Kg + e); *(u32x4*)(Vl + e) = *(const u32x4*)(Vg + e); }
      __syncthreads(); }
    const LAS bf16_t* KCC = (const LAS bf16_t*)Kl + kr0 * KP + 8 * q4; const LAS bf16_t* VCT = (const LAS bf16_t*)Vl + r16 * 32 + 8 * q4;
    const float* gates = wsp<float>(P, WS_GATE) + ((size_t)b * S + t) * 24;
    const int cmax = (t >= 31) ? ((t - 31) >> 4) : -1;
    f32x4 ia[4][2];
#pragma unroll
    for (int kt = 0; kt < 4; ++kt) { ia[kt][0] = (f32x4){0.f, 0.f, 0.f, 0.f}; ia[kt][1] = (f32x4){0.f, 0.f, 0.f, 0.f}; }
    bf16x8 qfa[4][4]; float g0a[4];
#pragma unroll
    for (int rr = 0; rr < 4; ++rr) { load_q(qfa[rr], wsp<bf16_t>(P, WS_CQ) + (((size_t)b * 8 + g * 4 + rr) * S + t) * 128, q4); g0a[rr] = gates[(g * 4 + rr) * 3 + 0]; }
#pragma unroll
    for (int rr = 0; rr < 4; ++rr) {
        const int hh = g * 4 + rr;
        asm volatile("" : "+v"(KCC), "+v"(VCT));
        bf16x8 qf[4];
#pragma unroll
        for (int ks = 0; ks < 4; ++ks) qf[ks] = qfa[rr][ks];
        f32x4 s[4][2]; float mx = NEG;
#pragma unroll
        for (int kt = 0; kt < 4; ++kt)
#pragma unroll
            for (int sub = 0; sub < 2; ++sub) { f32x4 a = (f32x4){0.f, 0.f, 0.f, 0.f};
#pragma unroll
                for (int ks = 0; ks < 4; ++ks) { const bf16x8 kf = *(const LAS bf16x8*)(KCC + (32 * kt + 4 * sub) * KP + 32 * ks); a = MFMA16(kf, qf[ks], a); }
#pragma unroll
                for (int j = 0; j < 4; ++j) { const int cc = 32 * kt + 8 * q4 + 4 * sub + j; const bool ok = (cc <= cmax) && (cc < 127); a[j] = ok ? a[j] : NEG; mx = fmaxf(mx, a[j]); }
                s[kt][sub] = a; __builtin_amdgcn_sched_barrier(0); }
        mx = fmaxf(mx, __shfl_xor(mx, 16)); mx = fmaxf(mx, __shfl_xor(mx, 32));
        float den = 0.f;
#pragma unroll
        for (int kt = 0; kt < 4; ++kt)
#pragma unroll
            for (int sub = 0; sub < 2; ++sub)
#pragma unroll
                for (int j = 0; j < 4; ++j) { const float e = (s[kt][sub][j] > -5.0e29f) ? fexp2(s[kt][sub][j] - mx) : 0.f; s[kt][sub][j] = e; den += e; }
        den += __shfl_xor(den, 16); den += __shfl_xor(den, 32);
        const float inv = den > 0.f ? 1.0f / den : 0.f;
        f32x4 o[8];
#pragma unroll
        for (int db = 0; db < 8; ++db) o[db] = (f32x4){0.f, 0.f, 0.f, 0.f};
#pragma unroll
        for (int kt = 0; kt < 4; ++kt) { float p[8];
#pragma unroll
            for (int sub = 0; sub < 2; ++sub) { s[kt][sub] = s[kt][sub] * inv; ia[kt][sub] += s[kt][sub];
#pragma unroll
                for (int j = 0; j < 4; ++j) p[4 * sub + j] = s[kt][sub][j]; }
            const u32x4 pw = pack8(p); const bf16x8 pb = __builtin_bit_cast(bf16x8, pw);
#pragma unroll
            for (int db = 0; db < 8; ++db) { const bf16x8 vf = *(const LAS bf16x8*)(VCT + kt * 4096 + (16 * db) * 32); o[db] = MFMA16(vf, pb, o[db]); }
            __builtin_amdgcn_sched_barrier(0); }
        const float g0 = g0a[rr]; bf16_t* dst = wsp<bf16_t>(P, WS_OC) + ((size_t)b * S + t) * 1024 + hh * 128;
#pragma unroll
        for (int db = 0; db < 8; ++db) { u32x2 w; w.x = pk2(o[db][0] * g0, o[db][1] * g0); w.y = pk2(o[db][2] * g0, o[db][3] * g0); *(u32x2*)(dst + 16 * db + 4 * q4) = w; }
    }
    float* impw = (float*)lds + wid * (16 * 33);
#pragma unroll
    for (int kt = 0; kt < 4; ++kt) {
        const float own = __shfl(ia[kt][1][3], (lane + 48) & 63);
        const float wrp = (kt > 0) ? __shfl(ia[kt > 0 ? kt - 1 : 0][1][3], (lane + 48) & 63) : 0.f;
        const float prev0 = (q4 == 0) ? wrp : own;
        const float v0 = (ia[kt][0][0] + ia[kt][0][1]) + (ia[kt][0][2] + ia[kt][0][3]) + prev0;
        const float v1 = (ia[kt][1][0] + ia[kt][1][1]) + (ia[kt][1][2] + ia[kt][1][3]) + ia[kt][0][3];
        impw[c * 33 + 8 * kt + 2 * q4] = v0; impw[c * 33 + 8 * kt + 2 * q4 + 1] = v1;
    }
    asm volatile("s_waitcnt lgkmcnt(0)" ::: "memory");
    __builtin_amdgcn_wave_barrier();
    const int cur = t >> 6; unsigned key[32];
#pragma unroll
    for (int n = 0; n < 32; ++n) { const float x = impw[c * 33 + n]; const float v = (n > cur) ? -__builtin_inff() : ((n == 0 || n == cur || n + 1 == cur) ? __builtin_inff() : x);
        const unsigned bts = __float_as_uint(v); const unsigned o = (bts & 0x80000000u) ? ~bts : (bts | 0x80000000u); key[n] = (o & ~31u) | (unsigned)(31 - n); }
    unsigned selbits = 0u;
#pragma unroll
    for (int e = 0; e < 8; ++e) { const int myn = 8 * q4 + e; const float x = impw[c * 33 + myn];
        const float v = (myn > cur) ? -__builtin_inff() : ((myn == 0 || myn == cur || myn + 1 == cur) ? __builtin_inff() : x);
        const unsigned bts = __float_as_uint(v); const unsigned o = (bts & 0x80000000u) ? ~bts : (bts | 0x80000000u); const unsigned km = (o & ~31u) | (unsigned)(31 - myn);
        int rank = 0;
#pragma unroll
        for (int n = 0; n < 32; ++n) rank += (key[n] > km) ? 1 : 0;
        if (rank < 16) selbits |= 1u << myn; }
    selbits |= __shfl_xor(selbits, 16); selbits |= __shfl_xor(selbits, 32);
    if (q4 == 0) wsp<unsigned>(P, WS_SEL)[(size_t)bg * S + t] = selbits;
    __builtin_amdgcn_wave_barrier();
}


enum { FK_B1 = 0, FK_B4 = 1, FK_B16 = 2, FK_C5 = 3, FK_C4 = 4, FK_A3 = 5 };
DI fa::BlockRef fa_ref(const Ptrs& P, int kind, int idx) {
    fa::BlockRef r; r.LSE = nullptr; r.aux = nullptr; r.lstr = 0; r.m = S; r.ecode = 0;
    if (kind <= FK_B16) {
        const int bh = idx & 31, pb = idx >> 5, b = bh >> 2, h = bh & 3; const size_t hb = (size_t)bh * S * 128, tb = (size_t)b * S;
        r.Q = wsp<bf16_t>(P, WS_BQ) + hb;
        r.K = wsp<bf16_t>(P, WS_BK1) + hb; r.V = wsp<bf16_t>(P, WS_BVT1) + hb;
        r.O = wsp<bf16_t>(P, kind == FK_B1 ? WS_OB1 : (kind == FK_B4 ? WS_OB4 : WS_OB16)) + tb * 512 + h * 128; r.ldo = 512;
        r.LSE = wsp<float>(P, kind == FK_B1 ? WS_LSE1 : (kind == FK_B4 ? WS_LSE4 : WS_LSE16)) + tb * 4 + h; r.lstr = 4;
        r.P0 = pb * 256; r.mode = fa::M_WIN; r.Wu = 129; r.m = (kind == FK_B1) ? S : (kind == FK_B4 ? S / 4 : S / 16);
        if (kind == FK_B1) { r.O = wsp<bf16_t>(P, WS_MIX) + tb * DM + 512 + h * 128; r.ldo = DM; r.LSE = nullptr; r.ecode = 3 | (h << 4) | (b << 8); }
    } else if (kind == FK_C5 || kind == FK_C4) {
        const int bhh = idx & 63, qb = 7 - (idx >> 6), b = bhh >> 3, hh = bhh & 7, g = hh >> 2; const size_t gb = ((size_t)b * 2 + g) * S * 128, tb = (size_t)b * S;
        r.Q = wsp<bf16_t>(P, WS_CQR) + (size_t)bhh * S * 128;
        r.K = wsp<bf16_t>(P, kind == FK_C5 ? WS_CKW : WS_CKS) + gb; r.V = wsp<bf16_t>(P, kind == FK_C5 ? WS_CVWT : WS_CVST) + gb;
        r.O = wsp<bf16_t>(P, kind == FK_C5 ? WS_OWIN : WS_OSLC) + tb * 1024 + hh * 128; r.ldo = 1024;
        r.P0 = qb * 256; r.mode = (kind == FK_C5) ? fa::M_WIN : fa::M_SEL; r.Wu = (kind == FK_C5) ? 512 : 0x40000000;
        r.aux = wsp<unsigned>(P, WS_SEL) + ((size_t)b * 2 + g) * S;
        if (kind == FK_C4) { r.O = wsp<bf16_t>(P, WS_MIX) + tb * DM + 1024 + hh * 128; r.ldo = DM; r.ecode = 2 | (hh << 4) | (b << 8); }
    } else {
        const int bh = idx & 31, qb = 7 - (idx >> 5), b = bh >> 2, h = bh & 3; const size_t tb = (size_t)b * S;
        r.Q = wsp<bf16_t>(P, WS_AQ) + (size_t)bh * S * 128; r.K = wsp<bf16_t>(P, WS_AK) + tb * 128; r.V = wsp<bf16_t>(P, WS_AVT) + tb * 128;
        r.O = wsp<bf16_t>(P, WS_MIX) + tb * DM + h * 128; r.ldo = DM;
        r.P0 = qb * 256; r.mode = fa::M_BITS; r.Wu = 0x40000000; r.aux = wsp<unsigned>(P, WS_BITS) + tb * 64;
    }
    return r;
}
struct FaList { int kind[4]; int n[4]; int ng; };
DI fa::BlockRef fa_list_ref(const Ptrs& P, const FaList& L, int i) {
    int g = 0;
#pragma unroll
    for (int k = 0; k < 3; ++k) if (g == k && k + 1 < L.ng && i >= L.n[k]) { i -= L.n[k]; g = k + 1; }
    const int kind = (g == 0) ? L.kind[0] : (g == 1 ? L.kind[1] : (g == 2 ? L.kind[2] : L.kind[3]));
    return fa_ref(P, kind, i);
}
struct FaNext {
    const Ptrs* P; const FaList* L; unsigned* ctr; unsigned char* lds; int total, tid; bool last;
    DI fa::BlockRef operator()(const fa::BlockRef& cur) { const int ni = q_next(ctr, lds, tid); last = ni >= total; return last ? cur : fa_list_ref(*P, *L, ni); }
};
DI void fa_stream(const Ptrs& P, const FaList& L, unsigned* ctr, unsigned char* lds) {
    const int tid = otid();
    int total = 0;
#pragma unroll
    for (int k = 0; k < 4; ++k) if (k < L.ng) total += L.n[k];
    const int i = q_next(ctr, lds, tid);
    if (i >= total) return;
    fa::BlockRef cur = fa_list_ref(P, L, i), nxt = cur;
    fa::Seam Sm;
    fa::prime(cur, (char*)lds, Sm, tid);
    fa::EpiPtrs ep; ep.oc = wsp<bf16_t>(P, WS_OC); ep.owin = wsp<bf16_t>(P, WS_OWIN); ep.gate = wsp<float>(P, WS_GATE); ep.ob4 = wsp<bf16_t>(P, WS_OB4); ep.ob16 = wsp<bf16_t>(P, WS_OB16); ep.lse4 = wsp<float>(P, WS_LSE4); ep.lse16 = wsp<float>(P, WS_LSE16);
    FaNext nf; nf.P = &P; nf.L = &L; nf.ctr = ctr; nf.lds = lds; nf.total = total; nf.tid = tid; nf.last = false;
    for (;;) {
        fa::block(cur, nxt, nf, ep, (char*)lds, Sm, tid);
        if (nf.last) break;
        cur = nxt;
    }
}

DI void phase_merge(const Ptrs& P) {
    const int tid = otid(), lane = tid & 63, gw = blockIdx.x * 8 + (tid >> 6), ngw = gridDim.x * 8;
    for (int row = gw; row < T; row += ngw) {
        bf16_t* dst = wsp<bf16_t>(P, WS_MIX) + (size_t)row * DM;
        {
            const int h = lane >> 4, col = 8 * lane;
            const float l1 = wsp<float>(P, WS_LSE1)[(size_t)row * 4 + h], l4 = wsp<float>(P, WS_LSE4)[(size_t)row * 4 + h], l16 = wsp<float>(P, WS_LSE16)[(size_t)row * 4 + h];
            const float mm = fmaxf(l1, fmaxf(l4, l16)), w1 = fexp2(l1 - mm), w4 = fexp2(l4 - mm), w16 = fexp2(l16 - mm), wi = 1.0f / (w1 + w4 + w16);
            float a[8], b4[8], c16[8], o[8];
            unpack8(*(const u32x4*)(wsp<bf16_t>(P, WS_OB1) + (size_t)row * 512 + col), a); unpack8(*(const u32x4*)(wsp<bf16_t>(P, WS_OB4) + (size_t)row * 512 + col), b4);
            unpack8(*(const u32x4*)(wsp<bf16_t>(P, WS_OB16) + (size_t)row * 512 + col), c16);
#pragma unroll
            for (int e = 0; e < 8; ++e) o[e] = (a[e] * w1 + b4[e] * w4 + c16[e] * w16) * wi;
            *(u32x4*)(dst + 512 + col) = pack8(o);
        }
#pragma unroll
        for (int j = 0; j < 2; ++j) {
            const int col = 8 * (lane + 64 * j), hh = col >> 7;
            const float* gt = wsp<float>(P, WS_GATE) + (size_t)row * 24 + hh * 3; const float g1 = gt[1], g2 = gt[2];
            float a[8], b[8], c[8], o[8];
            unpack8(*(const u32x4*)(wsp<bf16_t>(P, WS_OC) + (size_t)row * 1024 + col), a); unpack8(*(const u32x4*)(wsp<bf16_t>(P, WS_OSLC) + (size_t)row * 1024 + col), b);
            unpack8(*(const u32x4*)(wsp<bf16_t>(P, WS_OWIN) + (size_t)row * 1024 + col), c);
#pragma unroll
            for (int e = 0; e < 8; ++e) o[e] = a[e] + g1 * b[e] + g2 * c[e];
            *(u32x4*)(dst + 1024 + col) = pack8(o);
        }
    }
}

constexpr int NPH = 13;
constexpr int NPHASES = 1 + DEPTH * NPH;
struct Args { const float* in[16]; float* out; unsigned char* ws; int ph_lo, ph_hi; };

__global__ void __launch_bounds__(512, 2) fwd(Args a) {
    extern __shared__ __attribute__((aligned(16))) unsigned char lds[];
    Ptrs P;
#pragma unroll
    for (int i = 0; i < 16; ++i) P.in[i] = a.in[i];
    P.out = a.out; P.ws = a.ws;
    const int lo = a.ph_lo, hi = a.ph_hi;
    volatile LAS unsigned* bst = (volatile LAS unsigned*)((LAS unsigned char*)lds + LDS_BAR_OFF);
    if (otid() < 4) bst[otid()] = 0u;
    __syncthreads();
    XcdBarrier bar; bar.bar = (unsigned*)(P.ws + WS_CTL); bar.x = 0; bar.st = bst;
    if (hi - lo > 1) bar = xcd_barrier_post((unsigned*)(P.ws + WS_CTL), bst);
#define IN(k) (lo <= (k) && (k) < hi)
#define SEAM(k) do { if (IN(k) && IN((k) + 1)) xcd_barrier(bar); } while (0)
    if (IN(0)) { phase_rope_tables(P); for (int it = blockIdx.x; it < WMAX_ITEMS; it += gridDim.x) wmax_in_item(P, 0, it, lds); }
    SEAM(0);
    for (int layer = 0; layer < DEPTH; ++layer) {
        const int pb = 1 + layer * NPH;
        const float* xcur = (layer == 0) ? P.in[0] : P.out;
        if (layer == 0) { if (IN(pb + 0)) { phase_wconv(P, layer, lds); phase_norm<false, false, 2>(P.in[0], nullptr, nullptr, nullptr, P.in[12], wsp<bf16_t>(P, WS_H)); }
            SEAM(pb + 0); }
#if MK_DUP_PH == 100
        phase_wconv(P, layer, lds); xcd_barrier(bar);
#endif
        if (IN(pb + 1)) { pg8::Gemm g{wsp<bf16_t>(P, WS_H), wsp<bf16_t>(P, WS_WIN), T, NPAD, DM / 2}; pg8::StaticOrder So; So.init(T, NPAD, gridDim.x, blockIdx.x);
            const float wmx = __uint_as_float(__builtin_amdgcn_readfirstlane(__hip_atomic_load((unsigned*)(P.ws + WS_CTL) + CTL_WMAX + layer * 64 + 1, __ATOMIC_RELAXED, __HIP_MEMORY_SCOPE_AGENT)));
            EpiPrep E{P.ws, (const float*)(P.ws + WS_H + (size_t)T * DM), fmaxf(wmx, 1e-30f) * (1.0f / 127.0f)}; pg8::gemm_phase<EpiPrep, pg8::StaticOrder, false, 2>((LAS unsigned char*)lds, g, So, E, nullptr); }
        SEAM(pb + 1);
#if MK_DUP_PH == 101
        { pg8::Gemm g{wsp<bf16_t>(P, WS_H), wsp<bf16_t>(P, WS_WIN), T, NPAD, DM}; pg8::StaticOrder So; So.init(T, NPAD, gridDim.x, blockIdx.x);
            EpiPrep E{P.ws}; pg8::gemm_phase<EpiPrep, pg8::StaticOrder, false>((LAS unsigned char*)lds, g, So, E, nullptr); } xcd_barrier(bar);
#endif
#define ATT_BODY \
          \
        if (ATT_IN(3)) { unsigned* ctr = (unsigned*)(P.ws + WS_CTL) + 4096 + (layer * 16 + ATT_CB + 0) * 64; \
            if (ATT_PART(1) && blockIdx.x < 16) { const int kv = blockIdx.x >> 3; pg8::Gemm g{wsp<bf16_t>(P, kv ? WS_VC : WS_KC), wsp<bf16_t>(P, kv ? WS_CW1V : WS_CW1K), 2048, 256, 4096, 2048}; \
                pg8::StaticOrder So; So.init(2048, 256, 8, blockIdx.x & 7); EpiGelu E{wsp<bf16_t>(P, kv ? WS_G1V : WS_G1K), 256, wsp<float>(P, WS_CB1) + kv * 256}; \
                pg8::gemm_phase<EpiGelu, pg8::StaticOrder, false>((LAS unsigned char*)lds, g, So, E, nullptr); } \
            FaList L; L.ng = 2; L.kind[0] = FK_B4; L.n[0] = 256; L.kind[1] = FK_B16; L.n[1] = 256; L.kind[2] = 0; L.n[2] = 0; L.kind[3] = 0; L.n[3] = 0; \
            if (ATT_PART(2)) fa_stream(P, L, ctr, lds); \
            if (ATT_PART(3)) for (int it = q_next(ctr + 64, lds, otid()); it < NB * 40; it = q_next(ctr + 64, lds, otid())) a1_item(P, it); \
            conv_filler(P, layer, lds, (unsigned*)(P.ws + WS_CTL) + 8192 + (layer * 4 + 0) * 64, 0); } \
        ATT_SEAM(3); \
          \
        if (ATT_IN(4)) { unsigned* ctr = (unsigned*)(P.ws + WS_CTL) + 4096 + (layer * 16 + ATT_CB + 2) * 64; \
            FaList L; L.ng = 1; L.kind[0] = FK_B1; L.n[0] = 256; L.kind[1] = 0; L.n[1] = 0; L.kind[2] = 0; L.n[2] = 0; L.kind[3] = 0; L.n[3] = 0; \
            if (ATT_PART(2)) fa_stream(P, L, ctr, lds); \
            if (ATT_PART(3)) for (int it = q_next(ctr + 64, lds, otid()); it < T / 32 + 32; it = q_next(ctr + 64, lds, otid())) { if (it < 32) c1b_item(P, it); else a2_item(P, it - 32); } \
            conv_filler(P, layer, lds, (unsigned*)(P.ws + WS_CTL) + 8192 + (layer * 4 + 1) * 64, 1); } \
        ATT_SEAM(4); \
          \
        if (ATT_IN(5)) { unsigned* ctr = (unsigned*)(P.ws + WS_CTL) + 4096 + (layer * 16 + ATT_CB + 4) * 64; \
            FaList L; L.ng = 2; L.kind[0] = FK_A3; L.n[0] = 256; L.kind[1] = FK_C5; L.n[1] = 512; L.kind[2] = 0; L.n[2] = 0; L.kind[3] = 0; L.n[3] = 0; \
            if (ATT_PART(3)) for (int it = q_next(ctr + 64, lds, otid()); it < 256; it = q_next(ctr + 64, lds, otid())) c2_item(P, it, lds);     \
            if (ATT_PART(2)) fa_stream(P, L, ctr, lds); \
            conv_filler(P, layer, lds, (unsigned*)(P.ws + WS_CTL) + 8192 + (layer * 4 + 2) * 64, 2); } \
        ATT_SEAM(5); \
          \
        if (ATT_IN(6)) { unsigned* ctr = (unsigned*)(P.ws + WS_CTL) + 4096 + (layer * 16 + ATT_CB + 6) * 64; \
            FaList L; L.ng = 1; L.kind[0] = FK_C4; L.n[0] = 512; L.kind[1] = 0; L.n[1] = 0; L.kind[2] = 0; L.n[2] = 0; L.kind[3] = 0; L.n[3] = 0; \
            if (ATT_PART(2)) fa_stream(P, L, ctr, lds); \
            conv_filler(P, layer, lds, (unsigned*)(P.ws + WS_CTL) + 8192 + (layer * 4 + 3) * 64, 3); } \
        ATT_SEAM(6); \
          \

#define ATT_IN(k) IN(pb + (k))
#define ATT_SEAM(k) SEAM(pb + (k))
#define ATT_CB 0
#define ATT_PART(p) true
        ATT_BODY
#undef ATT_IN
#undef ATT_SEAM
#undef ATT_CB
#undef ATT_PART
#if MK_DUP_PH >= 30 && MK_DUP_PH <= 79
#define ATT_IN(k) ((k) == MK_DUP_PH / 10)
#define ATT_SEAM(k) do { if ((k) == MK_DUP_PH / 10) xcd_barrier(bar); } while (0)
#define ATT_CB 8
#define ATT_PART(p) ((p) == MK_DUP_PH % 10)
        ATT_BODY
#undef ATT_IN
#undef ATT_SEAM
#undef ATT_CB
#undef ATT_PART
#endif
#if MK_DUP_PH >= 3 && MK_DUP_PH <= 7
#define ATT_IN(k) ((k) == MK_DUP_PH)
#define ATT_SEAM(k) do { if ((k) == MK_DUP_PH) xcd_barrier(bar); } while (0)
#define ATT_CB 8
#define ATT_PART(p) true
        ATT_BODY
#undef ATT_IN
#undef ATT_SEAM
#undef ATT_CB
#undef ATT_PART
#endif
        if (IN(pb + 8)) { pg8::Gemm g{wsp<bf16_t>(P, WS_MIX), wsp<bf16_t>(P, WS_WOUT), T, DM, DM}; pg8::StaticOrder So; So.init(T, DM, gridDim.x, blockIdx.x);
            EpiRowsBf16 E{wsp<bf16_t>(P, WS_Y), DM, 1.0f}; pg8::gemm_phase<EpiRowsBf16, pg8::StaticOrder, false>((LAS unsigned char*)lds, g, So, E, nullptr); }
        SEAM(pb + 8);
#if MK_DUP_PH == 108
        { pg8::Gemm g{wsp<bf16_t>(P, WS_MIX), wsp<bf16_t>(P, WS_WOUT), T, DM, DM}; pg8::StaticOrder So; So.init(T, DM, gridDim.x, blockIdx.x);
            pg8::EpiBf16<0> E{wsp<bf16_t>(P, WS_Y), DM, nullptr, 0, 0}; pg8::gemm_phase<pg8::EpiBf16<0>, pg8::StaticOrder, false>((LAS unsigned char*)lds, g, So, E, nullptr); } xcd_barrier(bar);
#endif
        if (IN(pb + 9)) { if (layer == 0) phase_norm<false, true, 2>(P.in[0], wsp<bf16_t>(P, WS_XB), wsp<bf16_t>(P, WS_Y), P.in[13] + (size_t)layer * DM, P.in[14] + (size_t)layer * DM, wsp<bf16_t>(P, WS_H));
            else phase_norm<true, true, 2>(wsp<bf16_t>(P, WS_XB), wsp<bf16_t>(P, WS_XB), wsp<bf16_t>(P, WS_Y), P.in[13] + (size_t)layer * DM, P.in[14] + (size_t)layer * DM, wsp<bf16_t>(P, WS_H)); }
        SEAM(pb + 9);
#if MK_DUP_PH == 109
        phase_norm<true, true>(wsp<bf16_t>(P, WS_XB), wsp<bf16_t>(P, WS_BIG), wsp<bf16_t>(P, WS_Y), P.in[13] + (size_t)layer * DM, P.in[14] + (size_t)layer * DM, wsp<bf16_t>(P, WS_MIX)); xcd_barrier(bar);
#endif
        if (IN(pb + 10)) { pg8::Gemm g{wsp<bf16_t>(P, WS_H), wsp<bf16_t>(P, WS_WGU), T, NGU, DM / 2}; pg8::StaticOrder So; So.init(T, NGU, gridDim.x, blockIdx.x);
            const float wmx = __uint_as_float(__builtin_amdgcn_readfirstlane(__hip_atomic_load((unsigned*)(P.ws + WS_CTL) + CTL_WMAX + layer * 64, __ATOMIC_RELAXED, __HIP_MEMORY_SCOPE_AGENT)));
            EpiSwigluI8 E{wsp<unsigned char>(P, WS_HID), FF, (const float*)(P.ws + WS_H + (size_t)T * DM), fmaxf(wmx, 1e-30f) * (1.0f / 127.0f)}; pg8::gemm_phase<EpiSwigluI8, pg8::StaticOrder, false, 2>((LAS unsigned char*)lds, g, So, E, nullptr); }
        SEAM(pb + 10);
#if MK_DUP_PH == 110
        { pg8::Gemm g{wsp<bf16_t>(P, WS_H), wsp<bf16_t>(P, WS_WGU), T, NGU, DM}; pg8::StaticOrder So; So.init(T, NGU, gridDim.x, blockIdx.x);
            EpiSwiglu E{wsp<bf16_t>(P, WS_HID), FF}; pg8::gemm_phase<EpiSwiglu, pg8::StaticOrder, false>((LAS unsigned char*)lds, g, So, E, nullptr); } xcd_barrier(bar);
#endif
        if (IN(pb + 11)) { pg8::Gemm g{wsp<bf16_t>(P, WS_HID), wsp<bf16_t>(P, WS_WDN), T, DM, FF / 2}; pg8::StaticOrder So; So.init(T, DM, gridDim.x, blockIdx.x);
            EpiRowsBf16 E{wsp<bf16_t>(P, WS_Y), DM, 1.0f / (F8_SHID * F8_SW)}; pg8::gemm_phase<EpiRowsBf16, pg8::StaticOrder, false, 1>((LAS unsigned char*)lds, g, So, E, nullptr); }
        SEAM(pb + 11);
#if MK_DUP_PH == 111
        { pg8::Gemm g{wsp<bf16_t>(P, WS_HID), wsp<bf16_t>(P, WS_WDN), T, DM, FF}; pg8::StaticOrder So; So.init(T, DM, gridDim.x, blockIdx.x);
            pg8::EpiBf16<0> E{wsp<bf16_t>(P, WS_Y), DM, nullptr, 0, 0}; pg8::gemm_phase<pg8::EpiBf16<0>, pg8::StaticOrder, false>((LAS unsigned char*)lds, g, So, E, nullptr); } xcd_barrier(bar);
#endif
        if (IN(pb + 12)) { if (layer + 1 < DEPTH) phase_norm<true, true, 2>(wsp<bf16_t>(P, WS_XB), wsp<bf16_t>(P, WS_XB), wsp<bf16_t>(P, WS_Y), P.in[15] + (size_t)layer * DM, P.in[12] + (size_t)(layer + 1) * DM, wsp<bf16_t>(P, WS_H));
            else phase_norm<true, false>(wsp<bf16_t>(P, WS_XB), P.out, wsp<bf16_t>(P, WS_Y), P.in[15] + (size_t)layer * DM, nullptr, nullptr); }
        SEAM(pb + 12);
#if MK_DUP_PH == 120
        for (int i = 0; i < 10; ++i) xcd_barrier(bar);
#endif
    }
#undef IN
#undef SEAM
}
}

#ifndef MK_ONE_LAUNCH
#define MK_ONE_LAUNCH 1
#endif
extern "C" void kernel_launch(void* const* d_in, const int* in_sizes, int n_in, void* d_out, int out_size, void* d_ws, size_t ws_size, hipStream_t stream) {
    static int grid = 0;
    if (grid == 0) {
        if (n_in != 16 || out_size != mk::T * mk::DM || ws_size < mk::WS_END) { fprintf(stderr, "kernel_launch: unexpected shapes (n_in %d, out %d, ws %zu < %zu)\n", n_in, out_size, ws_size, (size_t)mk::WS_END); grid = -1; return; }
        int dev = 0, cus = 0, per_cu = 0;
        if (hipGetDevice(&dev) != hipSuccess || hipDeviceGetAttribute(&cus, hipDeviceAttributeMultiprocessorCount, dev) != hipSuccess) { grid = -1; return; }
        if (hipFuncSetAttribute((const void*)mk::fwd, hipFuncAttributeMaxDynamicSharedMemorySize, mk::LDS_BYTES) != hipSuccess) { fprintf(stderr, "kernel_launch: hipFuncSetAttribute failed\n"); grid = -1; return; }
        if (hipOccupancyMaxActiveBlocksPerMultiprocessor(&per_cu, (const void*)mk::fwd, 512, mk::LDS_BYTES) != hipSuccess || per_cu < 1) { fprintf(stderr, "kernel_launch: occupancy query says %d blocks per CU\n", per_cu); }
        (void)hipGetLastError();
        grid = cus;
    }
    if (grid < 0) return;
    (void)in_sizes;
    hipMemsetAsync((char*)d_ws + mk::WS_CTL, 0, mk::CTL_BYTES, stream);
    mk::Args a{};
    for (int i = 0; i < 16; ++i) a.in[i] = (const float*)d_in[i];
    a.out = (float*)d_out; a.ws = (unsigned char*)d_ws;
#if MK_ONE_LAUNCH
    a.ph_lo = 0; a.ph_hi = mk::NPHASES;
    hipLaunchKernelGGL(mk::fwd, dim3(grid), dim3(512), mk::LDS_BYTES, stream, a);
#else
    for (int ph = 0; ph < mk::NPHASES; ++ph) { a.ph_lo = ph; a.ph_hi = ph + 1; hipLaunchKernelGGL(mk::fwd, dim3(grid), dim3(512), mk::LDS_BYTES, stream, a); }
#endif
}
```

```cpp
#include <hip/hip_runtime.h>
#include <cstdio>
#include <cstdint>
namespace pg8 {
#define PG8_LAS __attribute__((address_space(3)))
typedef unsigned short bf16_t;
typedef short bf16x8 __attribute__((ext_vector_type(8)));
typedef float f32x4 __attribute__((ext_vector_type(4)));
typedef unsigned u32x4 __attribute__((ext_vector_type(4)));
typedef int i32x4 __attribute__((ext_vector_type(4)));
typedef int i32x8 __attribute__((ext_vector_type(8)));
constexpr int BM = 256, BK = 64, HALF = 128, HTB = HALF * BK * 2  , STAGE_BYTES = 8 * HTB, NXCD = 8, WGM = 8;

__host__ __device__ __forceinline__ int lds_byte(int r, int c) { const int st = (r >> 4) * 2 + (c >> 5), rr = r & 15, cc = c & 31, ob = rr * 64 + cc * 2; return st * 1024 + (ob ^ (((ob >> 9) & 1) << 5)); }
__host__ __device__ __forceinline__ void stage_rc(int b, int& R, int& C) { const int st = b / 1024, sb = b % 1024, swz = sb ^ (((sb >> 9) & 1) << 5); R = (st >> 1) * 16 + swz / 64; C = (st & 1) * 32 + (swz % 64) / 2; }
__host__ __device__ __forceinline__ int perm32(int rho) { const int n = rho >> 4, i = rho & 15; return 8 * (i >> 2) + 4 * n + (i & 3); }

struct Unit { int pm, pn; };
struct Gemm { const bf16_t* A; const bf16_t* Bt; int M, N, K; int lda; };

struct StaticOrder {
    int nM, nN, nwg, G, c;
    __host__ __device__ void init(int M, int N, int G_, int c_) { nM = M / BM; nN = N / BM; nwg = nM * nN; G = G_; c = c_; }
    __host__ __device__ bool next(int i, Unit& u) const {
        const long L = (long)i * G + c; if (L >= nwg) return false;
        int wgid = (int)L; { const int q = nwg / NXCD, r = nwg % NXCD, xcd = wgid % NXCD, off = wgid / NXCD; wgid = (xcd < r ? xcd * (q + 1) : r * (q + 1) + (xcd - r) * q) + off; }
        const int nig = WGM * nN, gid = wgid / nig, fm = gid * WGM, gsz = (nM - fm) < WGM ? (nM - fm) : WGM;
        u.pm = fm + ((wgid % nig) % gsz); u.pn = (wgid % nig) / gsz; return true;
    }
    __device__ __forceinline__ void a_ready(const Unit&) const {}
    __device__ __forceinline__ void done(const Unit&) const {}
};
struct CountedOrder : StaticOrder {
    const unsigned* ready; unsigned need; unsigned* tmo;
    __device__ __forceinline__ void a_ready(const Unit& u) const {
        if (threadIdx.x < 64) {
            const unsigned long long t0 = __builtin_amdgcn_s_memrealtime(); unsigned polls = 0;
            while ((unsigned)__builtin_amdgcn_readfirstlane(__hip_atomic_load(ready + 64 * u.pm, __ATOMIC_RELAXED, __HIP_MEMORY_SCOPE_AGENT)) < need) {
                if ((++polls & 255u) == 0u && __builtin_amdgcn_readfirstlane(__hip_atomic_load(tmo, __ATOMIC_RELAXED, __HIP_MEMORY_SCOPE_AGENT)) != 0u) break;
                if (__builtin_amdgcn_s_memrealtime() - t0 > 2000000ull) {
                    if (threadIdx.x == 0) { unsigned expect = 0u; __hip_atomic_compare_exchange_strong(tmo + 1, &expect, 0x600u | (unsigned)(u.pm & 0xff), __ATOMIC_RELAXED, __ATOMIC_RELAXED, __HIP_MEMORY_SCOPE_AGENT); __hip_atomic_store(tmo, 1u, __ATOMIC_RELAXED, __HIP_MEMORY_SCOPE_AGENT); }
                    break; }
                __builtin_amdgcn_s_sleep(2); }
            __builtin_amdgcn_fence(__ATOMIC_ACQUIRE, "agent");
            asm volatile("s_waitcnt vmcnt(0)" ::: "memory");
        }
#if !defined(BROKEN_HOOK_NO_BARRIER)
        asm volatile("" ::: "memory"); __builtin_amdgcn_s_barrier(); asm volatile("" ::: "memory");
#endif
    }
};

__device__ __forceinline__ unsigned cvt_pk_bf16(float lo, float hi) { unsigned r; asm volatile("v_cvt_pk_bf16_f32 %0, %1, %2" : "=v"(r) : "v"(lo), "v"(hi)); return r; }
typedef float f32x2 __attribute__((ext_vector_type(2)));
__device__ __forceinline__ f32x2 gelu_pk(f32x2 v) {
    const f32x2 av = __builtin_elementwise_abs(v), d = av * 0.2316418882f + 1.0f;
    f32x2 t; t.x = __builtin_amdgcn_rcpf(d.x); t.y = __builtin_amdgcn_rcpf(d.y);
    f32x2 q = t * 0.5307027145f + (-0.7265760135f); q = q * t + 0.7107068705f; q = q * t + (-0.142248368f); q = q * t + 0.127414796f; q = q * t;
    const f32x2 s = (v * v) * (-0.72134752044f);
    f32x2 e; e.x = __builtin_amdgcn_exp2f(s.x); e.y = __builtin_amdgcn_exp2f(s.y);
    const f32x2 m = v * (q * e), r = v - m;
    f32x2 o; o.x = v.x < 0.f ? m.x : r.x; o.y = v.y < 0.f ? m.y : r.y; return o;
}

struct EpiF32 {
    static constexpr bool PERM = false, AFTER_DRAIN = false;
    float* C; int ldc; const float* bias;
    __device__ __forceinline__ void operator()(const f32x4 (&acc)[2][2][4][2], const Unit& u, int wr, int wc, int fr, int fq) const {
        const int row0 = u.pm * BM + wr * 64 + fr, col0 = u.pn * BM + wc * 32 + 4 * fq;
        f32x4 bv[2][2];
#pragma unroll
        for (int bj = 0; bj < 2; ++bj)
#pragma unroll
            for (int n = 0; n < 2; ++n) bv[bj][n] = bias ? *(const f32x4*)(bias + col0 + bj * HALF + n * 16) : (f32x4){0.f, 0.f, 0.f, 0.f};
#pragma unroll
        for (int ai = 0; ai < 2; ++ai)
#pragma unroll
            for (int m = 0; m < 4; ++m) { float* rowp = C + (size_t)(row0 + ai * HALF + m * 16) * ldc + col0;
#pragma unroll
                for (int bj = 0; bj < 2; ++bj)
#pragma unroll
                    for (int n = 0; n < 2; ++n) *(f32x4*)(rowp + bj * HALF + n * 16) = acc[ai][bj][m][n] + bv[bj][n]; }
    }
};
template <int ACT  > struct EpiBf16 {
    static constexpr bool PERM = true, AFTER_DRAIN = false;
    bf16_t* O; int ldc; const float* bias; int split_cols; size_t split_stride;
    __device__ __forceinline__ void operator()(const f32x4 (&acc)[2][2][4][2], const Unit& u, int wr, int wc, int fr, int fq) const {
        const int row0 = u.pm * BM + wr * 64 + fr; int colt = u.pn * BM; bf16_t* base = O;
        if (split_cols) { const int t = colt / split_cols; base += (size_t)t * split_stride; colt -= t * split_cols; }
        const int col0 = colt + wc * 32 + 8 * fq, bcol0 = u.pn * BM + wc * 32 + 8 * fq;
        f32x4 bv[2][2];
#pragma unroll
        for (int bj = 0; bj < 2; ++bj)
#pragma unroll
            for (int n = 0; n < 2; ++n) bv[bj][n] = bias ? *(const f32x4*)(bias + bcol0 + bj * HALF + 4 * n) : (f32x4){0.f, 0.f, 0.f, 0.f};
#pragma unroll
        for (int ai = 0; ai < 2; ++ai)
#pragma unroll
            for (int m = 0; m < 4; ++m) { bf16_t* rowp = base + (size_t)(row0 + ai * HALF + m * 16) * ldc + col0;
#pragma unroll
                for (int bj = 0; bj < 2; ++bj) { f32x4 v0 = acc[ai][bj][m][0] + bv[bj][0], v1 = acc[ai][bj][m][1] + bv[bj][1];
                    if (ACT == 1) { f32x2 a = gelu_pk((f32x2){v0[0], v0[1]}), b = gelu_pk((f32x2){v0[2], v0[3]}), c = gelu_pk((f32x2){v1[0], v1[1]}), d = gelu_pk((f32x2){v1[2], v1[3]});
                        v0 = (f32x4){a.x, a.y, b.x, b.y}; v1 = (f32x4){c.x, c.y, d.x, d.y}; }
                    if (ACT == 2) {
#pragma unroll
                        for (int j = 0; j < 4; ++j) { v0[j] = 0.5f * v0[j] * (1.0f + erff(v0[j] * 0.70710678f)); v1[j] = 0.5f * v1[j] * (1.0f + erff(v1[j] * 0.70710678f)); } }
                    u32x4 w; w.x = cvt_pk_bf16(v0[0], v0[1]); w.y = cvt_pk_bf16(v0[2], v0[3]); w.z = cvt_pk_bf16(v1[0], v1[1]); w.w = cvt_pk_bf16(v1[2], v1[3]);
                    *(u32x4*)(rowp + bj * HALF) = w; } }
    }
};

struct PanelStats {
    unsigned* xbuf;
    unsigned* cnt;
    unsigned* tmo;
    int ntn; float eps;
    unsigned code;
    __device__ __forceinline__ bool run(const f32x4 (&v)[2][2][4][2], const Unit& u, int wr, int wc, int fr, int fq, PG8_LAS unsigned char* lds, int wid, int lane) const {
        typedef float f32x2v __attribute__((ext_vector_type(2)));
        PG8_LAS f32x2v* P = (PG8_LAS f32x2v*)lds;
        PG8_LAS f32x2v* S = (PG8_LAS f32x2v*)(lds + 8192);
        PG8_LAS unsigned* flag = (PG8_LAS unsigned*)(lds + 8192 + 2048);
#pragma unroll
        for (int ai = 0; ai < 2; ++ai)
#pragma unroll
            for (int m = 0; m < 4; ++m) {
                float s = 0.f;
#pragma unroll
                for (int bj = 0; bj < 2; ++bj)
#pragma unroll
                    for (int n = 0; n < 2; ++n) { const f32x4 x = v[ai][bj][m][n]; s += (x[0] + x[1]) + (x[2] + x[3]); }
                s += __shfl_xor(s, 16); s += __shfl_xor(s, 32);
                const float mw = s * (1.0f / 64.0f); float q = 0.f;
#pragma unroll
                for (int bj = 0; bj < 2; ++bj)
#pragma unroll
                    for (int n = 0; n < 2; ++n) { const f32x4 d = v[ai][bj][m][n] - mw; q += (d[0] * d[0] + d[1] * d[1]) + (d[2] * d[2] + d[3] * d[3]); }
                q += __shfl_xor(q, 16); q += __shfl_xor(q, 32);
                if (fq == 0) P[(ai * HALF + wr * 64 + m * 16 + fr) * 4 + wc] = (f32x2v){mw, q};
            }
        asm volatile("s_waitcnt lgkmcnt(0)" ::: "memory"); __builtin_amdgcn_s_barrier(); asm volatile("" ::: "memory");
#if defined(BROKEN_NO_WAIT)
        if (blockIdx.x >= 64) { const long long t0 = clock64(); while (clock64() - t0 < 60000) __builtin_amdgcn_s_sleep(8); }
#endif
        const int row = wid * 32 + (lane & 31);
        if (lane < 32) {
            const f32x2v a = P[row * 4 + 0], b = P[row * 4 + 1], c = P[row * 4 + 2], d = P[row * 4 + 3];
            const float mt = (a.x + b.x + c.x + d.x) * 0.25f;
            const float da = a.x - mt, db = b.x - mt, dc = c.x - mt, dd = d.x - mt;
            const float m2 = (a.y + b.y) + (c.y + d.y) + 64.0f * ((da * da + db * db) + (dc * dc + dd * dd));
            unsigned long long* slot = (unsigned long long*)xbuf + ((size_t)(u.pm * BM + row) * 4 + u.pn);
            __hip_atomic_store(slot, ((unsigned long long)__float_as_uint(m2) << 32) | __float_as_uint(mt), __ATOMIC_RELAXED, __HIP_MEMORY_SCOPE_AGENT);
        }
        asm volatile("s_waitcnt vmcnt(0)" ::: "memory");
        if (lane == 0) __hip_atomic_fetch_add(cnt + 64 * u.pm, 1u, __ATOMIC_RELAXED, __HIP_MEMORY_SCOPE_AGENT);
        if (wid == 0) {
            bool dead = false; const unsigned long long t0 = __builtin_amdgcn_s_memrealtime(); const unsigned want = 8u * (unsigned)ntn;
            for (;;) {
#if defined(BROKEN_NO_WAIT)
                break;
#endif
                if ((unsigned)__builtin_amdgcn_readfirstlane(__hip_atomic_load(cnt + 64 * u.pm, __ATOMIC_RELAXED, __HIP_MEMORY_SCOPE_AGENT)) >= want) break;
                if (__builtin_amdgcn_s_memrealtime() - t0 > 2000000ull) {
                    if (lane == 0) { unsigned expect = 0u; __hip_atomic_compare_exchange_strong(tmo + 1, &expect, code | (unsigned)(u.pm & 0xff), __ATOMIC_RELAXED, __ATOMIC_RELAXED, __HIP_MEMORY_SCOPE_AGENT);
                                     __hip_atomic_store(tmo, 1u, __ATOMIC_RELAXED, __HIP_MEMORY_SCOPE_AGENT); }
                    dead = true; break; }
                __builtin_amdgcn_s_sleep(2);
            }
            __builtin_amdgcn_fence(__ATOMIC_ACQUIRE, "agent");
            if (lane == 0) flag[0] = dead ? 1u : 0u;
        }
        asm volatile("s_waitcnt vmcnt(0) lgkmcnt(0)" ::: "memory"); __builtin_amdgcn_s_barrier(); asm volatile("" ::: "memory");
        const bool bad = flag[0] != 0u;
        if (lane < 32) {
            const unsigned long long* slot = (const unsigned long long*)xbuf + (size_t)(u.pm * BM + row) * 4; float mt[4], m2[4]; float ms = 0.f;
#pragma unroll
            for (int t = 0; t < 4; ++t) { if (t < ntn) { const unsigned long long w = __hip_atomic_load(slot + t, __ATOMIC_RELAXED, __HIP_MEMORY_SCOPE_AGENT); mt[t] = __uint_as_float((unsigned)w); m2[t] = __uint_as_float((unsigned)(w >> 32)); } else { mt[t] = 0.f; m2[t] = 0.f; } ms += mt[t]; }
            const float mean = ms / (float)ntn; float q = 0.f;
#pragma unroll
            for (int t = 0; t < 4; ++t) if (t < ntn) { const float dm = mt[t] - mean; q += m2[t] + 256.0f * dm * dm; }
            S[row] = (f32x2v){mean, 1.0f / sqrtf(q / (256.0f * (float)ntn) + eps)};
        }
        asm volatile("s_waitcnt lgkmcnt(0)" ::: "memory"); __builtin_amdgcn_s_barrier(); asm volatile("" ::: "memory");
        return bad;
    }
};
struct EpiLnRes {
    static constexpr bool PERM = false, AFTER_DRAIN = true;
    const float* base; float* out; int ldc; const float* bias; PanelStats st; unsigned poison;
    __device__ __forceinline__ void refuse(size_t i0, size_t stride, int M, int N) const { const float q = __builtin_nanf(""); for (size_t i = i0; i < (size_t)M * N; i += stride) out[(i / N) * ldc + i % N] = q;
        if (i0 == 0) { unsigned expect = 0u; __hip_atomic_compare_exchange_strong(st.tmo + 1, &expect, 0x7f0u, __ATOMIC_RELAXED, __ATOMIC_RELAXED, __HIP_MEMORY_SCOPE_AGENT); __hip_atomic_store(st.tmo, 1u, __ATOMIC_RELAXED, __HIP_MEMORY_SCOPE_AGENT); } }
    __device__ __forceinline__ void fused(f32x4 (&acc)[2][2][4][2], const Unit& u, int wr, int wc, int fr, int fq, PG8_LAS unsigned char* lds, int wid, int lane) const {
        typedef float f32x2v __attribute__((ext_vector_type(2)));
        const PG8_LAS f32x2v* S = (const PG8_LAS f32x2v*)(lds + 8192);
        const int col0 = u.pn * BM + wc * 32 + 4 * fq;
#pragma unroll
        for (int bj = 0; bj < 2; ++bj)
#pragma unroll
            for (int n = 0; n < 2; ++n) { const f32x4 bv = bias ? *(const f32x4*)(bias + col0 + bj * HALF + n * 16) : (f32x4){0.f, 0.f, 0.f, 0.f};
#pragma unroll
                for (int ai = 0; ai < 2; ++ai)
#pragma unroll
                    for (int m = 0; m < 4; ++m) acc[ai][bj][m][n] += bv; }
        const bool bad = st.run(acc, u, wr, wc, fr, fq, lds, wid, lane) || poison != 0u;
        const float qnan = __builtin_nanf("");
#pragma unroll
        for (int ai = 0; ai < 2; ++ai)
#pragma unroll
            for (int m = 0; m < 4; ++m) { const int r = ai * HALF + wr * 64 + m * 16 + fr; const f32x2v sr = S[r]; const size_t off = (size_t)(u.pm * BM + r) * ldc + col0;
#pragma unroll
                for (int bj = 0; bj < 2; ++bj)
#pragma unroll
                    for (int n = 0; n < 2; ++n) { const f32x4 bs = *(const f32x4*)(base + off + bj * HALF + n * 16); f32x4 o = bs + (acc[ai][bj][m][n] - sr.x) * sr.y;
                        if (bad) o = (f32x4){qnan, qnan, qnan, qnan}; *(f32x4*)(out + off + bj * HALF + n * 16) = o; }
                asm volatile("" ::: "memory"); }
    }
};
struct EpiLnResLn {
    static constexpr bool PERM = false, AFTER_DRAIN = true;
    const float* base; float* out; bf16_t* xn; int ldc; const float* bias; PanelStats st1, st2; unsigned poison;
    __device__ __forceinline__ void refuse(size_t i0, size_t stride, int M, int N) const { const float q = __builtin_nanf(""); for (size_t i = i0; i < (size_t)M * N; i += stride) { const size_t o = (i / N) * ldc + i % N; out[o] = q; xn[o] = (bf16_t)0x7fc0u; }
        if (i0 == 0) { unsigned expect = 0u; __hip_atomic_compare_exchange_strong(st1.tmo + 1, &expect, 0x7f0u, __ATOMIC_RELAXED, __ATOMIC_RELAXED, __HIP_MEMORY_SCOPE_AGENT); __hip_atomic_store(st1.tmo, 1u, __ATOMIC_RELAXED, __HIP_MEMORY_SCOPE_AGENT); } }
    __device__ __forceinline__ void fused(f32x4 (&acc)[2][2][4][2], const Unit& u, int wr, int wc, int fr, int fq, PG8_LAS unsigned char* lds, int wid, int lane) const {
        typedef float f32x2v __attribute__((ext_vector_type(2))); typedef unsigned u32x2v __attribute__((ext_vector_type(2)));
        const PG8_LAS f32x2v* S = (const PG8_LAS f32x2v*)(lds + 8192);
        const int col0 = u.pn * BM + wc * 32 + 4 * fq;
#pragma unroll
        for (int bj = 0; bj < 2; ++bj)
#pragma unroll
            for (int n = 0; n < 2; ++n) { const f32x4 bv = bias ? *(const f32x4*)(bias + col0 + bj * HALF + n * 16) : (f32x4){0.f, 0.f, 0.f, 0.f};
#pragma unroll
                for (int ai = 0; ai < 2; ++ai)
#pragma unroll
                    for (int m = 0; m < 4; ++m) acc[ai][bj][m][n] += bv; }
        bool bad = st1.run(acc, u, wr, wc, fr, fq, lds, wid, lane) || poison != 0u;
        const float qnan = __builtin_nanf("");
#pragma unroll
        for (int ai = 0; ai < 2; ++ai)
#pragma unroll
            for (int m = 0; m < 4; ++m) { const int r = ai * HALF + wr * 64 + m * 16 + fr; const f32x2v sr = S[r]; const size_t off = (size_t)(u.pm * BM + r) * ldc + col0;
#pragma unroll
                for (int bj = 0; bj < 2; ++bj)
#pragma unroll
                    for (int n = 0; n < 2; ++n) { const f32x4 bs = *(const f32x4*)(base + off + bj * HALF + n * 16); acc[ai][bj][m][n] = bs + (acc[ai][bj][m][n] - sr.x) * sr.y; }
                asm volatile("" : "+v"(acc[ai][0][m][0]), "+v"(acc[ai][0][m][1]), "+v"(acc[ai][1][m][0]), "+v"(acc[ai][1][m][1]));
                if (m & 1) asm volatile("" ::: "memory"); }
        const bool bad1 = bad;
        bad = st2.run(acc, u, wr, wc, fr, fq, lds, wid, lane) || bad;
#pragma unroll
        for (int ai = 0; ai < 2; ++ai)
#pragma unroll
            for (int m = 0; m < 4; ++m) { const int r = ai * HALF + wr * 64 + m * 16 + fr; const f32x2v sr = S[r]; const size_t off = (size_t)(u.pm * BM + r) * ldc + col0;
#pragma unroll
                for (int bj = 0; bj < 2; ++bj)
#pragma unroll
                    for (int n = 0; n < 2; ++n) { const f32x4 x1 = acc[ai][bj][m][n]; *(f32x4*)(out + off + bj * HALF + n * 16) = bad1 ? (f32x4){qnan, qnan, qnan, qnan} : x1;
                        const f32x4 o = (x1 - sr.x) * sr.y; u32x2v w; w.x = cvt_pk_bf16(o[0], o[1]); w.y = cvt_pk_bf16(o[2], o[3]);
                        if (bad) { w.x = 0x7fc07fc0u; w.y = 0x7fc07fc0u; } *(u32x2v*)(xn + off + bj * HALF + n * 16) = w; }
                asm volatile("" ::: "memory"); }
    }
};

template <class E, class = void> struct is_staged { static constexpr bool value = false; };
template <class E> struct is_staged<E, decltype((void)E::STAGED)> { static constexpr bool value = true; };
template <class Epi, class Sched, bool STAMP = false, int F8 = 0  >
__device__ __forceinline__ void gemm_phase(PG8_LAS unsigned char* lds, const Gemm g, const Sched& S, const Epi& E, unsigned long long* stamps) {
    int tid_o = threadIdx.x; asm volatile("" : "+v"(tid_o)); const int tid = tid_o, wid = __builtin_amdgcn_readfirstlane(tid >> 6), lane = tid & 63, wr = wid >> 2, wc = wid & 3, fr = lane & 15, fq = lane >> 4;
    const int K = g.K, nt = K / BK, LDA = g.lda ? g.lda : g.K;
    int ts_lo = 0, ts_hi = 0, nts = 0; const unsigned long long rt_entry = STAMP ? (unsigned long long)wall_clock64() : 0ull;
#define PG8_STAMP() do { if (STAMP && wid == 0 && nts < 64) { const unsigned long long _c = (unsigned long long)clock64(); \
        ts_lo = (lane == nts) ? (int)(unsigned)_c : ts_lo; ts_hi = (lane == nts) ? (int)(unsigned)(_c >> 32) : ts_hi; ++nts; } } while (0)
    PG8_STAMP();
    unsigned voffA[2], voffB[2];
#pragma unroll
    for (int i = 0; i < 2; ++i) { int R, C; stage_rc(tid * 16 + i * 8192, R, C); const int Rb = Epi::PERM ? ((R & ~31) + perm32(R & 31)) : R;
        voffA[i] = (unsigned)(R * LDA + C) * 2u; voffB[i] = (unsigned)(Rb * K + C) * 2u; }
    const size_t kstep = (size_t)(BK * 2);
    const size_t hstep = (size_t)HALF * K * 2;
    const size_t tstep = 2 * hstep;
    const size_t hstepA = (size_t)HALF * LDA * 2, tstepA = 2 * hstepA;
    const unsigned ldsw = (unsigned)wid * 1024u;
    const int aoff = lds_byte(wr * 64 + fr, fq * 8), boff = lds_byte(wc * 32 + fr, fq * 8);
#define PG8_SA(b, h) (((b) * 2 + (h)) * HTB)
#define PG8_SB(b, h) ((4 + (b) * 2 + (h)) * HTB)
#define PG8_STAGE(bufoff, gbase, voff) do { _Pragma("unroll") for (int _i = 0; _i < 2; ++_i) \
        __builtin_amdgcn_global_load_lds((const unsigned*)((const char*)(gbase) + (voff)[_i]), (PG8_LAS unsigned*)(lds + (bufoff) + ldsw + _i * 8192), 16, 0, 0); } while (0)
#define PG8_LDA(dst, b, h) do { _Pragma("unroll") for (int m = 0; m < 4; ++m) _Pragma("unroll") for (int k = 0; k < 2; ++k) dst[m][k] = *(const PG8_LAS bf16x8*)(lds + PG8_SA(b, h) + aoff + m * 2048 + k * 1024); } while (0)
#define PG8_LDB(dst, b, h) do { _Pragma("unroll") for (int n = 0; n < 2; ++n) _Pragma("unroll") for (int k = 0; k < 2; ++k) dst[n][k] = *(const PG8_LAS bf16x8*)(lds + PG8_SB(b, h) + boff + n * 2048 + k * 1024); } while (0)
#define PG8_CAT(x, y) __builtin_shufflevector(__builtin_bit_cast(i32x4, (x)), __builtin_bit_cast(i32x4, (y)), 0, 1, 2, 3, 4, 5, 6, 7)
#define PG8_MMA(ai, bj, At, Bt) do { __builtin_amdgcn_s_setprio(1); _Pragma("unroll") for (int m = 0; m < 4; ++m) _Pragma("unroll") for (int n = 0; n < 2; ++n) { \
        if constexpr (F8 == 2) { _Pragma("unroll") for (int k = 0; k < 2; ++k) acc[ai][bj][m][n] = __builtin_bit_cast(f32x4, __builtin_amdgcn_mfma_i32_16x16x64_i8(__builtin_bit_cast(i32x4, Bt[n][k]), __builtin_bit_cast(i32x4, At[m][k]), __builtin_bit_cast(i32x4, acc[ai][bj][m][n]), 0, 0, 0)); } \
        else if constexpr (F8 == 1) { const i32x8 _a = PG8_CAT(Bt[n][0], Bt[n][1]), _b = PG8_CAT(At[m][0], At[m][1]); asm volatile("v_mfma_f32_16x16x128_f8f6f4 %0, %1, %2, %0" : "+v"(acc[ai][bj][m][n]) : "v"(_a), "v"(_b)); } \
        else { _Pragma("unroll") for (int k = 0; k < 2; ++k) acc[ai][bj][m][n] = __builtin_amdgcn_mfma_f32_16x16x32_bf16(Bt[n][k], At[m][k], acc[ai][bj][m][n], 0, 0, 0); } } \
        __builtin_amdgcn_s_setprio(0); } while (0)
#define PG8_WAIT_V(n) asm volatile("s_waitcnt vmcnt(" #n ")" ::: "memory")
#define PG8_WAIT_L(n) asm volatile("s_waitcnt lgkmcnt(" #n ")" ::: "memory")
#define PG8_BAR __builtin_amdgcn_s_barrier()
#define PG8_SCHED __builtin_amdgcn_sched_barrier(0)
    Unit cur, nxt; int ui = 0;
    if (!S.next(0, cur)) return;
    f32x4 acc[2][2][4][2];
#pragma unroll
    for (int a = 0; a < 2; ++a)
#pragma unroll
        for (int b = 0; b < 2; ++b)
#pragma unroll
            for (int m = 0; m < 4; ++m)
#pragma unroll
                for (int n = 0; n < 2; ++n) acc[a][b][m][n] = (f32x4){0.f, 0.f, 0.f, 0.f};
    bf16x8 At[4][2], B0[2][2], B1[2][2];
    const char* cA = (const char*)g.A + (size_t)cur.pm * tstepA; const char* cB = (const char*)g.Bt + (size_t)cur.pn * tstep;
    S.a_ready(cur);
    PG8_STAGE(PG8_SB(0, 0), cB, voffB); PG8_STAGE(PG8_SA(0, 0), cA, voffA); PG8_STAGE(PG8_SB(0, 1), cB + hstep, voffB); PG8_STAGE(PG8_SA(0, 1), cA + hstepA, voffA);
    if (wr == 1) PG8_BAR;
    PG8_WAIT_V(4); PG8_BAR;
    PG8_STAGE(PG8_SB(1, 0), cB + kstep, voffB); PG8_STAGE(PG8_SA(1, 0), cA + kstep, voffA); PG8_STAGE(PG8_SB(1, 1), cB + hstep + kstep, voffB);
    PG8_WAIT_V(6); PG8_BAR;
    PG8_STAMP();
    for (;;) {
        const bool has_next = S.next(ui + 1, nxt);
        const char* nA = has_next ? (const char*)g.A + (size_t)nxt.pm * tstepA : cA; const char* nB = has_next ? (const char*)g.Bt + (size_t)nxt.pn * tstep : cB;
        for (int t = 0; t < nt; t += 2) {
            const bool last = (t == nt - 2);
            const char* a1 = cA + (size_t)(t + 1) * kstep;
            const char* a2 = last ? nA : cA + (size_t)(t + 2) * kstep; const char* b2 = last ? nB : cB + (size_t)(t + 2) * kstep;
            const char* a3 = a2 + kstep; const char* b3 = b2 + kstep;
            if (last && has_next) S.a_ready(nxt);
            PG8_LDB(B0, 0, 0); PG8_SCHED; PG8_LDA(At, 0, 0); PG8_STAGE(PG8_SA(1, 1), a1 + hstepA, voffA);
            PG8_WAIT_L(8); PG8_BAR; PG8_WAIT_L(0); PG8_MMA(0, 0, At, B0); PG8_BAR; PG8_SCHED;
            PG8_LDB(B1, 0, 1); PG8_STAGE(PG8_SB(0, 0), b2, voffB);
            PG8_BAR; PG8_WAIT_L(0); PG8_MMA(0, 1, At, B1); PG8_BAR;
            PG8_LDA(At, 0, 1); PG8_STAGE(PG8_SA(0, 0), a2, voffA);
            PG8_BAR; PG8_WAIT_L(0); PG8_MMA(1, 0, At, B0); PG8_BAR; PG8_SCHED;
            PG8_STAGE(PG8_SB(0, 1), b2 + hstep, voffB);
            PG8_WAIT_V(6); PG8_BAR; PG8_MMA(1, 1, At, B1); PG8_BAR;
            PG8_LDB(B0, 1, 0); PG8_SCHED; PG8_LDA(At, 1, 0); PG8_STAGE(PG8_SA(0, 1), a2 + hstepA, voffA);
            PG8_WAIT_L(8); PG8_BAR; PG8_WAIT_L(0); PG8_MMA(0, 0, At, B0); PG8_BAR; PG8_SCHED;
            PG8_LDB(B1, 1, 1); PG8_STAGE(PG8_SB(1, 0), b3, voffB);
            PG8_BAR; PG8_WAIT_L(0); PG8_MMA(0, 1, At, B1); PG8_BAR;
            PG8_LDA(At, 1, 1); PG8_STAGE(PG8_SA(1, 0), a3, voffA);
            PG8_BAR; PG8_WAIT_L(0); PG8_MMA(1, 0, At, B0); PG8_BAR; PG8_SCHED;
            PG8_STAGE(PG8_SB(1, 1), b3 + hstep, voffB);
            PG8_WAIT_V(6); PG8_BAR; PG8_MMA(1, 1, At, B1); PG8_BAR;
        }
        PG8_STAMP();
        if constexpr (F8 == 1) asm volatile("s_nop 15\n\ts_nop 15" ::: "memory");
        if constexpr (Epi::AFTER_DRAIN) {}
        else if constexpr (is_staged<Epi>::value) {
            if (wr == 0) PG8_BAR;
            E.staged(acc, cur, wr, wc, fr, fq, lds + STAGE_BYTES + 256, wid, lane);
            if (wr == 1) PG8_BAR;
            S.done(cur); }
        else if constexpr (!Epi::AFTER_DRAIN) { E(acc, cur, wr, wc, fr, fq); S.done(cur); }
        PG8_STAMP();
        if (!has_next) break;
#pragma unroll
        for (int a = 0; a < 2; ++a)
#pragma unroll
            for (int b = 0; b < 2; ++b)
#pragma unroll
                for (int m = 0; m < 4; ++m)
#pragma unroll
                    for (int n = 0; n < 2; ++n) acc[a][b][m][n] = (f32x4){0.f, 0.f, 0.f, 0.f};
        cur = nxt; cA = nA; cB = nB; ++ui;
    }
    PG8_WAIT_V(0);
    if (wr == 0) PG8_BAR;
    PG8_BAR;
    if constexpr (Epi::AFTER_DRAIN) { E.fused(acc, cur, wr, wc, fr, fq, lds, wid, lane); S.done(cur); }
    PG8_STAMP();
    if (STAMP && wid == 0) { stamps[lane] = lane < nts ? (((unsigned long long)(unsigned)ts_hi << 32) | (unsigned)ts_lo) : 0ull;
        if (lane == 62) stamps[62] = rt_entry; if (lane == 63) stamps[63] = (unsigned long long)wall_clock64(); }
#undef PG8_STAMP
#undef PG8_SA
#undef PG8_SB
#undef PG8_STAGE
#undef PG8_LDA
#undef PG8_LDB
#undef PG8_MMA
#undef PG8_CAT
#undef PG8_WAIT_V
#undef PG8_WAIT_L
#undef PG8_BAR
#undef PG8_SCHED
}
}
#define XB_TMO      128
#define XB_XCNT(j)  (256  + 64 * (j))
#define XB_XSUB(j)  (1280 + 64 * (j))
#define XB_XGEN(j)  (2304 + 64 * (j))
#define XB_TOP      3328
#define XB_TOPGEN   3392
#define XCD_BAR_WORDS 3456
#define XB_SPIN_CAP (1u << 23)
#define LAS __attribute__((address_space(3)))

__device__ __forceinline__ unsigned xb_ld(unsigned* p)              { return __hip_atomic_load(p, __ATOMIC_RELAXED, __HIP_MEMORY_SCOPE_AGENT); }
__device__ __forceinline__ unsigned xb_add(unsigned* p, unsigned v) { return __hip_atomic_fetch_add(p, v, __ATOMIC_RELAXED, __HIP_MEMORY_SCOPE_AGENT); }
__device__ __forceinline__ unsigned xb_xcc_id() { return (unsigned)__builtin_amdgcn_s_getreg((3 << 11) | 20) & 0xFu; }
#define XB_SPIN(cond, bar) do { unsigned _sp = 0; while (cond) { __builtin_amdgcn_s_sleep(1); \
    if ((++_sp & 255u) == 0u) { if (xb_ld(&(bar)[XB_TMO])) break; if (_sp > XB_SPIN_CAP) { atomicAdd(&(bar)[XB_TMO], 1u); break; } } } } while (0)

struct XcdBarrier {
    unsigned* bar; unsigned x;
    volatile LAS unsigned* st;
};

__device__ __forceinline__ XcdBarrier xcd_barrier_post(unsigned* bar, volatile LAS unsigned* st) {
    XcdBarrier b; b.bar = bar; b.x = xb_xcc_id(); b.st = st;
    if (threadIdx.x == 0) (void)xb_add(&bar[XB_XCNT(b.x)], 1u);
    return b;
}
__device__ __forceinline__ void xcd_barrier_complete(unsigned* bar, unsigned x, unsigned& nloc, unsigned& nx) {
    const unsigned G = gridDim.x * gridDim.y * gridDim.z;
    unsigned sum, cnt, mine, sp = 0u;
    for (;;) {
        sum = 0u; cnt = 0u; mine = 0u;
#pragma unroll
        for (unsigned j = 0; j < 16; ++j) { const unsigned c = xb_ld(&bar[XB_XCNT(j)]); sum += c; cnt += (c > 0u) ? 1u : 0u; mine = (j == x) ? c : mine; }
        if (sum == G) break;
        __builtin_amdgcn_s_sleep(1);
        if ((++sp & 255u) == 0u) { if (xb_ld(&bar[XB_TMO])) break; if (sp > XB_SPIN_CAP) { atomicAdd(&bar[XB_TMO], 1u); break; } }
    }
    nloc = mine > 0u ? mine : 1u; nx = cnt > 0u ? cnt : 1u;
}

__device__ __forceinline__ void xcd_barrier(const XcdBarrier& b) {
    asm volatile("s_waitcnt vmcnt(0)" ::: "memory");
    __syncthreads();
    if (threadIdx.x == 0) {
        unsigned* bar = b.bar;
        __builtin_amdgcn_s_waitcnt(0);
        unsigned nloc = b.st[0], nx = b.st[1];
        if (nloc == 0u) { xcd_barrier_complete(bar, b.x, nloc, nx); b.st[0] = nloc; b.st[1] = nx; }
        const unsigned old = xb_add(&bar[XB_XSUB(b.x)], 1u);
        const unsigned gen = old / nloc;
        if (old + 1u == (gen + 1u) * nloc) {
            __builtin_amdgcn_fence(__ATOMIC_RELEASE, "agent");
            asm volatile("s_waitcnt vmcnt(0)" ::: "memory");
            const unsigned og = xb_add(&bar[XB_TOP], 1u);
            const unsigned tg = og / nx;
            if (og + 1u == (tg + 1u) * nx) xb_add(&bar[XB_TOPGEN], 1u);
            else XB_SPIN(xb_ld(&bar[XB_TOPGEN]) == tg, bar);
            __builtin_amdgcn_fence(__ATOMIC_ACQUIRE, "agent");
            xb_add(&bar[XB_XGEN(b.x)], 1u);
            asm volatile("s_waitcnt vmcnt(0)" ::: "memory");
        } else {
            XB_SPIN(xb_ld(&bar[XB_XGEN(b.x)]) == gen, bar);
            __builtin_amdgcn_fence(__ATOMIC_ACQUIRE, "agent");
            asm volatile("s_waitcnt vmcnt(0)" ::: "memory");
        }
    }
    __syncthreads();
}

namespace fa {
typedef unsigned short bf16;
typedef short bf16x8 __attribute__((ext_vector_type(8)));
typedef short s16x4 __attribute__((ext_vector_type(4)));
typedef float f32x16 __attribute__((ext_vector_type(16)));
typedef float f32x4 __attribute__((ext_vector_type(4)));
typedef unsigned u32x4 __attribute__((ext_vector_type(4)));
typedef unsigned u32x2 __attribute__((ext_vector_type(2)));
constexpr int D = 128, SEQ = 2048;
constexpr float SCALE = 0.08838834764831845f, THR = 8.f;
constexpr int NW = 8, QBLK = 32, KVBLK = 64, QB = NW * QBLK;
constexpr int SHM_V = KVBLK * D * 2, SHM_K = KVBLK * D * 2;
constexpr int LDS_BYTES = 2 * SHM_V + 2 * SHM_K + NW * 64 * 4;
enum { M_WIN = 0, M_SEL = 1, M_BITS = 2 };

#define KSWZ(row, colB) ((row) * 256 + ((colB) ^ (((row) & 7) << 4)))
#define SBAR() __builtin_amdgcn_sched_barrier(0)
__device__ __forceinline__ int v_st(int k, int c) { const int kk = (k & ~0xC) | ((k & 4) << 1) | ((k & 8) >> 1); return ((kk >> 3) * 4 + (c >> 5)) * 512 + ((kk & 7) * 32 + (c & 31)) * 2; }
__device__ __forceinline__ int v_rd_base(int lane) { return ((lane & 3) << 3) | (((lane >> 2) & 3) << 6) | (((lane >> 4) & 1) << 5) | (((lane >> 5) & 1) << 8); }
constexpr int v_rd_off(int d0, int ks, int half) { return d0 * 512 + ks * 4096 + half * 2048; }
__device__ __forceinline__ int crow(int r, int hi) { return (r & 3) + 8 * (r >> 2) + 4 * hi; }
__device__ __forceinline__ unsigned cvtpk(float lo, float hi) { unsigned r; asm volatile("v_cvt_pk_bf16_f32 %0, %1, %2" : "=v"(r) : "v"(lo), "v"(hi)); return r; }
__device__ __forceinline__ int opq(int x) { asm volatile("" : "+v"(x)); return x; }
__device__ __forceinline__ bf16x8 load8(const bf16* p) { return *reinterpret_cast<const bf16x8*>(p); }

__device__ __forceinline__ void mask_tile(f32x16& p0, f32x16& p1, int dq, unsigned W) {
    const float NEG = -__builtin_inff();
#pragma unroll
    for (int r = 0; r < 16; ++r) {
        const int c = (r & 3) + 8 * (r >> 2);
        if ((unsigned)(dq - c) >= W) p0[r] = NEG;
        if ((unsigned)(dq - c - 32) >= W) p1[r] = NEG;
    }
}
__device__ __forceinline__ void mask_all(f32x16& p0, f32x16& p1) {
    const float NEG = -__builtin_inff();
#pragma unroll
    for (int r = 0; r < 16; ++r) { p0[r] = NEG; p1[r] = NEG; }
}
__device__ __forceinline__ void mask_bits(f32x16& p0, f32x16& p1, unsigned wlo, unsigned whi, int hi) {
    const float NEG = -__builtin_inff();
    const unsigned a = wlo >> (4 * hi), b = whi >> (4 * hi);
#pragma unroll
    for (int r = 0; r < 16; ++r) {
        const int c = (r & 3) + 8 * (r >> 2);
        if (!((a >> c) & 1u)) p0[r] = NEG;
        if (!((b >> c) & 1u)) p1[r] = NEG;
    }
}
__device__ __forceinline__ void partialSM(f32x16& p0, f32x16& p1, float& m_reg, float& mn, float& alpha) {
    float pmax = p0[0]; for (int r = 1; r < 16; ++r) pmax = fmaxf(pmax, p0[r]); for (int r = 0; r < 16; ++r) pmax = fmaxf(pmax, p1[r]);
    { auto rr = __builtin_amdgcn_permlane32_swap(__float_as_uint(pmax), __float_as_uint(pmax), false, false);
      pmax = fmaxf(__uint_as_float(rr[0]), __uint_as_float(rr[1])); }
    constexpr float C2 = 1.4426950408889634f * SCALE;
    if (__builtin_expect(__all((pmax - m_reg) * SCALE <= THR), 1)) { mn = m_reg; alpha = 1.f; }
    else { mn = fmaxf(m_reg, pmax); alpha = __builtin_amdgcn_exp2f((m_reg - mn) * C2); m_reg = mn; }
    const float mnL = -mn * C2;
    for (int r = 0; r < 16; ++r) p0[r] = fmaf(p0[r], C2, mnL); for (int r = 0; r < 16; ++r) p1[r] = fmaf(p1[r], C2, mnL);
    for (int r = 0; r < 16; ++r) p0[r] = __builtin_amdgcn_exp2f(p0[r]);
}
__device__ __forceinline__ void finishSM(f32x16& p0, f32x16& p1, float alpha, float& l_reg, bf16x8& pa0, bf16x8& pa1, bf16x8& pa2, bf16x8& pa3) {
    for (int r = 0; r < 16; ++r) p1[r] = __builtin_amdgcn_exp2f(p1[r]);
    float ps = 0; for (int r = 0; r < 16; ++r) ps += p0[r]; for (int r = 0; r < 16; ++r) ps += p1[r];
    { auto rr = __builtin_amdgcn_permlane32_swap(__float_as_uint(ps), __float_as_uint(ps), false, false);
      ps = __uint_as_float(rr[0]) + __uint_as_float(rr[1]); }
    l_reg = l_reg * alpha + ps;
#define PK4(P, B_, OUT) do { unsigned a0 = cvtpk(P[B_+0], P[B_+1]), a1 = cvtpk(P[B_+2], P[B_+3]);                          \
        unsigned b0 = cvtpk(P[B_+4], P[B_+5]), b1 = cvtpk(P[B_+6], P[B_+7]);                                             \
        auto r0 = __builtin_amdgcn_permlane32_swap(a0, b0, false, false); auto r1 = __builtin_amdgcn_permlane32_swap(a1, b1, false, false); \
        u32x4 w = {r0[0], r1[0], r0[1], r1[1]}; OUT = *reinterpret_cast<bf16x8*>(&w); } while (0)
    PK4(p0, 0, pa0); PK4(p0, 8, pa1); PK4(p1, 0, pa2); PK4(p1, 8, pa3);
#undef PK4
}
template <int KB>
__device__ __forceinline__ void qkt(f32x16& p0, f32x16& p1, const char* K_lds, int r32, int hi, const bf16x8* qr, bool act) {
    if (!act) { mask_all(p0, p1); return; }
    p0 = f32x16{}; p1 = f32x16{};
    const char* kb[4];
#pragma unroll
    for (int dd = 0; dd < 4; ++dd) kb[dd] = K_lds + KB * SHM_K + KSWZ(r32, (dd * 16 + hi * 8) * 2);
#pragma unroll
    for (int d0 = 0; d0 < 8; ++d0) { const char* a = kb[d0 & 3] + (d0 >> 2) * 128;
        bf16x8 b0 = *reinterpret_cast<const bf16x8*>(a);
        bf16x8 b1 = *reinterpret_cast<const bf16x8*>(a + 32 * 256);
        p0 = __builtin_amdgcn_mfma_f32_32x32x16_bf16(b0, qr[d0], p0, 0, 0, 0);
        p1 = __builtin_amdgcn_mfma_f32_32x32x16_bf16(b1, qr[d0], p1, 0, 0, 0); }
}
template <int VB>
__device__ __forceinline__ void pv_tile(f32x16* o, int vb0, bf16x8 pa0, bf16x8 pa1, bf16x8 pa2, bf16x8 pa3, bool act) {
    if (!act) return;
#define TRRD(dst, off) asm volatile("ds_read_b64_tr_b16 %0, %1 offset:%2" : "=&v"(dst) : "v"(vb0), "i"(off) : "memory")
#define PV_D0(d0) do { s16x4 l0, l1, l2, l3, h0, h1, h2, h3; constexpr int b_ = VB * SHM_V + v_rd_off(d0, 0, 0); \
        TRRD(l0, b_); TRRD(h0, b_ + 2048); TRRD(l1, b_ + 4096); TRRD(h1, b_ + 6144); TRRD(l2, b_ + 8192); TRRD(h2, b_ + 10240); TRRD(l3, b_ + 12288); TRRD(h3, b_ + 14336); \
        asm volatile("s_waitcnt lgkmcnt(0)" ::: "memory"); SBAR();   \
        o[d0] = __builtin_amdgcn_mfma_f32_32x32x16_bf16(pa0, (bf16x8){l0[0], l0[1], l0[2], l0[3], h0[0], h0[1], h0[2], h0[3]}, o[d0], 0, 0, 0);   \
        o[d0] = __builtin_amdgcn_mfma_f32_32x32x16_bf16(pa1, (bf16x8){l1[0], l1[1], l1[2], l1[3], h1[0], h1[1], h1[2], h1[3]}, o[d0], 0, 0, 0);   \
        o[d0] = __builtin_amdgcn_mfma_f32_32x32x16_bf16(pa2, (bf16x8){l2[0], l2[1], l2[2], l2[3], h2[0], h2[1], h2[2], h2[3]}, o[d0], 0, 0, 0);   \
        o[d0] = __builtin_amdgcn_mfma_f32_32x32x16_bf16(pa3, (bf16x8){l3[0], l3[1], l3[2], l3[3], h3[0], h3[1], h3[2], h3[3]}, o[d0], 0, 0, 0); } while (0)
    PV_D0(0); PV_D0(1); PV_D0(2); PV_D0(3);
#undef PV_D0
#undef TRRD
}

struct BlockRef { const bf16* Q; const bf16* K; const bf16* V; bf16* O; float* LSE; const unsigned* aux; int P0, ldo, lstr, mode, Wu, m, ecode; };
struct EpiPtrs { const bf16* oc; const bf16* owin; const float* gate; const bf16* ob4; const bf16* ob16; const float* lse4; const float* lse16; };
struct Seam { bf16x8 qr[8]; bf16x8 st_v0, st_v1, st_k0, st_k1; };
__device__ __forceinline__ int jlo_of(const BlockRef& r) { if (r.mode != M_WIN) return 0; int lowk = r.P0 - r.Wu + 1; const int cls = r.P0 & ~(r.m - 1); if (lowk < cls) lowk = cls;
    return lowk > 0 ? lowk / KVBLK : 0; }
__device__ __forceinline__ int tok_of(const BlockRef& r, int p) { return (p & (r.m - 1)) * (SEQ / r.m) + p / r.m; }
#define LDG(base, off) (*reinterpret_cast<const bf16x8*>(reinterpret_cast<const char*>(base) + (off)))
#define VMW() asm volatile("s_waitcnt vmcnt(0)" ::: "memory")
#define VMWN(n) asm volatile("s_waitcnt vmcnt(%0)" :: "i"(n) : "memory")
#define SLOAD_H(R, k0) do { const int t_ = opq(tid); const int p0_ = (k0) + (t_ >> 4), p1_ = p0_ + 32, lm_ = 31 - __builtin_clz((R).m), ld_ = 11 - lm_;                                 \
                         const unsigned c_ = (unsigned)((t_ & 15) * 16);                                                                                                                 \
                         const unsigned o0_ = (unsigned)((((p0_ & ((R).m - 1)) << ld_) + (p0_ >> lm_)) * (D * 2)) + c_, o1_ = (unsigned)((((p1_ & ((R).m - 1)) << ld_) + (p1_ >> lm_)) * (D * 2)) + c_; \
                         S.st_v0 = LDG((R).V, o0_); S.st_v1 = LDG((R).V, o1_); S.st_k0 = LDG((R).K, o0_); S.st_k1 = LDG((R).K, o1_); } while (0)
#define SWRITE_HK(bf) do { const int t_ = opq(tid); const int kws_ = KSWZ(t_ >> 4, (t_ & 15) * 16); *(bf16x8*)(K_lds + (bf) * SHM_K + kws_) = S.st_k0; *(bf16x8*)(K_lds + (bf) * SHM_K + kws_ + 32 * 256) = S.st_k1; } while (0)
#define SWRITE_HV(bf) do { const int t_ = opq(tid); *(bf16x8*)(V_lds + (bf) * SHM_V + v_st(t_ >> 4, (t_ & 15) * 8)) = S.st_v0; *(bf16x8*)(V_lds + (bf) * SHM_V + v_st(32 + (t_ >> 4), (t_ & 15) * 8)) = S.st_v1; } while (0)
#define SWRITE_H(bf) do { SWRITE_HV(bf); SWRITE_HK(bf); } while (0)
__device__ __forceinline__ void prime(const BlockRef& cur, char* lds, Seam& S, int tid) {
    const int wid = __builtin_amdgcn_readfirstlane(tid >> 6), lane = tid & 63, r32 = lane & 31, hi = lane >> 5;
    char* K_lds = lds + 2 * SHM_V;
    const int kb0 = jlo_of(cur) * KVBLK;
    const bf16* qrow = cur.Q + (size_t)tok_of(cur, cur.P0 + wid * QBLK + r32) * D + hi * 8;
    for (int d0 = 0; d0 < 8; ++d0) S.qr[d0] = load8(qrow + d0 * 16);
    SLOAD_H(cur, kb0); VMW(); SWRITE_HK(0);
    __syncthreads();
}
template <class NF> __device__ __forceinline__ void block(const BlockRef& cur, BlockRef& nxt, NF& nf, const EpiPtrs& ep, char* lds, Seam& S, int tid) {
    const int wid = __builtin_amdgcn_readfirstlane(tid >> 6), lane = tid & 63, r32 = lane & 31, hi = lane >> 5;
    const int mode = cur.mode, W = cur.Wu;
    const int j_lo = jlo_of(cur);
    int j_hi = (cur.P0 + QB - 1) / KVBLK + 1; if (j_hi > SEQ / KVBLK) j_hi = SEQ / KVBLK;
    const int NT = j_hi - j_lo;
    const int qlo = cur.P0 + wid * QBLK;
    const int cbase = qlo & (cur.m - 1);
    const bool force = cbase < W - 1;
    unsigned mrow = 0u;
    if (mode == M_SEL) mrow = cur.aux[qlo + r32]; else if (mode == M_BITS) mrow = (unsigned)(qlo + r32) * 256u;
    char* V_lds = lds; char* K_lds = lds + 2 * SHM_V;
    float* ws = (float*)(lds + 2 * SHM_V + 2 * SHM_K) + wid * 64; float* li_l = ws, * al_l = ws + 32;
    float m_reg = -1e30f, l_reg = 0; f32x16 o[4] = {};
#define VB0 ((int)(uintptr_t)V_lds + v_rd_base(opq(lane)))
#define RESC(a) do { if (__any((a) < 1.f)) { if (hi == 0) al_l[r32] = (a); asm volatile("s_waitcnt lgkmcnt(0)" ::: "memory");              \
                     for (int d_ = 0; d_ < 4; ++d_) for (int r = 0; r < 16; ++r) o[d_][r] *= al_l[crow(r, hi)]; } } while (0)
#define KBASE(t) ((j_lo + (t)) * KVBLK)
#define ACT(t) ((mode == M_WIN) ? (KBASE(t) <= qlo + QBLK - 1 && KBASE(t) + KVBLK - 1 >= qlo - W + 1) : ((mode == M_SEL) ? (__any((mrow >> (j_lo + (t))) & 1u) && KBASE(t) <= qlo + QBLK - 1) : (KBASE(t) <= qlo + QBLK - 1)))
#define MASKT(P0_, P1_, t) do { const int kb_ = KBASE(t); if (ACT(t)) { const int l_ = opq(lane); const int qm = qlo + (l_ & 31) - 4 * (l_ >> 5);                                                                                        \
        if (mode == M_WIN) { if (force || kb_ + KVBLK - 1 > qlo || kb_ <= qlo + QBLK - 1 - W) { int rx_ = r32; asm volatile("" : "+v"(rx_));                   \
                const unsigned cp_ = (unsigned)(cbase + rx_ + 1); mask_tile(P0_, P1_, qm - kb_, cp_ < (unsigned)W ? cp_ : (unsigned)W); } }                     \
        else if (mode == M_SEL) { if (kb_ + KVBLK - 1 > qlo) mask_tile(P0_, P1_, qm - kb_, 0x7fffffffu); if (!((mrow >> (j_lo + (t))) & 1u)) mask_all(P0_, P1_); } \
        else { const u32x2 w_ = *(const u32x2*)((const char*)cur.aux + mrow + 8u * (unsigned)(j_lo + (t))); mask_bits(P0_, P1_, w_.x, w_.y, hi); } } } while (0)
    constexpr int NQL = 8;
#define SEAM_K0() do { VMWN(NQL); SWRITE_HK(0); SBAR(); } while (0)
    f32x16 pA0, pA1, pB0, pB1; float mnA, mnB, alA, alB; bf16x8 pa0, pa1, pa2, pa3;
    SWRITE_HV(0); SBAR();
    if (NT > 1) { SLOAD_H(cur, KBASE(1)); }
    SBAR(); qkt<0>(pA0, pA1, K_lds, opq(r32), hi, S.qr, ACT(0));
    MASKT(pA0, pA1, 0); partialSM(pA0, pA1, m_reg, mnA, alA);
    if (NT > 1) { VMW(); SWRITE_H(1); }
    __syncthreads();
#define HALF_STEP(PX0, PX1, mnX, alX, PY0, PY1, alY, t, KB, VB, SB) do {                                                      \
        SBAR(); qkt<KB>(PX0, PX1, K_lds, opq(r32), hi, S.qr, ACT(t));                                                 \
        finishSM(PY0, PY1, alY, l_reg, pa0, pa1, pa2, pa3); SBAR();                                                           \
        if ((t) + 1 < NT) { SLOAD_H(cur, KBASE((t) + 1)); SBAR(); }                                                        \
        pv_tile<VB>(o, VB0, pa0, pa1, pa2, pa3, ACT((t) - 1)); MASKT(PX0, PX1, (t)); partialSM(PX0, PX1, m_reg, mnX, alX);    \
        __syncthreads();                                                                                                      \
        if ((t) + 1 < NT) { VMW(); SWRITE_H(SB); }                                                                            \
        RESC(alX); __syncthreads(); } while (0)
    for (int t = 1; t + 1 < NT; t += 2) {
        HALF_STEP(pB0, pB1, mnB, alB, pA0, pA1, alA, t, 1, 0, 0);
        HALF_STEP(pA0, pA1, mnA, alA, pB0, pB1, alB, t + 1, 0, 1, 1);
    }
    const bool even = (NT & 1) == 0;
    if (even) { SBAR(); qkt<1>(pB0, pB1, K_lds, opq(r32), hi, S.qr, ACT(NT - 1)); SBAR(); }
    nxt = nf(cur); const int kbn = jlo_of(nxt) * KVBLK;
    SLOAD_H(nxt, kbn); SBAR();
    { const bf16* qrow = nxt.Q + (size_t)tok_of(nxt, nxt.P0 + wid * QBLK + r32) * D + hi * 8;
#pragma unroll
      for (int d0 = 0; d0 < 8; ++d0) S.qr[d0] = load8(qrow + d0 * 16); }
    SBAR();
    finishSM(pA0, pA1, alA, l_reg, pa0, pa1, pa2, pa3); SBAR();
    pv_tile<0>(o, VB0, pa0, pa1, pa2, pa3, ACT(even ? NT - 2 : NT - 1));
    if (even) { MASKT(pB0, pB1, NT - 1); partialSM(pB0, pB1, m_reg, mnB, alB); __syncthreads(); RESC(alB);
        finishSM(pB0, pB1, alB, l_reg, pa0, pa1, pa2, pa3); SBAR(); pv_tile<1>(o, VB0, pa0, pa1, pa2, pa3, ACT(NT - 1)); }
    SBAR(); SEAM_K0();
    if (hi == 0) li_l[r32] = l_reg; asm volatile("s_waitcnt lgkmcnt(0)" ::: "memory");
    if (cur.LSE && hi == 0) cur.LSE[(size_t)tok_of(cur, qlo + r32) * cur.lstr] = m_reg * (1.4426950408889634f * SCALE) + __builtin_amdgcn_logf(l_reg);
    float rli[16];
#pragma unroll
    for (int r = 0; r < 16; ++r) rli[r] = __builtin_amdgcn_rcpf(li_l[crow(r, hi)]);
    const int emode = cur.ecode & 15;
    if (emode == 0) {
        char* stg = lds + (wid < 7 ? LDS_BYTES + wid * (32 * 272) : 131072 + 256);
        { const int l_ = opq(lane); char* wp_ = stg + (4 * (l_ >> 5)) * 272 + (l_ & 31) * 2;
#pragma unroll
          for (int r = 0; r < 16; ++r)
#pragma unroll
            for (int d0 = 0; d0 < 4; ++d0) *(unsigned short*)(wp_ + ((r & 3) + 8 * (r >> 2)) * 272 + d0 * 64) = (unsigned short)cvtpk(o[d0][r] * rli[r], 0.f); }
        asm volatile("s_waitcnt lgkmcnt(0)" ::: "memory");
        { const int l_ = opq(lane); const char* rp_ = stg + (l_ >> 4) * 272 + (l_ & 15) * 16;
#pragma unroll
          for (int i = 0; i < 8; ++i) { const u32x4 v = *(const u32x4*)(rp_ + i * 4 * 272);
              *(u32x4*)(cur.O + (size_t)tok_of(cur, qlo + i * 4 + (l_ >> 4)) * cur.ldo + (l_ & 15) * 8) = v; } }
    } else {
        const int ehead = (cur.ecode >> 4) & 15, etb = (cur.ecode >> 8) * SEQ;
        if (emode == 3) { if (hi == 0) al_l[r32] = m_reg * (1.4426950408889634f * SCALE) + __builtin_amdgcn_logf(l_reg); }
        char* stg = lds + (wid < 7 ? LDS_BYTES + wid * (32 * 272) : 131072 + 256);
        { const int l_ = opq(lane); char* wp_ = stg + (4 * (l_ >> 5)) * 272 + (l_ & 31) * 2;
#pragma unroll
          for (int r = 0; r < 16; ++r)
#pragma unroll
            for (int d0 = 0; d0 < 4; ++d0) *(unsigned short*)(wp_ + ((r & 3) + 8 * (r >> 2)) * 272 + d0 * 64) = (unsigned short)cvtpk(o[d0][r] * rli[r], 0.f); }
        asm volatile("s_waitcnt lgkmcnt(0)" ::: "memory");
        const int l_ = opq(lane), rq = l_ >> 4, c8 = (l_ & 15) * 8;
        const char* rp_ = stg + rq * 272 + (l_ & 15) * 16;
#pragma unroll
        for (int ib = 0; ib < 8; ib += 4) {
            u32x4 wo[4], wa[4], wb[4]; float s0[4], s1[4], l1[4];
#pragma unroll
            for (int k = 0; k < 4; ++k) { const int row = (ib + k) * 4 + rq; const size_t tg = (size_t)(etb + qlo + row);
                wo[k] = *(const u32x4*)(rp_ + (ib + k) * 4 * 272);
                if (emode == 2) { const float* gp = ep.gate + tg * 24 + ehead * 3; s0[k] = gp[1]; s1[k] = gp[2]; l1[k] = 0.f;
                    const size_t e = tg * 1024 + ehead * 128 + c8; wa[k] = *(const u32x4*)(ep.oc + e); wb[k] = *(const u32x4*)(ep.owin + e); }
                else { s0[k] = ep.lse4[tg * 4 + ehead]; s1[k] = ep.lse16[tg * 4 + ehead]; l1[k] = al_l[row];
                    const size_t e = tg * 512 + ehead * 128 + c8; wa[k] = *(const u32x4*)(ep.ob4 + e); wb[k] = *(const u32x4*)(ep.ob16 + e); } }
#pragma unroll
            for (int k = 0; k < 4; ++k) { const int row = (ib + k) * 4 + rq;
                float c0, ca, cb;
                if (emode == 2) { c0 = s0[k]; ca = 1.0f; cb = s1[k]; }
                else { const float mm = fmaxf(l1[k], fmaxf(s0[k], s1[k])), w1 = __builtin_amdgcn_exp2f(l1[k] - mm), w4 = __builtin_amdgcn_exp2f(s0[k] - mm), w16 = __builtin_amdgcn_exp2f(s1[k] - mm);
                    const float wi = __builtin_amdgcn_rcpf(w1 + w4 + w16); c0 = w1 * wi; ca = w4 * wi; cb = w16 * wi; }
                u32x4 w;
#pragma unroll
                for (int j = 0; j < 4; ++j) { const unsigned uo = wo[k][j], ua = wa[k][j], ub = wb[k][j];
                    const float x0 = c0 * __uint_as_float(uo << 16) + ca * __uint_as_float(ua << 16) + cb * __uint_as_float(ub << 16);
                    const float x1 = c0 * __uint_as_float(uo & 0xffff0000u) + ca * __uint_as_float(ua & 0xffff0000u) + cb * __uint_as_float(ub & 0xffff0000u);
                    w[j] = cvtpk(x0, x1); }
                *(u32x4*)(cur.O + (size_t)(qlo + row) * cur.ldo + c8) = w; }
        }
    }
    __syncthreads();
#undef RESC
#undef KBASE
#undef ACT
#undef MASKT
#undef SEAM_K0
#undef HALF_STEP
#undef VB0
}
#undef LDG
#undef VMW
#undef VMWN
#undef SLOAD_H
#undef SWRITE_HK
#undef SWRITE_HV
#undef SWRITE_H
#undef KSWZ
}
#ifndef MK_DUP_PH
#define MK_DUP_PH 0
#endif
namespace mk {
typedef unsigned short bf16_t;
typedef short bf16x8 __attribute__((ext_vector_type(8)));
typedef float f32x4 __attribute__((ext_vector_type(4)));
typedef float f32x2 __attribute__((ext_vector_type(2)));
typedef unsigned u32x4 __attribute__((ext_vector_type(4)));
typedef unsigned u32x2 __attribute__((ext_vector_type(2)));
typedef __bf16 bf16x2n __attribute__((ext_vector_type(2)));
#define DI __device__ __forceinline__
DI int otid() { int t = threadIdx.x; asm volatile("" : "+v"(t)); return t; }

constexpr int NB = 8, S = 2048, DM = 2048, T = NB * S, DEPTH = 4;
constexpr int NPAD = 6144, INW = 5992, FF = 5632, NGU = 2 * FF;
constexpr int NSEG = 47;
constexpr float QSCALE = 0.08838834764831845f * 1.4426950408889634f;
constexpr float NEG = -1.0e30f;
constexpr float RMS_EPS = 1e-6f;

constexpr size_t AL(size_t x) { return (x + 255) & ~(size_t)255; }
constexpr size_t WS_CTL   = 0;
constexpr size_t CTL_BYTES = 65536;
constexpr size_t WS_COS128 = WS_CTL + CTL_BYTES;
constexpr size_t WS_SIN128 = WS_COS128 + (size_t)S * 64 * 4;
constexpr size_t WS_COS64  = WS_SIN128 + (size_t)S * 64 * 4;
constexpr size_t WS_SIN64  = WS_COS64 + (size_t)S * 32 * 4;
constexpr size_t WS_WIN   = WS_SIN64 + (size_t)S * 32 * 4;
constexpr size_t WS_WOUT  = WS_WIN + (size_t)NPAD * DM * 2;
constexpr size_t WS_WGU   = WS_WOUT + (size_t)DM * DM * 2;
constexpr size_t WS_WDN   = WS_WGU + (size_t)NGU * DM * 2;
constexpr size_t WS_CW1K  = WS_WDN + (size_t)DM * FF * 2;
constexpr size_t WS_CW1V  = WS_CW1K + (size_t)256 * 4096 * 2;
constexpr size_t WS_CW2K  = WS_CW1V + (size_t)256 * 4096 * 2;
constexpr size_t WS_CW2V  = WS_CW2K + (size_t)128 * 256 * 2;
constexpr size_t WS_CB1   = WS_CW2V + (size_t)128 * 256 * 2;
constexpr size_t WS_H     = AL(WS_CB1 + 2 * 256 * 4);
constexpr size_t WS_MIX   = WS_H + (size_t)T * DM * 2;
constexpr size_t WS_BIG   = WS_MIX + (size_t)T * DM * 2;
constexpr size_t WS_P     = WS_BIG;
constexpr size_t WS_SC    = WS_BIG;
constexpr size_t WS_HID   = WS_BIG;
constexpr size_t WS_PREP  = WS_BIG + (size_t)T * NPAD * 2;
constexpr size_t WS_Y     = WS_PREP;
constexpr size_t SZ_H4 = (size_t)T * 512 * 2, SZ_H1 = (size_t)T * 128 * 2, SZ_H8 = (size_t)T * 1024 * 2, SZ_H2 = (size_t)T * 256 * 2;
constexpr size_t WS_AQ   = WS_PREP;
constexpr size_t WS_AK   = WS_AQ + SZ_H4;
constexpr size_t WS_AVT  = WS_AK + SZ_H1;
constexpr size_t WS_IQ   = WS_AVT + SZ_H1;
constexpr size_t WS_IK   = WS_IQ + SZ_H8;
constexpr size_t WS_IW   = WS_IK + (size_t)T * 64 * 2;
constexpr size_t WS_GATE = WS_IW + (size_t)T * 16 * 4;
constexpr size_t WS_BQ   = WS_GATE + (size_t)T * 24 * 4;
constexpr size_t WS_BK1  = WS_BQ + SZ_H4;
constexpr size_t WS_BVT1 = WS_BK1 + SZ_H4;
constexpr size_t WS_BK4  = WS_BK1, WS_BK16 = WS_BK1, WS_BVT4 = WS_BVT1, WS_BVT16 = WS_BVT1;
constexpr size_t WS_CQ   = WS_BVT1 + SZ_H4;
constexpr size_t WS_CQR  = WS_CQ + SZ_H8;
constexpr size_t WS_KC   = WS_CQR + SZ_H8;
constexpr size_t WS_VC   = WS_KC + SZ_H2 + 65536;
constexpr size_t WS_CKS  = WS_VC + SZ_H2 + 65536;
constexpr size_t WS_CVST = WS_CKS + SZ_H2;
constexpr size_t WS_CKW  = WS_CVST + SZ_H2;
constexpr size_t WS_CVWT = WS_CKW + SZ_H2;
constexpr size_t WS_PREP_END = WS_CVWT + SZ_H2;
constexpr size_t WS_BITS = WS_PREP_END;
constexpr size_t WS_OB4  = WS_BITS + (size_t)T * 64 * 4;
constexpr size_t WS_OB16 = WS_OB4 + SZ_H4;
constexpr size_t WS_LSE4 = WS_OB16 + SZ_H4;
constexpr size_t WS_LSE16 = WS_LSE4 + (size_t)T * 4 * 4;
constexpr size_t WS_LSE1 = WS_LSE16 + (size_t)T * 4 * 4;
constexpr size_t WS_OB1  = WS_LSE1 + (size_t)T * 4 * 4;
constexpr size_t WS_OSLC = WS_OB1 + SZ_H4;
constexpr size_t WS_OWIN = WS_OSLC + SZ_H8;
constexpr size_t WS_OC   = WS_OWIN + SZ_H8;
constexpr size_t WS_G1K  = WS_OC + SZ_H8;
constexpr size_t WS_G1V  = WS_G1K + (size_t)2048 * 256 * 2;
constexpr size_t WS_KCC  = WS_G1V + (size_t)2048 * 256 * 2;
constexpr size_t WS_VCT  = WS_KCC + (size_t)16 * 128 * 128 * 2;
constexpr size_t WS_SEL  = WS_VCT + (size_t)16 * 128 * 128 * 2;
constexpr size_t WS_XB   = AL(WS_SEL + (size_t)16 * S * 4);
constexpr size_t WS_END  = AL(WS_XB + (size_t)T * DM * 2);
static_assert(WS_HID + (size_t)T * FF * 2 <= WS_PREP, "hidden must fit inside P");
static_assert(WS_Y + (size_t)T * DM * 2 <= WS_PREP_END, "Y must fit inside the prep region");

constexpr int LDS_BAR_OFF = 131072;
constexpr int LDS_BYTES = 131072 + 256 + 128 * 144;   static_assert(2 * 32 * 272 <= 128 * 144 && 32 * 528 <= 128 * 144, "the in-projection's staging tile shares the region");

DI unsigned pk2(float a, float b) { f32x2 v = {a, b}; bf16x2n r = __builtin_convertvector(v, bf16x2n); return __builtin_bit_cast(unsigned, r); }
DI void st16_wt(void* p, u32x4 v) { asm volatile("global_store_dwordx4 %0, %1, off sc1\n\ts_nop 0" :: "v"(p), "v"(v) : "memory"); }
DI void st8_wt(void* p, u32x2 v) { asm volatile("global_store_dwordx2 %0, %1, off sc1\n\ts_nop 0" :: "v"(p), "v"(v) : "memory"); }
DI float bflo(unsigned w) { return __uint_as_float(w << 16); }
DI float bfhi(unsigned w) { return __uint_as_float(w & 0xffff0000u); }
DI float bf2f(bf16_t v) { return __uint_as_float(((unsigned)v) << 16); }
DI float wave_sum(float v) {
#pragma unroll
    for (int o = 1; o < 64; o <<= 1) v += __shfl_xor(v, o);
    return v;
}
DI float fexp2(float x) { return __builtin_amdgcn_exp2f(x); }
DI float frcp(float x) { return __builtin_amdgcn_rcpf(x); }
DI void unpack8(const u32x4 w, float (&x)[8]) { x[0] = bflo(w.x); x[1] = bfhi(w.x); x[2] = bflo(w.y); x[3] = bfhi(w.y); x[4] = bflo(w.z); x[5] = bfhi(w.z); x[6] = bflo(w.w); x[7] = bfhi(w.w); }
DI u32x4 pack8(const float (&x)[8]) { u32x4 w; w.x = pk2(x[0], x[1]); w.y = pk2(x[2], x[3]); w.z = pk2(x[4], x[5]); w.w = pk2(x[6], x[7]); return w; }
#define MFMA16(a, b, c) __builtin_amdgcn_mfma_f32_16x16x32_bf16((a), (b), (c), 0, 0, 0)
DI unsigned pk4_i8(float a, float b, float c, float d) {
    const float M = 12582912.0f;
    const unsigned ua = __float_as_uint(__builtin_amdgcn_fmed3f(a, -127.0f, 127.0f) + M), ub = __float_as_uint(__builtin_amdgcn_fmed3f(b, -127.0f, 127.0f) + M),
                   uc = __float_as_uint(__builtin_amdgcn_fmed3f(c, -127.0f, 127.0f) + M), ud = __float_as_uint(__builtin_amdgcn_fmed3f(d, -127.0f, 127.0f) + M);
    return (ua & 0xffu) | ((ub & 0xffu) << 8) | ((uc & 0xffu) << 16) | (ud << 24); }
constexpr size_t CTL_WMAX = 12288;
constexpr float F8_SW = 1024.0f, F8_SH = 16.0f, F8_SHID = 8.0f;
DI unsigned pk4_f8(float a, float b, float c, float d) {
    a = __builtin_amdgcn_fmed3f(a, -448.0f, 448.0f); b = __builtin_amdgcn_fmed3f(b, -448.0f, 448.0f); c = __builtin_amdgcn_fmed3f(c, -448.0f, 448.0f); d = __builtin_amdgcn_fmed3f(d, -448.0f, 448.0f);
    int w = __builtin_amdgcn_cvt_pk_fp8_f32(a, b, 0, false); w = __builtin_amdgcn_cvt_pk_fp8_f32(c, d, w, true); return (unsigned)w; }

struct Ptrs {
    const float* in[16];
    float* out;
    unsigned char* ws;
};
template <class TT> DI TT* wsp(const Ptrs& P, size_t off) { return (TT*)(P.ws + off); }

DI void phase_rope_tables(const Ptrs& P) {
    float* c128 = wsp<float>(P, WS_COS128); float* s128 = wsp<float>(P, WS_SIN128); float* c64 = wsp<float>(P, WS_COS64); float* s64 = wsp<float>(P, WS_SIN64);
    const int gt = blockIdx.x * blockDim.x + otid(), ng = gridDim.x * blockDim.x;
    for (int i = gt; i < S * 64; i += ng) { const int t = i >> 6, k = i & 63; const float inv = exp2f(-(float)k * (13.287712379549449f / 64.0f));
        const double a = (double)t * (double)inv * 0.15915494309189535; const float fr = (float)(a - floor(a));
        c128[i] = __builtin_amdgcn_cosf(fr); s128[i] = __builtin_amdgcn_sinf(fr); }
    for (int i = gt; i < S * 32; i += ng) { const int t = i >> 5, k = i & 31; const float inv = exp2f(-(float)k * (13.287712379549449f / 32.0f));
        const double a = (double)t * (double)inv * 0.15915494309189535; const float fr = (float)(a - floor(a));
        c64[i] = __builtin_amdgcn_cosf(fr); s64[i] = __builtin_amdgcn_sinf(fr); }
}

DI int incol(int pc) {
    const int tile = pc >> 8, q = pc & 255, bj = q >> 7, r = q & 127, wc = r >> 5, p = r & 31;
    if (tile == 23) { if (wc == 0) return 1792 + 32 * bj + p; if (wc == 1) { if (bj == 0) return p < 16 ? 1856 + p : -1; return p < 24 ? 5968 + p : -1; } return -1; }
    const int seg = 2 * tile + (wc >> 1), base = (seg < 14) ? seg * 128 : seg * 128 + 80;
    if (seg >= 6 && seg < 14) return base + 64 * (wc & 1) + 32 * bj + p;
    return base + 64 * bj + 32 * (wc & 1) + p;
}
DI int q_next(unsigned* ctr, unsigned char* lds, int tid) {
    volatile int* slot = (volatile int*)(lds + LDS_BAR_OFF + 64);
    __syncthreads();
    if (tid == 0) *slot = (int)__hip_atomic_fetch_add(ctr, 1u, __ATOMIC_RELAXED, __HIP_MEMORY_SCOPE_AGENT);
    __syncthreads();
    return __builtin_amdgcn_readfirstlane(*slot);
}
struct ConvIt { const float* src; bf16_t* dst; int srcN, K, n0, k0, sc, f8; float wmax; };
DI ConvIt conv_decode(const Ptrs& P, int layer, int it, int tid) {
    const float* w_in = P.in[1] + (size_t)layer * DM * INW; const float* w_out = P.in[2] + (size_t)layer * DM * DM;
    const float* w1k = P.in[4] + (size_t)layer * 4096 * 256; const float* w2k = P.in[5] + (size_t)layer * 256 * 128;
    const float* w1v = P.in[7] + (size_t)layer * 4096 * 256; const float* w2v = P.in[8] + (size_t)layer * 256 * 128;
    const float* wg = P.in[9] + (size_t)layer * DM * FF; const float* wu = P.in[10] + (size_t)layer * DM * FF; const float* wd = P.in[11] + (size_t)layer * FF * DM;
    constexpr int I0 = (NPAD / 64) * (DM / 128), I1 = (DM / 64) * (DM / 128), I2 = (NGU / 64) * (DM / 128), I3 = (DM / 64) * (FF / 128), I4 = 4 * 32, I6 = 2 * 2;
    const int nq = (tid & 15) * 4;
    ConvIt c; c.f8 = 0; c.wmax = 0.f; int r = it;
    if (r < I0) { const int nt = r / (DM / 128), kt = r % (DM / 128); c.src = w_in; c.dst = wsp<bf16_t>(P, WS_WIN); c.srcN = INW; c.K = DM; c.n0 = nt * 64; c.k0 = kt * 128; c.sc = incol(c.n0 + nq); c.f8 = 2;
        c.wmax = __uint_as_float(__builtin_amdgcn_readfirstlane(__hip_atomic_load((unsigned*)(P.ws + WS_CTL) + CTL_WMAX + layer * 64 + 1, __ATOMIC_RELAXED, __HIP_MEMORY_SCOPE_AGENT))); return c; } r -= I0;
    if (r < I4) { const int nt = r / 32, kt = r % 32; c.src = w1k; c.dst = wsp<bf16_t>(P, WS_CW1K); c.srcN = 256; c.K = 4096; c.n0 = nt * 64; c.k0 = kt * 128; c.sc = c.n0 + nq; return c; } r -= I4;
    if (r < I4) { const int nt = r / 32, kt = r % 32; c.src = w1v; c.dst = wsp<bf16_t>(P, WS_CW1V); c.srcN = 256; c.K = 4096; c.n0 = nt * 64; c.k0 = kt * 128; c.sc = c.n0 + nq; return c; } r -= I4;
    if (r < I6) { const int nt = r / 2, kt = r % 2; c.src = w2k; c.dst = wsp<bf16_t>(P, WS_CW2K); c.srcN = 128; c.K = 256; c.n0 = nt * 64; c.k0 = kt * 128; c.sc = c.n0 + nq; return c; } r -= I6;
    if (r < I6) { const int nt = r / 2, kt = r % 2; c.src = w2v; c.dst = wsp<bf16_t>(P, WS_CW2V); c.srcN = 128; c.K = 256; c.n0 = nt * 64; c.k0 = kt * 128; c.sc = c.n0 + nq; return c; } r -= I6;
    if (r < I1) { const int nt = r / (DM / 128), kt = r % (DM / 128); c.src = w_out; c.dst = wsp<bf16_t>(P, WS_WOUT); c.srcN = DM; c.K = DM; c.n0 = nt * 64; c.k0 = kt * 128; c.sc = c.n0 + nq; return c; } r -= I1;
    constexpr int DA = (I1 + I2 + I3) / 4 - I1; static_assert(DA >= 0 && DA <= I3, "late-set split");
    if (r >= DA && r < DA + I2) { r -= DA; const int nt = r / (DM / 128), kt = r % (DM / 128); const int n0 = nt * 64, tl = n0 >> 8, o = n0 & 255;
        c.src = (o < 128) ? wg : wu; c.dst = wsp<bf16_t>(P, WS_WGU); c.srcN = FF; c.K = DM; c.n0 = n0; c.k0 = kt * 128; c.sc = tl * 128 + (o & 127) + nq; c.f8 = 2; c.wmax = __uint_as_float(__builtin_amdgcn_readfirstlane(__hip_atomic_load((unsigned*)(P.ws + WS_CTL) + CTL_WMAX + layer * 64, __ATOMIC_RELAXED, __HIP_MEMORY_SCOPE_AGENT))); return c; }
    if (r >= DA) r -= I2;
    { const int nt = r / (FF / 128), kt = r % (FF / 128); c.src = wd; c.dst = wsp<bf16_t>(P, WS_WDN); c.srcN = DM; c.K = FF; c.n0 = nt * 64; c.k0 = kt * 128; c.sc = c.n0 + nq; c.f8 = 1; return c; }
}
constexpr int CONV_EARLY = (NPAD / 64) * (DM / 128) + 2 * 4 * 32 + 2 * 2 * 2;
constexpr int CONV_NIT = (NPAD / 64) * (DM / 128) + (DM / 64) * (DM / 128) + (NGU / 64) * (DM / 128) + (DM / 64) * (FF / 128) + 2 * 4 * 32 + 2 * 2 * 2;
DI void conv_load(const ConvIt& c, int tid, f32x4 (&v)[4]) {
    const int kr = tid >> 4;
#pragma unroll
    for (int i = 0; i < 4; ++i) v[i] = (c.sc >= 0) ? __builtin_nontemporal_load((const f32x4*)(c.src + (size_t)(c.k0 + kr + 32 * i) * c.srcN + c.sc)) : (f32x4){0.f, 0.f, 0.f, 0.f};
}
DI void conv_store(const ConvIt& c, int tid, const f32x4 (&v)[4], float* tile  ) {
    const int nq = (tid & 15) * 4, kr = tid >> 4;
#pragma unroll
    for (int i = 0; i < 4; ++i)
#pragma unroll
        for (int e = 0; e < 4; ++e) tile[(nq + e) * 129 + kr + 32 * i] = v[i][e];
    __syncthreads();
    const int n2 = tid >> 3, c8 = tid & 7;
#pragma unroll
    for (int j = 0; j < 2; ++j) { float x[8];
#pragma unroll
        for (int e = 0; e < 8; ++e) x[e] = tile[n2 * 129 + 8 * c8 + 64 * j + e];
        if (c.f8 == 2) { const float sw = 127.0f / fmaxf(c.wmax, 1e-30f); u32x2 w; w.x = pk4_i8(x[0] * sw, x[1] * sw, x[2] * sw, x[3] * sw); w.y = pk4_i8(x[4] * sw, x[5] * sw, x[6] * sw, x[7] * sw);
            *(u32x2*)((unsigned char*)c.dst + (size_t)(c.n0 + n2) * c.K + c.k0 + 8 * c8 + 64 * j) = w; }
        else if (c.f8) { u32x2 w; w.x = pk4_f8(x[0] * F8_SW, x[1] * F8_SW, x[2] * F8_SW, x[3] * F8_SW); w.y = pk4_f8(x[4] * F8_SW, x[5] * F8_SW, x[6] * F8_SW, x[7] * F8_SW);
            *(u32x2*)((unsigned char*)c.dst + (size_t)(c.n0 + n2) * c.K + c.k0 + 8 * c8 + 64 * j) = w; }
        else *(u32x4*)(c.dst + (size_t)(c.n0 + n2) * c.K + c.k0 + 8 * c8 + 64 * j) = pack8(x); }
}
DI void conv_range(const Ptrs& P, int layer, unsigned char* lds, int first, int end, int step) {
    const int tid = otid();
    float* tileA = (float*)lds; float* tileB = (float*)lds + 64 * 129;
    int it = first;
    if (it < end) {
        ConvIt ca = conv_decode(P, layer, it, tid), cb = ca; f32x4 va[4], vb[4];
        conv_load(ca, tid, va);
        for (;;) {
            const bool nb = it + step < end; if (nb) { cb = conv_decode(P, layer, it + step, tid); conv_load(cb, tid, vb); }
            conv_store(ca, tid, va, tileA);
            if (!nb) break;
            it += step;
            const bool na = it + step < end; if (na) { ca = conv_decode(P, layer, it + step, tid); conv_load(ca, tid, va); }
            conv_store(cb, tid, vb, tileB);
            if (!na) break;
            it += step;
        }
    }
    __syncthreads();
}
constexpr int CONV_FILL_TILES = 4, CONV_FILL_ITEMS = (CONV_NIT - CONV_EARLY) / CONV_FILL_TILES, CONV_FILL_PER_PHASE = CONV_FILL_ITEMS / 4;
static_assert((CONV_NIT - CONV_EARLY) % (CONV_FILL_TILES * 4) == 0, "filler items must split evenly over the four attention phases");
constexpr int WMAX_ITEMS = 512;
DI void wmax_item(const Ptrs& P, int layer, int it, unsigned char* lds) {
    constexpr int N4 = DM * FF / 4, PER = N4 / WMAX_ITEMS; static_assert(N4 % WMAX_ITEMS == 0 && PER % (512 * 11) == 0, "slice shape");
    const int tid = otid();
    const f32x4* wg = (const f32x4*)(P.in[9] + (size_t)layer * DM * FF) + (size_t)it * PER + tid; const f32x4* wu = (const f32x4*)(P.in[10] + (size_t)layer * DM * FF) + (size_t)it * PER + tid;
    float m = 0.f;
#pragma unroll 1
    for (int h = 0; h < PER / 512; h += 11) { f32x4 a[11], b[11];
#pragma unroll
        for (int j = 0; j < 11; ++j) { a[j] = wg[(h + j) * 512]; b[j] = wu[(h + j) * 512]; }
#pragma unroll
        for (int j = 0; j < 11; ++j) { m = fmaxf(m, fmaxf(fmaxf(fabsf(a[j][0]), fabsf(a[j][1])), fmaxf(fabsf(a[j][2]), fabsf(a[j][3])))); m = fmaxf(m, fmaxf(fmaxf(fabsf(b[j][0]), fabsf(b[j][1])), fmaxf(fabsf(b[j][2]), fabsf(b[j][3])))); } }
    unsigned* slot = (unsigned*)(lds + LDS_BAR_OFF + 128);
    if (tid == 0) *slot = 0u;
    __syncthreads();
    __hip_atomic_fetch_max(slot, __float_as_uint(m), __ATOMIC_RELAXED, __HIP_MEMORY_SCOPE_WORKGROUP);
    __syncthreads();
    if (tid == 0) __hip_atomic_fetch_max((unsigned*)(P.ws + WS_CTL) + CTL_WMAX + layer * 64, *slot, __ATOMIC_RELAXED, __HIP_MEMORY_SCOPE_AGENT);
}
DI void wmax_in_item(const Ptrs& P, int layer, int it, unsigned char* lds) {
    constexpr int N4 = DM * INW / 4, PER = N4 / WMAX_ITEMS; static_assert(N4 % WMAX_ITEMS == 0 && PER <= 12 * 512, "slice shape");
    const int tid = otid();
    const f32x4* w = (const f32x4*)(P.in[1] + (size_t)layer * DM * INW) + (size_t)it * PER;
    float m = 0.f; f32x4 a[12];
#pragma unroll
    for (int j = 0; j < 12; ++j) { int i = tid + 512 * j; i = i < PER ? i : PER - 1; a[j] = w[i]; }
#pragma unroll
    for (int j = 0; j < 12; ++j) m = fmaxf(m, fmaxf(fmaxf(fabsf(a[j][0]), fabsf(a[j][1])), fmaxf(fabsf(a[j][2]), fabsf(a[j][3]))));
    unsigned* slot = (unsigned*)(lds + LDS_BAR_OFF + 128);
    if (tid == 0) *slot = 0u;
    __syncthreads();
    __hip_atomic_fetch_max(slot, __float_as_uint(m), __ATOMIC_RELAXED, __HIP_MEMORY_SCOPE_WORKGROUP);
    __syncthreads();
    if (tid == 0) __hip_atomic_fetch_max((unsigned*)(P.ws + WS_CTL) + CTL_WMAX + layer * 64 + 1, *slot, __ATOMIC_RELAXED, __HIP_MEMORY_SCOPE_AGENT);
    __syncthreads();
}
constexpr int BIAS_ITEMS = 16;
DI void bias1_item(const Ptrs& P, int layer, int j, unsigned char* lds) {
    const int tid = otid(), wid = tid >> 6, lane = tid & 63, kq = lane >> 3, c4 = lane & 7, kv = j >> 3, n0 = (j & 7) * 32;
    const float* pe = P.in[kv ? 6 : 3] + (size_t)layer * 4096; const float* w1 = P.in[kv ? 7 : 4] + (size_t)layer * 4096 * 256 + n0 + 4 * c4;
    f32x4 acc = (f32x4){0.f, 0.f, 0.f, 0.f};
    const int k0 = wid * 512 + kq;
#pragma unroll 8
    for (int i = 0; i < 64; ++i) { const int k = k0 + 8 * i; const f32x4 w = *(const f32x4*)(w1 + (size_t)k * 256); const float p = pe[k]; acc[0] += w[0] * p; acc[1] += w[1] * p; acc[2] += w[2] * p; acc[3] += w[3] * p; }
#pragma unroll
    for (int e = 0; e < 4; ++e) { float v = acc[e]; v += __shfl_xor(v, 8); v += __shfl_xor(v, 16); v += __shfl_xor(v, 32); acc[e] = v; }
    float* part = (float*)lds;
    __syncthreads();
    if (kq == 0) { part[wid * 32 + 4 * c4] = acc[0]; part[wid * 32 + 4 * c4 + 1] = acc[1]; part[wid * 32 + 4 * c4 + 2] = acc[2]; part[wid * 32 + 4 * c4 + 3] = acc[3]; }
    __syncthreads();
    if (tid < 32) { float sacc = 0.f;
#pragma unroll
        for (int w = 0; w < 8; ++w) sacc += part[w * 32 + tid];
        wsp<float>(P, WS_CB1)[kv * 256 + n0 + tid] = sacc; }
    __syncthreads();
}
constexpr int EARLY_ITEMS = CONV_EARLY / CONV_FILL_TILES; static_assert(CONV_EARLY % CONV_FILL_TILES == 0, "early set in filler items");
DI void conv_filler(const Ptrs& P, int layer, unsigned char* lds, unsigned* ctr, int part) {
    const bool nxt = layer + 1 < DEPTH;
    int extra = 0;
    if (part == 0) extra = WMAX_ITEMS; else if (nxt) extra = (part == 1) ? WMAX_ITEMS : (part == 2 ? EARLY_ITEMS / 2 : EARLY_ITEMS - EARLY_ITEMS / 2 + BIAS_ITEMS);
    for (int it = q_next(ctr, lds, otid()); it < CONV_FILL_PER_PHASE + extra; it = q_next(ctr, lds, otid())) {
        const int j = it - CONV_FILL_PER_PHASE;
        if (j >= 0 && part == 0) { wmax_item(P, layer, j, lds); continue; }
        if (j >= 0 && part == 1) { wmax_in_item(P, layer + 1, j, lds); continue; }
        int lyr = layer, t0 = CONV_EARLY + (part * CONV_FILL_PER_PHASE + it) * CONV_FILL_TILES;
        if (j >= 0) { if (part == 3 && j < BIAS_ITEMS) { bias1_item(P, layer + 1, j, lds); continue; }
            const int e = (part == 2) ? j : j - BIAS_ITEMS + EARLY_ITEMS / 2; lyr = layer + 1; t0 = e * CONV_FILL_TILES; }
        conv_range(P, lyr, lds, t0, t0 + CONV_FILL_TILES, 1); }
}
DI void phase_wconv(const Ptrs& P, int layer, unsigned char* lds) {
    const int tid = otid();
    conv_range(P, layer, lds, blockIdx.x, CONV_EARLY, gridDim.x);
    __syncthreads();
    if (blockIdx.x < BIAS_ITEMS) bias1_item(P, layer, blockIdx.x, lds);
}

template <bool XI, bool XO, int H8 = 0  > DI void phase_norm(const void* xin_, void* xout_, const bf16_t* Y, const float* g_post, const float* g_pre, bf16_t* H) {
    const float* xin = (const float*)xin_; float* xout = (float*)xout_; const bf16_t* xinb = (const bf16_t*)xin_; bf16_t* xoutb = (bf16_t*)xout_;
    const int lane = otid() & 63, gw = blockIdx.x * 8 + (otid() >> 6), ngw = gridDim.x * 8;
    for (int row = gw; row < T; row += ngw) {
        float xv[4][8];
#pragma unroll
        for (int j = 0; j < 4; ++j) { const int col = 8 * (lane + 64 * j);
            if (XI) { unpack8(*(const u32x4*)(xinb + (size_t)row * DM + col), xv[j]); }
            else { const f32x4 a = *(const f32x4*)(xin + (size_t)row * DM + col), b = *(const f32x4*)(xin + (size_t)row * DM + col + 4);
                xv[j][0] = a[0]; xv[j][1] = a[1]; xv[j][2] = a[2]; xv[j][3] = a[3]; xv[j][4] = b[0]; xv[j][5] = b[1]; xv[j][6] = b[2]; xv[j][7] = b[3]; } }
        if (Y) {
            float yv[4][8]; float ss = 0.f;
#pragma unroll
            for (int j = 0; j < 4; ++j) { const int col = 8 * (lane + 64 * j); const u32x4 w = *(const u32x4*)(Y + (size_t)row * DM + col); unpack8(w, yv[j]);
#pragma unroll
                for (int e = 0; e < 8; ++e) ss += yv[j][e] * yv[j][e]; }
            const float rstd = rsqrtf(wave_sum(ss) * (1.0f / DM) + RMS_EPS);
#pragma unroll
            for (int j = 0; j < 4; ++j) { const int col = 8 * (lane + 64 * j); const f32x4 ga = *(const f32x4*)(g_post + col), gb = *(const f32x4*)(g_post + col + 4);
#pragma unroll
                for (int e = 0; e < 4; ++e) { xv[j][e] += yv[j][e] * rstd * ga[e]; xv[j][4 + e] += yv[j][4 + e] * rstd * gb[e]; }
                if (XO) { st16_wt(xoutb + (size_t)row * DM + col, pack8(xv[j])); unpack8(pack8(xv[j]), xv[j]); }
                else { *(f32x4*)(xout + (size_t)row * DM + col) = (f32x4){xv[j][0], xv[j][1], xv[j][2], xv[j][3]};
                    *(f32x4*)(xout + (size_t)row * DM + col + 4) = (f32x4){xv[j][4], xv[j][5], xv[j][6], xv[j][7]}; } }
        }
        if (H) {
            float ss = 0.f;
#pragma unroll
            for (int j = 0; j < 4; ++j)
#pragma unroll
                for (int e = 0; e < 8; ++e) ss += xv[j][e] * xv[j][e];
            const float rstd = rsqrtf(wave_sum(ss) * (1.0f / DM) + RMS_EPS);
            if (H8 == 2) { float am = 0.f;
#pragma unroll
                for (int j = 0; j < 4; ++j) { const int col = 8 * (lane + 64 * j); const f32x4 ga = *(const f32x4*)(g_pre + col), gb = *(const f32x4*)(g_pre + col + 4);
#pragma unroll
                    for (int e = 0; e < 4; ++e) { xv[j][e] *= rstd * ga[e]; xv[j][4 + e] *= rstd * gb[e]; am = fmaxf(am, fmaxf(fabsf(xv[j][e]), fabsf(xv[j][4 + e]))); } }
#pragma unroll
                for (int o = 1; o < 64; o <<= 1) am = fmaxf(am, __shfl_xor(am, o));
                am = fmaxf(am, 1e-30f); const float sa = 127.0f / am;
                if (lane == 0) ((float*)((unsigned char*)H + (size_t)T * DM))[row] = am * (1.0f / 127.0f);
#pragma unroll
                for (int j = 0; j < 4; ++j) { const int col = 8 * (lane + 64 * j); u32x2 w; w.x = pk4_i8(xv[j][0] * sa, xv[j][1] * sa, xv[j][2] * sa, xv[j][3] * sa); w.y = pk4_i8(xv[j][4] * sa, xv[j][5] * sa, xv[j][6] * sa, xv[j][7] * sa);
                    st8_wt((unsigned char*)H + (size_t)row * DM + col, w); }
            } else
#pragma unroll
            for (int j = 0; j < 4; ++j) { const int col = 8 * (lane + 64 * j); const f32x4 ga = *(const f32x4*)(g_pre + col), gb = *(const f32x4*)(g_pre + col + 4); float hv[8];
#pragma unroll
                for (int e = 0; e < 4; ++e) { hv[e] = xv[j][e] * rstd * ga[e]; hv[4 + e] = xv[j][4 + e] * rstd * gb[e]; }
                if (H8) { u32x2 w; w.x = pk4_f8(hv[0] * F8_SH, hv[1] * F8_SH, hv[2] * F8_SH, hv[3] * F8_SH); w.y = pk4_f8(hv[4] * F8_SH, hv[5] * F8_SH, hv[6] * F8_SH, hv[7] * F8_SH);
                    *(u32x2*)((unsigned char*)H + (size_t)row * DM + col) = w; }
                else *(u32x4*)(H + (size_t)row * DM + col) = pack8(hv); }
        }
    }
}

struct EpiSwiglu {
    static constexpr bool PERM = true, AFTER_DRAIN = false;
    bf16_t* O; int ldc;
    __device__ __forceinline__ void operator()(const pg8::f32x4 (&acc)[2][2][4][2], const pg8::Unit& u, int wr, int wc, int fr, int fq) const {
        const int row0 = u.pm * 256 + wr * 64 + fr, col0 = u.pn * 128 + wc * 32 + 8 * fq;
#pragma unroll
        for (int ai = 0; ai < 2; ++ai)
#pragma unroll
            for (int m = 0; m < 4; ++m) { bf16_t* rowp = O + (size_t)(row0 + ai * 128 + m * 16) * ldc + col0; float h[8];
#pragma unroll
                for (int n = 0; n < 2; ++n)
#pragma unroll
                    for (int i = 0; i < 4; ++i) { const float g = acc[ai][0][m][n][i], up = acc[ai][1][m][n][i]; h[4 * n + i] = g * frcp(1.0f + fexp2(-1.4426950408889634f * g)) * up; }
                *(u32x4*)rowp = pack8(h); }
    }
};

struct EpiSwiglu8 {
    static constexpr bool PERM = true, AFTER_DRAIN = false;
    unsigned char* O; int ldc;
    __device__ __forceinline__ void operator()(const pg8::f32x4 (&acc)[2][2][4][2], const pg8::Unit& u, int wr, int wc, int fr, int fq) const {
        const int row0 = u.pm * 256 + wr * 64 + fr, col0 = u.pn * 128 + wc * 32 + 8 * fq;
        constexpr float US = 1.0f / (F8_SH * F8_SW);
#pragma unroll
        for (int ai = 0; ai < 2; ++ai)
#pragma unroll
            for (int m = 0; m < 4; ++m) { unsigned char* rowp = O + (size_t)(row0 + ai * 128 + m * 16) * ldc + col0; float h[8];
#pragma unroll
                for (int n = 0; n < 2; ++n)
#pragma unroll
                    for (int i = 0; i < 4; ++i) { const float g = acc[ai][0][m][n][i] * US, up = acc[ai][1][m][n][i] * (US * F8_SHID); h[4 * n + i] = g * frcp(1.0f + fexp2(-1.4426950408889634f * g)) * up; }
                u32x2 w; w.x = pk4_f8(h[0], h[1], h[2], h[3]); w.y = pk4_f8(h[4], h[5], h[6], h[7]);
                *(u32x2*)rowp = w; }
    }
};
struct EpiSwigluI8 {
    static constexpr bool PERM = true, AFTER_DRAIN = false, STAGED = true;
    static constexpr int PITCH = 144;
    unsigned char* O; int ldc; const float* rs; float ws;
    __device__ __forceinline__ void staged(const pg8::f32x4 (&acc)[2][2][4][2], const pg8::Unit& u, int wr, int wc, int fr, int fq, PG8_LAS unsigned char* ep, int wid, int lane) const {
        const int row0 = u.pm * 256 + wr * 64 + fr;
        float scv[8];
#pragma unroll
        for (int i = 0; i < 8; ++i) scv[i] = rs[row0 + (i >> 2) * 128 + (i & 3) * 16] * ws;
#pragma unroll
        for (int ai = 0; ai < 2; ++ai) {
#pragma unroll
            for (int m = 0; m < 4; ++m) { float h[8]; const float sc = scv[ai * 4 + m];
#pragma unroll
                for (int n = 0; n < 2; ++n)
#pragma unroll
                    for (int i = 0; i < 4; ++i) { const float g = (float)__float_as_int(acc[ai][0][m][n][i]) * sc, up = (float)__float_as_int(acc[ai][1][m][n][i]) * (sc * F8_SHID); h[4 * n + i] = g * frcp(1.0f + fexp2(-1.4426950408889634f * g)) * up; }
                u32x2 w; w.x = pk4_f8(h[0], h[1], h[2], h[3]); w.y = pk4_f8(h[4], h[5], h[6], h[7]);
                *(PG8_LAS u32x2*)(ep + (wr * 64 + m * 16 + fr) * PITCH + wc * 32 + 8 * fq) = w; }
            asm volatile("s_waitcnt lgkmcnt(0)" ::: "memory"); __builtin_amdgcn_s_barrier(); asm volatile("" ::: "memory");
            u32x4 v[2];
#pragma unroll
            for (int h2 = 0; h2 < 2; ++h2) v[h2] = *(const PG8_LAS u32x4*)(ep + (wid * 16 + h2 * 8 + (lane >> 3)) * PITCH + (lane & 7) * 16);
            asm volatile("s_waitcnt lgkmcnt(0)" ::: "memory"); __builtin_amdgcn_s_barrier(); asm volatile("" ::: "memory");
#pragma unroll
            for (int h2 = 0; h2 < 2; ++h2) *(u32x4*)(O + (size_t)(u.pm * 256 + ai * 128 + wid * 16 + h2 * 8 + (lane >> 3)) * ldc + u.pn * 128 + (lane & 7) * 16) = v[h2];
        }
    }
    __device__ __forceinline__ void operator()(const pg8::f32x4 (&acc)[2][2][4][2], const pg8::Unit& u, int wr, int wc, int fr, int fq) const {
        const int row0 = u.pm * 256 + wr * 64 + fr, col0 = u.pn * 128 + wc * 32 + 8 * fq;
#pragma unroll
        for (int ai = 0; ai < 2; ++ai)
#pragma unroll
            for (int m = 0; m < 4; ++m) { const int row = row0 + ai * 128 + m * 16; unsigned char* rowp = O + (size_t)row * ldc + col0; float h[8]; const float sc = rs[row] * ws;
#pragma unroll
                for (int n = 0; n < 2; ++n)
#pragma unroll
                    for (int i = 0; i < 4; ++i) { const float g = (float)__float_as_int(acc[ai][0][m][n][i]) * sc, up = (float)__float_as_int(acc[ai][1][m][n][i]) * (sc * F8_SHID); h[4 * n + i] = g * frcp(1.0f + fexp2(-1.4426950408889634f * g)) * up; }
                u32x2 w; w.x = pk4_f8(h[0], h[1], h[2], h[3]); w.y = pk4_f8(h[4], h[5], h[6], h[7]);
                *(u32x2*)rowp = w; }
    }
};
struct EpiRowsBf16 {
    static constexpr bool PERM = true, AFTER_DRAIN = false, STAGED = true;
    static constexpr int RPITCH = 528;
    bf16_t* O; int ldc; float US;
    __device__ __forceinline__ void staged(const pg8::f32x4 (&acc)[2][2][4][2], const pg8::Unit& u, int wr, int wc, int fr_in, int fq_in, PG8_LAS unsigned char* ep, int wid, int lane_in) const {
        int fr = fr_in, fq = fq_in, lane = lane_in; asm volatile("" : "+v"(fr), "+v"(fq), "+v"(lane));
        PG8_LAS unsigned char* wt = ep + (wr * 16 + fr) * RPITCH + (wc * 32 + 8 * fq) * 2;
        const int rrow = wid * 4 + (lane >> 5);
        const PG8_LAS unsigned char* rt = ep + rrow * RPITCH + (lane & 31) * 16;
        bf16_t* obase = O + (size_t)(u.pm * 256 + (rrow >> 4) * 64 + (rrow & 15)) * ldc + u.pn * 256 + (lane & 31) * 8;
#pragma unroll
        for (int idx = 0; idx < 8; ++idx) { const int ai = idx >> 2, m = idx & 3;
#pragma unroll
            for (int bj = 0; bj < 2; ++bj) { const pg8::f32x4 v0 = acc[ai][bj][m][0] * US, v1 = acc[ai][bj][m][1] * US;
                u32x4 w; w.x = pg8::cvt_pk_bf16(v0[0], v0[1]); w.y = pg8::cvt_pk_bf16(v0[2], v0[3]); w.z = pg8::cvt_pk_bf16(v1[0], v1[1]); w.w = pg8::cvt_pk_bf16(v1[2], v1[3]);
                *(PG8_LAS u32x4*)(wt + bj * 256) = w; }
            asm volatile("s_waitcnt lgkmcnt(0)" ::: "memory"); __builtin_amdgcn_s_barrier(); asm volatile("" ::: "memory");
            const u32x4 r0 = *(const PG8_LAS u32x4*)rt, r1 = *(const PG8_LAS u32x4*)(rt + 2 * RPITCH);
            asm volatile("s_waitcnt lgkmcnt(0)" ::: "memory"); __builtin_amdgcn_s_barrier(); asm volatile("" ::: "memory");
            bf16_t* d = obase + (size_t)(ai * 128 + m * 16) * ldc;
            *(u32x4*)d = r0; *(u32x4*)(d + (size_t)2 * ldc) = r1; }
    }
};
struct EpiDown8 {
    static constexpr bool PERM = true, AFTER_DRAIN = false;
    bf16_t* O; int ldc;
    __device__ __forceinline__ void operator()(const pg8::f32x4 (&acc)[2][2][4][2], const pg8::Unit& u, int wr, int wc, int fr, int fq) const {
        const int row0 = u.pm * 256 + wr * 64 + fr, col0 = u.pn * 256 + wc * 32 + 8 * fq;
        constexpr float US = 1.0f / (F8_SHID * F8_SW);
#pragma unroll
        for (int ai = 0; ai < 2; ++ai)
#pragma unroll
            for (int m = 0; m < 4; ++m) { bf16_t* rowp = O + (size_t)(row0 + ai * 128 + m * 16) * ldc + col0;
#pragma unroll
                for (int bj = 0; bj < 2; ++bj) { const pg8::f32x4 v0 = acc[ai][bj][m][0] * US, v1 = acc[ai][bj][m][1] * US;
                    u32x4 w; w.x = pg8::cvt_pk_bf16(v0[0], v0[1]); w.y = pg8::cvt_pk_bf16(v0[2], v0[3]); w.z = pg8::cvt_pk_bf16(v1[0], v1[1]); w.w = pg8::cvt_pk_bf16(v1[2], v1[3]);
                    *(u32x4*)(rowp + bj * 128) = w; } }
    }
};

DI float gelu_tanh(float x) { const float u2 = 2.0f * 0.7978845608028654f * (x + 0.044715f * x * x * x); const float e = fexp2(u2 * 1.4426950408889634f); return x - x * frcp(e + 1.0f); }
struct EpiGelu {
    static constexpr bool PERM = true, AFTER_DRAIN = false;
    bf16_t* O; int ldc; const float* bias;
    __device__ __forceinline__ void operator()(const pg8::f32x4 (&acc)[2][2][4][2], const pg8::Unit& u, int wr, int wc, int fr, int fq) const {
        const int row0 = u.pm * 256 + wr * 64 + fr, col0 = u.pn * 256 + wc * 32 + 8 * fq;
#pragma unroll
        for (int bj = 0; bj < 2; ++bj) { const f32x4 b0 = *(const f32x4*)(bias + col0 + bj * 128), b1 = *(const f32x4*)(bias + col0 + bj * 128 + 4);
#pragma unroll
            for (int ai = 0; ai < 2; ++ai)
#pragma unroll
                for (int m = 0; m < 4; ++m) { float h[8];
#pragma unroll
                    for (int i = 0; i < 4; ++i) { h[i] = gelu_tanh(acc[ai][bj][m][0][i] + b0[i]); h[4 + i] = gelu_tanh(acc[ai][bj][m][1][i] + b1[i]); }
                    *(u32x4*)(O + (size_t)(row0 + ai * 128 + m * 16) * ldc + col0 + bj * 128) = pack8(h); } }
    }
};


struct EpiPrep {
    static constexpr bool PERM = true, AFTER_DRAIN = false, STAGED = true;
    static constexpr int TPITCH = 272, HTILE = 32 * 272;
    unsigned char* ws_; const float* rs; float ws;
    template <class TT> __device__ __forceinline__ TT* wp(size_t off) const { return (TT*)(ws_ + off); }
    __device__ __forceinline__ static void st8(bf16_t* p, const f32x4 a, const f32x4 b) { u32x4 w; w.x = pk2(a[0], a[1]); w.y = pk2(a[2], a[3]); w.z = pk2(b[0], b[1]); w.w = pk2(b[2], b[3]); *(u32x4*)p = w; }
    __device__ __forceinline__ static f32x4 cv(const pg8::f32x4 v, float sc) { f32x4 r; r[0] = (float)__float_as_int(v[0]) * sc; r[1] = (float)__float_as_int(v[1]) * sc; r[2] = (float)__float_as_int(v[2]) * sc; r[3] = (float)__float_as_int(v[3]) * sc; return r; }
    __device__ __forceinline__ static int kind_of(int seg) {
        return (seg >= 6 && seg < 14) ? 2 : ((seg == 5 || (seg >= 22 && seg < 26) || (seg >= 34 && seg < 38) || seg == 40 || seg == 41 || seg == 44 || seg == 45) ? 1 : 0); }
    __device__ __forceinline__ void operator()(const pg8::f32x4 (&acc)[2][2][4][2], const pg8::Unit& u, int wr, int wc, int fr_in, int fq_in) const {
        int fr = fr_in, fq = fq_in; asm volatile("" : "+v"(fr), "+v"(fq));
        const int b = u.pm >> 3, tb = (u.pm & 7) * 256 + wr * 64 + fr;
        const float* rsp = rs + (size_t)b * S + tb; float nsc = rsp[0] * ws;
        if (u.pn == 23) {
            if (wc >= 2) return;
            const int dd = 8 * fq;
#pragma unroll
            for (int idx = 0; idx < 8; ++idx) { const int ai = idx >> 2, m = idx & 3, t = tb + ai * 128 + m * 16, row = b * S + t;
                const float sc = nsc; if (idx < 7) nsc = rsp[((idx + 1) >> 2) * 128 + ((idx + 1) & 3) * 16] * ws;
                const f32x4 a0 = cv(acc[ai][0][m][0], sc), a1 = cv(acc[ai][0][m][1], sc), c0 = cv(acc[ai][1][m][0], sc), c1 = cv(acc[ai][1][m][1], sc);
                if (wc == 0) { const float* cp = wp<float>(WS_COS64) + (size_t)t * 32 + dd; const float* sp = wp<float>(WS_SIN64) + (size_t)t * 32 + dd;
                    const f32x4 cs0 = *(const f32x4*)cp, cs1 = *(const f32x4*)(cp + 4), sn0 = *(const f32x4*)sp, sn1 = *(const f32x4*)(sp + 4);
                    bf16_t* d = wp<bf16_t>(WS_IK) + (size_t)row * 64 + dd; st8(d, a0 * cs0 - c0 * sn0, a1 * cs1 - c1 * sn1); st8(d + 32, c0 * cs0 + a0 * sn0, c1 * cs1 + a1 * sn1); }
                else { if (fq < 2) { float* d = wp<float>(WS_IW) + (size_t)row * 16 + dd; *(f32x4*)d = a0 * 0.03125f; *(f32x4*)(d + 4) = a1 * 0.03125f; }
                    if (fq < 3) { float* d = wp<float>(WS_GATE) + (size_t)row * 24 + dd; f32x4 g0, g1;
#pragma unroll
                        for (int i = 0; i < 4; ++i) { g0[i] = frcp(1.0f + fexp2(-1.4426950408889634f * c0[i])); g1[i] = frcp(1.0f + fexp2(-1.4426950408889634f * c1[i])); }
                        *(f32x4*)d = g0; *(f32x4*)(d + 4) = g1; } }
                __builtin_amdgcn_sched_barrier(0); }
            return;
        }
        const int seg = 2 * u.pn + (wc >> 1), kind = kind_of(seg);
        if (kind == 2) {
            const int head = 4 * (u.pn - 3) + wc, dd = 8 * fq;
#pragma unroll
            for (int idx = 0; idx < 8; ++idx) { const int ai = idx >> 2, m = idx & 3, t = tb + ai * 128 + m * 16;
                const float sc = nsc; if (idx < 7) nsc = rsp[((idx + 1) >> 2) * 128 + ((idx + 1) & 3) * 16] * ws;
                const f32x4 a0 = cv(acc[ai][0][m][0], sc), a1 = cv(acc[ai][0][m][1], sc), c0 = cv(acc[ai][1][m][0], sc), c1 = cv(acc[ai][1][m][1], sc);
                const float* cp = wp<float>(WS_COS64) + (size_t)t * 32 + dd; const float* sp = wp<float>(WS_SIN64) + (size_t)t * 32 + dd;
                const f32x4 cs0 = *(const f32x4*)cp, cs1 = *(const f32x4*)(cp + 4), sn0 = *(const f32x4*)sp, sn1 = *(const f32x4*)(sp + 4);
                bf16_t* d = wp<bf16_t>(WS_IQ) + (((size_t)b * 16 + head) * S + t) * 64 + dd; st8(d, a0 * cs0 - c0 * sn0, a1 * cs1 - c1 * sn1); st8(d + 32, c0 * cs0 + a0 * sn0, c1 * cs1 + a1 * sn1);
                __builtin_amdgcn_sched_barrier(0); }
            return;
        }
        const int d0 = 32 * (wc & 1) + 8 * fq;
        size_t dst = 0; int nh = 1, hd = 0;
        if (seg < 4) { dst = WS_AQ; nh = 4; hd = seg; } else if (seg == 4) { dst = WS_AK; } else if (seg == 5) { dst = WS_AVT; }
        else if (seg < 18) { dst = WS_BQ; nh = 4; hd = seg - 14; } else if (seg < 22) { dst = WS_BK1; nh = 4; hd = seg - 18; } else if (seg < 26) { dst = WS_BVT1; nh = 4; hd = seg - 22; }
        else if (seg < 34) { dst = WS_CQR; nh = 8; hd = seg - 26; } else if (seg < 36) { dst = WS_KC; nh = 2; hd = seg - 34; } else if (seg < 38) { dst = WS_VC; nh = 2; hd = seg - 36; }
        else if (seg < 40) { dst = WS_CKS; nh = 2; hd = seg - 38; } else if (seg < 42) { dst = WS_CVST; nh = 2; hd = seg - 40; } else if (seg < 44) { dst = WS_CKW; nh = 2; hd = seg - 42; } else { dst = WS_CVWT; nh = 2; hd = seg - 44; }
        bf16_t* dbase = wp<bf16_t>(dst) + ((size_t)(b * nh + hd) * S) * 128 + d0;
        const bool cq = (seg >= 26 && seg < 34);
        bf16_t* qbase = wp<bf16_t>(WS_CQ) + ((size_t)(b * 8 + (seg - 26)) * S) * 128 + d0;
        const float* cb = wp<float>(WS_COS128) + d0; const float* sb = wp<float>(WS_SIN128) + d0;
        f32x4 ncs0 = *(const f32x4*)(cb + (size_t)tb * 64), ncs1 = *(const f32x4*)(cb + (size_t)tb * 64 + 4), nsn0 = *(const f32x4*)(sb + (size_t)tb * 64), nsn1 = *(const f32x4*)(sb + (size_t)tb * 64 + 4);
#pragma unroll
        for (int idx = 0; idx < 8; ++idx) { const int ai = idx >> 2, m = idx & 3, t = tb + ai * 128 + m * 16;
            const float sc = nsc; if (idx < 7) nsc = rsp[((idx + 1) >> 2) * 128 + ((idx + 1) & 3) * 16] * ws;
            const f32x4 a0 = cv(acc[ai][0][m][0], sc), a1 = cv(acc[ai][0][m][1], sc), c0 = cv(acc[ai][1][m][0], sc), c1 = cv(acc[ai][1][m][1], sc);
            bf16_t* d = dbase + (size_t)t * 128;
            const f32x4 cs0 = ncs0, cs1 = ncs1, sn0 = nsn0, sn1 = nsn1;
            if (idx < 7) { const size_t tn = (size_t)(tb + ((idx + 1) >> 2) * 128 + ((idx + 1) & 3) * 16) * 64;
                ncs0 = *(const f32x4*)(cb + tn); ncs1 = *(const f32x4*)(cb + tn + 4); nsn0 = *(const f32x4*)(sb + tn); nsn1 = *(const f32x4*)(sb + tn + 4); }
            if (kind == 0) {
                st8(d, a0 * cs0 - c0 * sn0, a1 * cs1 - c1 * sn1); st8(d + 64, c0 * cs0 + a0 * sn0, c1 * cs1 + a1 * sn1);
                if (cq) { bf16_t* q = qbase + (size_t)t * 128; st8(q, a0 * QSCALE, a1 * QSCALE); st8(q + 64, c0 * QSCALE, c1 * QSCALE); } }
            else { st8(d, a0, a1); st8(d + 64, c0, c1); }
            __builtin_amdgcn_sched_barrier(0); }
    }
    __device__ __forceinline__ static void seg_dst(int seg, size_t& dst, int& nh, int& hd) {
        dst = 0; nh = 1; hd = 0;
        if (seg < 4) { dst = WS_AQ; nh = 4; hd = seg; } else if (seg == 4) { dst = WS_AK; } else if (seg == 5) { dst = WS_AVT; }
        else if (seg < 18) { dst = WS_BQ; nh = 4; hd = seg - 14; } else if (seg < 22) { dst = WS_BK1; nh = 4; hd = seg - 18; } else if (seg < 26) { dst = WS_BVT1; nh = 4; hd = seg - 22; }
        else if (seg < 34) { dst = WS_CQR; nh = 8; hd = seg - 26; } else if (seg < 36) { dst = WS_KC; nh = 2; hd = seg - 34; } else if (seg < 38) { dst = WS_VC; nh = 2; hd = seg - 36; }
        else if (seg < 40) { dst = WS_CKS; nh = 2; hd = seg - 38; } else if (seg < 42) { dst = WS_CVST; nh = 2; hd = seg - 40; } else if (seg < 44) { dst = WS_CKW; nh = 2; hd = seg - 42; } else { dst = WS_CVWT; nh = 2; hd = seg - 44; }
    }
    __device__ __forceinline__ void staged(const pg8::f32x4 (&acc)[2][2][4][2], const pg8::Unit& u, int wr, int wc, int fr_in, int fq_in, PG8_LAS unsigned char* ep, int wid, int lane_in) const {
        if (u.pn == 23 || (u.pn >= 3 && u.pn <= 6)) { (*this)(acc, u, wr, wc, fr_in, fq_in); return; }
        int fr = fr_in, fq = fq_in, lane = lane_in; asm volatile("" : "+v"(fr), "+v"(fq), "+v"(lane));
        const int b = u.pm >> 3, tb = (u.pm & 7) * 256 + wr * 64 + fr;
        const float* rsp = rs + (size_t)b * S + tb; float nsc = rsp[0] * ws;
        const int seg = 2 * u.pn + (wc >> 1), kind = kind_of(seg), d0 = 32 * (wc & 1) + 8 * fq;
        size_t dstR; int nhR, hdR; seg_dst(2 * u.pn + (wid >> 2), dstR, nhR, hdR);
        bf16_t* dbaseR = wp<bf16_t>(dstR) + ((size_t)(b * nhR + hdR) * S) * 128 + (lane & 15) * 8;
        const bool cq = (seg >= 26 && seg < 34);
        bf16_t* qbase = wp<bf16_t>(WS_CQ) + ((size_t)(b * 8 + (seg - 26)) * S) * 128 + d0;
        const float* cb = wp<float>(WS_COS128) + d0; const float* sb = wp<float>(WS_SIN128) + d0;
        f32x4 ncs0 = *(const f32x4*)(cb + (size_t)tb * 64), ncs1 = *(const f32x4*)(cb + (size_t)tb * 64 + 4), nsn0 = *(const f32x4*)(sb + (size_t)tb * 64), nsn1 = *(const f32x4*)(sb + (size_t)tb * 64 + 4);
        PG8_LAS unsigned char* wt = ep + (wc >> 1) * HTILE + (wr * 16 + fr) * TPITCH + d0 * 2;
        const PG8_LAS unsigned char* rt = ep + (wid >> 2) * HTILE + ((wid & 3) * 8 + (lane >> 4)) * TPITCH + (lane & 15) * 16;
        const int rrow = (wid & 3) * 8 + (lane >> 4), tR0 = (u.pm & 7) * 256 + (rrow >> 4) * 64 + (rrow & 15);
#pragma unroll
        for (int idx = 0; idx < 8; ++idx) { const int ai = idx >> 2, m = idx & 3, t = tb + ai * 128 + m * 16;
            const float sc = nsc; if (idx < 7) nsc = rsp[((idx + 1) >> 2) * 128 + ((idx + 1) & 3) * 16] * ws;
            const f32x4 a0 = cv(acc[ai][0][m][0], sc), a1 = cv(acc[ai][0][m][1], sc), c0 = cv(acc[ai][1][m][0], sc), c1 = cv(acc[ai][1][m][1], sc);
            const f32x4 cs0 = ncs0, cs1 = ncs1, sn0 = nsn0, sn1 = nsn1;
            if (idx < 7) { const size_t tn = (size_t)(tb + ((idx + 1) >> 2) * 128 + ((idx + 1) & 3) * 16) * 64;
                ncs0 = *(const f32x4*)(cb + tn); ncs1 = *(const f32x4*)(cb + tn + 4); nsn0 = *(const f32x4*)(sb + tn); nsn1 = *(const f32x4*)(sb + tn + 4); }
            f32x4 x0, x1, y0, y1;
            if (kind == 0) { x0 = a0 * cs0 - c0 * sn0; x1 = a1 * cs1 - c1 * sn1; y0 = c0 * cs0 + a0 * sn0; y1 = c1 * cs1 + a1 * sn1;
                if (cq) { bf16_t* q = qbase + (size_t)t * 128; st8(q, a0 * QSCALE, a1 * QSCALE); st8(q + 64, c0 * QSCALE, c1 * QSCALE); } }
            else { x0 = a0; x1 = a1; y0 = c0; y1 = c1; }
            u32x4 w1, w2; w1.x = pk2(x0[0], x0[1]); w1.y = pk2(x0[2], x0[3]); w1.z = pk2(x1[0], x1[1]); w1.w = pk2(x1[2], x1[3]); w2.x = pk2(y0[0], y0[1]); w2.y = pk2(y0[2], y0[3]); w2.z = pk2(y1[0], y1[1]); w2.w = pk2(y1[2], y1[3]);
            *(PG8_LAS u32x4*)wt = w1; *(PG8_LAS u32x4*)(wt + 128) = w2;
            asm volatile("s_waitcnt lgkmcnt(0)" ::: "memory"); __builtin_amdgcn_s_barrier(); asm volatile("" ::: "memory");
            const u32x4 v0 = *(const PG8_LAS u32x4*)rt, v1 = *(const PG8_LAS u32x4*)(rt + 4 * TPITCH);
            asm volatile("s_waitcnt lgkmcnt(0)" ::: "memory"); __builtin_amdgcn_s_barrier(); asm volatile("" ::: "memory");
            bf16_t* dR = dbaseR + (size_t)(tR0 + ai * 128 + m * 16) * 128;
            *(u32x4*)dR = v0; *(u32x4*)(dR + 4 * 128) = v1; }
    }
};

constexpr int TP = 136;
DI void lds_row8(const bf16_t* tile, int tok, int ch, float (&x)[8]) { const u32x4 w = *(const u32x4*)(tile + tok * TP + ch * 8); unpack8(w, x); }
template <int HD> DI void rope_chunk(const bf16_t* tile, int tok, int ch, int hc0, const float* cs, const float* sn, int t, float scale, float (&o)[8]) {
    constexpr int NCH = HD / 8, HALF_CH = NCH / 2;
    const int cc = ch - hc0; float own[8], par[8];
    lds_row8(tile, tok, ch, own); lds_row8(tile, tok, hc0 + (cc ^ HALF_CH), par);
    const int ci = (cc & (HALF_CH - 1)) * 8; const float* cp = cs + (size_t)t * (HD / 2) + ci; const float* sp = sn + (size_t)t * (HD / 2) + ci;
    const f32x4 c0 = *(const f32x4*)cp, c1 = *(const f32x4*)(cp + 4), s0 = *(const f32x4*)sp, s1 = *(const f32x4*)(sp + 4);
    const float sg = (cc < HALF_CH) ? -1.0f : 1.0f;
#pragma unroll
    for (int e = 0; e < 4; ++e) { o[e] = (own[e] * c0[e] + sg * par[e] * s0[e]) * scale; o[4 + e] = (own[4 + e] * c1[e] + sg * par[4 + e] * s1[e]) * scale; }
}
DI void phase_prep(const Ptrs& P, unsigned char* lds) {
    bf16_t* tile = (bf16_t*)lds;
    const bf16_t* Pm = wsp<bf16_t>(P, WS_P);
    const float* c128 = wsp<float>(P, WS_COS128); const float* s128 = wsp<float>(P, WS_SIN128); const float* c64 = wsp<float>(P, WS_COS64); const float* s64 = wsp<float>(P, WS_SIN64);
    const int tid = otid(), tok = tid >> 4, ch = tid & 15;
    for (int it = blockIdx.x; it < (T / 32) * NSEG; it += gridDim.x) {
        const int tl = it / NSEG, seg = it % NSEG, b = tl >> 6, s0 = (tl & 63) * 32, t = s0 + tok; const size_t row = (size_t)b * S + t;
        *(u32x4*)(tile + tok * TP + ch * 8) = *(const u32x4*)(Pm + row * NPAD + seg * 128 + ch * 8);
        __syncthreads();
        float o[8];
        if (seg < 4) { rope_chunk<128>(tile, tok, ch, 0, c128, s128, t, 1.0f, o); *(u32x4*)(wsp<bf16_t>(P, WS_AQ) + (((size_t)b * 4 + seg) * S + t) * 128 + ch * 8) = pack8(o); }
        else if (seg == 4) { rope_chunk<128>(tile, tok, ch, 0, c128, s128, t, 1.0f, o); *(u32x4*)(wsp<bf16_t>(P, WS_AK) + row * 128 + ch * 8) = pack8(o); }
        else if (seg == 5) { *(u32x4*)(wsp<bf16_t>(P, WS_AVT) + row * 128 + ch * 8) = *(const u32x4*)(tile + tok * TP + ch * 8); }
        else if (seg < 14) { const int hc0 = ch & 8, head = 2 * (seg - 6) + (ch >> 3); rope_chunk<64>(tile, tok, ch, hc0, c64, s64, t, 1.0f, o);
            *(u32x4*)(wsp<bf16_t>(P, WS_IQ) + (((size_t)b * 16 + head) * S + t) * 64 + (ch & 7) * 8) = pack8(o); }
        else if (seg < 18) { rope_chunk<128>(tile, tok, ch, 0, c128, s128, t, 1.0f, o); *(u32x4*)(wsp<bf16_t>(P, WS_BQ) + (((size_t)b * 4 + (seg - 14)) * S + t) * 128 + ch * 8) = pack8(o); }
        else if (seg < 22) { rope_chunk<128>(tile, tok, ch, 0, c128, s128, t, 1.0f, o); const u32x4 w = pack8(o); const size_t hb = ((size_t)b * 4 + (seg - 18)) * S;
            *(u32x4*)(wsp<bf16_t>(P, WS_BK1) + (hb + t) * 128 + ch * 8) = w;
            *(u32x4*)(wsp<bf16_t>(P, WS_BK4) + (hb + (t & 3) * 512 + (t >> 2)) * 128 + ch * 8) = w;
            *(u32x4*)(wsp<bf16_t>(P, WS_BK16) + (hb + (t & 15) * 128 + (t >> 4)) * 128 + ch * 8) = w; }
        else if (seg < 26) { const u32x4 w = *(const u32x4*)(tile + tok * TP + ch * 8); const size_t hb = ((size_t)b * 4 + (seg - 22)) * S;
            *(u32x4*)(wsp<bf16_t>(P, WS_BVT1) + (hb + t) * 128 + ch * 8) = w;
            *(u32x4*)(wsp<bf16_t>(P, WS_BVT4) + (hb + (t & 3) * 512 + (t >> 2)) * 128 + ch * 8) = w;
            *(u32x4*)(wsp<bf16_t>(P, WS_BVT16) + (hb + (t & 15) * 128 + (t >> 4)) * 128 + ch * 8) = w; }
        else if (seg < 34) { const size_t hb = (((size_t)b * 8 + (seg - 26)) * S + t) * 128 + ch * 8; float x[8]; lds_row8(tile, tok, ch, x);
#pragma unroll
            for (int e = 0; e < 8; ++e) x[e] *= QSCALE;
            *(u32x4*)(wsp<bf16_t>(P, WS_CQ) + hb) = pack8(x);
            rope_chunk<128>(tile, tok, ch, 0, c128, s128, t, 1.0f, o); *(u32x4*)(wsp<bf16_t>(P, WS_CQR) + hb) = pack8(o); }
        else if (seg < 36) { *(u32x4*)(wsp<bf16_t>(P, WS_KC) + (((size_t)b * 2 + (seg - 34)) * S + t) * 128 + ch * 8) = *(const u32x4*)(tile + tok * TP + ch * 8); }
        else if (seg < 38) { *(u32x4*)(wsp<bf16_t>(P, WS_VC) + (((size_t)b * 2 + (seg - 36)) * S + t) * 128 + ch * 8) = *(const u32x4*)(tile + tok * TP + ch * 8); }
        else if (seg < 40) { rope_chunk<128>(tile, tok, ch, 0, c128, s128, t, 1.0f, o); *(u32x4*)(wsp<bf16_t>(P, WS_CKS) + (((size_t)b * 2 + (seg - 38)) * S + t) * 128 + ch * 8) = pack8(o); }
        else if (seg < 42) { *(u32x4*)(wsp<bf16_t>(P, WS_CVST) + (((size_t)b * 2 + (seg - 40)) * S + t) * 128 + ch * 8) = *(const u32x4*)(tile + tok * TP + ch * 8); }
        else if (seg < 44) { rope_chunk<128>(tile, tok, ch, 0, c128, s128, t, 1.0f, o); *(u32x4*)(wsp<bf16_t>(P, WS_CKW) + (((size_t)b * 2 + (seg - 42)) * S + t) * 128 + ch * 8) = pack8(o); }
        else if (seg < 46) { *(u32x4*)(wsp<bf16_t>(P, WS_CVWT) + (((size_t)b * 2 + (seg - 44)) * S + t) * 128 + ch * 8) = *(const u32x4*)(tile + tok * TP + ch * 8); }
        else {
            if (ch < 8) { rope_chunk<64>(tile, tok, ch, 0, c64, s64, t, 1.0f, o); *(u32x4*)(wsp<bf16_t>(P, WS_IK) + row * 64 + ch * 8) = pack8(o); }
            else if (ch < 10) { float x[8]; lds_row8(tile, tok, ch, x); float* d = wsp<float>(P, WS_IW) + row * 16 + (ch - 8) * 8;
                *(f32x4*)d = (f32x4){x[0], x[1], x[2], x[3]} * 0.03125f; *(f32x4*)(d + 4) = (f32x4){x[4], x[5], x[6], x[7]} * 0.03125f; }
            else if (ch < 13) { float x[8]; lds_row8(tile, tok, ch, x); float* d = wsp<float>(P, WS_GATE) + row * 24 + (ch - 10) * 8;
#pragma unroll
                for (int e = 0; e < 8; ++e) x[e] = frcp(1.0f + fexp2(-1.4426950408889634f * x[e]));
                *(f32x4*)d = (f32x4){x[0], x[1], x[2], x[3]}; *(f32x4*)(d + 4) = (f32x4){x[4], x[5], x[6], x[7]}; }
        }
        __syncthreads();
    }
}

DI void a1_item(const Ptrs& P, int it) {
    const int wid = otid() >> 6, lane = otid() & 63, c = lane & 15, q4 = lane >> 4;
    const int b = it & 7; int rem = it >> 3, qblk = 15, np = 2;
    for (;; --qblk) { np = ((((qblk + 2) >> 1) + 1) >> 1); if (rem < np) break; rem -= np; }
    const int nk = (qblk + 2) >> 1, kb_lo = rem * nk / np, kb_hi = (rem + 1) * nk / np - 1, t0 = qblk * 128 + wid * 16, t = t0 + c;
    const bf16_t* IQ = wsp<bf16_t>(P, WS_IQ); const bf16_t* IK = wsp<bf16_t>(P, WS_IK); const float* IW = wsp<float>(P, WS_IW); float* SC = wsp<float>(P, WS_SC);
    bf16x8 iq[16][2]; float w[16];
#pragma unroll
    for (int h = 0; h < 16; ++h) { const bf16_t* p = IQ + (((size_t)b * 16 + h) * S + t) * 64 + 8 * q4; iq[h][0] = *(const bf16x8*)p; iq[h][1] = *(const bf16x8*)(p + 32); }
#pragma unroll
    for (int h4 = 0; h4 < 4; ++h4) { const f32x4 v = *(const f32x4*)(IW + ((size_t)b * S + t) * 16 + 4 * h4); w[4 * h4] = v[0]; w[4 * h4 + 1] = v[1]; w[4 * h4 + 2] = v[2]; w[4 * h4 + 3] = v[3]; }
    const int k16_lo = kb_lo * 16; int k16_hi = kb_hi * 16 + 15; const int lim = (t0 + 15) >> 4; if (k16_hi > lim) k16_hi = lim;
    const bf16_t* kp = IK + ((size_t)b * S + k16_lo * 16 + c) * 64 + 8 * q4;
    bf16x8 nk0 = *(const bf16x8*)kp, nk1 = *(const bf16x8*)(kp + 32);
    for (int k16 = k16_lo; k16 <= k16_hi; ++k16) {
        const bf16x8 k0 = nk0, k1 = nk1;
        if (k16 < k16_hi) { kp += 16 * 64; nk0 = *(const bf16x8*)kp; nk1 = *(const bf16x8*)(kp + 32); }
        f32x4 acc = (f32x4){0.f, 0.f, 0.f, 0.f};
#pragma unroll
        for (int h = 0; h < 16; ++h) { f32x4 s = (f32x4){0.f, 0.f, 0.f, 0.f}; s = MFMA16(k0, iq[h][0], s); s = MFMA16(k1, iq[h][1], s);
#pragma unroll
            for (int j = 0; j < 4; ++j) acc[j] += w[h] * fmaxf(s[j], 0.f); }
        *(f32x4*)(SC + ((size_t)b * S + t) * S + k16 * 16 + 4 * q4) = acc;
    }
}

DI void a2_load(const Ptrs& P, int row, int lane, unsigned (&raw)[32]) {
    const int t = row & (S - 1); const float* sc = wsp<float>(P, WS_SC) + (size_t)row * S;
#pragma unroll
    for (int i = 0; i < 32; ++i) { const int key = 64 * i + lane; raw[i] = __float_as_uint(sc[(key <= t) ? key : lane]); }
}
DI void a2_select(const Ptrs& P, int row  , int lane, const unsigned (&raw)[32]) {
    const int t = row & (S - 1);
    unsigned long long* bits = wsp<unsigned long long>(P, WS_BITS) + (size_t)row * 32;
    unsigned long long mine = 0ull;
    if (t < 256) {
#pragma unroll
        for (int i = 0; i < 32; ++i) { const unsigned long long m = __ballot(64 * i + lane <= t); if (lane == i) mine = m; }
    } else {
        unsigned u[32];
#pragma unroll
        for (int i = 0; i < 32; ++i) { const int key = 64 * i + lane; const unsigned bts = raw[i]; const unsigned x = (bts & 0x80000000u) ? ~bts : (bts | 0x80000000u); u[i] = (key <= t) ? x : 0u; }
        unsigned prefix = 0u; bool exact = false;
        for (int bit = 31; bit >= 0; --bit) { const unsigned cand = prefix | (1u << bit); int cnt = 0;
#pragma unroll
            for (int i = 0; i < 32; ++i) cnt += __builtin_popcountll(__ballot(u[i] >= cand));
            if (cnt >= 256) prefix = cand;
            if (cnt == 256) { exact = true; break; } }
        int cgt = 0;
        if (exact) prefix -= 1u;
#pragma unroll
        for (int i = 0; i < 32; ++i) cgt += __builtin_popcountll(__ballot(u[i] > prefix));
        const int need = 256 - cgt; int carried = 0; const unsigned long long lt = (lane == 0) ? 0ull : (~0ull >> (64 - lane));
#pragma unroll
        for (int i = 0; i < 32; ++i) { const bool eq = (u[i] == prefix); const unsigned long long meq = __ballot(eq);
            const int rk = carried + __builtin_popcountll(meq & lt); carried += __builtin_popcountll(meq);
            const bool sel = ((u[i] > prefix) || (eq && rk < need)) && (64 * i + lane <= t);
            const unsigned long long m = __ballot(sel); if (lane == i) mine = m; }
    }
    if (lane < 32) bits[lane] = mine;
}
DI void a2_item(const Ptrs& P, int j) {
    const int lane = otid() & 63, wid = otid() >> 6, base = (T - 1) - 32 * j - wid;
    unsigned ra[32], rb[32];
    a2_load(P, base, lane, ra);
    a2_load(P, base - 8, lane, rb);  a2_select(P, base, lane, ra);
    a2_load(P, base - 16, lane, ra); a2_select(P, base - 8, lane, rb);
    a2_load(P, base - 24, lane, rb); a2_select(P, base - 16, lane, ra);
    a2_select(P, base - 24, lane, rb);
}
DI void c1b_item(const Ptrs& P, int it) {
    const int wid = otid() >> 6, lane = otid() & 63, c = lane & 15, q4 = lane >> 4;
    const int kv = it >> 4, rt = (it & 15) * 8 + wid, row = 16 * rt + c, bg = row >> 7, cc = row & 127;
    const bf16_t* A = wsp<bf16_t>(P, kv ? WS_G1V : WS_G1K) + (size_t)row * 256 + 8 * q4;
    const bf16_t* Bt = wsp<bf16_t>(P, kv ? WS_CW2V : WS_CW2K) + (size_t)c * 256 + 8 * q4;
    f32x4 acc[8];
#pragma unroll
    for (int n = 0; n < 8; ++n) acc[n] = (f32x4){0.f, 0.f, 0.f, 0.f};
#pragma unroll
    for (int ks = 0; ks < 8; ++ks) { const bf16x8 a = *(const bf16x8*)(A + 32 * ks);
#pragma unroll
        for (int n = 0; n < 8; ++n) { const bf16x8 bt = *(const bf16x8*)(Bt + (size_t)(16 * n) * 256 + 32 * ks); acc[n] = MFMA16(bt, a, acc[n]); } }
    const bool zr = (cc == 127);
    if (!kv) { bf16_t* dst = wsp<bf16_t>(P, WS_KCC) + ((size_t)bg * 128 + cc) * 128;
#pragma unroll
        for (int n = 0; n < 8; ++n) { u32x2 w; w.x = zr ? 0u : pk2(acc[n][0], acc[n][1]); w.y = zr ? 0u : pk2(acc[n][2], acc[n][3]); *(u32x2*)(dst + 16 * n + 4 * q4) = w; }
    } else { bf16_t* dst = wsp<bf16_t>(P, WS_VCT) + ((size_t)bg * 4 + (cc >> 5)) * 4096 + (cc & 31);
#pragma unroll
        for (int n = 0; n < 8; ++n)
#pragma unroll
            for (int j = 0; j < 4; ++j) dst[(16 * n + 4 * q4 + j) * 32] = zr ? (bf16_t)0 : (bf16_t)(pk2(acc[n][j], 0.f) & 0xffffu);
    }
}

DI void load_q(bf16x8 (&qf)[4], const bf16_t* qrow, int q4) {
#pragma unroll
    for (int ks = 0; ks < 4; ++ks) qf[ks] = *(const bf16x8*)(qrow + 32 * ks + 8 * q4);
}
DI void c2_item(const Ptrs& P, int it, unsigned char* lds) {
    const int wid = otid() >> 6, lane = otid() & 63, c = lane & 15, q4 = lane >> 4, r16 = lane & 15;
    const int bg = it >> 4, b = bg >> 1, g = bg & 1, t0 = (it & 15) * 128 + wid * 16, t = t0 + c, kr0 = 8 * (r16 >> 2) + (r16 & 3);
    constexpr int KP = 136;
    bf16_t* Kl = (bf16_t*)(lds + 32768); bf16_t* Vl = (bf16_t*)(lds + 32768 + 128 * KP * 2);
    { const int tid = otid(); const bf16_t* Kg = wsp<bf16_t>(P, WS_KCC) + (size_t)bg * 128 * 128; const bf16_t* Vg = wsp<bf16_t>(P, WS_VCT) + (size_t)bg * 4 * 4096;
      __syncthreads();
#pragma unroll
      for (int i = 0; i < 4; ++i) { const int e = (tid + 512 * i) * 8, row = e >> 7, col = e & 127; *(u32x4*)(Kl + row * KP + col) = *(const u32x4*)(Kg + e); *(u32x4*)(Vl + e) = *(const u32x4*)(Vg + e); }
      __syncthreads(); }
    const LAS bf16_t* KCC = (const LAS bf16_t*)Kl + kr0 * KP + 8 * q4; const LAS bf16_t* VCT = (const LAS bf16_t*)Vl + r16 * 32 + 8 * q4;
    const float* gates = wsp<float>(P, WS_GATE) + ((size_t)b * S + t) * 24;
    const int cmax = (t >= 31) ? ((t - 31) >> 4) : -1;
    f32x4 ia[4][2];
#pragma unroll
    for (int kt = 0; kt < 4; ++kt) { ia[kt][0] = (f32x4){0.f, 0.f, 0.f, 0.f}; ia[kt][1] = (f32x4){0.f, 0.f, 0.f, 0.f}; }
    bf16x8 qfa[4][4]; float g0a[4];
#pragma unroll
    for (int rr = 0; rr < 4; ++rr) { load_q(qfa[rr], wsp<bf16_t>(P, WS_CQ) + (((size_t)b * 8 + g * 4 + rr) * S + t) * 128, q4); g0a[rr] = gates[(g * 4 + rr) * 3 + 0]; }
#pragma unroll
    for (int rr = 0; rr < 4; ++rr) {
        const int hh = g * 4 + rr;
        asm volatile("" : "+v"(KCC), "+v"(VCT));
        bf16x8 qf[4];
#pragma unroll
        for (int ks = 0; ks < 4; ++ks) qf[ks] = qfa[rr][ks];
        f32x4 s[4][2]; float mx = NEG;
#pragma unroll
        for (int kt = 0; kt < 4; ++kt)
#pragma unroll
            for (int sub = 0; sub < 2; ++sub) { f32x4 a = (f32x4){0.f, 0.f, 0.f, 0.f};
#pragma unroll
                for (int ks = 0; ks < 4; ++ks) { const bf16x8 kf = *(const LAS bf16x8*)(KCC + (32 * kt + 4 * sub) * KP + 32 * ks); a = MFMA16(kf, qf[ks], a); }
#pragma unroll
                for (int j = 0; j < 4; ++j) { const int cc = 32 * kt + 8 * q4 + 4 * sub + j; const bool ok = (cc <= cmax) && (cc < 127); a[j] = ok ? a[j] : NEG; mx = fmaxf(mx, a[j]); }
                s[kt][sub] = a; __builtin_amdgcn_sched_barrier(0); }
        mx = fmaxf(mx, __shfl_xor(mx, 16)); mx = fmaxf(mx, __shfl_xor(mx, 32));
        float den = 0.f;
#pragma unroll
        for (int kt = 0; kt < 4; ++kt)
#pragma unroll
            for (int sub = 0; sub < 2; ++sub)
#pragma unroll
                for (int j = 0; j < 4; ++j) { const float e = (s[kt][sub][j] > -5.0e29f) ? fexp2(s[kt][sub][j] - mx) : 0.f; s[kt][sub][j] = e; den += e; }
        den += __shfl_xor(den, 16); den += __shfl_xor(den, 32);
        const float inv = den > 0.f ? 1.0f / den : 0.f;
        f32x4 o[8];
#pragma unroll
        for (int db = 0; db < 8; ++db) o[db] = (f32x4){0.f, 0.f, 0.f, 0.f};
#pragma unroll
        for (int kt = 0; kt < 4; ++kt) { float p[8];
#pragma unroll
            for (int sub = 0; sub < 2; ++sub) { s[kt][sub] = s[kt][sub] * inv; ia[kt][sub] += s[kt][sub];
#pragma unroll
                for (int j = 0; j < 4; ++j) p[4 * sub + j] = s[kt][sub][j]; }
            const u32x4 pw = pack8(p); const bf16x8 pb = __builtin_bit_cast(bf16x8, pw);
#pragma unroll
            for (int db = 0; db < 8; ++db) { const bf16x8 vf = *(const LAS bf16x8*)(VCT + kt * 4096 + (16 * db) * 32); o[db] = MFMA16(vf, pb, o[db]); }
            __builtin_amdgcn_sched_barrier(0); }
        const float g0 = g0a[rr]; bf16_t* dst = wsp<bf16_t>(P, WS_OC) + ((size_t)b * S + t) * 1024 + hh * 128;
#pragma unroll
        for (int db = 0; db < 8; ++db) { u32x2 w; w.x = pk2(o[db][0] * g0, o[db][1] * g0); w.y = pk2(o[db][2] * g0, o[db][3] * g0); *(u32x2*)(dst + 16 * db + 4 * q4) = w; }
    }
    float* impw = (float*)lds + wid * (16 * 33);
#pragma unroll
    for (int kt = 0; kt < 4; ++kt) {
        const float own = __shfl(ia[kt][1][3], (lane + 48) & 63);
        const float wrp = (kt > 0) ? __shfl(ia[kt > 0 ? kt - 1 : 0][1][3], (lane + 48) & 63) : 0.f;
        const float prev0 = (q4 == 0) ? wrp : own;
        const float v0 = (ia[kt][0][0] + ia[kt][0][1]) + (ia[kt][0][2] + ia[kt][0][3]) + prev0;
        const float v1 = (ia[kt][1][0] + ia[kt][1][1]) + (ia[kt][1][2] + ia[kt][1][3]) + ia[kt][0][3];
        impw[c * 33 + 8 * kt + 2 * q4] = v0; impw[c * 33 + 8 * kt + 2 * q4 + 1] = v1;
    }
    asm volatile("s_waitcnt lgkmcnt(0)" ::: "memory");
    __builtin_amdgcn_wave_barrier();
    const int cur = t >> 6; unsigned key[32];
#pragma unroll
    for (int n = 0; n < 32; ++n) { const float x = impw[c * 33 + n]; const float v = (n > cur) ? -__builtin_inff() : ((n == 0 || n == cur || n + 1 == cur) ? __builtin_inff() : x);
        const unsigned bts = __float_as_uint(v); const unsigned o = (bts & 0x80000000u) ? ~bts : (bts | 0x80000000u); key[n] = (o & ~31u) | (unsigned)(31 - n); }
    unsigned selbits = 0u;
#pragma unroll
    for (int e = 0; e < 8; ++e) { const int myn = 8 * q4 + e; const float x = impw[c * 33 + myn];
        const float v = (myn > cur) ? -__builtin_inff() : ((myn == 0 || myn == cur || myn + 1 == cur) ? __builtin_inff() : x);
        const unsigned bts = __float_as_uint(v); const unsigned o = (bts & 0x80000000u) ? ~bts : (bts | 0x80000000u); const unsigned km = (o & ~31u) | (unsigned)(31 - myn);
        int rank = 0;
#pragma unroll
        for (int n = 0; n < 32; ++n) rank += (key[n] > km) ? 1 : 0;
        if (rank < 16) selbits |= 1u << myn; }
    selbits |= __shfl_xor(selbits, 16); selbits |= __shfl_xor(selbits, 32);
    if (q4 == 0) wsp<unsigned>(P, WS_SEL)[(size_t)bg * S + t] = selbits;
    __builtin_amdgcn_wave_barrier();
}


enum { FK_B1 = 0, FK_B4 = 1, FK_B16 = 2, FK_C5 = 3, FK_C4 = 4, FK_A3 = 5 };
DI fa::BlockRef fa_ref(const Ptrs& P, int kind, int idx) {
    fa::BlockRef r; r.LSE = nullptr; r.aux = nullptr; r.lstr = 0; r.m = S; r.ecode = 0;
    if (kind <= FK_B16) {
        const int bh = idx & 31, pb = idx >> 5, b = bh >> 2, h = bh & 3; const size_t hb = (size_t)bh * S * 128, tb = (size_t)b * S;
        r.Q = wsp<bf16_t>(P, WS_BQ) + hb;
        r.K = wsp<bf16_t>(P, WS_BK1) + hb; r.V = wsp<bf16_t>(P, WS_BVT1) + hb;
        r.O = wsp<bf16_t>(P, kind == FK_B1 ? WS_OB1 : (kind == FK_B4 ? WS_OB4 : WS_OB16)) + tb * 512 + h * 128; r.ldo = 512;
        r.LSE = wsp<float>(P, kind == FK_B1 ? WS_LSE1 : (kind == FK_B4 ? WS_LSE4 : WS_LSE16)) + tb * 4 + h; r.lstr = 4;
        r.P0 = pb * 256; r.mode = fa::M_WIN; r.Wu = 129; r.m = (kind == FK_B1) ? S : (kind == FK_B4 ? S / 4 : S / 16);
        if (kind == FK_B1) { r.O = wsp<bf16_t>(P, WS_MIX) + tb * DM + 512 + h * 128; r.ldo = DM; r.LSE = nullptr; r.ecode = 3 | (h << 4) | (b << 8); }
    } else if (kind == FK_C5 || kind == FK_C4) {
        const int bhh = idx & 63, qb = 7 - (idx >> 6), b = bhh >> 3, hh = bhh & 7, g = hh >> 2; const size_t gb = ((size_t)b * 2 + g) * S * 128, tb = (size_t)b * S;
        r.Q = wsp<bf16_t>(P, WS_CQR) + (size_t)bhh * S * 128;
        r.K = wsp<bf16_t>(P, kind == FK_C5 ? WS_CKW : WS_CKS) + gb; r.V = wsp<bf16_t>(P, kind == FK_C5 ? WS_CVWT : WS_CVST) + gb;
        r.O = wsp<bf16_t>(P, kind == FK_C5 ? WS_OWIN : WS_OSLC) + tb * 1024 + hh * 128; r.ldo = 1024;
        r.P0 = qb * 256; r.mode = (kind == FK_C5) ? fa::M_WIN : fa::M_SEL; r.Wu = (kind == FK_C5) ? 512 : 0x40000000;
        r.aux = wsp<unsigned>(P, WS_SEL) + ((size_t)b * 2 + g) * S;
        if (kind == FK_C4) { r.O = wsp<bf16_t>(P, WS_MIX) + tb * DM + 1024 + hh * 128; r.ldo = DM; r.ecode = 2 | (hh << 4) | (b << 8); }
    } else {
        const int bh = idx & 31, qb = 7 - (idx >> 5), b = bh >> 2, h = bh & 3; const size_t tb = (size_t)b * S;
        r.Q = wsp<bf16_t>(P, WS_AQ) + (size_t)bh * S * 128; r.K = wsp<bf16_t>(P, WS_AK) + tb * 128; r.V = wsp<bf16_t>(P, WS_AVT) + tb * 128;
        r.O = wsp<bf16_t>(P, WS_MIX) + tb * DM + h * 128; r.ldo = DM;
        r.P0 = qb * 256; r.mode = fa::M_BITS; r.Wu = 0x40000000; r.aux = wsp<unsigned>(P, WS_BITS) + tb * 64;
    }
    return r;
}
struct FaList { int kind[4]; int n[4]; int ng; };
DI fa::BlockRef fa_list_ref(const Ptrs& P, const FaList& L, int i) {
    int g = 0;
#pragma unroll
    for (int k = 0; k < 3; ++k) if (g == k && k + 1 < L.ng && i >= L.n[k]) { i -= L.n[k]; g = k + 1; }
    const int kind = (g == 0) ? L.kind[0] : (g == 1 ? L.kind[1] : (g == 2 ? L.kind[2] : L.kind[3]));
    return fa_ref(P, kind, i);
}
struct FaNext {
    const Ptrs* P; const FaList* L; unsigned* ctr; unsigned char* lds; int total, tid; bool last;
    DI fa::BlockRef operator()(const fa::BlockRef& cur) { const int ni = q_next(ctr, lds, tid); last = ni >= total; return last ? cur : fa_list_ref(*P, *L, ni); }
};
DI void fa_stream(const Ptrs& P, const FaList& L, unsigned* ctr, unsigned char* lds) {
    const int tid = otid();
    int total = 0;
#pragma unroll
    for (int k = 0; k < 4; ++k) if (k < L.ng) total += L.n[k];
    const int i = q_next(ctr, lds, tid);
    if (i >= total) return;
    fa::BlockRef cur = fa_list_ref(P, L, i), nxt = cur;
    fa::Seam Sm;
    fa::prime(cur, (char*)lds, Sm, tid);
    fa::EpiPtrs ep; ep.oc = wsp<bf16_t>(P, WS_OC); ep.owin = wsp<bf16_t>(P, WS_OWIN); ep.gate = wsp<float>(P, WS_GATE); ep.ob4 = wsp<bf16_t>(P, WS_OB4); ep.ob16 = wsp<bf16_t>(P, WS_OB16); ep.lse4 = wsp<float>(P, WS_LSE4); ep.lse16 = wsp<float>(P, WS_LSE16);
    FaNext nf; nf.P = &P; nf.L = &L; nf.ctr = ctr; nf.lds = lds; nf.total = total; nf.tid = tid; nf.last = false;
    for (;;) {
        fa::block(cur, nxt, nf, ep, (char*)lds, Sm, tid);
        if (nf.last) break;
        cur = nxt;
    }
}

DI void phase_merge(const Ptrs& P) {
    const int tid = otid(), lane = tid & 63, gw = blockIdx.x * 8 + (tid >> 6), ngw = gridDim.x * 8;
    for (int row = gw; row < T; row += ngw) {
        bf16_t* dst = wsp<bf16_t>(P, WS_MIX) + (size_t)row * DM;
        {
            const int h = lane >> 4, col = 8 * lane;
            const float l1 = wsp<float>(P, WS_LSE1)[(size_t)row * 4 + h], l4 = wsp<float>(P, WS_LSE4)[(size_t)row * 4 + h], l16 = wsp<float>(P, WS_LSE16)[(size_t)row * 4 + h];
            const float mm = fmaxf(l1, fmaxf(l4, l16)), w1 = fexp2(l1 - mm), w4 = fexp2(l4 - mm), w16 = fexp2(l16 - mm), wi = 1.0f / (w1 + w4 + w16);
            float a[8], b4[8], c16[8], o[8];
            unpack8(*(const u32x4*)(wsp<bf16_t>(P, WS_OB1) + (size_t)row * 512 + col), a); unpack8(*(const u32x4*)(wsp<bf16_t>(P, WS_OB4) + (size_t)row * 512 + col), b4);
            unpack8(*(const u32x4*)(wsp<bf16_t>(P, WS_OB16) + (size_t)row * 512 + col), c16);
#pragma unroll
            for (int e = 0; e < 8; ++e) o[e] = (a[e] * w1 + b4[e] * w4 + c16[e] * w16) * wi;
            *(u32x4*)(dst + 512 + col) = pack8(o);
        }
#pragma unroll
        for (int j = 0; j < 2; ++j) {
            const int col = 8 * (lane + 64 * j), hh = col >> 7;
            const float* gt = wsp<float>(P, WS_GATE) + (size_t)row * 24 + hh * 3; const float g1 = gt[1], g2 = gt[2];
            float a[8], b[8], c[8], o[8];
            unpack8(*(const u32x4*)(wsp<bf16_t>(P, WS_OC) + (size_t)row * 1024 + col), a); unpack8(*(const u32x4*)(wsp<bf16_t>(P, WS_OSLC) + (size_t)row * 1024 + col), b);
            unpack8(*(const u32x4*)(wsp<bf16_t>(P, WS_OWIN) + (size_t)row * 1024 + col), c);
#pragma unroll
            for (int e = 0; e < 8; ++e) o[e] = a[e] + g1 * b[e] + g2 * c[e];
            *(u32x4*)(dst + 1024 + col) = pack8(o);
        }
    }
}

constexpr int NPH = 13;
constexpr int NPHASES = 1 + DEPTH * NPH;
struct Args { const float* in[16]; float* out; unsigned char* ws; int ph_lo, ph_hi; };

__global__ void __launch_bounds__(512, 2) fwd(Args a) {
    extern __shared__ __attribute__((aligned(16))) unsigned char lds[];
    Ptrs P;
#pragma unroll
    for (int i = 0; i < 16; ++i) P.in[i] = a.in[i];
    P.out = a.out; P.ws = a.ws;
    const int lo = a.ph_lo, hi = a.ph_hi;
    volatile LAS unsigned* bst = (volatile LAS unsigned*)((LAS unsigned char*)lds + LDS_BAR_OFF);
    if (otid() < 4) bst[otid()] = 0u;
    __syncthreads();
    XcdBarrier bar; bar.bar = (unsigned*)(P.ws + WS_CTL); bar.x = 0; bar.st = bst;
    if (hi - lo > 1) bar = xcd_barrier_post((unsigned*)(P.ws + WS_CTL), bst);
#define IN(k) (lo <= (k) && (k) < hi)
#define SEAM(k) do { if (IN(k) && IN((k) + 1)) xcd_barrier(bar); } while (0)
    if (IN(0)) { phase_rope_tables(P); for (int it = blockIdx.x; it < WMAX_ITEMS; it += gridDim.x) wmax_in_item(P, 0, it, lds); }
    SEAM(0);
    for (int layer = 0; layer < DEPTH; ++layer) {
        const int pb = 1 + layer * NPH;
        const float* xcur = (layer == 0) ? P.in[0] : P.out;
        if (layer == 0) { if (IN(pb + 0)) { phase_wconv(P, layer, lds); phase_norm<false, false, 2>(P.in[0], nullptr, nullptr, nullptr, P.in[12], wsp<bf16_t>(P, WS_H)); }
            SEAM(pb + 0); }
#if MK_DUP_PH == 100
        phase_wconv(P, layer, lds); xcd_barrier(bar);
#endif
        if (IN(pb + 1)) { pg8::Gemm g{wsp<bf16_t>(P, WS_H), wsp<bf16_t>(P, WS_WIN), T, NPAD, DM / 2}; pg8::StaticOrder So; So.init(T, NPAD, gridDim.x, blockIdx.x);
            const float wmx = __uint_as_float(__builtin_amdgcn_readfirstlane(__hip_atomic_load((unsigned*)(P.ws + WS_CTL) + CTL_WMAX + layer * 64 + 1, __ATOMIC_RELAXED, __HIP_MEMORY_SCOPE_AGENT)));
            EpiPrep E{P.ws, (const float*)(P.ws + WS_H + (size_t)T * DM), fmaxf(wmx, 1e-30f) * (1.0f / 127.0f)}; pg8::gemm_phase<EpiPrep, pg8::StaticOrder, false, 2>((LAS unsigned char*)lds, g, So, E, nullptr); }
        SEAM(pb + 1);
#if MK_DUP_PH == 101
        { pg8::Gemm g{wsp<bf16_t>(P, WS_H), wsp<bf16_t>(P, WS_WIN), T, NPAD, DM}; pg8::StaticOrder So; So.init(T, NPAD, gridDim.x, blockIdx.x);
            EpiPrep E{P.ws}; pg8::gemm_phase<EpiPrep, pg8::StaticOrder, false>((LAS unsigned char*)lds, g, So, E, nullptr); } xcd_barrier(bar);
#endif
#define ATT_BODY \
          \
        if (ATT_IN(3)) { unsigned* ctr = (unsigned*)(P.ws + WS_CTL) + 4096 + (layer * 16 + ATT_CB + 0) * 64; \
            if (ATT_PART(1) && blockIdx.x < 16) { const int kv = blockIdx.x >> 3; pg8::Gemm g{wsp<bf16_t>(P, kv ? WS_VC : WS_KC), wsp<bf16_t>(P, kv ? WS_CW1V : WS_CW1K), 2048, 256, 4096, 2048}; \
                pg8::StaticOrder So; So.init(2048, 256, 8, blockIdx.x & 7); EpiGelu E{wsp<bf16_t>(P, kv ? WS_G1V : WS_G1K), 256, wsp<float>(P, WS_CB1) + kv * 256}; \
                pg8::gemm_phase<EpiGelu, pg8::StaticOrder, false>((LAS unsigned char*)lds, g, So, E, nullptr); } \
            FaList L; L.ng = 2; L.kind[0] = FK_B4; L.n[0] = 256; L.kind[1] = FK_B16; L.n[1] = 256; L.kind[2] = 0; L.n[2] = 0; L.kind[3] = 0; L.n[3] = 0; \
            if (ATT_PART(2)) fa_stream(P, L, ctr, lds); \
            if (ATT_PART(3)) for (int it = q_next(ctr + 64, lds, otid()); it < NB * 40; it = q_next(ctr + 64, lds, otid())) a1_item(P, it); \
            conv_filler(P, layer, lds, (unsigned*)(P.ws + WS_CTL) + 8192 + (layer * 4 + 0) * 64, 0); } \
        ATT_SEAM(3); \
          \
        if (ATT_IN(4)) { unsigned* ctr = (unsigned*)(P.ws + WS_CTL) + 4096 + (layer * 16 + ATT_CB + 2) * 64; \
            FaList L; L.ng = 1; L.kind[0] = FK_B1; L.n[0] = 256; L.kind[1] = 0; L.n[1] = 0; L.kind[2] = 0; L.n[2] = 0; L.kind[3] = 0; L.n[3] = 0; \
            if (ATT_PART(2)) fa_stream(P, L, ctr, lds); \
            if (ATT_PART(3)) for (int it = q_next(ctr + 64, lds, otid()); it < T / 32 + 32; it = q_next(ctr + 64, lds, otid())) { if (it < 32) c1b_item(P, it); else a2_item(P, it - 32); } \
            conv_filler(P, layer, lds, (unsigned*)(P.ws + WS_CTL) + 8192 + (layer * 4 + 1) * 64, 1); } \
        ATT_SEAM(4); \
          \
        if (ATT_IN(5)) { unsigned* ctr = (unsigned*)(P.ws + WS_CTL) + 4096 + (layer * 16 + ATT_CB + 4) * 64; \
            FaList L; L.ng = 2; L.kind[0] = FK_A3; L.n[0] = 256; L.kind[1] = FK_C5; L.n[1] = 512; L.kind[2] = 0; L.n[2] = 0; L.kind[3] = 0; L.n[3] = 0; \
            if (ATT_PART(3)) for (int it = q_next(ctr + 64, lds, otid()); it < 256; it = q_next(ctr + 64, lds, otid())) c2_item(P, it, lds);     \
            if (ATT_PART(2)) fa_stream(P, L, ctr, lds); \
            conv_filler(P, layer, lds, (unsigned*)(P.ws + WS_CTL) + 8192 + (layer * 4 + 2) * 64, 2); } \
        ATT_SEAM(5); \
          \
        if (ATT_IN(6)) { unsigned* ctr = (unsigned*)(P.ws + WS_CTL) + 4096 + (layer * 16 + ATT_CB + 6) * 64; \
            FaList L; L.ng = 1; L.kind[0] = FK_C4; L.n[0] = 512; L.kind[1] = 0; L.n[1] = 0; L.kind[2] = 0; L.n[2] = 0; L.kind[3] = 0; L.n[3] = 0; \
            if (ATT_PART(2)) fa_stream(P, L, ctr, lds); \
            conv_filler(P, layer, lds, (unsigned*)(P.ws + WS_CTL) + 8192 + (layer * 4 + 3) * 64, 3); } \
        ATT_SEAM(6); \
          \

#define ATT_IN(k) IN(pb + (k))
#define ATT_SEAM(k) SEAM(pb + (k))
#define ATT_CB 0
#define ATT_PART(p) true
        ATT_BODY
#undef ATT_IN
#undef ATT_SEAM
#undef ATT_CB
#undef ATT_PART
#if MK_DUP_PH >= 30 && MK_DUP_PH <= 79
#define ATT_IN(k) ((k) == MK_DUP_PH / 10)
#define ATT_SEAM(k) do { if ((k) == MK_DUP_PH / 10) xcd_barrier(bar); } while (0)
#define ATT_CB 8
#define ATT_PART(p) ((p) == MK_DUP_PH % 10)
        ATT_BODY
#undef ATT_IN
#undef ATT_SEAM
#undef ATT_CB
#undef ATT_PART
#endif
#if MK_DUP_PH >= 3 && MK_DUP_PH <= 7
#define ATT_IN(k) ((k) == MK_DUP_PH)
#define ATT_SEAM(k) do { if ((k) == MK_DUP_PH) xcd_barrier(bar); } while (0)
#define ATT_CB 8
#define ATT_PART(p) true
        ATT_BODY
#undef ATT_IN
#undef ATT_SEAM
#undef ATT_CB
#undef ATT_PART
#endif
        if (IN(pb + 8)) { pg8::Gemm g{wsp<bf16_t>(P, WS_MIX), wsp<bf16_t>(P, WS_WOUT), T, DM, DM}; pg8::StaticOrder So; So.init(T, DM, gridDim.x, blockIdx.x);
            EpiRowsBf16 E{wsp<bf16_t>(P, WS_Y), DM, 1.0f}; pg8::gemm_phase<EpiRowsBf16, pg8::StaticOrder, false>((LAS unsigned char*)lds, g, So, E, nullptr); }
        SEAM(pb + 8);
#if MK_DUP_PH == 108
        { pg8::Gemm g{wsp<bf16_t>(P, WS_MIX), wsp<bf16_t>(P, WS_WOUT), T, DM, DM}; pg8::StaticOrder So; So.init(T, DM, gridDim.x, blockIdx.x);
            pg8::EpiBf16<0> E{wsp<bf16_t>(P, WS_Y), DM, nullptr, 0, 0}; pg8::gemm_phase<pg8::EpiBf16<0>, pg8::StaticOrder, false>((LAS unsigned char*)lds, g, So, E, nullptr); } xcd_barrier(bar);
#endif
        if (IN(pb + 9)) { if (layer == 0) phase_norm<false, true, 2>(P.in[0], wsp<bf16_t>(P, WS_XB), wsp<bf16_t>(P, WS_Y), P.in[13] + (size_t)layer * DM, P.in[14] + (size_t)layer * DM, wsp<bf16_t>(P, WS_H));
            else phase_norm<true, true, 2>(wsp<bf16_t>(P, WS_XB), wsp<bf16_t>(P, WS_XB), wsp<bf16_t>(P, WS_Y), P.in[13] + (size_t)layer * DM, P.in[14] + (size_t)layer * DM, wsp<bf16_t>(P, WS_H)); }
        SEAM(pb + 9);
#if MK_DUP_PH == 109
        phase_norm<true, true>(wsp<bf16_t>(P, WS_XB), wsp<bf16_t>(P, WS_BIG), wsp<bf16_t>(P, WS_Y), P.in[13] + (size_t)layer * DM, P.in[14] + (size_t)layer * DM, wsp<bf16_t>(P, WS_MIX)); xcd_barrier(bar);
#endif
        if (IN(pb + 10)) { pg8::Gemm g{wsp<bf16_t>(P, WS_H), wsp<bf16_t>(P, WS_WGU), T, NGU, DM / 2}; pg8::StaticOrder So; So.init(T, NGU, gridDim.x, blockIdx.x);
            const float wmx = __uint_as_float(__builtin_amdgcn_readfirstlane(__hip_atomic_load((unsigned*)(P.ws + WS_CTL) + CTL_WMAX + layer * 64, __ATOMIC_RELAXED, __HIP_MEMORY_SCOPE_AGENT)));
            EpiSwigluI8 E{wsp<unsigned char>(P, WS_HID), FF, (const float*)(P.ws + WS_H + (size_t)T * DM), fmaxf(wmx, 1e-30f) * (1.0f / 127.0f)}; pg8::gemm_phase<EpiSwigluI8, pg8::StaticOrder, false, 2>((LAS unsigned char*)lds, g, So, E, nullptr); }
        SEAM(pb + 10);
#if MK_DUP_PH == 110
        { pg8::Gemm g{wsp<bf16_t>(P, WS_H), wsp<bf16_t>(P, WS_WGU), T, NGU, DM}; pg8::StaticOrder So; So.init(T, NGU, gridDim.x, blockIdx.x);
            EpiSwiglu E{wsp<bf16_t>(P, WS_HID), FF}; pg8::gemm_phase<EpiSwiglu, pg8::StaticOrder, false>((LAS unsigned char*)lds, g, So, E, nullptr); } xcd_barrier(bar);
#endif
        if (IN(pb + 11)) { pg8::Gemm g{wsp<bf16_t>(P, WS_HID), wsp<bf16_t>(P, WS_WDN), T, DM, FF / 2}; pg8::StaticOrder So; So.init(T, DM, gridDim.x, blockIdx.x);
            EpiRowsBf16 E{wsp<bf16_t>(P, WS_Y), DM, 1.0f / (F8_SHID * F8_SW)}; pg8::gemm_phase<EpiRowsBf16, pg8::StaticOrder, false, 1>((LAS unsigned char*)lds, g, So, E, nullptr); }
        SEAM(pb + 11);
#if MK_DUP_PH == 111
        { pg8::Gemm g{wsp<bf16_t>(P, WS_HID), wsp<bf16_t>(P, WS_WDN), T, DM, FF}; pg8::StaticOrder So; So.init(T, DM, gridDim.x, blockIdx.x);
            pg8::EpiBf16<0> E{wsp<bf16_t>(P, WS_Y), DM, nullptr, 0, 0}; pg8::gemm_phase<pg8::EpiBf16<0>, pg8::StaticOrder, false>((LAS unsigned char*)lds, g, So, E, nullptr); } xcd_barrier(bar);
#endif
        if (IN(pb + 12)) { if (layer + 1 < DEPTH) phase_norm<true, true, 2>(wsp<bf16_t>(P, WS_XB), wsp<bf16_t>(P, WS_XB), wsp<bf16_t>(P, WS_Y), P.in[15] + (size_t)layer * DM, P.in[12] + (size_t)(layer + 1) * DM, wsp<bf16_t>(P, WS_H));
            else phase_norm<true, false>(wsp<bf16_t>(P, WS_XB), P.out, wsp<bf16_t>(P, WS_Y), P.in[15] + (size_t)layer * DM, nullptr, nullptr); }
        SEAM(pb + 12);
#if MK_DUP_PH == 120
        for (int i = 0; i < 10; ++i) xcd_barrier(bar);
#endif
    }
#undef IN
#undef SEAM
}
}

#ifndef MK_ONE_LAUNCH
#define MK_ONE_LAUNCH 1
#endif
extern "C" void kernel_launch(void* const* d_in, const int* in_sizes, int n_in, void* d_out, int out_size, void* d_ws, size_t ws_size, hipStream_t stream) {
    static int grid = 0;
    if (grid == 0) {
        if (n_in != 16 || out_size != mk::T * mk::DM || ws_size < mk::WS_END) { fprintf(stderr, "kernel_launch: unexpected shapes (n_in %d, out %d, ws %zu < %zu)\n", n_in, out_size, ws_size, (size_t)mk::WS_END); grid = -1; return; }
        int dev = 0, cus = 0, per_cu = 0;
        if (hipGetDevice(&dev) != hipSuccess || hipDeviceGetAttribute(&cus, hipDeviceAttributeMultiprocessorCount, dev) != hipSuccess) { grid = -1; return; }
        if (hipFuncSetAttribute((const void*)mk::fwd, hipFuncAttributeMaxDynamicSharedMemorySize, mk::LDS_BYTES) != hipSuccess) { fprintf(stderr, "kernel_launch: hipFuncSetAttribute failed\n"); grid = -1; return; }
        if (hipOccupancyMaxActiveBlocksPerMultiprocessor(&per_cu, (const void*)mk::fwd, 512, mk::LDS_BYTES) != hipSuccess || per_cu < 1) { fprintf(stderr, "kernel_launch: occupancy query says %d blocks per CU\n", per_cu); }
        (void)hipGetLastError();
        grid = cus;
    }
    if (grid < 0) return;
    (void)in_sizes;
    hipMemsetAsync((char*)d_ws + mk::WS_CTL, 0, mk::CTL_BYTES, stream);
    mk::Args a{};
    for (int i = 0; i < 16; ++i) a.in[i] = (const float*)d_in[i];
    a.out = (float*)d_out; a.ws = (unsigned char*)d_ws;
#if MK_ONE_LAUNCH
    a.ph_lo = 0; a.ph_hi = mk::NPHASES;
    hipLaunchKernelGGL(mk::fwd, dim3(grid), dim3(512), mk::LDS_BYTES, stream, a);
#else
    for (int ph = 0; ph < mk::NPHASES; ++ph) { a.ph_lo = ph; a.ph_hi = ph + 1; hipLaunchKernelGGL(mk::fwd, dim3(grid), dim3(512), mk::LDS_BYTES, stream, a); }
#endif
}
```
